# Optimizing an MI355X kernel written in HIP

```python
import math
import jax, jax.numpy as jnp
from jax import lax
import numpy as np

D_MODEL = 1024
BATCH = 16
SEQ = 4096
DEPTH = 4

MEM_TOKENS = 256
ROPE_THETA = 10000.0
NORM_EPS = 1e-6
Q_BLOCK = 128

MLA_HEADS = 8
MLA_Q_LORA = 256
MLA_KV_LORA = 128
MLA_NOPE_DIM = 64
MLA_ROPE_DIM = 32
MLA_V_DIM = 64

DIFF_HEADS = 8
DIFF_HEAD_DIM = 32

XATTN_HEADS = 4
XATTN_HEAD_DIM = 128

N_BRANCHES = 3
BRANCH_WIDTH = MLA_HEADS * MLA_V_DIM

IN_SPLITS = (
    MLA_Q_LORA,
    MLA_KV_LORA,
    MLA_ROPE_DIM,
    DIFF_HEADS * 2 * DIFF_HEAD_DIM,
    DIFF_HEADS * 2 * DIFF_HEAD_DIM,
    DIFF_HEADS * 2 * DIFF_HEAD_DIM,
    XATTN_HEADS * XATTN_HEAD_DIM,
    N_BRANCHES * BRANCH_WIDTH,
    N_BRANCHES * D_MODEL,
)
IN_WIDTH = sum(IN_SPLITS)
IN_OFFSETS = tuple(int(v) for v in np.cumsum(IN_SPLITS)[:-1])

kernel_name = "hybrid_mla_diffattn_memxattn_gated_block"


def rmsnorm(x, g):
    xf = x.astype(jnp.float32)
    y = xf * lax.rsqrt(jnp.mean(xf * xf, axis=-1, keepdims=True) + NORM_EPS)
    return (y * g.astype(jnp.float32)).astype(x.dtype)


def rope_tables(positions, dim):
    inv = ROPE_THETA ** (-jnp.arange(0, dim, 2, dtype=jnp.float32) / dim)
    ang = positions.astype(jnp.float32)[:, None] * inv[None, :]
    return jnp.cos(ang), jnp.sin(ang)


def apply_rope(x, cos, sin):
    half = x.shape[-1] // 2
    x1, x2 = x[..., :half], x[..., half:]
    c, s = cos.astype(x.dtype), sin.astype(x.dtype)
    return jnp.concatenate([x1 * c - x2 * s, x2 * c + x1 * s], axis=-1)


def causal_map_attention(q, k, v, coef, scale):
    B, G, H, S, Dk = q.shape
    n_blk = S // Q_BLOCK
    qb = jnp.moveaxis(q.reshape(B, G, H, n_blk, Q_BLOCK, Dk), 3, 0)
    key_pos = jnp.arange(S)
    coef32 = coef.astype(jnp.float32)

    def one_block(args):
        q_blk, start = args
        s = jnp.einsum('bghqd,bghkd->bghqk', q_blk, k).astype(jnp.float32) * scale
        q_pos = start + jnp.arange(Q_BLOCK)
        mask = key_pos[None, :] <= q_pos[:, None]
        s = jnp.where(mask, s, -jnp.inf)
        p = jax.nn.softmax(s, axis=-1)
        p = jnp.einsum('g,bghqk->bhqk', coef32, p)
        return jnp.einsum('bhqk,bhkd->bhqd', p.astype(v.dtype), v)

    starts = jnp.arange(n_blk) * Q_BLOCK
    o = lax.map(one_block, (qb, starts))
    return jnp.moveaxis(o, 0, 2).reshape(B, H, S, v.shape[-1])


def hybrid_layer(x, mem, cos_r, sin_r, cos_d, sin_d, lam_init,
                 norm_pre, norm_post, w_in, q_norm, w_uq, kv_norm, w_ukv,
                 lambda_q1, lambda_k1, lambda_q2, lambda_k2, diff_subln,
                 mem_norm, w_mem_kv, b_gate, w_branch, w_out):
    B, S, D = x.shape
    h = rmsnorm(x, norm_pre)
    proj = h @ w_in
    (c_q, c_kv, k_pe, q_d, k_d, v_d, q_x, silu_gates, gate_logits) = jnp.split(proj, IN_OFFSETS, axis=-1)

    c_q = rmsnorm(c_q, q_norm)
    q_a = (c_q @ w_uq).reshape(B, S, MLA_HEADS, MLA_NOPE_DIM + MLA_ROPE_DIM).transpose(0, 2, 1, 3)
    q_nope, q_pe = q_a[..., :MLA_NOPE_DIM], apply_rope(q_a[..., MLA_NOPE_DIM:], cos_r, sin_r)
    c_kv = rmsnorm(c_kv, kv_norm)
    kv = (c_kv @ w_ukv).reshape(B, S, MLA_HEADS, MLA_NOPE_DIM + MLA_V_DIM).transpose(0, 2, 1, 3)
    k_nope, v_a = kv[..., :MLA_NOPE_DIM], kv[..., MLA_NOPE_DIM:]
    k_pe = apply_rope(k_pe[:, None], cos_r, sin_r)
    q_a = jnp.concatenate([q_nope, q_pe], axis=-1)[:, None]
    k_a = jnp.concatenate([k_nope, jnp.broadcast_to(k_pe, (B, MLA_HEADS, S, MLA_ROPE_DIM))], axis=-1)[:, None]
    o_a = causal_map_attention(q_a, k_a, v_a, jnp.ones((1,), jnp.float32),
                               (MLA_NOPE_DIM + MLA_ROPE_DIM) ** -0.5)
    o_a = o_a.transpose(0, 2, 1, 3).reshape(B, S, BRANCH_WIDTH)

    q_d = apply_rope(q_d.reshape(B, S, DIFF_HEADS, 2, DIFF_HEAD_DIM).transpose(0, 3, 2, 1, 4), cos_d, sin_d)
    k_d = apply_rope(k_d.reshape(B, S, DIFF_HEADS, 2, DIFF_HEAD_DIM).transpose(0, 3, 2, 1, 4), cos_d, sin_d)
    v_d = v_d.reshape(B, S, DIFF_HEADS, 2 * DIFF_HEAD_DIM).transpose(0, 2, 1, 3)
    lam = (jnp.exp(jnp.sum(lambda_q1.astype(jnp.float32) * lambda_k1.astype(jnp.float32)))
           - jnp.exp(jnp.sum(lambda_q2.astype(jnp.float32) * lambda_k2.astype(jnp.float32)))
           + lam_init)
    coef = jnp.stack([jnp.ones_like(lam), -lam])
    o_b = causal_map_attention(q_d, k_d, v_d, coef, DIFF_HEAD_DIM ** -0.5)
    o_b = rmsnorm(o_b, diff_subln) * (1.0 - lam_init)
    o_b = o_b.transpose(0, 2, 1, 3).reshape(B, S, BRANCH_WIDTH)

    m = rmsnorm(mem, mem_norm)
    kv_m = m @ w_mem_kv
    M = mem.shape[1]
    k_m = kv_m[..., :XATTN_HEADS * XATTN_HEAD_DIM].reshape(B, M, XATTN_HEADS, XATTN_HEAD_DIM).transpose(0, 2, 1, 3)
    v_m = kv_m[..., XATTN_HEADS * XATTN_HEAD_DIM:].reshape(B, M, XATTN_HEADS, XATTN_HEAD_DIM).transpose(0, 2, 1, 3)
    q_x = q_x.reshape(B, S, XATTN_HEADS, XATTN_HEAD_DIM).transpose(0, 2, 1, 3)
    s_x = jnp.einsum('bhqd,bhkd->bhqk', q_x, k_m).astype(jnp.float32) * XATTN_HEAD_DIM ** -0.5
    p_x = jax.nn.softmax(s_x, axis=-1)
    o_c = jnp.einsum('bhqk,bhkd->bhqd', p_x.astype(v_m.dtype), v_m)
    o_c = o_c.transpose(0, 2, 1, 3).reshape(B, S, BRANCH_WIDTH)

    g_paths = jnp.split(silu_gates, N_BRANCHES, axis=-1)
    gl = (gate_logits + b_gate).reshape(B, S, N_BRANCHES, D)
    branches = (o_a, o_b, o_c)
    merged = None
    for i in range(N_BRANCHES):
        y = (branches[i] * jax.nn.silu(g_paths[i])) @ w_branch[i]
        term = jax.nn.sigmoid(gl[:, :, i]) * y
        merged = term if merged is None else merged + term
    out = merged @ w_out
    return x + rmsnorm(out, norm_post)


def setup_inputs(seed: int = 0) -> dict:
    key = jax.random.key(seed)
    ks = jax.random.split(key, 24)
    L, D = DEPTH, D_MODEL
    nrm = lambda k, shape, scale: jax.random.normal(k, shape, jnp.float32) * scale
    gain = lambda k, shape: 1.0 + 0.05 * jax.random.normal(k, shape, jnp.float32)
    start = jax.random.randint(ks[2], (), 0, 1024, dtype=jnp.int32)
    return {
        'x': nrm(ks[0], (BATCH, SEQ, D), 1.0),
        'mem': nrm(ks[1], (BATCH, MEM_TOKENS, D), 1.0),
        'positions': (start + jnp.arange(SEQ, dtype=jnp.int32)).astype(jnp.int32),
        'norm_pre': gain(ks[3], (L, D)),
        'norm_post': gain(ks[4], (L, D)),
        'w_in': nrm(ks[5], (L, D, IN_WIDTH), D ** -0.5),
        'q_norm': gain(ks[6], (L, MLA_Q_LORA)),
        'w_uq': nrm(ks[7], (L, MLA_Q_LORA, MLA_HEADS * (MLA_NOPE_DIM + MLA_ROPE_DIM)), MLA_Q_LORA ** -0.5),
        'kv_norm': gain(ks[8], (L, MLA_KV_LORA)),
        'w_ukv': nrm(ks[9], (L, MLA_KV_LORA, MLA_HEADS * (MLA_NOPE_DIM + MLA_V_DIM)), MLA_KV_LORA ** -0.5),
        'lambda_q1': nrm(ks[10], (L, DIFF_HEAD_DIM), 0.1),
        'lambda_k1': nrm(ks[11], (L, DIFF_HEAD_DIM), 0.1),
        'lambda_q2': nrm(ks[12], (L, DIFF_HEAD_DIM), 0.1),
        'lambda_k2': nrm(ks[13], (L, DIFF_HEAD_DIM), 0.1),
        'diff_subln': gain(ks[14], (L, 2 * DIFF_HEAD_DIM)),
        'mem_norm': gain(ks[15], (L, D)),
        'w_mem_kv': nrm(ks[16], (L, D, 2 * XATTN_HEADS * XATTN_HEAD_DIM), D ** -0.5),
        'b_gate': nrm(ks[17], (L, N_BRANCHES * D), 0.1),
        'w_branch': nrm(ks[18], (L, N_BRANCHES, BRANCH_WIDTH, D), BRANCH_WIDTH ** -0.5),
        'w_out': nrm(ks[19], (L, D, D), D ** -0.5),
    }


def reference(x, mem, positions, norm_pre, norm_post, w_in, q_norm, w_uq, kv_norm, w_ukv,
              lambda_q1, lambda_k1, lambda_q2, lambda_k2, diff_subln,
              mem_norm, w_mem_kv, b_gate, w_branch, w_out):
    cos_r, sin_r = rope_tables(positions, MLA_ROPE_DIM)
    cos_d, sin_d = rope_tables(positions, DIFF_HEAD_DIM)
    for l in range(DEPTH):
        lam_init = 0.8 - 0.6 * math.exp(-0.3 * l)
        x = hybrid_layer(x, mem, cos_r, sin_r, cos_d, sin_d, lam_init,
                         norm_pre[l], norm_post[l], w_in[l], q_norm[l], w_uq[l], kv_norm[l], w_ukv[l],
                         lambda_q1[l], lambda_k1[l], lambda_q2[l], lambda_k2[l], diff_subln[l],
                         mem_norm[l], w_mem_kv[l], b_gate[l], w_branch[l], w_out[l])
    return x
```

```cpp
#include <hip/hip_runtime.h>
#include <hip/hip_cooperative_groups.h>
#include <cstdio>
#include <cstdint>
namespace cg = cooperative_groups;

#ifndef ATTSEL
#define ATTSEL 7
#endif
#ifndef GSEL
#define GSEL 0xFFFF
#endif
#ifndef PHSEL
#define PHSEL 0xFFFF
#endif
#ifndef MK_ONE_LAUNCH
#define MK_ONE_LAUNCH 1
#endif

#define LAS __attribute__((address_space(3)))
typedef unsigned short bf16_t;
typedef short bf16x8 __attribute__((ext_vector_type(8)));
typedef short s16x4 __attribute__((ext_vector_type(4)));
typedef float f32x4 __attribute__((ext_vector_type(4)));
typedef float f32x16 __attribute__((ext_vector_type(16)));
typedef unsigned u32x4 __attribute__((ext_vector_type(4)));
typedef unsigned u32x2 __attribute__((ext_vector_type(2)));
typedef float f32x2_t __attribute__((ext_vector_type(2)));
typedef __bf16 bf16x2_t __attribute__((ext_vector_type(2)));

constexpr int D_MODEL = 1024, BATCH = 16, SEQ = 4096, DEPTH = 4, MEMT = 256;
constexpr int MTOK = BATCH * SEQ;
constexpr int MMEM = BATCH * MEMT;
constexpr int IN_WIDTH = 7072;
constexpr float NORM_EPS = 1e-6f;
constexpr float LOG2E = 1.4426950408889634f;

constexpr size_t WL_IN = 0;
constexpr size_t WL_UQ = WL_IN + (size_t)7168 * 1024;
constexpr size_t WL_UKV = WL_UQ + (size_t)768 * 256;
constexpr size_t WL_MEM = WL_UKV + (size_t)1024 * 128;
constexpr size_t WL_BR = WL_MEM + (size_t)1024 * 1024;
constexpr size_t WL_OUT = WL_BR + (size_t)3 * 1024 * 512;
constexpr size_t WL_TOTAL = WL_OUT + (size_t)1024 * 3072;

constexpr size_t MiB = 1u << 20;
constexpr size_t OFF_W = 0;
constexpr size_t OFF_COS = 104 * MiB, OFF_SIN = OFF_COS + 256 * 1024;
constexpr size_t OFF_SSQQ = 105 * MiB, OFF_SSQKV = 106 * MiB;
constexpr size_t OFF_MN = 108 * MiB;
constexpr size_t OFF_KM = 116 * MiB;
constexpr size_t OFF_VMT = 132 * MiB;
constexpr size_t OFF_XN = 148 * MiB;
constexpr size_t OFF_O = 276 * MiB;
constexpr size_t OFF_R = 468 * MiB;
constexpr size_t OFF_CQ = OFF_R;
constexpr size_t OFF_CKV = OFF_CQ + 32 * MiB;
constexpr size_t OFF_KPE = OFF_CKV + 16 * MiB;
constexpr size_t OFF_QD = OFF_KPE + 4 * MiB;
constexpr size_t OFF_KD = OFF_QD + 64 * MiB;
constexpr size_t OFF_VDT = OFF_KD + 64 * MiB;
constexpr size_t OFF_QX = OFF_VDT + 64 * MiB;
constexpr size_t OFF_QA = OFF_QX + 64 * MiB;
constexpr size_t OFF_KN = OFF_QA + 96 * MiB;
constexpr size_t OFF_VAT = OFF_KN + 64 * MiB;
constexpr size_t WS_END = OFF_VAT + 64 * MiB;
constexpr size_t OFF_S = OFF_R;
constexpr size_t OFF_MERGED = OFF_R + 384 * MiB;
constexpr size_t OFF_OUT = OFF_R + 384 * MiB;
static_assert(4 * WL_TOTAL * 2 <= OFF_COS && OFF_MERGED + 128 * MiB <= WS_END, "ws map");

constexpr int LDS_BYTES = 147456;
constexpr int NPHASE = 1 + 7 * DEPTH;

__device__ __forceinline__ unsigned cvtpk(float lo, float hi) { f32x2_t v = {lo, hi}; bf16x2_t b = __builtin_convertvector(v, bf16x2_t); return __builtin_bit_cast(unsigned, b); }
__device__ __forceinline__ void store4bf(bf16_t* p, f32x4 v) { u32x2 w; w.x = cvtpk(v[0], v[1]); w.y = cvtpk(v[2], v[3]); *(u32x2*)p = w; }
__device__ __forceinline__ f32x4 unpack4bf(u32x2 w) { f32x4 r; r[0] = __uint_as_float(w.x << 16); r[1] = __uint_as_float(w.x & 0xffff0000u); r[2] = __uint_as_float(w.y << 16); r[3] = __uint_as_float(w.y & 0xffff0000u); return r; }
__device__ __forceinline__ float fast_rcp(float x) { return __builtin_amdgcn_rcpf(x); }
__device__ __forceinline__ float fast_exp2(float x) { return __builtin_amdgcn_exp2f(x); }
__device__ __forceinline__ float sigmoidf_(float v) { return fast_rcp(1.0f + fast_exp2(-v * LOG2E)); }

namespace pg8 {
constexpr int BM = 256, BK = 64, HALF = 128, HTB = HALF * BK * 2, STAGE_BYTES = 8 * HTB, NXCD = 8, WGM = 8;
__host__ __device__ __forceinline__ int lds_byte(int r, int c) { const int st = (r >> 4) * 2 + (c >> 5), rr = r & 15, cc = c & 31, ob = rr * 64 + cc * 2; return st * 1024 + (ob ^ (((ob >> 9) & 1) << 5)); }
__host__ __device__ __forceinline__ void stage_rc(int b, int& R, int& C) { const int st = b / 1024, sb = b % 1024, swz = sb ^ (((sb >> 9) & 1) << 5); R = (st >> 1) * 16 + swz / 64; C = (st & 1) * 32 + (swz % 64) / 2; }

struct Unit { int pm, pn, z; };
struct Gemm { const bf16_t* A; const bf16_t* Bt; int M, N, K, lda, ldb; size_t zA, zB; };

struct StaticOrder {
    int nM, nN, nwg, G, c, nz;
    __device__ void init(int M, int N, int G_, int c_, int nz_ = 1) { nM = M / BM; nN = N / BM; nwg = nM * nN; G = G_; c = c_; nz = nz_; }
    __device__ bool next(int i, Unit& u) const {
        const int ib = i / nz; u.z = i - ib * nz;
        const long L = (long)ib * G + c; if (L >= nwg) return false;
        int wgid = (int)L; { const int q = nwg / NXCD, r = nwg % NXCD, xcd = wgid % NXCD, off = wgid / NXCD; wgid = (xcd < r ? xcd * (q + 1) : r * (q + 1) + (xcd - r) * q) + off; }
        const int nig = WGM * nN, gid = wgid / nig, fm = gid * WGM, gsz = (nM - fm) < WGM ? (nM - fm) : WGM;
        u.pm = fm + ((wgid % nig) % gsz); u.pn = (wgid % nig) / gsz; return true;
    }
};

template <class Epi>
__device__ __forceinline__ void gemm_phase(LAS unsigned char* lds, const Gemm g, const StaticOrder& S, const Epi& E) {
    int tid = threadIdx.x; asm volatile("" : "+v"(tid));
    const int wid = __builtin_amdgcn_readfirstlane(tid >> 6), lane = tid & 63, wr = wid >> 2, wc = wid & 3, fr = lane & 15, fq = lane >> 4;
    int K = g.K; asm volatile("" : "+s"(K)); const int nt = K / BK;
    unsigned voffA[2], voffB[2];
#pragma unroll
    for (int i = 0; i < 2; ++i) { int R, C; stage_rc(tid * 16 + i * 8192, R, C);
        voffA[i] = (unsigned)(R * g.lda + C) * 2u; voffB[i] = (unsigned)(R * g.ldb + C) * 2u; }
    const size_t kstep = (size_t)(BK * 2);
    const size_t hstepA = (size_t)HALF * g.lda * 2, hstepB = (size_t)HALF * g.ldb * 2;
    const size_t tstepA = 2 * hstepA, tstepB = 2 * hstepB;
    const unsigned ldsw = (unsigned)wid * 1024u;
    const int aoff = lds_byte(wr * 64 + fr, fq * 8), boff = lds_byte(wc * 32 + fr, fq * 8);
#define PG8_SA(b, h) (((b) * 2 + (h)) * HTB)
#define PG8_SB(b, h) ((4 + (b) * 2 + (h)) * HTB)
#define PG8_STAGE(bufoff, gbase, voff) do { _Pragma("unroll") for (int _i = 0; _i < 2; ++_i) \
        __builtin_amdgcn_global_load_lds((const unsigned*)((const char*)(gbase) + (voff)[_i]), (LAS unsigned*)(lds + (bufoff) + ldsw + _i * 8192), 16, 0, 0); } while (0)
#define PG8_LDA(dst, b, h) do { _Pragma("unroll") for (int m = 0; m < 4; ++m) _Pragma("unroll") for (int k = 0; k < 2; ++k) dst[m][k] = *(const LAS bf16x8*)(lds + PG8_SA(b, h) + aoff + m * 2048 + k * 1024); } while (0)
#define PG8_LDB(dst, b, h) do { _Pragma("unroll") for (int n = 0; n < 2; ++n) _Pragma("unroll") for (int k = 0; k < 2; ++k) dst[n][k] = *(const LAS bf16x8*)(lds + PG8_SB(b, h) + boff + n * 2048 + k * 1024); } while (0)
#define PG8_MMA(ai, bj, At, Bt) do { __builtin_amdgcn_s_setprio(1); _Pragma("unroll") for (int m = 0; m < 4; ++m) _Pragma("unroll") for (int n = 0; n < 2; ++n) _Pragma("unroll") for (int k = 0; k < 2; ++k) \
        acc[ai][bj][m][n] = __builtin_amdgcn_mfma_f32_16x16x32_bf16(Bt[n][k], At[m][k], acc[ai][bj][m][n], 0, 0, 0); __builtin_amdgcn_s_setprio(0); } while (0)
#define PG8_WAIT_V(n) asm volatile("s_waitcnt vmcnt(" #n ")" ::: "memory")
#define PG8_WAIT_L(n) asm volatile("s_waitcnt lgkmcnt(" #n ")" ::: "memory")
#define PG8_BAR __builtin_amdgcn_s_barrier()
#define PG8_SCHED __builtin_amdgcn_sched_barrier(0)
    Unit cur, nxt; int ui = 0;
    if (!S.next(0, cur)) return;
    f32x4 acc[2][2][4][2];
#pragma unroll
    for (int a = 0; a < 2; ++a)
#pragma unroll
        for (int b = 0; b < 2; ++b)
#pragma unroll
            for (int m = 0; m < 4; ++m)
#pragma unroll
                for (int n = 0; n < 2; ++n) acc[a][b][m][n] = (f32x4){0.f, 0.f, 0.f, 0.f};
    bf16x8 At[4][2], B0[2][2], B1[2][2];
    const char* cA = (const char*)g.A + ((size_t)cur.z * g.zA) * 2 + (size_t)cur.pm * tstepA;
    const char* cB = (const char*)g.Bt + ((size_t)cur.z * g.zB) * 2 + (size_t)cur.pn * tstepB;
    PG8_STAGE(PG8_SB(0, 0), cB, voffB); PG8_STAGE(PG8_SB(0, 1), cB + hstepB, voffB); PG8_STAGE(PG8_SA(0, 0), cA, voffA); PG8_STAGE(PG8_SA(0, 1), cA + hstepA, voffA);
    if (wr == 1) PG8_BAR;
    PG8_WAIT_V(2); PG8_BAR;
    PG8_STAGE(PG8_SB(1, 0), cB + kstep, voffB); PG8_STAGE(PG8_SA(1, 0), cA + kstep, voffA); PG8_STAGE(PG8_SB(1, 1), cB + hstepB + kstep, voffB);
    PG8_WAIT_V(6); PG8_BAR;
    for (;;) {
        const bool has_next = S.next(ui + 1, nxt);
        const char* nA = has_next ? (const char*)g.A + ((size_t)nxt.z * g.zA) * 2 + (size_t)nxt.pm * tstepA : cA;
        const char* nB = has_next ? (const char*)g.Bt + ((size_t)nxt.z * g.zB) * 2 + (size_t)nxt.pn * tstepB : cB;
        for (int t = 0; t < nt; t += 2) {
            const bool last = (t == nt - 2);
            const char* a1 = cA + (size_t)(t + 1) * kstep;
            const char* a2 = last ? nA : cA + (size_t)(t + 2) * kstep; const char* b2 = last ? nB : cB + (size_t)(t + 2) * kstep;
            const char* a3 = a2 + kstep; const char* b3 = b2 + kstep;
            PG8_LDB(B0, 0, 0); PG8_LDB(B1, 0, 1); PG8_SCHED; PG8_LDA(At, 0, 0); PG8_STAGE(PG8_SA(1, 1), a1 + hstepA, voffA);
            PG8_WAIT_V(8); PG8_WAIT_L(0); PG8_BAR; PG8_MMA(0, 0, At, B0); PG8_MMA(0, 1, At, B1); PG8_BAR; PG8_SCHED;
            PG8_LDA(At, 0, 1); PG8_STAGE(PG8_SB(0, 0), b2, voffB); PG8_STAGE(PG8_SB(0, 1), b2 + hstepB, voffB); PG8_STAGE(PG8_SA(0, 0), a2, voffA);
            PG8_WAIT_V(8); PG8_WAIT_L(0); PG8_BAR; PG8_MMA(1, 0, At, B0); PG8_MMA(1, 1, At, B1); PG8_BAR; PG8_SCHED;
            PG8_LDB(B0, 1, 0); PG8_LDB(B1, 1, 1); PG8_SCHED; PG8_LDA(At, 1, 0); PG8_STAGE(PG8_SA(0, 1), a2 + hstepA, voffA);
            PG8_WAIT_V(8); PG8_WAIT_L(0); PG8_BAR; PG8_MMA(0, 0, At, B0); PG8_MMA(0, 1, At, B1); PG8_BAR; PG8_SCHED;
            PG8_LDA(At, 1, 1); PG8_STAGE(PG8_SB(1, 0), b3, voffB); PG8_STAGE(PG8_SB(1, 1), b3 + hstepB, voffB); PG8_STAGE(PG8_SA(1, 0), a3, voffA);
            PG8_WAIT_V(8); PG8_WAIT_L(0); PG8_BAR; PG8_MMA(1, 0, At, B0); PG8_MMA(1, 1, At, B1); PG8_BAR; PG8_SCHED;
        }
        if (wr == 0) PG8_BAR;
        E(acc, cur, wr, wc, fr, fq);
        if (!has_next) break;
#pragma unroll
        for (int a = 0; a < 2; ++a)
#pragma unroll
            for (int b = 0; b < 2; ++b)
#pragma unroll
                for (int m = 0; m < 4; ++m)
#pragma unroll
                    for (int n = 0; n < 2; ++n) acc[a][b][m][n] = (f32x4){0.f, 0.f, 0.f, 0.f};
        cur = nxt; cA = nA; cB = nB; ++ui;
        if (wr == 1) PG8_BAR;
    }
    PG8_WAIT_V(0);
    PG8_BAR;
    asm volatile("" ::: "memory"); PG8_SCHED;
#undef PG8_SA
#undef PG8_SB
#undef PG8_STAGE
#undef PG8_LDA
#undef PG8_LDB
#undef PG8_MMA
#undef PG8_WAIT_V
#undef PG8_WAIT_L
#undef PG8_BAR
#undef PG8_SCHED
}

#define EPI_ROWS_BEGIN _Pragma("unroll") for (int ai = 0; ai < 2; ++ai) _Pragma("unroll") for (int m = 0; m < 4; ++m) { const int row = u.pm * BM + ai * HALF + wr * 64 + m * 16 + fr;
#define EPI_ROWS_END asm volatile("" ::: "memory"); }
#define EPI_COLS_BEGIN _Pragma("unroll") for (int bj = 0; bj < 2; ++bj) _Pragma("unroll") for (int n = 0; n < 2; ++n) { const int colt = bj * HALF + wc * 32 + n * 16 + 4 * fq;
#define EPI_COLS_END }
typedef f32x4 Acc[2][2][4][2];

__device__ __forceinline__ float rstd4(const float* ssq, int row, float inv_dim) { const f32x4 p = *(const f32x4*)(ssq + (size_t)row * 4); return __builtin_amdgcn_rsqf(((p[0] + p[1]) + (p[2] + p[3])) * inv_dim + NORM_EPS); }

struct Epi1 {
    bf16_t *CQ, *CKV, *KPE, *QD, *KD, *QX; float *SSQq, *SSQkv; const float *COS, *SIN; float sc_d, sc_x;
    __device__ __forceinline__ void operator()(const Acc& acc, const Unit& u, int wr, int wc, int fr, int fq) const {
        const int pn = u.pn;
        EPI_ROWS_BEGIN
            const float r = 1.0f;
            if (pn == 0) {
                float ss = 0.f;
                EPI_COLS_BEGIN const f32x4 v = acc[ai][bj][m][n] * r; ss += (v[0] * v[0] + v[1] * v[1]) + (v[2] * v[2] + v[3] * v[3]); store4bf(CQ + (size_t)row * 256 + colt, v); EPI_COLS_END
                ss += __shfl_xor(ss, 16); ss += __shfl_xor(ss, 32);
                if (fq == 0) SSQq[(size_t)row * 4 + wc] = ss;
            } else if (pn == 1) {
                float ss = 0.f;
#pragma unroll
                for (int n = 0; n < 2; ++n) { const f32x4 v = acc[ai][0][m][n] * r; ss += (v[0] * v[0] + v[1] * v[1]) + (v[2] * v[2] + v[3] * v[3]); store4bf(CKV + (size_t)row * 128 + wc * 32 + n * 16 + 4 * fq, v); }
                ss += __shfl_xor(ss, 16); ss += __shfl_xor(ss, 32);
                if (fq == 0) SSQkv[(size_t)row * 4 + wc] = ss;
                if (wc == 0) {
                    const int s = row & (SEQ - 1); const f32x4 cs = *(const f32x4*)(COS + s * 16 + 4 * fq), sn = *(const f32x4*)(SIN + s * 16 + 4 * fq);
                    const f32x4 x1 = acc[ai][1][m][0] * r, x2 = acc[ai][1][m][1] * r;
                    store4bf(KPE + (size_t)row * 32 + 4 * fq, x1 * cs - x2 * sn); store4bf(KPE + (size_t)row * 32 + 16 + 4 * fq, x2 * cs + x1 * sn);
                }
            } else if (pn < 6) {
                bf16_t* dst = (pn < 4 ? QD : KD) + (size_t)row * 512 + (pn & 1) * 256 + wc * 32 + 4 * fq; const float sc = (pn < 4 ? sc_d : 1.0f) * r;
                const int s = row & (SEQ - 1); const f32x4 cs = *(const f32x4*)(COS + s * 16 + 4 * fq), sn = *(const f32x4*)(SIN + s * 16 + 4 * fq);
#pragma unroll
                for (int bj = 0; bj < 2; ++bj) { const f32x4 x1 = acc[ai][bj][m][0] * sc, x2 = acc[ai][bj][m][1] * sc;
                    store4bf(dst + bj * HALF, x1 * cs - x2 * sn); store4bf(dst + bj * HALF + 16, x2 * cs + x1 * sn); }
            } else {
                const float sc = sc_x * r;
                EPI_COLS_BEGIN store4bf(QX + (size_t)row * 512 + (pn - 6) * 256 + colt, acc[ai][bj][m][n] * sc); EPI_COLS_END
            }
        EPI_ROWS_END
    }
};
struct EpiT {
    bf16_t* O; size_t ldc; size_t zO; const float* ssq; float inv_dim; const float* colscale;
    __device__ __forceinline__ void operator()(const Acc& acc, const Unit& u, int wr, int wc, int fr, int fq) const {
        f32x4 cs[2][2];
        EPI_COLS_BEGIN
            const int col = u.pn * BM + colt;
            if (ssq) { for (int i = 0; i < 4; ++i) cs[bj][n][i] = rstd4(ssq, col + i, inv_dim); }
            else if (colscale) cs[bj][n] = *(const f32x4*)(colscale + col);
            else cs[bj][n] = (f32x4){1.f, 1.f, 1.f, 1.f};
        EPI_COLS_END
        bf16_t* base = O + (size_t)u.z * zO;
        EPI_ROWS_BEGIN
            EPI_COLS_BEGIN store4bf(base + (size_t)row * ldc + u.pn * BM + colt, acc[ai][bj][m][n] * cs[bj][n]); EPI_COLS_END
        EPI_ROWS_END
    }
};
struct EpiRow {
    bf16_t* O; size_t ldc; size_t zO; const float* ssq; float inv_dim;
    __device__ __forceinline__ void operator()(const Acc& acc, const Unit& u, int wr, int wc, int fr, int fq) const {
        bf16_t* base = O + (size_t)u.z * zO;
        EPI_ROWS_BEGIN
            const float sc = ssq ? rstd4(ssq, row, inv_dim) : 1.0f;
            EPI_COLS_BEGIN store4bf(base + (size_t)row * ldc + u.pn * BM + colt, acc[ai][bj][m][n] * sc); EPI_COLS_END
        EPI_ROWS_END
    }
};
struct Epi2 {
    bf16_t* QA; const float* SSQq; const float *COS, *SIN; float sc_a;
    __device__ __forceinline__ void operator()(const Acc& acc, const Unit& u, int wr, int wc, int fr, int fq) const {
        EPI_ROWS_BEGIN
            const float sc = rstd4(SSQq, row, 1.0f / 256.0f) * sc_a;
            if (u.pn < 2) {
                EPI_COLS_BEGIN const int nn = u.pn * BM + colt; store4bf(QA + (size_t)row * 768 + (nn >> 6) * 96 + (nn & 63), acc[ai][bj][m][n] * sc); EPI_COLS_END
            } else {
                const int s = row & (SEQ - 1); const f32x4 cs = *(const f32x4*)(COS + s * 16 + 4 * fq), sn = *(const f32x4*)(SIN + s * 16 + 4 * fq);
#pragma unroll
                for (int bj = 0; bj < 2; ++bj) { const f32x4 x1 = acc[ai][bj][m][0] * sc, x2 = acc[ai][bj][m][1] * sc; bf16_t* dst = QA + (size_t)row * 768 + (4 * bj + wc) * 96 + 64 + 4 * fq;
                    store4bf(dst, x1 * cs - x2 * sn); store4bf(dst + 16, x2 * cs + x1 * sn); }
            }
        EPI_ROWS_END
    }
};
struct EpiSG {
    bf16_t* O;
    __device__ __forceinline__ void operator()(const Acc& acc, const Unit& u, int wr, int wc, int fr, int fq) const {
        EPI_ROWS_BEGIN
            const float r = 1.0f;
            EPI_COLS_BEGIN bf16_t* p = O + (size_t)row * 1536 + u.pn * BM + colt; const f32x4 o = unpack4bf(*(const u32x2*)p); const f32x4 g = acc[ai][bj][m][n] * r; f32x4 v;
#pragma unroll
                for (int i = 0; i < 4; ++i) v[i] = o[i] * g[i] * sigmoidf_(g[i]);
                store4bf(p, v); EPI_COLS_END
        EPI_ROWS_END
    }
};
struct EpiGL {
    bf16_t* S; const float* bias;
    __device__ __forceinline__ void operator()(const Acc& acc, const Unit& u, int wr, int wc, int fr, int fq) const {
        f32x4 bv[2][2];
        EPI_COLS_BEGIN bv[bj][n] = *(const f32x4*)(bias + u.pn * BM + colt); EPI_COLS_END
        EPI_ROWS_BEGIN
            const float r = 1.0f;
            EPI_COLS_BEGIN const f32x4 g = acc[ai][bj][m][n] * r + bv[bj][n]; f32x4 v;
#pragma unroll
                for (int i = 0; i < 4; ++i) v[i] = sigmoidf_(g[i]);
                store4bf(S + (size_t)row * 3072 + u.pn * BM + colt, v); EPI_COLS_END
        EPI_ROWS_END
    }
};
struct EpiBR {
    bf16_t* S;
    __device__ __forceinline__ void operator()(const Acc& acc, const Unit& u, int wr, int wc, int fr, int fq) const {
        EPI_ROWS_BEGIN
            EPI_COLS_BEGIN bf16_t* p = S + (size_t)row * 3072 + u.z * 1024 + u.pn * BM + colt; const f32x4 s = unpack4bf(*(const u32x2*)p); store4bf(p, s * acc[ai][bj][m][n]); EPI_COLS_END
        EPI_ROWS_END
    }
};
struct EpiOut {
    float* OUT;
    __device__ __forceinline__ void operator()(const Acc& acc, const Unit& u, int wr, int wc, int fr, int fq) const {
        EPI_ROWS_BEGIN
            EPI_COLS_BEGIN *(f32x4*)(OUT + (size_t)row * 1024 + u.pn * BM + colt) = acc[ai][bj][m][n]; EPI_COLS_END
        EPI_ROWS_END
    }
};
}

__device__ __forceinline__ int crow(int r, int hi) { return (r & 3) + 8 * (r >> 2) + 4 * hi; }

template <int NMAP, int DKM, int DV, bool CAUSAL, int W0, int W1>
__device__ __forceinline__ void attn_unit(LAS unsigned char* lds, const bf16_t* __restrict__ Q, int ldq, const bf16_t* __restrict__ K0, int ldk0, const bf16_t* __restrict__ K1, int ldk1,
                                          const bf16_t* __restrict__ Vt, size_t ldv, int q0, int NT, bf16_t* O, int ldo, float lam, const float* subln, float outscale) {
    constexpr int DKT = NMAP * DKM, KS = DKT * 2 + 16, VS = 136, KBUF = 64 * KS, VBUF = DV * VS;
    constexpr int NC = DKM / 16, NDB = DV / 32;
    constexpr int K0C = W0 / 8, K0N = (64 * K0C) / 512, K1C = W1 / 8, VN = (DV * 8) / 512;
    static_assert(W0 + W1 == DKT && K0N >= 1 && VN >= 1, "attention staging geometry");
    int tid = threadIdx.x; asm volatile("" : "+v"(tid));
    const int lane = tid & 63, wid = __builtin_amdgcn_readfirstlane(tid >> 6), r32 = lane & 31, hi = lane >> 5;
    LAS unsigned char* Kb = lds; LAS unsigned char* Vb = lds + 2 * KBUF;
    bf16x8 qf[NMAP][NC];
    { const bf16_t* qrow = Q + (size_t)(q0 + wid * 32 + r32) * ldq;
#pragma unroll
      for (int mp = 0; mp < NMAP; ++mp)
#pragma unroll
          for (int c = 0; c < NC; ++c) qf[mp][c] = *(const bf16x8*)(qrow + mp * DKM + 16 * c + 8 * hi); }
    f32x16 o[NMAP][NDB]; float mrow[NMAP], lrow[NMAP];
#pragma unroll
    for (int mp = 0; mp < NMAP; ++mp) { mrow[mp] = -INFINITY; lrow[mp] = 0.f;
#pragma unroll
        for (int db = 0; db < NDB; ++db)
#pragma unroll
            for (int r = 0; r < 16; ++r) o[mp][db][r] = 0.f; }
    u32x4 kreg[K0N], k1reg = {0u, 0u, 0u, 0u}, vreg[VN];
#define ATT_GLOAD(t) do { \
    _Pragma("unroll") for (int i = 0; i < K0N; ++i) { const int idx = tid + 512 * i, rr = idx / K0C, cc = idx % K0C; kreg[i] = *(const u32x4*)(K0 + (size_t)(64 * (t) + rr) * ldk0 + cc * 8); } \
    if (W1 > 0) { if (tid < 64 * K1C) { const int rr = tid / (K1C > 0 ? K1C : 1), cc = tid % (K1C > 0 ? K1C : 1); k1reg = *(const u32x4*)(K1 + (size_t)(64 * (t) + rr) * ldk1 + cc * 8); } } \
    _Pragma("unroll") for (int i = 0; i < VN; ++i) { const int idx = tid + 512 * i, dd = idx >> 3, cc = idx & 7; vreg[i] = *(const u32x4*)(Vt + (size_t)dd * ldv + 64 * (t) + cc * 8); } } while (0)
#define ATT_LWRITE(buf) do { \
    _Pragma("unroll") for (int i = 0; i < K0N; ++i) { const int idx = tid + 512 * i, rr = idx / K0C, cc = idx % K0C; *(LAS u32x4*)(Kb + (buf) * KBUF + rr * KS + cc * 16) = kreg[i]; } \
    if (W1 > 0) { if (tid < 64 * K1C) { const int rr = tid / (K1C > 0 ? K1C : 1), cc = tid % (K1C > 0 ? K1C : 1); *(LAS u32x4*)(Kb + (buf) * KBUF + rr * KS + W0 * 2 + cc * 16) = k1reg; } } \
    _Pragma("unroll") for (int i = 0; i < VN; ++i) { const int idx = tid + 512 * i, dd = idx >> 3, cc = idx & 7; LAS u32x2* vp = (LAS u32x2*)(Vb + (buf) * VBUF + dd * VS + cc * 16); \
        u32x2 lo_; lo_.x = vreg[i].x; lo_.y = vreg[i].y; u32x2 hi_; hi_.x = vreg[i].z; hi_.y = vreg[i].w; vp[0] = lo_; vp[1] = hi_; } } while (0)
    ATT_GLOAD(0);
    ATT_LWRITE(0);
    __syncthreads();
    const int qw0 = q0 + wid * 32;
    for (int t = 0; t < NT; ++t) {
        const int buf = t & 1;
        if (t + 1 < NT) ATT_GLOAD(t + 1);
#pragma unroll
        for (int kb = 0; kb < 2; ++kb) {
            const int kv0 = 64 * t + 32 * kb;
            if (CAUSAL && kv0 > qw0) continue;
            const bool diag = CAUSAL && (kv0 == qw0);
            bf16x8 vf[NDB][2];
#pragma unroll
            for (int db = 0; db < NDB; ++db)
#pragma unroll
                for (int j = 0; j < 2; ++j) { const LAS unsigned char* vp = Vb + buf * VBUF + (32 * db + r32) * VS + (32 * kb + 16 * j + 4 * hi) * 2;
                    const s16x4 lo = *(const LAS s16x4*)vp, hh = *(const LAS s16x4*)(vp + 16);
                    vf[db][j] = (bf16x8){lo[0], lo[1], lo[2], lo[3], hh[0], hh[1], hh[2], hh[3]}; }
#pragma unroll
            for (int mp = 0; mp < NMAP; ++mp) {
                f32x16 s;
#pragma unroll
                for (int r = 0; r < 16; ++r) s[r] = 0.f;
#pragma unroll
                for (int c = 0; c < NC; ++c) { const bf16x8 kf = *(const LAS bf16x8*)(Kb + buf * KBUF + (32 * kb + r32) * KS + (mp * DKM + 16 * c + 8 * hi) * 2);
                    s = __builtin_amdgcn_mfma_f32_32x32x16_bf16(kf, qf[mp][c], s, 0, 0, 0); }
                if (diag) {
#pragma unroll
                    for (int r = 0; r < 16; ++r) if (crow(r, hi) > r32) s[r] = -INFINITY;
                }
                float mx = s[0];
#pragma unroll
                for (int r = 1; r < 16; ++r) mx = fmaxf(mx, s[r]);
                mx = fmaxf(mx, __shfl_xor(mx, 32));
                if (__any(mx > mrow[mp])) {
                    const float mnew = fmaxf(mrow[mp], mx), alpha = fast_exp2(mrow[mp] - mnew);
                    mrow[mp] = mnew; lrow[mp] *= alpha;
#pragma unroll
                    for (int db = 0; db < NDB; ++db)
#pragma unroll
                        for (int r = 0; r < 16; ++r) o[mp][db][r] *= alpha;
                }
                const float mcur = mrow[mp]; float ls = 0.f;
#pragma unroll
                for (int r = 0; r < 16; ++r) { s[r] = fast_exp2(s[r] - mcur); ls += s[r]; }
                lrow[mp] += ls;
                bf16x8 pa[2];
#pragma unroll
                for (int j = 0; j < 2; ++j) { u32x4 w; w.x = cvtpk(s[8 * j + 0], s[8 * j + 1]); w.y = cvtpk(s[8 * j + 2], s[8 * j + 3]); w.z = cvtpk(s[8 * j + 4], s[8 * j + 5]); w.w = cvtpk(s[8 * j + 6], s[8 * j + 7]); pa[j] = __builtin_bit_cast(bf16x8, w); }
#pragma unroll
                for (int db = 0; db < NDB; ++db)
#pragma unroll
                    for (int j = 0; j < 2; ++j) o[mp][db] = __builtin_amdgcn_mfma_f32_32x32x16_bf16(vf[db][j], pa[j], o[mp][db], 0, 0, 0);
            }
        }
        if (t + 1 < NT) ATT_LWRITE(buf ^ 1);
        __syncthreads();
    }
#undef ATT_GLOAD
#undef ATT_LWRITE
    float inv[NMAP];
#pragma unroll
    for (int mp = 0; mp < NMAP; ++mp) { const float lt = lrow[mp] + __shfl_xor(lrow[mp], 32); inv[mp] = 1.0f / lt; }
    bf16_t* orow = O + (size_t)(q0 + wid * 32 + r32) * ldo;
    if constexpr (NMAP == 1) {
#pragma unroll
        for (int db = 0; db < NDB; ++db)
#pragma unroll
            for (int g = 0; g < 4; ++g) { f32x4 v; for (int i = 0; i < 4; ++i) v[i] = o[0][db][4 * g + i] * inv[0]; store4bf(orow + 32 * db + 8 * g + 4 * hi, v); }
    } else {
        float ss = 0.f;
#pragma unroll
        for (int db = 0; db < NDB; ++db)
#pragma unroll
            for (int r = 0; r < 16; ++r) { const float v = o[0][db][r] * inv[0] - lam * (o[1][db][r] * inv[1]); o[0][db][r] = v; ss += v * v; }
        ss += __shfl_xor(ss, 32);
        const float rstd = __builtin_amdgcn_rsqf(ss * (1.0f / DV) + NORM_EPS) * outscale;
#pragma unroll
        for (int db = 0; db < NDB; ++db)
#pragma unroll
            for (int g = 0; g < 4; ++g) { const f32x4 gn = *(const f32x4*)(subln + 32 * db + 8 * g + 4 * hi); f32x4 v; for (int i = 0; i < 4; ++i) v[i] = o[0][db][4 * g + i] * rstd * gn[i]; store4bf(orow + 32 * db + 8 * g + 4 * hi, v); }
    }
}

__device__ __forceinline__ float wave_sum(float v) {
#pragma unroll
    for (int o = 1; o < 64; o <<= 1) v += __shfl_xor(v, o);
    return v;
}
__device__ __forceinline__ void transpose_block(const float* __restrict__ W, int ldw, int src_col0, const float* __restrict__ gain, bf16_t* WT, int K, int dst_row0, int k0, LAS float* scr, int lane) {
#pragma unroll 8
    for (int i = 0; i < 32; ++i) { const int kk = 2 * i + (lane >> 5); float v = W[(size_t)(k0 + kk) * ldw + src_col0 + (lane & 31)]; if (gain) v *= gain[k0 + kk]; scr[kk * 33 + (lane & 31)] = v; }
    asm volatile("s_waitcnt lgkmcnt(0)" ::: "memory");
    const int c = lane & 7;
#pragma unroll
    for (int j = 0; j < 4; ++j) { const int n = (lane >> 3) + 8 * j; const LAS float* s = scr + (8 * c) * 33 + n;
        u32x4 ov; ov.x = cvtpk(s[0 * 33], s[1 * 33]); ov.y = cvtpk(s[2 * 33], s[3 * 33]); ov.z = cvtpk(s[4 * 33], s[5 * 33]); ov.w = cvtpk(s[6 * 33], s[7 * 33]);
        *(u32x4*)(WT + (size_t)(dst_row0 + n) * K + k0 + 8 * c) = ov; }
    asm volatile("s_waitcnt lgkmcnt(0)" ::: "memory");
}

struct Args { const float* in[20]; float* out; unsigned char* ws; int ph_lo, ph_hi, coop, pad; float lam_init[4]; };

__global__ void __launch_bounds__(512, 2) hybrid_fwd(Args a) {
    extern __shared__ __attribute__((aligned(16))) unsigned char lds_raw[];
    LAS unsigned char* lds = (LAS unsigned char*)lds_raw;
    const float* x_in = a.in[0]; const float* mem = a.in[1]; const int* positions = (const int*)a.in[2];
    const float* norm_pre = a.in[3]; const float* norm_post = a.in[4]; const float* w_in = a.in[5]; const float* q_norm = a.in[6]; const float* w_uq = a.in[7];
    const float* kv_norm = a.in[8]; const float* w_ukv = a.in[9]; const float* lq1 = a.in[10]; const float* lk1 = a.in[11]; const float* lq2 = a.in[12]; const float* lk2 = a.in[13];
    const float* diff_subln = a.in[14]; const float* mem_norm = a.in[15]; const float* w_mem_kv = a.in[16]; const float* b_gate = a.in[17]; const float* w_branch = a.in[18]; const float* w_out = a.in[19];
#define P_WT ((bf16_t*)(ws + OFF_W))
#define P_COS ((float*)(ws + OFF_COS))
#define P_SIN ((float*)(ws + OFF_SIN))
#define P_SSQq ((float*)(ws + OFF_SSQQ))
#define P_SSQkv ((float*)(ws + OFF_SSQKV))
#define P_MN ((bf16_t*)(ws + OFF_MN))
#define P_KM ((bf16_t*)(ws + OFF_KM))
#define P_VMT ((bf16_t*)(ws + OFF_VMT))
#define P_XN ((bf16_t*)(ws + OFF_XN))
#define P_OB ((bf16_t*)(ws + OFF_O))
#define P_CQ ((bf16_t*)(ws + OFF_CQ))
#define P_CKV ((bf16_t*)(ws + OFF_CKV))
#define P_KPE ((bf16_t*)(ws + OFF_KPE))
#define P_QD ((bf16_t*)(ws + OFF_QD))
#define P_KD ((bf16_t*)(ws + OFF_KD))
#define P_VDT ((bf16_t*)(ws + OFF_VDT))
#define P_QX ((bf16_t*)(ws + OFF_QX))
#define P_QA ((bf16_t*)(ws + OFF_QA))
#define P_KN ((bf16_t*)(ws + OFF_KN))
#define P_VAT ((bf16_t*)(ws + OFF_VAT))
#define P_SB ((bf16_t*)(ws + OFF_S))
#define P_MG ((bf16_t*)(ws + OFF_MERGED))
#define P_OUTB ((float*)(ws + OFF_OUT))

    for (int ph = a.ph_lo; ph < a.ph_hi; ++ph) {
        __attribute__((address_space(1))) unsigned char* ws = (__attribute__((address_space(1))) unsigned char*)a.ws; asm volatile("" : "+s"(ws));
        int tid = threadIdx.x; asm volatile("" : "+v"(tid)); const int lane = tid & 63, wave = __builtin_amdgcn_readfirstlane(tid >> 6);
        int G = gridDim.x, bx = blockIdx.x; asm volatile("" : "+s"(G), "+s"(bx));
        const int vcu = (G % 8 == 0) ? (bx % 8) * (G / 8) + bx / 8 : bx;
        const int gw = vcu * 8 + wave, NGW = G * 8;
        if (ph == 0) {
#if PHSEL & 1
            LAS float* scr = (LAS float*)(lds + wave * 16384);
            constexpr int I_IN = 16 * 221, I_UQ = 4 * 24, I_UKV = 2 * 32, I_MEM = 16 * 32, I_BR = 3 * 256, I_OUT = 3 * 16 * 32;
            constexpr int I_L = I_IN + I_UQ + I_UKV + I_MEM + I_BR + I_OUT;
            for (int it = gw; it < DEPTH * I_L; it += NGW) {
                const int l = it / I_L; int r = it - l * I_L; bf16_t* wl = P_WT + (size_t)l * WL_TOTAL;
                if (r < I_IN) { const int kb = r / 221, nb = r - kb * 221, n = nb * 32; int dr;
                    if (n < 416) dr = n; else if (n < 1440) dr = n + 96; else if (n < 1952) dr = n - 1440 + 2048; else if (n < 2464) dr = n - 1952 + 1536; else dr = n + 96;
                    transpose_block(w_in + (size_t)l * 1024 * IN_WIDTH, IN_WIDTH, n, norm_pre + l * 1024, wl + WL_IN, 1024, dr, kb * 64, scr, lane); continue; }
                r -= I_IN;
                if (r < I_UQ) { const int kb = r / 24, nb = r - kb * 24, n = nb * 32, h = n / 96, w = n - h * 96; const int dr = (w < 64) ? h * 64 + w : 512 + h * 32 + (w - 64);
                    transpose_block(w_uq + (size_t)l * 256 * 768, 768, n, q_norm + l * 256, wl + WL_UQ, 256, dr, kb * 64, scr, lane); continue; }
                r -= I_UQ;
                if (r < I_UKV) { const int kb = r / 32, nb = r - kb * 32, n = nb * 32, h = n / 128, w = n - h * 128; const int dr = (w < 64) ? h * 64 + w : 512 + h * 64 + (w - 64);
                    transpose_block(w_ukv + (size_t)l * 128 * 1024, 1024, n, kv_norm + l * 128, wl + WL_UKV, 128, dr, kb * 64, scr, lane); continue; }
                r -= I_UKV;
                if (r < I_MEM) { const int kb = r / 32, nb = r - kb * 32;
                    transpose_block(w_mem_kv + (size_t)l * 1024 * 1024, 1024, nb * 32, mem_norm + l * 1024, wl + WL_MEM, 1024, nb * 32, kb * 64, scr, lane); continue; }
                r -= I_MEM;
                if (r < I_BR) { const int i = r / 256, rr = r - i * 256, kb = rr / 32, nb = rr - kb * 32;
                    transpose_block(w_branch + (size_t)(l * 3 + i) * 512 * 1024, 1024, nb * 32, nullptr, wl + WL_BR + (size_t)i * 1024 * 512, 512, nb * 32, kb * 64, scr, lane); continue; }
                r -= I_BR;
                { const int zz = r / 512, rr = r - zz * 512, kb = rr / 32, nb = rr - kb * 32;
                    transpose_block(w_out + (size_t)l * 1024 * 1024, 1024, nb * 32, nullptr, wl + WL_OUT + zz * 1024, 3072, nb * 32, kb * 64, scr, lane); }
            }
            for (int i = bx * 512 + tid; i < DEPTH * 96 * 1024 / 8; i += G * 512) { const int l = i / (96 * 1024 / 8), rr = i - l * (96 * 1024 / 8);
                *(u32x4*)(P_WT + (size_t)l * WL_TOTAL + WL_IN + (size_t)416 * 1024 + (size_t)rr * 8) = (u32x4){0u, 0u, 0u, 0u}; }
            for (int i = bx * 512 + tid; i < SEQ * 16; i += G * 512) { const int s = i >> 4, j = i & 15;
                const float invf = powf(10000.0f, -(float)j / 16.0f); const float ang = (float)positions[s] * invf;
                double rv = (double)ang * 0.15915494309189535; rv -= floor(rv); const float f = (float)rv;
                P_COS[i] = __builtin_amdgcn_cosf(f); P_SIN[i] = __builtin_amdgcn_sinf(f); }
            for (int m = gw; m < MMEM + MTOK; m += NGW) {
                const float* src = (m < MMEM) ? mem + (size_t)m * 1024 : x_in + (size_t)(m - MMEM) * 1024; bf16_t* dst = (m < MMEM) ? P_MN + (size_t)m * 1024 : P_XN + (size_t)(m - MMEM) * 1024;
                f32x4 v[4]; float s = 0.f;
#pragma unroll
                for (int j = 0; j < 4; ++j) { v[j] = ((const f32x4*)src)[64 * j + lane]; s += (v[j][0] * v[j][0] + v[j][1] * v[j][1]) + (v[j][2] * v[j][2] + v[j][3] * v[j][3]); }
                const float rstd = __builtin_amdgcn_rsqf(wave_sum(s) * (1.0f / 1024.0f) + NORM_EPS);
#pragma unroll
                for (int j = 0; j < 4; ++j) store4bf(dst + 4 * (64 * j + lane), v[j] * rstd);
            }
#endif
        } else {
            const int l = (ph - 1) / 7, sub = (ph - 1) % 7;
            const bf16_t* wl = P_WT + (size_t)l * WL_TOTAL;
            if (sub == 0) {
#if PHSEL & 2
#if GSEL & 1
                { pg8::Gemm g{P_XN, wl + WL_IN, MTOK, 2048, 1024, 1024, 1024, 0, 0}; pg8::StaticOrder S; S.init(MTOK, 2048, G, bx);
                  pg8::Epi1 E{P_CQ, P_CKV, P_KPE, P_QD, P_KD, P_QX, P_SSQq, P_SSQkv, P_COS, P_SIN, 0.17677669529663687f * LOG2E, 0.08838834764831845f * LOG2E};
                  pg8::gemm_phase(lds, g, S, E); }
#endif
#if GSEL & 2
                { pg8::Gemm g{wl + WL_IN + (size_t)2048 * 1024, P_XN, 512, MTOK, 1024, 1024, 1024, 0, 0}; pg8::StaticOrder S; S.init(512, MTOK, G, bx);
                  pg8::EpiT E{P_VDT, (size_t)MTOK, 0, nullptr, 0.f, nullptr};
                  pg8::gemm_phase(lds, g, S, E); }
#endif
                if (l == 0) {
#if GSEL & 4
                    { pg8::Gemm g{P_MN, P_WT + WL_MEM, MMEM, 512, 1024, 1024, 1024, 0, WL_TOTAL}; pg8::StaticOrder S; S.init(MMEM, 512, G, bx, DEPTH);
                      pg8::EpiRow E{P_KM, 512, (size_t)MMEM * 512, nullptr, 0.f};
                      pg8::gemm_phase(lds, g, S, E); }
#endif
#if GSEL & 8
                    { pg8::Gemm g{P_WT + WL_MEM + (size_t)512 * 1024, P_MN, 512, MMEM, 1024, 1024, 1024, WL_TOTAL, 0}; pg8::StaticOrder S; S.init(512, MMEM, G, bx, DEPTH);
                      pg8::EpiT E{P_VMT, (size_t)MMEM, (size_t)512 * MMEM, nullptr, 0.f, nullptr};
                      pg8::gemm_phase(lds, g, S, E); }
#endif
                }
#endif
            } else if (sub == 1) {
#if PHSEL & 4
#if GSEL & 16
                { pg8::Gemm g{P_CQ, wl + WL_UQ, MTOK, 768, 256, 256, 256, 0, 0}; pg8::StaticOrder S; S.init(MTOK, 768, G, bx);
                  pg8::Epi2 E{P_QA, P_SSQq, P_COS, P_SIN, 0.10206207261596575f * LOG2E};
                  pg8::gemm_phase(lds, g, S, E); }
#endif
#if GSEL & 32
                { pg8::Gemm g{P_CKV, wl + WL_UKV, MTOK, 512, 128, 128, 128, 0, 0}; pg8::StaticOrder S; S.init(MTOK, 512, G, bx);
                  pg8::EpiRow E{P_KN, 512, 0, P_SSQkv, 1.0f / 128.0f};
                  pg8::gemm_phase(lds, g, S, E); }
#endif
#if GSEL & 64
                { pg8::Gemm g{wl + WL_UKV + (size_t)512 * 128, P_CKV, 512, MTOK, 128, 128, 128, 0, 0}; pg8::StaticOrder S; S.init(512, MTOK, G, bx);
                  pg8::EpiT E{P_VAT, (size_t)MTOK, 0, P_SSQkv, 1.0f / 128.0f, nullptr};
                  pg8::gemm_phase(lds, g, S, E); }
#endif
#endif
            } else if (sub == 2) {
#if PHSEL & 8
                const float d1 = wave_sum(lane < 32 ? lq1[l * 32 + lane] * lk1[l * 32 + lane] : 0.f), d2 = wave_sum(lane < 32 ? lq2[l * 32 + lane] * lk2[l * 32 + lane] : 0.f);
                const float lam_init = a.lam_init[l]; const float lam = expf(d1) - expf(d2) + lam_init;
#if ATTSEL & 1
                for (int P = vcu; P < 1024; P += G) { const int bh = P >> 3, s = P & 7, b = bh >> 3, h = bh & 7; const size_t rb = (size_t)b * SEQ;
                    for (int k = 0; k < 2; ++k) { const int qb = k ? s : 15 - s;
                        attn_unit<1, 96, 64, true, 64, 32>(lds, P_QA + rb * 768 + h * 96, 768, P_KN + rb * 512 + h * 64, 512, P_KPE + rb * 32, 32, P_VAT + (size_t)(h * 64) * MTOK + rb, (size_t)MTOK,
                                                            qb * 256, 4 * (qb + 1), P_OB + rb * 1536 + h * 64, 1536, 0.f, nullptr, 1.f); } }
#endif
                asm volatile("" ::: "memory"); __builtin_amdgcn_sched_barrier(0);
#if ATTSEL & 2
                for (int P = vcu; P < 1024; P += G) { const int bh = P >> 3, s = P & 7, b = bh >> 3, h = bh & 7; const size_t rb = (size_t)b * SEQ;
                    for (int k = 0; k < 2; ++k) { const int qb = k ? s : 15 - s;
                        attn_unit<2, 32, 64, true, 64, 0>(lds, P_QD + rb * 512 + h * 64, 512, P_KD + rb * 512 + h * 64, 512, nullptr, 0, P_VDT + (size_t)(h * 64) * MTOK + rb, (size_t)MTOK,
                                                           qb * 256, 4 * (qb + 1), P_OB + rb * 1536 + 512 + h * 64, 1536, lam, diff_subln + l * 64, 1.0f - lam_init); } }
#endif
                asm volatile("" ::: "memory"); __builtin_amdgcn_sched_barrier(0);
#if ATTSEL & 4
                for (int X = vcu; X < 1024; X += G) { const int bh = X >> 4, qb = X & 15, b = bh >> 2, h = bh & 3; const size_t rb = (size_t)b * SEQ;
                    attn_unit<1, 128, 128, false, 128, 0>(lds, P_QX + rb * 512 + h * 128, 512, P_KM + (size_t)l * MMEM * 512 + (size_t)b * MEMT * 512 + h * 128, 512, nullptr, 0,
                                                           P_VMT + (size_t)l * 512 * MMEM + (size_t)(h * 128) * MMEM + (size_t)b * MEMT, (size_t)MMEM,
                                                           qb * 256, 4, P_OB + rb * 1536 + 1024 + h * 128, 1536, 0.f, nullptr, 1.f); }
#endif
#endif
            } else if (sub == 3) {
#if PHSEL & 16
                { pg8::Gemm g{P_XN, wl + WL_IN + (size_t)2560 * 1024, MTOK, 1536, 1024, 1024, 1024, 0, 0}; pg8::StaticOrder S; S.init(MTOK, 1536, G, bx);
                  pg8::EpiSG E{P_OB};
                  pg8::gemm_phase(lds, g, S, E); }
                { pg8::Gemm g{P_XN, wl + WL_IN + (size_t)4096 * 1024, MTOK, 3072, 1024, 1024, 1024, 0, 0}; pg8::StaticOrder S; S.init(MTOK, 3072, G, bx);
                  pg8::EpiGL E{P_SB, b_gate + l * 3072};
                  pg8::gemm_phase(lds, g, S, E); }
#endif
            } else if (sub == 4) {
#if PHSEL & 32
                pg8::Gemm g{P_OB, wl + WL_BR, MTOK, 1024, 512, 1536, 512, 512, (size_t)1024 * 512}; pg8::StaticOrder S; S.init(MTOK, 1024, G, bx, 3);
                pg8::EpiBR E{P_SB};
                pg8::gemm_phase(lds, g, S, E);
#endif
            } else if (sub == 5) {
#if PHSEL & 64
                pg8::Gemm g{P_SB, wl + WL_OUT, MTOK, 1024, 3072, 3072, 3072, 0, 0}; pg8::StaticOrder S; S.init(MTOK, 1024, G, bx);
                pg8::EpiRow E{(bf16_t*)P_OUTB, 1024, 0, nullptr, 0.f};
                pg8::gemm_phase(lds, g, S, E);
#endif
            } else {
#if PHSEL & 128
                const float* xo = (l == 0) ? x_in : a.out; const float* gp = norm_post + l * 1024;
                for (int m = gw; m < MTOK; m += NGW) {
                    f32x4 v[4]; float s = 0.f;
#pragma unroll
                    for (int j = 0; j < 4; ++j) { v[j] = unpack4bf(((const u32x2*)((const bf16_t*)P_OUTB + (size_t)m * 1024))[64 * j + lane]); s += (v[j][0] * v[j][0] + v[j][1] * v[j][1]) + (v[j][2] * v[j][2] + v[j][3] * v[j][3]); }
                    const float rstd = __builtin_amdgcn_rsqf(wave_sum(s) * (1.0f / 1024.0f) + NORM_EPS); float s2 = 0.f;
#pragma unroll
                    for (int j = 0; j < 4; ++j) { const f32x4 xv = ((const f32x4*)(xo + (size_t)m * 1024))[64 * j + lane]; const f32x4 gv = ((const f32x4*)gp)[64 * j + lane];
                        v[j] = xv + v[j] * rstd * gv; ((f32x4*)(a.out + (size_t)m * 1024))[64 * j + lane] = v[j];
                        s2 += (v[j][0] * v[j][0] + v[j][1] * v[j][1]) + (v[j][2] * v[j][2] + v[j][3] * v[j][3]); }
                    if (l + 1 < DEPTH) { const float rstd2 = __builtin_amdgcn_rsqf(wave_sum(s2) * (1.0f / 1024.0f) + NORM_EPS);
#pragma unroll
                        for (int j = 0; j < 4; ++j) store4bf(P_XN + (size_t)m * 1024 + 4 * (64 * j + lane), v[j] * rstd2); }
                }
#endif
            }
        }
        if (ph + 1 < a.ph_hi) { if (a.coop) cg::this_grid().sync(); }
    }
#ifdef DBG_NPH
    if (a.pad) {
        if (a.coop) cg::this_grid().sync();
        const unsigned short* w16 = (const unsigned short*)(a.ws + OFF_MN);
        const size_t n16 = (WS_END - OFF_MN) / 2, nout = (size_t)MTOK * 1024;
        for (size_t i = (size_t)blockIdx.x * 512 + threadIdx.x; i < nout; i += (size_t)gridDim.x * 512) {
            unsigned x = 0; for (size_t k = i; k < n16; k += nout) x ^= w16[k];
            const unsigned short* w2 = (const unsigned short*)(a.ws + OFF_COS); if (i < (size_t)(4 * MiB) / 2) x ^= w2[i];
            a.out[i] = (float)x;
        }
    }
#endif
}

extern "C" void kernel_launch(void* const* d_in, const int* in_sizes, int n_in, void* d_out, int out_size, void* d_ws, size_t ws_size, hipStream_t stream) {
    static int grid = 0;
    if (grid == 0) {
        if (n_in != 20 || ws_size < WS_END) { fprintf(stderr, "kernel_launch: need 20 inputs and >= %zu bytes of workspace (got %d, %zu)\n", (size_t)WS_END, n_in, ws_size); grid = -1; return; }
        int dev = 0, cus = 0, per_cu = 0;
        hipGetDevice(&dev); hipDeviceGetAttribute(&cus, hipDeviceAttributeMultiprocessorCount, dev);
        if (hipFuncSetAttribute((const void*)hybrid_fwd, hipFuncAttributeMaxDynamicSharedMemorySize, LDS_BYTES) != hipSuccess) { fprintf(stderr, "kernel_launch: hipFuncSetAttribute failed\n"); grid = -1; return; }
        if (hipOccupancyMaxActiveBlocksPerMultiprocessor(&per_cu, (const void*)hybrid_fwd, 512, LDS_BYTES) != hipSuccess || per_cu < 1) per_cu = 1;
        (void)hipGetLastError();
        grid = cus * 1;
    }
    if (grid < 0) return;
    Args a{};
    for (int i = 0; i < 20; ++i) a.in[i] = (const float*)d_in[i];
    a.out = (float*)d_out; a.ws = (unsigned char*)d_ws; a.pad = 0;
    a.lam_init[0] = 0.2f; a.lam_init[1] = 0.35550906759096926f; a.lam_init[2] = 0.47071301834358424f; a.lam_init[3] = 0.55605820415654f;
#if MK_ONE_LAUNCH
#ifdef DBG_NPH
    a.ph_lo = 0; a.ph_hi = DBG_NPH; a.coop = 1; a.pad = 1;
#else
    a.ph_lo = 0; a.ph_hi = NPHASE; a.coop = 1;
#endif
    void* args[] = {&a};
    hipError_t e = hipLaunchCooperativeKernel((const void*)hybrid_fwd, dim3(grid), dim3(512), args, LDS_BYTES, stream);
    if (e != hipSuccess) fprintf(stderr, "cooperative launch failed: %s (grid %d)\n", hipGetErrorString(e), grid);
#else
    for (int ph = 0; ph < NPHASE; ++ph) { a.ph_lo = ph; a.ph_hi = ph + 1; a.coop = 0;
        hipLaunchKernelGGL(hybrid_fwd, dim3(grid), dim3(512), LDS_BYTES, stream, a); }
#endif
}
```

```cpp
#include <hip/hip_runtime.h>
#include <hip/hip_cooperative_groups.h>
#include <cstdio>
#include <cstdint>
namespace cg = cooperative_groups;

#ifndef ATTSEL
#define ATTSEL 7
#endif
#ifndef GSEL
#define GSEL 0xFFFF
#endif
#ifndef PHSEL
#define PHSEL 0xFFFF
#endif
#ifndef MK_ONE_LAUNCH
#define MK_ONE_LAUNCH 1
#endif

#define LAS __attribute__((address_space(3)))
typedef unsigned short bf16_t;
typedef short bf16x8 __attribute__((ext_vector_type(8)));
typedef short s16x4 __attribute__((ext_vector_type(4)));
typedef float f32x4 __attribute__((ext_vector_type(4)));
typedef float f32x16 __attribute__((ext_vector_type(16)));
typedef unsigned u32x4 __attribute__((ext_vector_type(4)));
typedef unsigned u32x2 __attribute__((ext_vector_type(2)));
typedef float f32x2_t __attribute__((ext_vector_type(2)));
typedef __bf16 bf16x2_t __attribute__((ext_vector_type(2)));

constexpr int D_MODEL = 1024, BATCH = 16, SEQ = 4096, DEPTH = 4, MEMT = 256;
constexpr int MTOK = BATCH * SEQ;
constexpr int MMEM = BATCH * MEMT;
constexpr int IN_WIDTH = 7072;
constexpr float NORM_EPS = 1e-6f;
constexpr float LOG2E = 1.4426950408889634f;

constexpr size_t WL_IN = 0;
constexpr size_t WL_UQ = WL_IN + (size_t)7168 * 1024;
constexpr size_t WL_UKV = WL_UQ + (size_t)768 * 256;
constexpr size_t WL_MEM = WL_UKV + (size_t)1024 * 128;
constexpr size_t WL_BR = WL_MEM + (size_t)1024 * 1024;
constexpr size_t WL_OUT = WL_BR + (size_t)3 * 1024 * 512;
constexpr size_t WL_TOTAL = WL_OUT + (size_t)1024 * 3072;

constexpr size_t MiB = 1u << 20;
constexpr size_t OFF_W = 0;
constexpr size_t OFF_COS = 104 * MiB, OFF_SIN = OFF_COS + 256 * 1024;
constexpr size_t OFF_SSQQ = 105 * MiB, OFF_SSQKV = 106 * MiB;
constexpr size_t OFF_MN = 108 * MiB;
constexpr size_t OFF_KM = 116 * MiB;
constexpr size_t OFF_VMT = 132 * MiB;
constexpr size_t OFF_XN = 148 * MiB;
constexpr size_t OFF_O = 276 * MiB;
constexpr size_t OFF_R = 468 * MiB;
constexpr size_t OFF_CQ = OFF_R;
constexpr size_t OFF_CKV = OFF_CQ + 32 * MiB;
constexpr size_t OFF_KPE = OFF_CKV + 16 * MiB;
constexpr size_t OFF_QD = OFF_KPE + 4 * MiB;
constexpr size_t OFF_KD = OFF_QD + 64 * MiB;
constexpr size_t OFF_VDT = OFF_KD + 64 * MiB;
constexpr size_t OFF_QX = OFF_VDT + 64 * MiB;
constexpr size_t OFF_QA = OFF_QX + 64 * MiB;
constexpr size_t OFF_KN = OFF_QA + 96 * MiB;
constexpr size_t OFF_VAT = OFF_KN + 64 * MiB;
constexpr size_t WS_END = OFF_VAT + 64 * MiB;
constexpr size_t OFF_S = OFF_R;
constexpr size_t OFF_MERGED = OFF_R + 384 * MiB;
constexpr size_t OFF_OUT = OFF_R;
static_assert(4 * WL_TOTAL * 2 <= OFF_COS && OFF_MERGED + 128 * MiB <= WS_END, "ws map");

constexpr int LDS_BYTES = 147456;
constexpr int NPHASE = 1 + 7 * DEPTH;

__device__ __forceinline__ unsigned cvtpk(float lo, float hi) { f32x2_t v = {lo, hi}; bf16x2_t b = __builtin_convertvector(v, bf16x2_t); return __builtin_bit_cast(unsigned, b); }
__device__ __forceinline__ void store4bf(bf16_t* p, f32x4 v) { u32x2 w; w.x = cvtpk(v[0], v[1]); w.y = cvtpk(v[2], v[3]); *(u32x2*)p = w; }
__device__ __forceinline__ f32x4 unpack4bf(u32x2 w) { f32x4 r; r[0] = __uint_as_float(w.x << 16); r[1] = __uint_as_float(w.x & 0xffff0000u); r[2] = __uint_as_float(w.y << 16); r[3] = __uint_as_float(w.y & 0xffff0000u); return r; }
__device__ __forceinline__ float fast_rcp(float x) { return __builtin_amdgcn_rcpf(x); }
__device__ __forceinline__ float fast_exp2(float x) { return __builtin_amdgcn_exp2f(x); }
__device__ __forceinline__ float sigmoidf_(float v) { return fast_rcp(1.0f + fast_exp2(-v * LOG2E)); }

namespace pg8 {
constexpr int BM = 256, BK = 64, HALF = 128, HTB = HALF * BK * 2, STAGE_BYTES = 8 * HTB, NXCD = 8, WGM = 8;
__host__ __device__ __forceinline__ int lds_byte(int r, int c) { const int st = (r >> 4) * 2 + (c >> 5), rr = r & 15, cc = c & 31, ob = rr * 64 + cc * 2; return st * 1024 + (ob ^ (((ob >> 9) & 1) << 5)); }
__host__ __device__ __forceinline__ void stage_rc(int b, int& R, int& C) { const int st = b / 1024, sb = b % 1024, swz = sb ^ (((sb >> 9) & 1) << 5); R = (st >> 1) * 16 + swz / 64; C = (st & 1) * 32 + (swz % 64) / 2; }

struct Unit { int pm, pn, z; };
struct Gemm { const bf16_t* A; const bf16_t* Bt; int M, N, K, lda, ldb; size_t zA, zB; };

struct StaticOrder {
    int nM, nN, nwg, G, c, nz;
    __device__ void init(int M, int N, int G_, int c_, int nz_ = 1) { nM = M / BM; nN = N / BM; nwg = nM * nN; G = G_; c = c_; nz = nz_; }
    __device__ bool next(int i, Unit& u) const {
        const int ib = i / nz; u.z = i - ib * nz;
        const long L = (long)ib * G + c; if (L >= nwg) return false;
        int wgid = (int)L; { const int q = nwg / NXCD, r = nwg % NXCD, xcd = wgid % NXCD, off = wgid / NXCD; wgid = (xcd < r ? xcd * (q + 1) : r * (q + 1) + (xcd - r) * q) + off; }
        const int nig = WGM * nN, gid = wgid / nig, fm = gid * WGM, gsz = (nM - fm) < WGM ? (nM - fm) : WGM;
        u.pm = fm + ((wgid % nig) % gsz); u.pn = (wgid % nig) / gsz; return true;
    }
};

template <class Epi>
__device__ __forceinline__ void gemm_phase(LAS unsigned char* lds, const Gemm g, const StaticOrder& S, const Epi& E) {
    int tid = threadIdx.x; asm volatile("" : "+v"(tid));
    const int wid = __builtin_amdgcn_readfirstlane(tid >> 6), lane = tid & 63, wr = wid >> 2, wc = wid & 3, fr = lane & 15, fq = lane >> 4;
    int K = g.K; asm volatile("" : "+s"(K)); const int nt = K / BK;
    unsigned voffA[2], voffB[2];
#pragma unroll
    for (int i = 0; i < 2; ++i) { int R, C; stage_rc(tid * 16 + i * 8192, R, C);
        voffA[i] = (unsigned)(R * g.lda + C) * 2u; voffB[i] = (unsigned)(R * g.ldb + C) * 2u; }
    const size_t kstep = (size_t)(BK * 2);
    const size_t hstepA = (size_t)HALF * g.lda * 2, hstepB = (size_t)HALF * g.ldb * 2;
    const size_t tstepA = 2 * hstepA, tstepB = 2 * hstepB;
    const unsigned ldsw = (unsigned)wid * 1024u;
    const int aoff = lds_byte(wr * 64 + fr, fq * 8), boff = lds_byte(wc * 32 + fr, fq * 8);
#define PG8_SA(b, h) (((b) * 2 + (h)) * HTB)
#define PG8_SB(b, h) ((4 + (b) * 2 + (h)) * HTB)
#define PG8_STAGE(bufoff, gbase, voff) do { _Pragma("unroll") for (int _i = 0; _i < 2; ++_i) \
        __builtin_amdgcn_global_load_lds((const unsigned*)((const char*)(gbase) + (voff)[_i]), (LAS unsigned*)(lds + (bufoff) + ldsw + _i * 8192), 16, 0, 0); } while (0)
#define PG8_LDA(dst, b, h) do { _Pragma("unroll") for (int m = 0; m < 4; ++m) _Pragma("unroll") for (int k = 0; k < 2; ++k) dst[m][k] = *(const LAS bf16x8*)(lds + PG8_SA(b, h) + aoff + m * 2048 + k * 1024); } while (0)
#define PG8_LDB(dst, b, h) do { _Pragma("unroll") for (int n = 0; n < 2; ++n) _Pragma("unroll") for (int k = 0; k < 2; ++k) dst[n][k] = *(const LAS bf16x8*)(lds + PG8_SB(b, h) + boff + n * 2048 + k * 1024); } while (0)
#define PG8_MMA(ai, bj, At, Bt) do { __builtin_amdgcn_s_setprio(1); _Pragma("unroll") for (int m = 0; m < 4; ++m) _Pragma("unroll") for (int n = 0; n < 2; ++n) _Pragma("unroll") for (int k = 0; k < 2; ++k) \
        acc[ai][bj][m][n] = __builtin_amdgcn_mfma_f32_16x16x32_bf16(Bt[n][k], At[m][k], acc[ai][bj][m][n], 0, 0, 0); __builtin_amdgcn_s_setprio(0); } while (0)
#define PG8_WAIT_V(n) asm volatile("s_waitcnt vmcnt(" #n ")" ::: "memory")
#define PG8_WAIT_L(n) asm volatile("s_waitcnt lgkmcnt(" #n ")" ::: "memory")
#define PG8_BAR __builtin_amdgcn_s_barrier()
#define PG8_SCHED __builtin_amdgcn_sched_barrier(0)
    Unit cur, nxt; int ui = 0;
    if (!S.next(0, cur)) return;
    f32x4 acc[2][2][4][2];
#pragma unroll
    for (int a = 0; a < 2; ++a)
#pragma unroll
        for (int b = 0; b < 2; ++b)
#pragma unroll
            for (int m = 0; m < 4; ++m)
#pragma unroll
                for (int n = 0; n < 2; ++n) acc[a][b][m][n] = (f32x4){0.f, 0.f, 0.f, 0.f};
    bf16x8 At[4][2], B0[2][2], B1[2][2];
    const char* cA = (const char*)g.A + ((size_t)cur.z * g.zA) * 2 + (size_t)cur.pm * tstepA;
    const char* cB = (const char*)g.Bt + ((size_t)cur.z * g.zB) * 2 + (size_t)cur.pn * tstepB;
    PG8_STAGE(PG8_SB(0, 0), cB, voffB); PG8_STAGE(PG8_SB(0, 1), cB + hstepB, voffB); PG8_STAGE(PG8_SA(0, 0), cA, voffA); PG8_STAGE(PG8_SA(0, 1), cA + hstepA, voffA);
    if (wr == 1) PG8_BAR;
    PG8_WAIT_V(2); PG8_BAR;
    PG8_STAGE(PG8_SB(1, 0), cB + kstep, voffB); PG8_STAGE(PG8_SA(1, 0), cA + kstep, voffA); PG8_STAGE(PG8_SB(1, 1), cB + hstepB + kstep, voffB);
    PG8_WAIT_V(6); PG8_BAR;
    for (;;) {
        const bool has_next = S.next(ui + 1, nxt);
        const char* nA = has_next ? (const char*)g.A + ((size_t)nxt.z * g.zA) * 2 + (size_t)nxt.pm * tstepA : cA;
        const char* nB = has_next ? (const char*)g.Bt + ((size_t)nxt.z * g.zB) * 2 + (size_t)nxt.pn * tstepB : cB;
        for (int t = 0; t < nt; t += 2) {
            const bool last = (t == nt - 2);
            const char* a1 = cA + (size_t)(t + 1) * kstep;
            const char* a2 = last ? nA : cA + (size_t)(t + 2) * kstep; const char* b2 = last ? nB : cB + (size_t)(t + 2) * kstep;
            const char* a3 = a2 + kstep; const char* b3 = b2 + kstep;
            PG8_LDB(B0, 0, 0); PG8_LDB(B1, 0, 1); PG8_SCHED; PG8_LDA(At, 0, 0); PG8_STAGE(PG8_SA(1, 1), a1 + hstepA, voffA);
            PG8_WAIT_V(8); PG8_WAIT_L(0); PG8_BAR; PG8_MMA(0, 0, At, B0); PG8_MMA(0, 1, At, B1); PG8_BAR; PG8_SCHED;
            PG8_LDA(At, 0, 1); PG8_STAGE(PG8_SB(0, 0), b2, voffB); PG8_STAGE(PG8_SB(0, 1), b2 + hstepB, voffB); PG8_STAGE(PG8_SA(0, 0), a2, voffA);
            PG8_WAIT_V(8); PG8_WAIT_L(0); PG8_BAR; PG8_MMA(1, 0, At, B0); PG8_MMA(1, 1, At, B1); PG8_BAR; PG8_SCHED;
            PG8_LDB(B0, 1, 0); PG8_LDB(B1, 1, 1); PG8_SCHED; PG8_LDA(At, 1, 0); PG8_STAGE(PG8_SA(0, 1), a2 + hstepA, voffA);
            PG8_WAIT_V(8); PG8_WAIT_L(0); PG8_BAR; PG8_MMA(0, 0, At, B0); PG8_MMA(0, 1, At, B1); PG8_BAR; PG8_SCHED;
            PG8_LDA(At, 1, 1); PG8_STAGE(PG8_SB(1, 0), b3, voffB); PG8_STAGE(PG8_SB(1, 1), b3 + hstepB, voffB); PG8_STAGE(PG8_SA(1, 0), a3, voffA);
            PG8_WAIT_V(8); PG8_WAIT_L(0); PG8_BAR; PG8_MMA(1, 0, At, B0); PG8_MMA(1, 1, At, B1); PG8_BAR; PG8_SCHED;
        }
        if (wr == 0) PG8_BAR;
        E(acc, cur, wr, wc, fr, fq);
        if (!has_next) break;
#pragma unroll
        for (int a = 0; a < 2; ++a)
#pragma unroll
            for (int b = 0; b < 2; ++b)
#pragma unroll
                for (int m = 0; m < 4; ++m)
#pragma unroll
                    for (int n = 0; n < 2; ++n) acc[a][b][m][n] = (f32x4){0.f, 0.f, 0.f, 0.f};
        cur = nxt; cA = nA; cB = nB; ++ui;
        if (wr == 1) PG8_BAR;
    }
    PG8_WAIT_V(0);
    PG8_BAR;
    asm volatile("" ::: "memory"); PG8_SCHED;
#undef PG8_SA
#undef PG8_SB
#undef PG8_STAGE
#undef PG8_LDA
#undef PG8_LDB
#undef PG8_MMA
#undef PG8_WAIT_V
#undef PG8_WAIT_L
#undef PG8_BAR
#undef PG8_SCHED
}

#define EPI_ROWS_BEGIN _Pragma("unroll") for (int ai = 0; ai < 2; ++ai) _Pragma("unroll") for (int m = 0; m < 4; ++m) { const int row = u.pm * BM + ai * HALF + wr * 64 + m * 16 + fr;
#define EPI_ROWS_END asm volatile("" ::: "memory"); }
#define EPI_COLS_BEGIN _Pragma("unroll") for (int bj = 0; bj < 2; ++bj) _Pragma("unroll") for (int n = 0; n < 2; ++n) { const int colt = bj * HALF + wc * 32 + n * 16 + 4 * fq;
#define EPI_COLS_END }
typedef f32x4 Acc[2][2][4][2];

__device__ __forceinline__ float rstd4(const float* ssq, int row, float inv_dim) { const f32x4 p = *(const f32x4*)(ssq + (size_t)row * 4); return __builtin_amdgcn_rsqf(((p[0] + p[1]) + (p[2] + p[3])) * inv_dim + NORM_EPS); }

struct Epi1 {
    bf16_t *CQ, *CKV, *KPE, *QD, *KD, *QX; float *SSQq, *SSQkv; const float *COS, *SIN; float sc_d, sc_x;
    __device__ __forceinline__ void operator()(const Acc& acc, const Unit& u, int wr, int wc, int fr, int fq) const {
        const int pn = u.pn;
        EPI_ROWS_BEGIN
            const float r = 1.0f;
            if (pn == 0) {
                float ss = 0.f;
                EPI_COLS_BEGIN const f32x4 v = acc[ai][bj][m][n] * r; ss += (v[0] * v[0] + v[1] * v[1]) + (v[2] * v[2] + v[3] * v[3]); store4bf(CQ + (size_t)row * 256 + colt, v); EPI_COLS_END
                ss += __shfl_xor(ss, 16); ss += __shfl_xor(ss, 32);
                if (fq == 0) SSQq[(size_t)row * 4 + wc] = ss;
            } else if (pn == 1) {
                float ss = 0.f;
#pragma unroll
                for (int n = 0; n < 2; ++n) { const f32x4 v = acc[ai][0][m][n] * r; ss += (v[0] * v[0] + v[1] * v[1]) + (v[2] * v[2] + v[3] * v[3]); store4bf(CKV + (size_t)row * 128 + wc * 32 + n * 16 + 4 * fq, v); }
                ss += __shfl_xor(ss, 16); ss += __shfl_xor(ss, 32);
                if (fq == 0) SSQkv[(size_t)row * 4 + wc] = ss;
                if (wc == 0) {
                    const int s = row & (SEQ - 1); const f32x4 cs = *(const f32x4*)(COS + s * 16 + 4 * fq), sn = *(const f32x4*)(SIN + s * 16 + 4 * fq);
                    const f32x4 x1 = acc[ai][1][m][0] * r, x2 = acc[ai][1][m][1] * r;
                    store4bf(KPE + (size_t)row * 32 + 4 * fq, x1 * cs - x2 * sn); store4bf(KPE + (size_t)row * 32 + 16 + 4 * fq, x2 * cs + x1 * sn);
                }
            } else if (pn < 6) {
                bf16_t* dst = (pn < 4 ? QD : KD) + (size_t)row * 512 + (pn & 1) * 256 + wc * 32 + 4 * fq; const float sc = (pn < 4 ? sc_d : 1.0f) * r;
                const int s = row & (SEQ - 1); const f32x4 cs = *(const f32x4*)(COS + s * 16 + 4 * fq), sn = *(const f32x4*)(SIN + s * 16 + 4 * fq);
#pragma unroll
                for (int bj = 0; bj < 2; ++bj) { const f32x4 x1 = acc[ai][bj][m][0] * sc, x2 = acc[ai][bj][m][1] * sc;
                    store4bf(dst + bj * HALF, x1 * cs - x2 * sn); store4bf(dst + bj * HALF + 16, x2 * cs + x1 * sn); }
            } else {
                const float sc = sc_x * r;
                EPI_COLS_BEGIN store4bf(QX + (size_t)row * 512 + (pn - 6) * 256 + colt, acc[ai][bj][m][n] * sc); EPI_COLS_END
            }
        EPI_ROWS_END
    }
};
struct EpiT {
    bf16_t* O; size_t ldc; size_t zO; const float* ssq; float inv_dim; const float* colscale;
    __device__ __forceinline__ void operator()(const Acc& acc, const Unit& u, int wr, int wc, int fr, int fq) const {
        f32x4 cs[2][2];
        EPI_COLS_BEGIN
            const int col = u.pn * BM + colt;
            if (ssq) { for (int i = 0; i < 4; ++i) cs[bj][n][i] = rstd4(ssq, col + i, inv_dim); }
            else if (colscale) cs[bj][n] = *(const f32x4*)(colscale + col);
            else cs[bj][n] = (f32x4){1.f, 1.f, 1.f, 1.f};
        EPI_COLS_END
        bf16_t* base = O + (size_t)u.z * zO;
        EPI_ROWS_BEGIN
            EPI_COLS_BEGIN store4bf(base + (size_t)row * ldc + u.pn * BM + colt, acc[ai][bj][m][n] * cs[bj][n]); EPI_COLS_END
        EPI_ROWS_END
    }
};
struct EpiRow {
    bf16_t* O; size_t ldc; size_t zO; const float* ssq; float inv_dim;
    __device__ __forceinline__ void operator()(const Acc& acc, const Unit& u, int wr, int wc, int fr, int fq) const {
        bf16_t* base = O + (size_t)u.z * zO;
        EPI_ROWS_BEGIN
            const float sc = ssq ? rstd4(ssq, row, inv_dim) : 1.0f;
            EPI_COLS_BEGIN store4bf(base + (size_t)row * ldc + u.pn * BM + colt, acc[ai][bj][m][n] * sc); EPI_COLS_END
        EPI_ROWS_END
    }
};
struct Epi2 {
    bf16_t* QA; const float* SSQq; const float *COS, *SIN; float sc_a;
    __device__ __forceinline__ void operator()(const Acc& acc, const Unit& u, int wr, int wc, int fr, int fq) const {
        EPI_ROWS_BEGIN
            const float sc = rstd4(SSQq, row, 1.0f / 256.0f) * sc_a;
            if (u.pn < 2) {
                EPI_COLS_BEGIN const int nn = u.pn * BM + colt; store4bf(QA + (size_t)row * 768 + (nn >> 6) * 96 + (nn & 63), acc[ai][bj][m][n] * sc); EPI_COLS_END
            } else {
                const int s = row & (SEQ - 1); const f32x4 cs = *(const f32x4*)(COS + s * 16 + 4 * fq), sn = *(const f32x4*)(SIN + s * 16 + 4 * fq);
#pragma unroll
                for (int bj = 0; bj < 2; ++bj) { const f32x4 x1 = acc[ai][bj][m][0] * sc, x2 = acc[ai][bj][m][1] * sc; bf16_t* dst = QA + (size_t)row * 768 + (4 * bj + wc) * 96 + 64 + 4 * fq;
                    store4bf(dst, x1 * cs - x2 * sn); store4bf(dst + 16, x2 * cs + x1 * sn); }
            }
        EPI_ROWS_END
    }
};
struct EpiSG {
    bf16_t* O;
    __device__ __forceinline__ void operator()(const Acc& acc, const Unit& u, int wr, int wc, int fr, int fq) const {
        EPI_ROWS_BEGIN
            const float r = 1.0f;
            EPI_COLS_BEGIN bf16_t* p = O + (size_t)row * 1536 + u.pn * BM + colt; const f32x4 o = unpack4bf(*(const u32x2*)p); const f32x4 g = acc[ai][bj][m][n] * r; f32x4 v;
#pragma unroll
                for (int i = 0; i < 4; ++i) v[i] = o[i] * g[i] * sigmoidf_(g[i]);
                store4bf(p, v); EPI_COLS_END
        EPI_ROWS_END
    }
};
struct EpiGL {
    bf16_t* S; const float* bias;
    __device__ __forceinline__ void operator()(const Acc& acc, const Unit& u, int wr, int wc, int fr, int fq) const {
        f32x4 bv[2][2];
        EPI_COLS_BEGIN bv[bj][n] = *(const f32x4*)(bias + u.pn * BM + colt); EPI_COLS_END
        EPI_ROWS_BEGIN
            const float r = 1.0f;
            EPI_COLS_BEGIN const f32x4 g = acc[ai][bj][m][n] * r + bv[bj][n]; f32x4 v;
#pragma unroll
                for (int i = 0; i < 4; ++i) v[i] = sigmoidf_(g[i]);
                store4bf(S + (size_t)row * 3072 + u.pn * BM + colt, v); EPI_COLS_END
        EPI_ROWS_END
    }
};
struct EpiBR {
    const bf16_t* S; bf16_t* MG;
    __device__ __forceinline__ void operator()(const Acc& acc, const Unit& u, int wr, int wc, int fr, int fq) const {
        EPI_ROWS_BEGIN
            EPI_COLS_BEGIN const int col = u.pn * BM + colt; const f32x4 s = unpack4bf(*(const u32x2*)(S + (size_t)row * 3072 + u.z * 1024 + col)); f32x4 v = s * acc[ai][bj][m][n];
                bf16_t* p = MG + (size_t)row * 1024 + col;
                if (u.z > 0) { const unsigned long long w = __hip_atomic_load((const unsigned long long*)p, __ATOMIC_RELAXED, __HIP_MEMORY_SCOPE_AGENT); u32x2 ww; ww.x = (unsigned)w; ww.y = (unsigned)(w >> 32); v += unpack4bf(ww); }
                store4bf(p, v); EPI_COLS_END
        EPI_ROWS_END
    }
};
struct EpiOut {
    float* OUT;
    __device__ __forceinline__ void operator()(const Acc& acc, const Unit& u, int wr, int wc, int fr, int fq) const {
        EPI_ROWS_BEGIN
            EPI_COLS_BEGIN *(f32x4*)(OUT + (size_t)row * 1024 + u.pn * BM + colt) = acc[ai][bj][m][n]; EPI_COLS_END
        EPI_ROWS_END
    }
};
}

__device__ __forceinline__ int crow(int r, int hi) { return (r & 3) + 8 * (r >> 2) + 4 * hi; }

template <int NMAP, int DKM, int DV, bool CAUSAL, int W0, int W1>
__device__ __forceinline__ void attn_unit(LAS unsigned char* lds, const bf16_t* __restrict__ Q, int ldq, const bf16_t* __restrict__ K0, int ldk0, const bf16_t* __restrict__ K1, int ldk1,
                                          const bf16_t* __restrict__ Vt, size_t ldv, int q0, int NT, bf16_t* O, int ldo, float lam, const float* subln, float outscale) {
    constexpr int DKT = NMAP * DKM, KS = DKT * 2 + 16, VS = 136, KBUF = 64 * KS, VBUF = DV * VS;
    constexpr int NC = DKM / 16, NDB = DV / 32;
    constexpr int K0C = W0 / 8, K0N = (64 * K0C) / 512, K1C = W1 / 8, VN = (DV * 8) / 512;
    static_assert(W0 + W1 == DKT && K0N >= 1 && VN >= 1, "attention staging geometry");
    int tid = threadIdx.x; asm volatile("" : "+v"(tid));
    const int lane = tid & 63, wid = __builtin_amdgcn_readfirstlane(tid >> 6), r32 = lane & 31, hi = lane >> 5;
    LAS unsigned char* Kb = lds; LAS unsigned char* Vb = lds + 2 * KBUF;
    bf16x8 qf[NMAP][NC];
    { const bf16_t* qrow = Q + (size_t)(q0 + wid * 32 + r32) * ldq;
#pragma unroll
      for (int mp = 0; mp < NMAP; ++mp)
#pragma unroll
          for (int c = 0; c < NC; ++c) qf[mp][c] = *(const bf16x8*)(qrow + mp * DKM + 16 * c + 8 * hi); }
    f32x16 o[NMAP][NDB]; float mrow[NMAP], lrow[NMAP];
#pragma unroll
    for (int mp = 0; mp < NMAP; ++mp) { mrow[mp] = -INFINITY; lrow[mp] = 0.f;
#pragma unroll
        for (int db = 0; db < NDB; ++db)
#pragma unroll
            for (int r = 0; r < 16; ++r) o[mp][db][r] = 0.f; }
    u32x4 kreg[K0N], k1reg = {0u, 0u, 0u, 0u}, vreg[VN];
#define ATT_GLOAD(t) do { \
    _Pragma("unroll") for (int i = 0; i < K0N; ++i) { const int idx = tid + 512 * i, rr = idx / K0C, cc = idx % K0C; kreg[i] = *(const u32x4*)(K0 + (size_t)(64 * (t) + rr) * ldk0 + cc * 8); } \
    if (W1 > 0) { if (tid < 64 * K1C) { const int rr = tid / (K1C > 0 ? K1C : 1), cc = tid % (K1C > 0 ? K1C : 1); k1reg = *(const u32x4*)(K1 + (size_t)(64 * (t) + rr) * ldk1 + cc * 8); } } \
    _Pragma("unroll") for (int i = 0; i < VN; ++i) { const int idx = tid + 512 * i, dd = idx >> 3, cc = idx & 7; vreg[i] = *(const u32x4*)(Vt + (size_t)dd * ldv + 64 * (t) + cc * 8); } } while (0)
#define ATT_LWRITE(buf) do { \
    _Pragma("unroll") for (int i = 0; i < K0N; ++i) { const int idx = tid + 512 * i, rr = idx / K0C, cc = idx % K0C; *(LAS u32x4*)(Kb + (buf) * KBUF + rr * KS + cc * 16) = kreg[i]; } \
    if (W1 > 0) { if (tid < 64 * K1C) { const int rr = tid / (K1C > 0 ? K1C : 1), cc = tid % (K1C > 0 ? K1C : 1); *(LAS u32x4*)(Kb + (buf) * KBUF + rr * KS + W0 * 2 + cc * 16) = k1reg; } } \
    _Pragma("unroll") for (int i = 0; i < VN; ++i) { const int idx = tid + 512 * i, dd = idx >> 3, cc = idx & 7; LAS u32x2* vp = (LAS u32x2*)(Vb + (buf) * VBUF + dd * VS + cc * 16); \
        u32x2 lo_; lo_.x = vreg[i].x; lo_.y = vreg[i].y; u32x2 hi_; hi_.x = vreg[i].z; hi_.y = vreg[i].w; vp[0] = lo_; vp[1] = hi_; } } while (0)
    ATT_GLOAD(0);
    ATT_LWRITE(0);
    __syncthreads();
    const int qw0 = q0 + wid * 32;
    for (int t = 0; t < NT; ++t) {
        const int buf = t & 1;
        if (t + 1 < NT) ATT_GLOAD(t + 1);
#pragma unroll
        for (int kb = 0; kb < 2; ++kb) {
            const int kv0 = 64 * t + 32 * kb;
            if (CAUSAL && kv0 > qw0) continue;
            const bool diag = CAUSAL && (kv0 == qw0);
            bf16x8 vf[NDB][2];
#pragma unroll
            for (int db = 0; db < NDB; ++db)
#pragma unroll
                for (int j = 0; j < 2; ++j) { const LAS unsigned char* vp = Vb + buf * VBUF + (32 * db + r32) * VS + (32 * kb + 16 * j + 4 * hi) * 2;
                    const s16x4 lo = *(const LAS s16x4*)vp, hh = *(const LAS s16x4*)(vp + 16);
                    vf[db][j] = (bf16x8){lo[0], lo[1], lo[2], lo[3], hh[0], hh[1], hh[2], hh[3]}; }
#pragma unroll
            for (int mp = 0; mp < NMAP; ++mp) {
                f32x16 s;
#pragma unroll
                for (int r = 0; r < 16; ++r) s[r] = 0.f;
#pragma unroll
                for (int c = 0; c < NC; ++c) { const bf16x8 kf = *(const LAS bf16x8*)(Kb + buf * KBUF + (32 * kb + r32) * KS + (mp * DKM + 16 * c + 8 * hi) * 2);
                    s = __builtin_amdgcn_mfma_f32_32x32x16_bf16(kf, qf[mp][c], s, 0, 0, 0); }
                if (diag) {
#pragma unroll
                    for (int r = 0; r < 16; ++r) if (crow(r, hi) > r32) s[r] = -INFINITY;
                }
                float mx = s[0];
#pragma unroll
                for (int r = 1; r < 16; ++r) mx = fmaxf(mx, s[r]);
                mx = fmaxf(mx, __shfl_xor(mx, 32));
                if (__any(mx > mrow[mp])) {
                    const float mnew = fmaxf(mrow[mp], mx), alpha = fast_exp2(mrow[mp] - mnew);
                    mrow[mp] = mnew; lrow[mp] *= alpha;
#pragma unroll
                    for (int db = 0; db < NDB; ++db)
#pragma unroll
                        for (int r = 0; r < 16; ++r) o[mp][db][r] *= alpha;
                }
                const float mcur = mrow[mp]; float ls = 0.f;
#pragma unroll
                for (int r = 0; r < 16; ++r) { s[r] = fast_exp2(s[r] - mcur); ls += s[r]; }
                lrow[mp] += ls;
                bf16x8 pa[2];
#pragma unroll
                for (int j = 0; j < 2; ++j) { u32x4 w; w.x = cvtpk(s[8 * j + 0], s[8 * j + 1]); w.y = cvtpk(s[8 * j + 2], s[8 * j + 3]); w.z = cvtpk(s[8 * j + 4], s[8 * j + 5]); w.w = cvtpk(s[8 * j + 6], s[8 * j + 7]); pa[j] = __builtin_bit_cast(bf16x8, w); }
#pragma unroll
                for (int db = 0; db < NDB; ++db)
#pragma unroll
                    for (int j = 0; j < 2; ++j) o[mp][db] = __builtin_amdgcn_mfma_f32_32x32x16_bf16(vf[db][j], pa[j], o[mp][db], 0, 0, 0);
            }
        }
        if (t + 1 < NT) ATT_LWRITE(buf ^ 1);
        __syncthreads();
    }
#undef ATT_GLOAD
#undef ATT_LWRITE
    float inv[NMAP];
#pragma unroll
    for (int mp = 0; mp < NMAP; ++mp) { const float lt = lrow[mp] + __shfl_xor(lrow[mp], 32); inv[mp] = 1.0f / lt; }
    bf16_t* orow = O + (size_t)(q0 + wid * 32 + r32) * ldo;
    if constexpr (NMAP == 1) {
#pragma unroll
        for (int db = 0; db < NDB; ++db)
#pragma unroll
            for (int g = 0; g < 4; ++g) { f32x4 v; for (int i = 0; i < 4; ++i) v[i] = o[0][db][4 * g + i] * inv[0]; store4bf(orow + 32 * db + 8 * g + 4 * hi, v); }
    } else {
        float ss = 0.f;
#pragma unroll
        for (int db = 0; db < NDB; ++db)
#pragma unroll
            for (int r = 0; r < 16; ++r) { const float v = o[0][db][r] * inv[0] - lam * (o[1][db][r] * inv[1]); o[0][db][r] = v; ss += v * v; }
        ss += __shfl_xor(ss, 32);
        const float rstd = __builtin_amdgcn_rsqf(ss * (1.0f / DV) + NORM_EPS) * outscale;
#pragma unroll
        for (int db = 0; db < NDB; ++db)
#pragma unroll
            for (int g = 0; g < 4; ++g) { const f32x4 gn = *(const f32x4*)(subln + 32 * db + 8 * g + 4 * hi); f32x4 v; for (int i = 0; i < 4; ++i) v[i] = o[0][db][4 * g + i] * rstd * gn[i]; store4bf(orow + 32 * db + 8 * g + 4 * hi, v); }
    }
}

template <int NMAP, int DKM, int DV, int W0, int W1>
__device__ __forceinline__ void attn_unit2(LAS unsigned char* lds, const bf16_t* __restrict__ Q, int ldq, const bf16_t* __restrict__ K0, int ldk0, const bf16_t* __restrict__ K1, int ldk1,
                                           const bf16_t* __restrict__ Vt, size_t ldv, int q0, int NT, bf16_t* O, int ldo, float lam, const float* subln, float outscale) {
    constexpr int DKT = NMAP * DKM, KS = DKT * 2 + 16, VS = 136, KBUF = 64 * KS, VBUF = DV * VS;
    constexpr int NC = DKM / 16, NDB = DV / 32;
    constexpr int K0C = W0 / 8, K0N = (64 * K0C) / 512, K1C = W1 / 8, VN = (DV * 8) / 512;
    static_assert(W0 + W1 == DKT && K0N >= 1 && VN >= 1, "attention staging geometry");
    int tid = threadIdx.x; asm volatile("" : "+v"(tid));
    const int lane = tid & 63, wid = __builtin_amdgcn_readfirstlane(tid >> 6), r32 = lane & 31, hi = lane >> 5;
    LAS unsigned char* Kb = lds; LAS unsigned char* Vb = lds + 2 * KBUF;
    bf16x8 qf[NMAP][NC];
    { const bf16_t* qrow = Q + (size_t)(q0 + wid * 32 + r32) * ldq;
#pragma unroll
      for (int mp = 0; mp < NMAP; ++mp)
#pragma unroll
          for (int c = 0; c < NC; ++c) qf[mp][c] = *(const bf16x8*)(qrow + mp * DKM + 16 * c + 8 * hi); }
    f32x16 o[NMAP][NDB], negm[NMAP]; float lrow[NMAP];
#pragma unroll
    for (int mp = 0; mp < NMAP; ++mp) { lrow[mp] = 0.f;
#pragma unroll
        for (int r = 0; r < 16; ++r) negm[mp][r] = 0.f;
#pragma unroll
        for (int db = 0; db < NDB; ++db)
#pragma unroll
            for (int r = 0; r < 16; ++r) o[mp][db][r] = 0.f; }
    u32x4 kreg[K0N], k1reg = {0u, 0u, 0u, 0u}, vreg[VN];
#define ATT_GLOAD(t) do { \
    _Pragma("unroll") for (int i = 0; i < K0N; ++i) { const int idx = tid + 512 * i, rr = idx / K0C, cc = idx % K0C; kreg[i] = *(const u32x4*)(K0 + (size_t)(64 * (t) + rr) * ldk0 + cc * 8); } \
    if (W1 > 0) { if (tid < 64 * K1C) { const int rr = tid / (K1C > 0 ? K1C : 1), cc = tid % (K1C > 0 ? K1C : 1); k1reg = *(const u32x4*)(K1 + (size_t)(64 * (t) + rr) * ldk1 + cc * 8); } } \
    _Pragma("unroll") for (int i = 0; i < VN; ++i) { const int idx = tid + 512 * i, dd = idx >> 3, cc = idx & 7; vreg[i] = *(const u32x4*)(Vt + (size_t)dd * ldv + 64 * (t) + cc * 8); } } while (0)
#define ATT_LWRITE(buf) do { \
    _Pragma("unroll") for (int i = 0; i < K0N; ++i) { const int idx = tid + 512 * i, rr = idx / K0C, cc = idx % K0C; *(LAS u32x4*)(Kb + (buf) * KBUF + rr * KS + cc * 16) = kreg[i]; } \
    if (W1 > 0) { if (tid < 64 * K1C) { const int rr = tid / (K1C > 0 ? K1C : 1), cc = tid % (K1C > 0 ? K1C : 1); *(LAS u32x4*)(Kb + (buf) * KBUF + rr * KS + W0 * 2 + cc * 16) = k1reg; } } \
    _Pragma("unroll") for (int i = 0; i < VN; ++i) { const int idx = tid + 512 * i, dd = idx >> 3, cc = idx & 7; LAS u32x2* vp = (LAS u32x2*)(Vb + (buf) * VBUF + dd * VS + cc * 16); \
        u32x2 lo_; lo_.x = vreg[i].x; lo_.y = vreg[i].y; u32x2 hi_; hi_.x = vreg[i].z; hi_.y = vreg[i].w; vp[0] = lo_; vp[1] = hi_; } } while (0)
    ATT_GLOAD(0);
    ATT_LWRITE(0);
    __syncthreads();
    const int qw0 = q0 + wid * 32;
    for (int t = 0; t < NT; ++t) {
        const int buf = t & 1;
        if (t + 1 < NT) ATT_GLOAD(t + 1);
        const int kvt = 64 * t;
        if (kvt <= qw0) {
            const bool band = (kvt + 63 > qw0);
#pragma unroll
            for (int mp = 0; mp < NMAP; ++mp) {
                f32x16 s0, s1;
#pragma unroll
                for (int c = 0; c < NC; ++c) {
                    const bf16x8 kf0 = *(const LAS bf16x8*)(Kb + buf * KBUF + r32 * KS + (mp * DKM + 16 * c + 8 * hi) * 2);
                    const bf16x8 kf1 = *(const LAS bf16x8*)(Kb + buf * KBUF + (32 + r32) * KS + (mp * DKM + 16 * c + 8 * hi) * 2);
                    if (c == 0) { s0 = __builtin_amdgcn_mfma_f32_32x32x16_bf16(kf0, qf[mp][0], negm[mp], 0, 0, 0); s1 = __builtin_amdgcn_mfma_f32_32x32x16_bf16(kf1, qf[mp][0], negm[mp], 0, 0, 0); }
                    else { s0 = __builtin_amdgcn_mfma_f32_32x32x16_bf16(kf0, qf[mp][c], s0, 0, 0, 0); s1 = __builtin_amdgcn_mfma_f32_32x32x16_bf16(kf1, qf[mp][c], s1, 0, 0, 0); }
                }
                if (band) {
                    const int qd = qw0 + r32 - kvt;
#pragma unroll
                    for (int r = 0; r < 16; ++r) { const int kv = crow(r, hi); if (kv > qd) s0[r] = -INFINITY; if (kv + 32 > qd) s1[r] = -INFINITY; }
                }
                float mx = fmaxf(s0[0], s1[0]);
#pragma unroll
                for (int r = 1; r < 16; ++r) mx = fmaxf(mx, fmaxf(s0[r], s1[r]));
                mx = fmaxf(mx, __shfl_xor(mx, 32));
                if (__any(t == 0 || mx > 8.0f)) {
                    const float dl = (t == 0) ? mx : fmaxf(mx, 0.f), alpha = fast_exp2(-dl);
                    lrow[mp] *= alpha;
#pragma unroll
                    for (int r = 0; r < 16; ++r) { s0[r] -= dl; s1[r] -= dl; negm[mp][r] -= dl; }
#pragma unroll
                    for (int db = 0; db < NDB; ++db)
#pragma unroll
                        for (int r = 0; r < 16; ++r) o[mp][db][r] *= alpha;
                }
                float ls = 0.f;
#pragma unroll
                for (int kb = 0; kb < 2; ++kb) {
                    f32x16& s = kb ? s1 : s0;
                    bf16x8 vf[NDB][2];
#pragma unroll
                    for (int db = 0; db < NDB; ++db)
#pragma unroll
                        for (int j = 0; j < 2; ++j) { const LAS unsigned char* vp = Vb + buf * VBUF + (32 * db + r32) * VS + (32 * kb + 16 * j + 4 * hi) * 2;
                            const s16x4 lo = *(const LAS s16x4*)vp, hh = *(const LAS s16x4*)(vp + 16);
                            vf[db][j] = (bf16x8){lo[0], lo[1], lo[2], lo[3], hh[0], hh[1], hh[2], hh[3]}; }
#pragma unroll
                    for (int r = 0; r < 16; ++r) { s[r] = fast_exp2(s[r]); ls += s[r]; }
                    bf16x8 pa[2];
#pragma unroll
                    for (int j = 0; j < 2; ++j) { u32x4 w; w.x = cvtpk(s[8 * j + 0], s[8 * j + 1]); w.y = cvtpk(s[8 * j + 2], s[8 * j + 3]); w.z = cvtpk(s[8 * j + 4], s[8 * j + 5]); w.w = cvtpk(s[8 * j + 6], s[8 * j + 7]); pa[j] = __builtin_bit_cast(bf16x8, w); }
#pragma unroll
                    for (int db = 0; db < NDB; ++db)
#pragma unroll
                        for (int j = 0; j < 2; ++j) o[mp][db] = __builtin_amdgcn_mfma_f32_32x32x16_bf16(vf[db][j], pa[j], o[mp][db], 0, 0, 0);
                }
                lrow[mp] += ls;
                if (NMAP > 1) __builtin_amdgcn_sched_barrier(0);
            }
        }
        if (t + 1 < NT) ATT_LWRITE(buf ^ 1);
        __syncthreads();
    }
#undef ATT_GLOAD
#undef ATT_LWRITE
    float inv[NMAP];
#pragma unroll
    for (int mp = 0; mp < NMAP; ++mp) { const float lt = lrow[mp] + __shfl_xor(lrow[mp], 32); inv[mp] = 1.0f / lt; }
    bf16_t* orow = O + (size_t)(q0 + wid * 32 + r32) * ldo;
    if constexpr (NMAP == 1) {
#pragma unroll
        for (int db = 0; db < NDB; ++db)
#pragma unroll
            for (int g = 0; g < 4; ++g) { f32x4 v; for (int i = 0; i < 4; ++i) v[i] = o[0][db][4 * g + i] * inv[0]; store4bf(orow + 32 * db + 8 * g + 4 * hi, v); }
    } else {
        float ss = 0.f;
#pragma unroll
        for (int db = 0; db < NDB; ++db)
#pragma unroll
            for (int r = 0; r < 16; ++r) { const float v = o[0][db][r] * inv[0] - lam * (o[1][db][r] * inv[1]); o[0][db][r] = v; ss += v * v; }
        ss += __shfl_xor(ss, 32);
        const float rstd = __builtin_amdgcn_rsqf(ss * (1.0f / DV) + NORM_EPS) * outscale;
#pragma unroll
        for (int db = 0; db < NDB; ++db)
#pragma unroll
            for (int g = 0; g < 4; ++g) { const f32x4 gn = *(const f32x4*)(subln + 32 * db + 8 * g + 4 * hi); f32x4 v; for (int i = 0; i < 4; ++i) v[i] = o[0][db][4 * g + i] * rstd * gn[i]; store4bf(orow + 32 * db + 8 * g + 4 * hi, v); }
    }
}

__device__ __forceinline__ float wave_sum(float v) {
#pragma unroll
    for (int o = 1; o < 64; o <<= 1) v += __shfl_xor(v, o);
    return v;
}
__device__ __forceinline__ void transpose_block(const float* __restrict__ W, int ldw, int src_col0, const float* __restrict__ gain, bf16_t* WT, int K, int dst_row0, int k0, LAS float* scr, int lane) {
#pragma unroll 8
    for (int i = 0; i < 32; ++i) { const int kk = 2 * i + (lane >> 5); float v = W[(size_t)(k0 + kk) * ldw + src_col0 + (lane & 31)]; if (gain) v *= gain[k0 + kk]; scr[kk * 33 + (lane & 31)] = v; }
    asm volatile("s_waitcnt lgkmcnt(0)" ::: "memory");
    const int c = lane & 7;
#pragma unroll
    for (int j = 0; j < 4; ++j) { const int n = (lane >> 3) + 8 * j; const LAS float* s = scr + (8 * c) * 33 + n;
        u32x4 ov; ov.x = cvtpk(s[0 * 33], s[1 * 33]); ov.y = cvtpk(s[2 * 33], s[3 * 33]); ov.z = cvtpk(s[4 * 33], s[5 * 33]); ov.w = cvtpk(s[6 * 33], s[7 * 33]);
        *(u32x4*)(WT + (size_t)(dst_row0 + n) * K + k0 + 8 * c) = ov; }
    asm volatile("s_waitcnt lgkmcnt(0)" ::: "memory");
}

struct Args { const float* in[20]; float* out; unsigned char* ws; int ph_lo, ph_hi, coop, pad; float lam_init[4]; };

__global__ void __launch_bounds__(512, 2) hybrid_fwd(Args a) {
    extern __shared__ __attribute__((aligned(16))) unsigned char lds_raw[];
    LAS unsigned char* lds = (LAS unsigned char*)lds_raw;
    const float* x_in = a.in[0]; const float* mem = a.in[1]; const int* positions = (const int*)a.in[2];
    const float* norm_pre = a.in[3]; const float* norm_post = a.in[4]; const float* w_in = a.in[5]; const float* q_norm = a.in[6]; const float* w_uq = a.in[7];
    const float* kv_norm = a.in[8]; const float* w_ukv = a.in[9]; const float* lq1 = a.in[10]; const float* lk1 = a.in[11]; const float* lq2 = a.in[12]; const float* lk2 = a.in[13];
    const float* diff_subln = a.in[14]; const float* mem_norm = a.in[15]; const float* w_mem_kv = a.in[16]; const float* b_gate = a.in[17]; const float* w_branch = a.in[18]; const float* w_out = a.in[19];
#define P_WT ((bf16_t*)(ws + OFF_W))
#define P_COS ((float*)(ws + OFF_COS))
#define P_SIN ((float*)(ws + OFF_SIN))
#define P_SSQq ((float*)(ws + OFF_SSQQ))
#define P_SSQkv ((float*)(ws + OFF_SSQKV))
#define P_MN ((bf16_t*)(ws + OFF_MN))
#define P_KM ((bf16_t*)(ws + OFF_KM))
#define P_VMT ((bf16_t*)(ws + OFF_VMT))
#define P_XN ((bf16_t*)(ws + OFF_XN))
#define P_OB ((bf16_t*)(ws + OFF_O))
#define P_CQ ((bf16_t*)(ws + OFF_CQ))
#define P_CKV ((bf16_t*)(ws + OFF_CKV))
#define P_KPE ((bf16_t*)(ws + OFF_KPE))
#define P_QD ((bf16_t*)(ws + OFF_QD))
#define P_KD ((bf16_t*)(ws + OFF_KD))
#define P_VDT ((bf16_t*)(ws + OFF_VDT))
#define P_QX ((bf16_t*)(ws + OFF_QX))
#define P_QA ((bf16_t*)(ws + OFF_QA))
#define P_KN ((bf16_t*)(ws + OFF_KN))
#define P_VAT ((bf16_t*)(ws + OFF_VAT))
#define P_SB ((bf16_t*)(ws + OFF_S))
#define P_MG ((bf16_t*)(ws + OFF_MERGED))
#define P_OUTB ((float*)(ws + OFF_OUT))

    for (int ph = a.ph_lo; ph < a.ph_hi; ++ph) {
        __attribute__((address_space(1))) unsigned char* ws = (__attribute__((address_space(1))) unsigned char*)a.ws; asm volatile("" : "+s"(ws));
        int tid = threadIdx.x; asm volatile("" : "+v"(tid)); const int lane = tid & 63, wave = __builtin_amdgcn_readfirstlane(tid >> 6);
        int G = gridDim.x, bx = blockIdx.x; asm volatile("" : "+s"(G), "+s"(bx));
        const int vcu = (G % 8 == 0) ? (bx % 8) * (G / 8) + bx / 8 : bx;
        const int gw = vcu * 8 + wave, NGW = G * 8;
        if (ph == 0) {
#if PHSEL & 1
            LAS float* scr = (LAS float*)(lds + wave * 16384);
            constexpr int I_IN = 16 * 221, I_UQ = 4 * 24, I_UKV = 2 * 32, I_MEM = 16 * 32, I_BR = 3 * 256, I_OUT = 16 * 32;
            constexpr int I_L = I_IN + I_UQ + I_UKV + I_MEM + I_BR + I_OUT;
            for (int it = gw; it < DEPTH * I_L; it += NGW) {
                const int l = it / I_L; int r = it - l * I_L; bf16_t* wl = P_WT + (size_t)l * WL_TOTAL;
                if (r < I_IN) { const int kb = r / 221, nb = r - kb * 221, n = nb * 32; int dr;
                    if (n < 416) dr = n; else if (n < 1440) dr = n + 96; else if (n < 1952) dr = n - 1440 + 2048; else if (n < 2464) dr = n - 1952 + 1536; else dr = n + 96;
                    transpose_block(w_in + (size_t)l * 1024 * IN_WIDTH, IN_WIDTH, n, norm_pre + l * 1024, wl + WL_IN, 1024, dr, kb * 64, scr, lane); continue; }
                r -= I_IN;
                if (r < I_UQ) { const int kb = r / 24, nb = r - kb * 24, n = nb * 32, h = n / 96, w = n - h * 96; const int dr = (w < 64) ? h * 64 + w : 512 + h * 32 + (w - 64);
                    transpose_block(w_uq + (size_t)l * 256 * 768, 768, n, q_norm + l * 256, wl + WL_UQ, 256, dr, kb * 64, scr, lane); continue; }
                r -= I_UQ;
                if (r < I_UKV) { const int kb = r / 32, nb = r - kb * 32, n = nb * 32, h = n / 128, w = n - h * 128; const int dr = (w < 64) ? h * 64 + w : 512 + h * 64 + (w - 64);
                    transpose_block(w_ukv + (size_t)l * 128 * 1024, 1024, n, kv_norm + l * 128, wl + WL_UKV, 128, dr, kb * 64, scr, lane); continue; }
                r -= I_UKV;
                if (r < I_MEM) { const int kb = r / 32, nb = r - kb * 32;
                    transpose_block(w_mem_kv + (size_t)l * 1024 * 1024, 1024, nb * 32, mem_norm + l * 1024, wl + WL_MEM, 1024, nb * 32, kb * 64, scr, lane); continue; }
                r -= I_MEM;
                if (r < I_BR) { const int i = r / 256, rr = r - i * 256, kb = rr / 32, nb = rr - kb * 32;
                    transpose_block(w_branch + (size_t)(l * 3 + i) * 512 * 1024, 1024, nb * 32, nullptr, wl + WL_BR + (size_t)i * 1024 * 512, 512, nb * 32, kb * 64, scr, lane); continue; }
                r -= I_BR;
                { const int kb = r / 32, nb = r - kb * 32;
                    transpose_block(w_out + (size_t)l * 1024 * 1024, 1024, nb * 32, nullptr, wl + WL_OUT, 1024, nb * 32, kb * 64, scr, lane); }
            }
            for (int i = bx * 512 + tid; i < DEPTH * 96 * 1024 / 8; i += G * 512) { const int l = i / (96 * 1024 / 8), rr = i - l * (96 * 1024 / 8);
                *(u32x4*)(P_WT + (size_t)l * WL_TOTAL + WL_IN + (size_t)416 * 1024 + (size_t)rr * 8) = (u32x4){0u, 0u, 0u, 0u}; }
            for (int i = bx * 512 + tid; i < SEQ * 16; i += G * 512) { const int s = i >> 4, j = i & 15;
                const float invf = powf(10000.0f, -(float)j / 16.0f); const float ang = (float)positions[s] * invf;
                double rv = (double)ang * 0.15915494309189535; rv -= floor(rv); const float f = (float)rv;
                P_COS[i] = __builtin_amdgcn_cosf(f); P_SIN[i] = __builtin_amdgcn_sinf(f); }
            for (int m = gw; m < MMEM + MTOK; m += NGW) {
                const float* src = (m < MMEM) ? mem + (size_t)m * 1024 : x_in + (size_t)(m - MMEM) * 1024; bf16_t* dst = (m < MMEM) ? P_MN + (size_t)m * 1024 : P_XN + (size_t)(m - MMEM) * 1024;
                f32x4 v[4]; float s = 0.f;
#pragma unroll
                for (int j = 0; j < 4; ++j) { v[j] = ((const f32x4*)src)[64 * j + lane]; s += (v[j][0] * v[j][0] + v[j][1] * v[j][1]) + (v[j][2] * v[j][2] + v[j][3] * v[j][3]); }
                const float rstd = __builtin_amdgcn_rsqf(wave_sum(s) * (1.0f / 1024.0f) + NORM_EPS);
#pragma unroll
                for (int j = 0; j < 4; ++j) store4bf(dst + 4 * (64 * j + lane), v[j] * rstd);
            }
#endif
        } else {
            const int l = (ph - 1) / 7, sub = (ph - 1) % 7;
            const bf16_t* wl = P_WT + (size_t)l * WL_TOTAL;
            if (sub == 0) {
#if PHSEL & 2
#if GSEL & 1
                { pg8::Gemm g{P_XN, wl + WL_IN, MTOK, 2048, 1024, 1024, 1024, 0, 0}; pg8::StaticOrder S; S.init(MTOK, 2048, G, bx);
                  pg8::Epi1 E{P_CQ, P_CKV, P_KPE, P_QD, P_KD, P_QX, P_SSQq, P_SSQkv, P_COS, P_SIN, 0.17677669529663687f * LOG2E, 0.08838834764831845f * LOG2E};
                  pg8::gemm_phase(lds, g, S, E); }
#endif
#if GSEL & 2
                { pg8::Gemm g{wl + WL_IN + (size_t)2048 * 1024, P_XN, 512, MTOK, 1024, 1024, 1024, 0, 0}; pg8::StaticOrder S; S.init(512, MTOK, G, bx);
                  pg8::EpiT E{P_VDT, (size_t)MTOK, 0, nullptr, 0.f, nullptr};
                  pg8::gemm_phase(lds, g, S, E); }
#endif
                if (l == 0) {
#if GSEL & 4
                    { pg8::Gemm g{P_MN, P_WT + WL_MEM, MMEM, 512, 1024, 1024, 1024, 0, WL_TOTAL}; pg8::StaticOrder S; S.init(MMEM, 512, G, bx, DEPTH);
                      pg8::EpiRow E{P_KM, 512, (size_t)MMEM * 512, nullptr, 0.f};
                      pg8::gemm_phase(lds, g, S, E); }
#endif
#if GSEL & 8
                    { pg8::Gemm g{P_WT + WL_MEM + (size_t)512 * 1024, P_MN, 512, MMEM, 1024, 1024, 1024, WL_TOTAL, 0}; pg8::StaticOrder S; S.init(512, MMEM, G, bx, DEPTH);
                      pg8::EpiT E{P_VMT, (size_t)MMEM, (size_t)512 * MMEM, nullptr, 0.f, nullptr};
                      pg8::gemm_phase(lds, g, S, E); }
#endif
                }
#endif
            } else if (sub == 1) {
#if PHSEL & 4
#if GSEL & 16
                { pg8::Gemm g{P_CQ, wl + WL_UQ, MTOK, 768, 256, 256, 256, 0, 0}; pg8::StaticOrder S; S.init(MTOK, 768, G, bx);
                  pg8::Epi2 E{P_QA, P_SSQq, P_COS, P_SIN, 0.10206207261596575f * LOG2E};
                  pg8::gemm_phase(lds, g, S, E); }
#endif
#if GSEL & 32
                { pg8::Gemm g{P_CKV, wl + WL_UKV, MTOK, 512, 128, 128, 128, 0, 0}; pg8::StaticOrder S; S.init(MTOK, 512, G, bx);
                  pg8::EpiRow E{P_KN, 512, 0, P_SSQkv, 1.0f / 128.0f};
                  pg8::gemm_phase(lds, g, S, E); }
#endif
#if GSEL & 64
                { pg8::Gemm g{wl + WL_UKV + (size_t)512 * 128, P_CKV, 512, MTOK, 128, 128, 128, 0, 0}; pg8::StaticOrder S; S.init(512, MTOK, G, bx);
                  pg8::EpiT E{P_VAT, (size_t)MTOK, 0, P_SSQkv, 1.0f / 128.0f, nullptr};
                  pg8::gemm_phase(lds, g, S, E); }
#endif
#endif
            } else if (sub == 2) {
#if PHSEL & 8
                const float d1 = wave_sum(lane < 32 ? lq1[l * 32 + lane] * lk1[l * 32 + lane] : 0.f), d2 = wave_sum(lane < 32 ? lq2[l * 32 + lane] * lk2[l * 32 + lane] : 0.f);
                const float lam_init = a.lam_init[l]; const float lam = expf(d1) - expf(d2) + lam_init;
#if ATTSEL & 1
                for (int P = vcu; P < 1024; P += G) { const int bh = P >> 3, s = P & 7, b = bh >> 3, h = bh & 7; const size_t rb = (size_t)b * SEQ;
                    for (int k = 0; k < 2; ++k) { const int qb = k ? s : 15 - s;
                        attn_unit2<1, 96, 64, 64, 32>(lds, P_QA + rb * 768 + h * 96, 768, P_KN + rb * 512 + h * 64, 512, P_KPE + rb * 32, 32, P_VAT + (size_t)(h * 64) * MTOK + rb, (size_t)MTOK,
                                                            qb * 256, 4 * (qb + 1), P_OB + rb * 1536 + h * 64, 1536, 0.f, nullptr, 1.f); } }
#endif
                asm volatile("" ::: "memory"); __builtin_amdgcn_sched_barrier(0);
#if ATTSEL & 2
                for (int P = vcu; P < 1024; P += G) { const int bh = P >> 3, s = P & 7, b = bh >> 3, h = bh & 7; const size_t rb = (size_t)b * SEQ;
                    for (int k = 0; k < 2; ++k) { const int qb = k ? s : 15 - s;
                        attn_unit2<2, 32, 64, 64, 0>(lds, P_QD + rb * 512 + h * 64, 512, P_KD + rb * 512 + h * 64, 512, nullptr, 0, P_VDT + (size_t)(h * 64) * MTOK + rb, (size_t)MTOK,
                                                           qb * 256, 4 * (qb + 1), P_OB + rb * 1536 + 512 + h * 64, 1536, lam, diff_subln + l * 64, 1.0f - lam_init); } }
#endif
                asm volatile("" ::: "memory"); __builtin_amdgcn_sched_barrier(0);
#if ATTSEL & 4
                for (int X = vcu; X < 1024; X += G) { const int bh = X >> 4, qb = X & 15, b = bh >> 2, h = bh & 3; const size_t rb = (size_t)b * SEQ;
                    attn_unit<1, 128, 128, false, 128, 0>(lds, P_QX + rb * 512 + h * 128, 512, P_KM + (size_t)l * MMEM * 512 + (size_t)b * MEMT * 512 + h * 128, 512, nullptr, 0,
                                                           P_VMT + (size_t)l * 512 * MMEM + (size_t)(h * 128) * MMEM + (size_t)b * MEMT, (size_t)MMEM,
                                                           qb * 256, 4, P_OB + rb * 1536 + 1024 + h * 128, 1536, 0.f, nullptr, 1.f); }
#endif
#endif
            } else if (sub == 3) {
#if PHSEL & 16
                { pg8::Gemm g{P_XN, wl + WL_IN + (size_t)2560 * 1024, MTOK, 1536, 1024, 1024, 1024, 0, 0}; pg8::StaticOrder S; S.init(MTOK, 1536, G, bx);
                  pg8::EpiSG E{P_OB};
                  pg8::gemm_phase(lds, g, S, E); }
                { pg8::Gemm g{P_XN, wl + WL_IN + (size_t)4096 * 1024, MTOK, 3072, 1024, 1024, 1024, 0, 0}; pg8::StaticOrder S; S.init(MTOK, 3072, G, bx);
                  pg8::EpiGL E{P_SB, b_gate + l * 3072};
                  pg8::gemm_phase(lds, g, S, E); }
#endif
            } else if (sub == 4) {
#if PHSEL & 32
                pg8::Gemm g{P_OB, wl + WL_BR, MTOK, 1024, 512, 1536, 512, 512, (size_t)1024 * 512}; pg8::StaticOrder S; S.init(MTOK, 1024, G, bx, 3);
                pg8::EpiBR E{P_SB, P_MG};
                pg8::gemm_phase(lds, g, S, E);
#endif
            } else if (sub == 5) {
#if PHSEL & 64
                pg8::Gemm g{P_MG, wl + WL_OUT, MTOK, 1024, 1024, 1024, 1024, 0, 0}; pg8::StaticOrder S; S.init(MTOK, 1024, G, bx);
                pg8::EpiRow E{(bf16_t*)P_OUTB, 1024, 0, nullptr, 0.f};
                pg8::gemm_phase(lds, g, S, E);
#endif
            } else {
#if PHSEL & 128
                const float* xo = (l == 0) ? x_in : a.out; const float* gp = norm_post + l * 1024;
                for (int m = gw; m < MTOK; m += NGW) {
                    f32x4 v[4]; float s = 0.f;
#pragma unroll
                    for (int j = 0; j < 4; ++j) { v[j] = unpack4bf(((const u32x2*)((const bf16_t*)P_OUTB + (size_t)m * 1024))[64 * j + lane]); s += (v[j][0] * v[j][0] + v[j][1] * v[j][1]) + (v[j][2] * v[j][2] + v[j][3] * v[j][3]); }
                    const float rstd = __builtin_amdgcn_rsqf(wave_sum(s) * (1.0f / 1024.0f) + NORM_EPS); float s2 = 0.f;
#pragma unroll
                    for (int j = 0; j < 4; ++j) { const f32x4 xv = ((const f32x4*)(xo + (size_t)m * 1024))[64 * j + lane]; const f32x4 gv = ((const f32x4*)gp)[64 * j + lane];
                        v[j] = xv + v[j] * rstd * gv; ((f32x4*)(a.out + (size_t)m * 1024))[64 * j + lane] = v[j];
                        s2 += (v[j][0] * v[j][0] + v[j][1] * v[j][1]) + (v[j][2] * v[j][2] + v[j][3] * v[j][3]); }
                    if (l + 1 < DEPTH) { const float rstd2 = __builtin_amdgcn_rsqf(wave_sum(s2) * (1.0f / 1024.0f) + NORM_EPS);
#pragma unroll
                        for (int j = 0; j < 4; ++j) store4bf(P_XN + (size_t)m * 1024 + 4 * (64 * j + lane), v[j] * rstd2); }
                }
#endif
            }
        }
        if (ph + 1 < a.ph_hi) { if (a.coop) cg::this_grid().sync(); }
    }
#ifdef DBG_NPH
    if (a.pad) {
        if (a.coop) cg::this_grid().sync();
        const unsigned short* w16 = (const unsigned short*)(a.ws + OFF_MN);
        const size_t n16 = (WS_END - OFF_MN) / 2, nout = (size_t)MTOK * 1024;
        for (size_t i = (size_t)blockIdx.x * 512 + threadIdx.x; i < nout; i += (size_t)gridDim.x * 512) {
            unsigned x = 0; for (size_t k = i; k < n16; k += nout) x ^= w16[k];
            const unsigned short* w2 = (const unsigned short*)(a.ws + OFF_COS); if (i < (size_t)(4 * MiB) / 2) x ^= w2[i];
            a.out[i] = (float)x;
        }
    }
#endif
}

extern "C" void kernel_launch(void* const* d_in, const int* in_sizes, int n_in, void* d_out, int out_size, void* d_ws, size_t ws_size, hipStream_t stream) {
    static int grid = 0;
    if (grid == 0) {
        if (n_in != 20 || ws_size < WS_END) { fprintf(stderr, "kernel_launch: need 20 inputs and >= %zu bytes of workspace (got %d, %zu)\n", (size_t)WS_END, n_in, ws_size); grid = -1; return; }
        int dev = 0, cus = 0, per_cu = 0;
        hipGetDevice(&dev); hipDeviceGetAttribute(&cus, hipDeviceAttributeMultiprocessorCount, dev);
        if (hipFuncSetAttribute((const void*)hybrid_fwd, hipFuncAttributeMaxDynamicSharedMemorySize, LDS_BYTES) != hipSuccess) { fprintf(stderr, "kernel_launch: hipFuncSetAttribute failed\n"); grid = -1; return; }
        if (hipOccupancyMaxActiveBlocksPerMultiprocessor(&per_cu, (const void*)hybrid_fwd, 512, LDS_BYTES) != hipSuccess || per_cu < 1) per_cu = 1;
        (void)hipGetLastError();
        grid = cus * 1;
    }
    if (grid < 0) return;
    Args a{};
    for (int i = 0; i < 20; ++i) a.in[i] = (const float*)d_in[i];
    a.out = (float*)d_out; a.ws = (unsigned char*)d_ws; a.pad = 0;
    a.lam_init[0] = 0.2f; a.lam_init[1] = 0.35550906759096926f; a.lam_init[2] = 0.47071301834358424f; a.lam_init[3] = 0.55605820415654f;
#if MK_ONE_LAUNCH
#ifdef DBG_NPH
    a.ph_lo = 0; a.ph_hi = DBG_NPH; a.coop = 1; a.pad = 1;
#else
    a.ph_lo = 0; a.ph_hi = NPHASE; a.coop = 1;
#endif
    void* args[] = {&a};
    hipError_t e = hipLaunchCooperativeKernel((const void*)hybrid_fwd, dim3(grid), dim3(512), args, LDS_BYTES, stream);
    if (e != hipSuccess) fprintf(stderr, "cooperative launch failed: %s (grid %d)\n", hipGetErrorString(e), grid);
#else
    for (int ph = 0; ph < NPHASE; ++ph) { a.ph_lo = ph; a.ph_hi = ph + 1; a.coop = 0;
        hipLaunchKernelGGL(hybrid_fwd, dim3(grid), dim3(512), LDS_BYTES, stream, a); }
#endif
}
```

```cpp
#include <hip/hip_runtime.h>
#include <hip/hip_cooperative_groups.h>
#include <cstdio>
#include <cstdint>
namespace cg = cooperative_groups;

#ifndef ATTSEL
#define ATTSEL 7
#endif
#ifndef GSEL
#define GSEL 0xFFFF
#endif
#ifndef PHSEL
#define PHSEL 0xFFFF
#endif
#ifndef MK_ONE_LAUNCH
#define MK_ONE_LAUNCH 1
#endif

#define LAS __attribute__((address_space(3)))
typedef unsigned short bf16_t;
typedef short bf16x8 __attribute__((ext_vector_type(8)));
typedef short s16x4 __attribute__((ext_vector_type(4)));
typedef float f32x4 __attribute__((ext_vector_type(4)));
typedef float f32x16 __attribute__((ext_vector_type(16)));
typedef unsigned u32x4 __attribute__((ext_vector_type(4)));
typedef unsigned u32x2 __attribute__((ext_vector_type(2)));
typedef float f32x2_t __attribute__((ext_vector_type(2)));
typedef __bf16 bf16x2_t __attribute__((ext_vector_type(2)));

constexpr int D_MODEL = 1024, BATCH = 16, SEQ = 4096, DEPTH = 4, MEMT = 256;
constexpr int MTOK = BATCH * SEQ;
constexpr int MMEM = BATCH * MEMT;
constexpr int IN_WIDTH = 7072;
constexpr float NORM_EPS = 1e-6f;
constexpr float LOG2E = 1.4426950408889634f;

constexpr size_t WL_IN = 0;
constexpr size_t WL_UQ = WL_IN + (size_t)7168 * 1024;
constexpr size_t WL_UKV = WL_UQ + (size_t)768 * 256;
constexpr size_t WL_MEM = WL_UKV + (size_t)1024 * 128;
constexpr size_t WL_BR = WL_MEM + (size_t)1024 * 1024;
constexpr size_t WL_OUT = WL_BR + (size_t)3 * 1024 * 512;
constexpr size_t WL_TOTAL = WL_OUT + (size_t)1024 * 3072;

constexpr size_t MiB = 1u << 20;
constexpr size_t OFF_W = 0;
constexpr size_t OFF_COS = 104 * MiB, OFF_SIN = OFF_COS + 256 * 1024;
constexpr size_t OFF_SSQQ = 105 * MiB, OFF_SSQKV = 106 * MiB;
constexpr size_t OFF_BAR = 107 * MiB;
constexpr size_t OFF_MN = 108 * MiB;
constexpr size_t OFF_KM = 116 * MiB;
constexpr size_t OFF_VMT = 132 * MiB;
constexpr size_t OFF_XN = 148 * MiB;
constexpr size_t OFF_O = 276 * MiB;
constexpr size_t OFF_R = 468 * MiB;
constexpr size_t OFF_CQ = OFF_R;
constexpr size_t OFF_CKV = OFF_CQ + 32 * MiB;
constexpr size_t OFF_KPE = OFF_CKV + 16 * MiB;
constexpr size_t OFF_QD = OFF_KPE + 4 * MiB;
constexpr size_t OFF_KD = OFF_QD + 64 * MiB;
constexpr size_t OFF_VDT = OFF_KD + 64 * MiB;
constexpr size_t OFF_QX = OFF_VDT + 64 * MiB;
constexpr size_t OFF_QA = OFF_QX + 64 * MiB;
constexpr size_t OFF_KN = OFF_QA + 96 * MiB;
constexpr size_t OFF_VAT = OFF_KN + 64 * MiB;
constexpr size_t WS_END = OFF_VAT + 64 * MiB;
constexpr size_t OFF_S = OFF_R;
constexpr size_t OFF_MERGED = OFF_R + 384 * MiB;
constexpr size_t OFF_OUT = OFF_R;
static_assert(4 * WL_TOTAL * 2 <= OFF_COS && OFF_MERGED + 128 * MiB <= WS_END, "ws map");

constexpr int LDS_BYTES = 147456;
constexpr int NPHASE = 1 + 7 * DEPTH;

__device__ __forceinline__ unsigned cvtpk(float lo, float hi) { f32x2_t v = {lo, hi}; bf16x2_t b = __builtin_convertvector(v, bf16x2_t); return __builtin_bit_cast(unsigned, b); }
__device__ __forceinline__ void store4bf(bf16_t* p, f32x4 v) { u32x2 w; w.x = cvtpk(v[0], v[1]); w.y = cvtpk(v[2], v[3]); *(u32x2*)p = w; }
__device__ __forceinline__ f32x4 unpack4bf(u32x2 w) { f32x4 r; r[0] = __uint_as_float(w.x << 16); r[1] = __uint_as_float(w.x & 0xffff0000u); r[2] = __uint_as_float(w.y << 16); r[3] = __uint_as_float(w.y & 0xffff0000u); return r; }
__device__ __forceinline__ float fast_rcp(float x) { return __builtin_amdgcn_rcpf(x); }
__device__ __forceinline__ float fast_exp2(float x) { return __builtin_amdgcn_exp2f(x); }
__device__ __forceinline__ float sigmoidf_(float v) { return fast_rcp(1.0f + fast_exp2(-v * LOG2E)); }

namespace pg8 {
constexpr int BM = 256, BK = 64, HALF = 128, HTB = HALF * BK * 2, STAGE_BYTES = 8 * HTB, NXCD = 8, WGM = 8;
__host__ __device__ __forceinline__ int lds_byte(int r, int c) { const int st = (r >> 4) * 2 + (c >> 5), rr = r & 15, cc = c & 31, ob = rr * 64 + cc * 2; return st * 1024 + (ob ^ (((ob >> 9) & 1) << 5)); }
__host__ __device__ __forceinline__ void stage_rc(int b, int& R, int& C) { const int st = b / 1024, sb = b % 1024, swz = sb ^ (((sb >> 9) & 1) << 5); R = (st >> 1) * 16 + swz / 64; C = (st & 1) * 32 + (swz % 64) / 2; }

struct Unit { int pm, pn, z; };
struct Gemm { const bf16_t* A; const bf16_t* Bt; int M, N, K, lda, ldb; size_t zA, zB; };

struct StaticOrder {
    int nM, nN, nwg, G, c, nz;
    __device__ void init(int M, int N, int G_, int c_, int nz_ = 1) { nM = M / BM; nN = N / BM; nwg = nM * nN; G = G_; c = c_; nz = nz_; }
    __device__ bool next(int i, Unit& u) const {
        const int ib = i / nz; u.z = i - ib * nz;
        const long L = (long)ib * G + c; if (L >= nwg) return false;
        int wgid = (int)L; { const int q = nwg / NXCD, r = nwg % NXCD, xcd = wgid % NXCD, off = wgid / NXCD; wgid = (xcd < r ? xcd * (q + 1) : r * (q + 1) + (xcd - r) * q) + off; }
        const int nig = WGM * nN, gid = wgid / nig, fm = gid * WGM, gsz = (nM - fm) < WGM ? (nM - fm) : WGM;
        u.pm = fm + ((wgid % nig) % gsz); u.pn = (wgid % nig) / gsz; return true;
    }
};

template <class Epi>
__device__ __forceinline__ void gemm_phase(LAS unsigned char* lds, const Gemm g, const StaticOrder& S, const Epi& E) {
    int tid = threadIdx.x; asm volatile("" : "+v"(tid));
    const int wid = __builtin_amdgcn_readfirstlane(tid >> 6), lane = tid & 63, wr = wid >> 2, wc = wid & 3, fr = lane & 15, fq = lane >> 4;
    int K = g.K; asm volatile("" : "+s"(K)); const int nt = K / BK;
    unsigned voffA[2], voffB[2];
#pragma unroll
    for (int i = 0; i < 2; ++i) { int R, C; stage_rc(tid * 16 + i * 8192, R, C);
        voffA[i] = (unsigned)(R * g.lda + C) * 2u; voffB[i] = (unsigned)(R * g.ldb + C) * 2u; }
    const size_t kstep = (size_t)(BK * 2);
    const size_t hstepA = (size_t)HALF * g.lda * 2, hstepB = (size_t)HALF * g.ldb * 2;
    const size_t tstepA = 2 * hstepA, tstepB = 2 * hstepB;
    const unsigned ldsw = (unsigned)wid * 1024u;
    const int aoff = lds_byte(wr * 64 + fr, fq * 8), boff = lds_byte(wc * 32 + fr, fq * 8);
#define PG8_SA(b, h) (((b) * 2 + (h)) * HTB)
#define PG8_SB(b, h) ((4 + (b) * 2 + (h)) * HTB)
#define PG8_STAGE(bufoff, gbase, voff) do { _Pragma("unroll") for (int _i = 0; _i < 2; ++_i) \
        __builtin_amdgcn_global_load_lds((const unsigned*)((const char*)(gbase) + (voff)[_i]), (LAS unsigned*)(lds + (bufoff) + ldsw + _i * 8192), 16, 0, 0); } while (0)
#define PG8_LDA(dst, b, h) do { _Pragma("unroll") for (int m = 0; m < 4; ++m) _Pragma("unroll") for (int k = 0; k < 2; ++k) dst[m][k] = *(const LAS bf16x8*)(lds + PG8_SA(b, h) + aoff + m * 2048 + k * 1024); } while (0)
#define PG8_LDB(dst, b, h) do { _Pragma("unroll") for (int n = 0; n < 2; ++n) _Pragma("unroll") for (int k = 0; k < 2; ++k) dst[n][k] = *(const LAS bf16x8*)(lds + PG8_SB(b, h) + boff + n * 2048 + k * 1024); } while (0)
#define PG8_MMA(ai, bj, At, Bt) do { __builtin_amdgcn_s_setprio(1); _Pragma("unroll") for (int m = 0; m < 4; ++m) _Pragma("unroll") for (int n = 0; n < 2; ++n) _Pragma("unroll") for (int k = 0; k < 2; ++k) \
        acc[ai][bj][m][n] = __builtin_amdgcn_mfma_f32_16x16x32_bf16(Bt[n][k], At[m][k], acc[ai][bj][m][n], 0, 0, 0); __builtin_amdgcn_s_setprio(0); } while (0)
#define PG8_WAIT_V(n) asm volatile("s_waitcnt vmcnt(" #n ")" ::: "memory")
#define PG8_WAIT_L(n) asm volatile("s_waitcnt lgkmcnt(" #n ")" ::: "memory")
#define PG8_BAR __builtin_amdgcn_s_barrier()
#define PG8_SCHED __builtin_amdgcn_sched_barrier(0)
    Unit cur, nxt; int ui = 0;
    if (!S.next(0, cur)) return;
    f32x4 acc[2][2][4][2];
#pragma unroll
    for (int a = 0; a < 2; ++a)
#pragma unroll
        for (int b = 0; b < 2; ++b)
#pragma unroll
            for (int m = 0; m < 4; ++m)
#pragma unroll
                for (int n = 0; n < 2; ++n) acc[a][b][m][n] = (f32x4){0.f, 0.f, 0.f, 0.f};
    bf16x8 At[4][2], B0[2][2], B1[2][2];
    const char* cA = (const char*)g.A + ((size_t)cur.z * g.zA) * 2 + (size_t)cur.pm * tstepA;
    const char* cB = (const char*)g.Bt + ((size_t)cur.z * g.zB) * 2 + (size_t)cur.pn * tstepB;
    PG8_STAGE(PG8_SB(0, 0), cB, voffB); PG8_STAGE(PG8_SB(0, 1), cB + hstepB, voffB); PG8_STAGE(PG8_SA(0, 0), cA, voffA); PG8_STAGE(PG8_SA(0, 1), cA + hstepA, voffA);
    if (wr == 1) PG8_BAR;
    PG8_WAIT_V(2); PG8_BAR;
    PG8_STAGE(PG8_SB(1, 0), cB + kstep, voffB); PG8_STAGE(PG8_SA(1, 0), cA + kstep, voffA); PG8_STAGE(PG8_SB(1, 1), cB + hstepB + kstep, voffB);
    PG8_WAIT_V(6); PG8_BAR;
    for (;;) {
        const bool has_next = S.next(ui + 1, nxt);
        const char* nA = has_next ? (const char*)g.A + ((size_t)nxt.z * g.zA) * 2 + (size_t)nxt.pm * tstepA : cA;
        const char* nB = has_next ? (const char*)g.Bt + ((size_t)nxt.z * g.zB) * 2 + (size_t)nxt.pn * tstepB : cB;
        for (int t = 0; t < nt; t += 2) {
            const bool last = (t == nt - 2);
            const char* a1 = cA + (size_t)(t + 1) * kstep;
            const char* a2 = last ? nA : cA + (size_t)(t + 2) * kstep; const char* b2 = last ? nB : cB + (size_t)(t + 2) * kstep;
            const char* a3 = a2 + kstep; const char* b3 = b2 + kstep;
            PG8_LDB(B0, 0, 0); PG8_LDB(B1, 0, 1); PG8_SCHED; PG8_LDA(At, 0, 0); PG8_STAGE(PG8_SA(1, 1), a1 + hstepA, voffA);
            PG8_WAIT_V(8); PG8_WAIT_L(0); PG8_BAR; PG8_MMA(0, 0, At, B0); PG8_MMA(0, 1, At, B1); PG8_BAR; PG8_SCHED;
            PG8_LDA(At, 0, 1); PG8_STAGE(PG8_SB(0, 0), b2, voffB); PG8_STAGE(PG8_SB(0, 1), b2 + hstepB, voffB); PG8_STAGE(PG8_SA(0, 0), a2, voffA);
            PG8_WAIT_V(8); PG8_WAIT_L(0); PG8_BAR; PG8_MMA(1, 0, At, B0); PG8_MMA(1, 1, At, B1); PG8_BAR; PG8_SCHED;
            PG8_LDB(B0, 1, 0); PG8_LDB(B1, 1, 1); PG8_SCHED; PG8_LDA(At, 1, 0); PG8_STAGE(PG8_SA(0, 1), a2 + hstepA, voffA);
            PG8_WAIT_V(8); PG8_WAIT_L(0); PG8_BAR; PG8_MMA(0, 0, At, B0); PG8_MMA(0, 1, At, B1); PG8_BAR; PG8_SCHED;
            PG8_LDA(At, 1, 1); PG8_STAGE(PG8_SB(1, 0), b3, voffB); PG8_STAGE(PG8_SB(1, 1), b3 + hstepB, voffB); PG8_STAGE(PG8_SA(1, 0), a3, voffA);
            PG8_WAIT_V(8); PG8_WAIT_L(0); PG8_BAR; PG8_MMA(1, 0, At, B0); PG8_MMA(1, 1, At, B1); PG8_BAR; PG8_SCHED;
        }
        if (wr == 0) PG8_BAR;
        E(acc, cur, wr, wc, fr, fq);
        if (!has_next) break;
#pragma unroll
        for (int a = 0; a < 2; ++a)
#pragma unroll
            for (int b = 0; b < 2; ++b)
#pragma unroll
                for (int m = 0; m < 4; ++m)
#pragma unroll
                    for (int n = 0; n < 2; ++n) acc[a][b][m][n] = (f32x4){0.f, 0.f, 0.f, 0.f};
        cur = nxt; cA = nA; cB = nB; ++ui;
        if (wr == 1) PG8_BAR;
    }
    PG8_WAIT_V(0);
    PG8_BAR;
    asm volatile("" ::: "memory"); PG8_SCHED;
#undef PG8_SA
#undef PG8_SB
#undef PG8_STAGE
#undef PG8_LDA
#undef PG8_LDB
#undef PG8_MMA
#undef PG8_WAIT_V
#undef PG8_WAIT_L
#undef PG8_BAR
#undef PG8_SCHED
}

#define EPI_ROWS_BEGIN _Pragma("unroll") for (int ai = 0; ai < 2; ++ai) _Pragma("unroll") for (int m = 0; m < 4; ++m) { const int row = u.pm * BM + ai * HALF + wr * 64 + m * 16 + fr;
#define EPI_ROWS_END asm volatile("" ::: "memory"); }
#define EPI_COLS_BEGIN _Pragma("unroll") for (int bj = 0; bj < 2; ++bj) _Pragma("unroll") for (int n = 0; n < 2; ++n) { const int colt = bj * HALF + wc * 32 + n * 16 + 4 * fq;
#define EPI_COLS_END }
typedef f32x4 Acc[2][2][4][2];

__device__ __forceinline__ float rstd4(const float* ssq, int row, float inv_dim) { const f32x4 p = *(const f32x4*)(ssq + (size_t)row * 4); return __builtin_amdgcn_rsqf(((p[0] + p[1]) + (p[2] + p[3])) * inv_dim + NORM_EPS); }

struct Epi1 {
    bf16_t *CQ, *CKV, *KPE, *QD, *KD, *QX; float *SSQq, *SSQkv; const float *COS, *SIN; float sc_d, sc_x;
    __device__ __forceinline__ void operator()(const Acc& acc, const Unit& u, int wr, int wc, int fr, int fq) const {
        const int pn = u.pn;
        EPI_ROWS_BEGIN
            const float r = 1.0f;
            if (pn == 0) {
                float ss = 0.f;
                EPI_COLS_BEGIN const f32x4 v = acc[ai][bj][m][n] * r; ss += (v[0] * v[0] + v[1] * v[1]) + (v[2] * v[2] + v[3] * v[3]); store4bf(CQ + (size_t)row * 256 + colt, v); EPI_COLS_END
                ss += __shfl_xor(ss, 16); ss += __shfl_xor(ss, 32);
                if (fq == 0) SSQq[(size_t)row * 4 + wc] = ss;
            } else if (pn == 1) {
                float ss = 0.f;
#pragma unroll
                for (int n = 0; n < 2; ++n) { const f32x4 v = acc[ai][0][m][n] * r; ss += (v[0] * v[0] + v[1] * v[1]) + (v[2] * v[2] + v[3] * v[3]); store4bf(CKV + (size_t)row * 128 + wc * 32 + n * 16 + 4 * fq, v); }
                ss += __shfl_xor(ss, 16); ss += __shfl_xor(ss, 32);
                if (fq == 0) SSQkv[(size_t)row * 4 + wc] = ss;
                if (wc == 0) {
                    const int s = row & (SEQ - 1); const f32x4 cs = *(const f32x4*)(COS + s * 16 + 4 * fq), sn = *(const f32x4*)(SIN + s * 16 + 4 * fq);
                    const f32x4 x1 = acc[ai][1][m][0] * r, x2 = acc[ai][1][m][1] * r;
                    store4bf(KPE + (size_t)row * 32 + 4 * fq, x1 * cs - x2 * sn); store4bf(KPE + (size_t)row * 32 + 16 + 4 * fq, x2 * cs + x1 * sn);
                }
            } else if (pn < 6) {
                bf16_t* dst = (pn < 4 ? QD : KD) + (size_t)row * 512 + (pn & 1) * 256 + wc * 32 + 4 * fq; const float sc = (pn < 4 ? sc_d : 1.0f) * r;
                const int s = row & (SEQ - 1); const f32x4 cs = *(const f32x4*)(COS + s * 16 + 4 * fq), sn = *(const f32x4*)(SIN + s * 16 + 4 * fq);
#pragma unroll
                for (int bj = 0; bj < 2; ++bj) { const f32x4 x1 = acc[ai][bj][m][0] * sc, x2 = acc[ai][bj][m][1] * sc;
                    store4bf(dst + bj * HALF, x1 * cs - x2 * sn); store4bf(dst + bj * HALF + 16, x2 * cs + x1 * sn); }
            } else {
                const float sc = sc_x * r;
                EPI_COLS_BEGIN store4bf(QX + (size_t)row * 512 + (pn - 6) * 256 + colt, acc[ai][bj][m][n] * sc); EPI_COLS_END
            }
        EPI_ROWS_END
    }
};
struct EpiT {
    bf16_t* O; size_t ldc; size_t zO; const float* ssq; float inv_dim; const float* colscale;
    __device__ __forceinline__ void operator()(const Acc& acc, const Unit& u, int wr, int wc, int fr, int fq) const {
        f32x4 cs[2][2];
        EPI_COLS_BEGIN
            const int col = u.pn * BM + colt;
            if (ssq) { for (int i = 0; i < 4; ++i) cs[bj][n][i] = rstd4(ssq, col + i, inv_dim); }
            else if (colscale) cs[bj][n] = *(const f32x4*)(colscale + col);
            else cs[bj][n] = (f32x4){1.f, 1.f, 1.f, 1.f};
        EPI_COLS_END
        bf16_t* base = O + (size_t)u.z * zO;
        EPI_ROWS_BEGIN
            EPI_COLS_BEGIN store4bf(base + (size_t)row * ldc + u.pn * BM + colt, acc[ai][bj][m][n] * cs[bj][n]); EPI_COLS_END
        EPI_ROWS_END
    }
};
struct EpiRow {
    bf16_t* O; size_t ldc; size_t zO; const float* ssq; float inv_dim;
    __device__ __forceinline__ void operator()(const Acc& acc, const Unit& u, int wr, int wc, int fr, int fq) const {
        bf16_t* base = O + (size_t)u.z * zO;
        EPI_ROWS_BEGIN
            const float sc = ssq ? rstd4(ssq, row, inv_dim) : 1.0f;
            EPI_COLS_BEGIN store4bf(base + (size_t)row * ldc + u.pn * BM + colt, acc[ai][bj][m][n] * sc); EPI_COLS_END
        EPI_ROWS_END
    }
};
struct Epi2 {
    bf16_t* QA; const float* SSQq; const float *COS, *SIN; float sc_a;
    __device__ __forceinline__ void operator()(const Acc& acc, const Unit& u, int wr, int wc, int fr, int fq) const {
        EPI_ROWS_BEGIN
            const float sc = rstd4(SSQq, row, 1.0f / 256.0f) * sc_a;
            if (u.pn < 2) {
                EPI_COLS_BEGIN const int nn = u.pn * BM + colt; store4bf(QA + (size_t)row * 768 + (nn >> 6) * 96 + (nn & 63), acc[ai][bj][m][n] * sc); EPI_COLS_END
            } else {
                const int s = row & (SEQ - 1); const f32x4 cs = *(const f32x4*)(COS + s * 16 + 4 * fq), sn = *(const f32x4*)(SIN + s * 16 + 4 * fq);
#pragma unroll
                for (int bj = 0; bj < 2; ++bj) { const f32x4 x1 = acc[ai][bj][m][0] * sc, x2 = acc[ai][bj][m][1] * sc; bf16_t* dst = QA + (size_t)row * 768 + (4 * bj + wc) * 96 + 64 + 4 * fq;
                    store4bf(dst, x1 * cs - x2 * sn); store4bf(dst + 16, x2 * cs + x1 * sn); }
            }
        EPI_ROWS_END
    }
};
struct EpiSG {
    bf16_t* O;
    __device__ __forceinline__ void operator()(const Acc& acc, const Unit& u, int wr, int wc, int fr, int fq) const {
        EPI_ROWS_BEGIN
            const float r = 1.0f;
            EPI_COLS_BEGIN bf16_t* p = O + (size_t)row * 1536 + u.pn * BM + colt; const f32x4 o = unpack4bf(*(const u32x2*)p); const f32x4 g = acc[ai][bj][m][n] * r; f32x4 v;
#pragma unroll
                for (int i = 0; i < 4; ++i) v[i] = o[i] * g[i] * sigmoidf_(g[i]);
                store4bf(p, v); EPI_COLS_END
        EPI_ROWS_END
    }
};
struct EpiGL {
    bf16_t* S; const float* bias;
    __device__ __forceinline__ void operator()(const Acc& acc, const Unit& u, int wr, int wc, int fr, int fq) const {
        f32x4 bv[2][2];
        EPI_COLS_BEGIN bv[bj][n] = *(const f32x4*)(bias + u.pn * BM + colt); EPI_COLS_END
        EPI_ROWS_BEGIN
            const float r = 1.0f;
            EPI_COLS_BEGIN const f32x4 g = acc[ai][bj][m][n] * r + bv[bj][n]; f32x4 v;
#pragma unroll
                for (int i = 0; i < 4; ++i) v[i] = sigmoidf_(g[i]);
                store4bf(S + (size_t)row * 3072 + u.pn * BM + colt, v); EPI_COLS_END
        EPI_ROWS_END
    }
};
struct EpiBR {
    const bf16_t* S; bf16_t* MG;
    __device__ __forceinline__ void operator()(const Acc& acc, const Unit& u, int wr, int wc, int fr, int fq) const {
        EPI_ROWS_BEGIN
            EPI_COLS_BEGIN const int col = u.pn * BM + colt; const f32x4 s = unpack4bf(*(const u32x2*)(S + (size_t)row * 3072 + u.z * 1024 + col)); f32x4 v = s * acc[ai][bj][m][n];
                bf16_t* p = MG + (size_t)row * 1024 + col;
                if (u.z > 0) { const unsigned long long w = __hip_atomic_load((const unsigned long long*)p, __ATOMIC_RELAXED, __HIP_MEMORY_SCOPE_AGENT); u32x2 ww; ww.x = (unsigned)w; ww.y = (unsigned)(w >> 32); v += unpack4bf(ww); }
                store4bf(p, v); EPI_COLS_END
        EPI_ROWS_END
    }
};
struct EpiOut {
    float* OUT;
    __device__ __forceinline__ void operator()(const Acc& acc, const Unit& u, int wr, int wc, int fr, int fq) const {
        EPI_ROWS_BEGIN
            EPI_COLS_BEGIN *(f32x4*)(OUT + (size_t)row * 1024 + u.pn * BM + colt) = acc[ai][bj][m][n]; EPI_COLS_END
        EPI_ROWS_END
    }
};
}

__device__ __forceinline__ int crow(int r, int hi) { return (r & 3) + 8 * (r >> 2) + 4 * hi; }

template <int NMAP, int DKM, int DV, bool CAUSAL, int W0, int W1>
__device__ __forceinline__ void attn_unit(LAS unsigned char* lds, const bf16_t* __restrict__ Q, int ldq, const bf16_t* __restrict__ K0, int ldk0, const bf16_t* __restrict__ K1, int ldk1,
                                          const bf16_t* __restrict__ Vt, size_t ldv, int q0, int NT, bf16_t* O, int ldo, float lam, const float* subln, float outscale) {
    constexpr int DKT = NMAP * DKM, KS = DKT * 2 + 16, VS = 136, KBUF = 64 * KS, VBUF = DV * VS;
    constexpr int NC = DKM / 16, NDB = DV / 32;
    constexpr int K0C = W0 / 8, K0N = (64 * K0C) / 512, K1C = W1 / 8, VN = (DV * 8) / 512;
    static_assert(W0 + W1 == DKT && K0N >= 1 && VN >= 1, "attention staging geometry");
    int tid = threadIdx.x; asm volatile("" : "+v"(tid));
    const int lane = tid & 63, wid = __builtin_amdgcn_readfirstlane(tid >> 6), r32 = lane & 31, hi = lane >> 5;
    LAS unsigned char* Kb = lds; LAS unsigned char* Vb = lds + 2 * KBUF;
    bf16x8 qf[NMAP][NC];
    { const bf16_t* qrow = Q + (size_t)(q0 + wid * 32 + r32) * ldq;
#pragma unroll
      for (int mp = 0; mp < NMAP; ++mp)
#pragma unroll
          for (int c = 0; c < NC; ++c) qf[mp][c] = *(const bf16x8*)(qrow + mp * DKM + 16 * c + 8 * hi); }
    f32x16 o[NMAP][NDB]; float mrow[NMAP], lrow[NMAP];
#pragma unroll
    for (int mp = 0; mp < NMAP; ++mp) { mrow[mp] = -INFINITY; lrow[mp] = 0.f;
#pragma unroll
        for (int db = 0; db < NDB; ++db)
#pragma unroll
            for (int r = 0; r < 16; ++r) o[mp][db][r] = 0.f; }
    u32x4 kreg[K0N], k1reg = {0u, 0u, 0u, 0u}, vreg[VN];
#define ATT_GLOAD(t) do { \
    _Pragma("unroll") for (int i = 0; i < K0N; ++i) { const int idx = tid + 512 * i, rr = idx / K0C, cc = idx % K0C; kreg[i] = *(const u32x4*)(K0 + (size_t)(64 * (t) + rr) * ldk0 + cc * 8); } \
    if (W1 > 0) { if (tid < 64 * K1C) { const int rr = tid / (K1C > 0 ? K1C : 1), cc = tid % (K1C > 0 ? K1C : 1); k1reg = *(const u32x4*)(K1 + (size_t)(64 * (t) + rr) * ldk1 + cc * 8); } } \
    _Pragma("unroll") for (int i = 0; i < VN; ++i) { const int idx = tid + 512 * i, dd = idx >> 3, cc = idx & 7; vreg[i] = *(const u32x4*)(Vt + (size_t)dd * ldv + 64 * (t) + cc * 8); } } while (0)
#define ATT_LWRITE(buf) do { \
    _Pragma("unroll") for (int i = 0; i < K0N; ++i) { const int idx = tid + 512 * i, rr = idx / K0C, cc = idx % K0C; *(LAS u32x4*)(Kb + (buf) * KBUF + rr * KS + cc * 16) = kreg[i]; } \
    if (W1 > 0) { if (tid < 64 * K1C) { const int rr = tid / (K1C > 0 ? K1C : 1), cc = tid % (K1C > 0 ? K1C : 1); *(LAS u32x4*)(Kb + (buf) * KBUF + rr * KS + W0 * 2 + cc * 16) = k1reg; } } \
    _Pragma("unroll") for (int i = 0; i < VN; ++i) { const int idx = tid + 512 * i, dd = idx >> 3, cc = idx & 7; LAS u32x2* vp = (LAS u32x2*)(Vb + (buf) * VBUF + dd * VS + cc * 16); \
        u32x2 lo_; lo_.x = vreg[i].x; lo_.y = vreg[i].y; u32x2 hi_; hi_.x = vreg[i].z; hi_.y = vreg[i].w; vp[0] = lo_; vp[1] = hi_; } } while (0)
    ATT_GLOAD(0);
    ATT_LWRITE(0);
    __syncthreads();
    const int qw0 = q0 + wid * 32;
    for (int t = 0; t < NT; ++t) {
        const int buf = t & 1;
        if (t + 1 < NT) ATT_GLOAD(t + 1);
#pragma unroll
        for (int kb = 0; kb < 2; ++kb) {
            const int kv0 = 64 * t + 32 * kb;
            if (CAUSAL && kv0 > qw0) continue;
            const bool diag = CAUSAL && (kv0 == qw0);
            bf16x8 vf[NDB][2];
#pragma unroll
            for (int db = 0; db < NDB; ++db)
#pragma unroll
                for (int j = 0; j < 2; ++j) { const LAS unsigned char* vp = Vb + buf * VBUF + (32 * db + r32) * VS + (32 * kb + 16 * j + 4 * hi) * 2;
                    const s16x4 lo = *(const LAS s16x4*)vp, hh = *(const LAS s16x4*)(vp + 16);
                    vf[db][j] = (bf16x8){lo[0], lo[1], lo[2], lo[3], hh[0], hh[1], hh[2], hh[3]}; }
#pragma unroll
            for (int mp = 0; mp < NMAP; ++mp) {
                f32x16 s;
#pragma unroll
                for (int r = 0; r < 16; ++r) s[r] = 0.f;
#pragma unroll
                for (int c = 0; c < NC; ++c) { const bf16x8 kf = *(const LAS bf16x8*)(Kb + buf * KBUF + (32 * kb + r32) * KS + (mp * DKM + 16 * c + 8 * hi) * 2);
                    s = __builtin_amdgcn_mfma_f32_32x32x16_bf16(kf, qf[mp][c], s, 0, 0, 0); }
                if (diag) {
#pragma unroll
                    for (int r = 0; r < 16; ++r) if (crow(r, hi) > r32) s[r] = -INFINITY;
                }
                float mx = s[0];
#pragma unroll
                for (int r = 1; r < 16; ++r) mx = fmaxf(mx, s[r]);
                mx = fmaxf(mx, __shfl_xor(mx, 32));
                if (__any(mx > mrow[mp])) {
                    const float mnew = fmaxf(mrow[mp], mx), alpha = fast_exp2(mrow[mp] - mnew);
                    mrow[mp] = mnew; lrow[mp] *= alpha;
#pragma unroll
                    for (int db = 0; db < NDB; ++db)
#pragma unroll
                        for (int r = 0; r < 16; ++r) o[mp][db][r] *= alpha;
                }
                const float mcur = mrow[mp]; float ls = 0.f;
#pragma unroll
                for (int r = 0; r < 16; ++r) { s[r] = fast_exp2(s[r] - mcur); ls += s[r]; }
                lrow[mp] += ls;
                bf16x8 pa[2];
#pragma unroll
                for (int j = 0; j < 2; ++j) { u32x4 w; w.x = cvtpk(s[8 * j + 0], s[8 * j + 1]); w.y = cvtpk(s[8 * j + 2], s[8 * j + 3]); w.z = cvtpk(s[8 * j + 4], s[8 * j + 5]); w.w = cvtpk(s[8 * j + 6], s[8 * j + 7]); pa[j] = __builtin_bit_cast(bf16x8, w); }
#pragma unroll
                for (int db = 0; db < NDB; ++db)
#pragma unroll
                    for (int j = 0; j < 2; ++j) o[mp][db] = __builtin_amdgcn_mfma_f32_32x32x16_bf16(vf[db][j], pa[j], o[mp][db], 0, 0, 0);
            }
        }
        if (t + 1 < NT) ATT_LWRITE(buf ^ 1);
        __syncthreads();
    }
#undef ATT_GLOAD
#undef ATT_LWRITE
    float inv[NMAP];
#pragma unroll
    for (int mp = 0; mp < NMAP; ++mp) { const float lt = lrow[mp] + __shfl_xor(lrow[mp], 32); inv[mp] = 1.0f / lt; }
    bf16_t* orow = O + (size_t)(q0 + wid * 32 + r32) * ldo;
    if constexpr (NMAP == 1) {
#pragma unroll
        for (int db = 0; db < NDB; ++db)
#pragma unroll
            for (int g = 0; g < 4; ++g) { f32x4 v; for (int i = 0; i < 4; ++i) v[i] = o[0][db][4 * g + i] * inv[0]; store4bf(orow + 32 * db + 8 * g + 4 * hi, v); }
    } else {
        float ss = 0.f;
#pragma unroll
        for (int db = 0; db < NDB; ++db)
#pragma unroll
            for (int r = 0; r < 16; ++r) { const float v = o[0][db][r] * inv[0] - lam * (o[1][db][r] * inv[1]); o[0][db][r] = v; ss += v * v; }
        ss += __shfl_xor(ss, 32);
        const float rstd = __builtin_amdgcn_rsqf(ss * (1.0f / DV) + NORM_EPS) * outscale;
#pragma unroll
        for (int db = 0; db < NDB; ++db)
#pragma unroll
            for (int g = 0; g < 4; ++g) { const f32x4 gn = *(const f32x4*)(subln + 32 * db + 8 * g + 4 * hi); f32x4 v; for (int i = 0; i < 4; ++i) v[i] = o[0][db][4 * g + i] * rstd * gn[i]; store4bf(orow + 32 * db + 8 * g + 4 * hi, v); }
    }
}

template <int NMAP, int DKM, int DV, int W0, int W1>
__device__ __forceinline__ void attn_unit2(LAS unsigned char* lds, const bf16_t* __restrict__ Q, int ldq, const bf16_t* __restrict__ K0, int ldk0, const bf16_t* __restrict__ K1, int ldk1,
                                           const bf16_t* __restrict__ Vt, size_t ldv, int q0, int NT, bf16_t* O, int ldo, float lam, const float* subln, float outscale) {
    constexpr int DKT = NMAP * DKM, KS = DKT * 2 + 16, VS = 136, KBUF = 64 * KS, VBUF = DV * VS;
    constexpr int NC = DKM / 16, NDB = DV / 32;
    constexpr int K0C = W0 / 8, K0N = (64 * K0C) / 512, K1C = W1 / 8, VN = (DV * 8) / 512;
    static_assert(W0 + W1 == DKT && K0N >= 1 && VN >= 1, "attention staging geometry");
    int tid = threadIdx.x; asm volatile("" : "+v"(tid));
    const int lane = tid & 63, wid = __builtin_amdgcn_readfirstlane(tid >> 6), r32 = lane & 31, hi = lane >> 5;
    LAS unsigned char* Kb = lds; LAS unsigned char* Vb = lds + 2 * KBUF;
    bf16x8 qf[NMAP][NC];
    { const bf16_t* qrow = Q + (size_t)(q0 + wid * 32 + r32) * ldq;
#pragma unroll
      for (int mp = 0; mp < NMAP; ++mp)
#pragma unroll
          for (int c = 0; c < NC; ++c) qf[mp][c] = *(const bf16x8*)(qrow + mp * DKM + 16 * c + 8 * hi); }
    f32x16 o[NMAP][NDB], negm[NMAP]; float lrow[NMAP];
#pragma unroll
    for (int mp = 0; mp < NMAP; ++mp) { lrow[mp] = 0.f;
#pragma unroll
        for (int r = 0; r < 16; ++r) negm[mp][r] = 0.f;
#pragma unroll
        for (int db = 0; db < NDB; ++db)
#pragma unroll
            for (int r = 0; r < 16; ++r) o[mp][db][r] = 0.f; }
    u32x4 kreg[K0N], k1reg = {0u, 0u, 0u, 0u}, vreg[VN];
#define ATT_GLOAD(t) do { \
    _Pragma("unroll") for (int i = 0; i < K0N; ++i) { const int idx = tid + 512 * i, rr = idx / K0C, cc = idx % K0C; kreg[i] = *(const u32x4*)(K0 + (size_t)(64 * (t) + rr) * ldk0 + cc * 8); } \
    if (W1 > 0) { if (tid < 64 * K1C) { const int rr = tid / (K1C > 0 ? K1C : 1), cc = tid % (K1C > 0 ? K1C : 1); k1reg = *(const u32x4*)(K1 + (size_t)(64 * (t) + rr) * ldk1 + cc * 8); } } \
    _Pragma("unroll") for (int i = 0; i < VN; ++i) { const int idx = tid + 512 * i, dd = idx >> 3, cc = idx & 7; vreg[i] = *(const u32x4*)(Vt + (size_t)dd * ldv + 64 * (t) + cc * 8); } } while (0)
#define ATT_LWRITE(buf) do { \
    _Pragma("unroll") for (int i = 0; i < K0N; ++i) { const int idx = tid + 512 * i, rr = idx / K0C, cc = idx % K0C; *(LAS u32x4*)(Kb + (buf) * KBUF + rr * KS + cc * 16) = kreg[i]; } \
    if (W1 > 0) { if (tid < 64 * K1C) { const int rr = tid / (K1C > 0 ? K1C : 1), cc = tid % (K1C > 0 ? K1C : 1); *(LAS u32x4*)(Kb + (buf) * KBUF + rr * KS + W0 * 2 + cc * 16) = k1reg; } } \
    _Pragma("unroll") for (int i = 0; i < VN; ++i) { const int idx = tid + 512 * i, dd = idx >> 3, cc = idx & 7; LAS u32x2* vp = (LAS u32x2*)(Vb + (buf) * VBUF + dd * VS + cc * 16); \
        u32x2 lo_; lo_.x = vreg[i].x; lo_.y = vreg[i].y; u32x2 hi_; hi_.x = vreg[i].z; hi_.y = vreg[i].w; vp[0] = lo_; vp[1] = hi_; } } while (0)
    ATT_GLOAD(0);
    ATT_LWRITE(0);
    __syncthreads();
    const int qw0 = q0 + wid * 32;
    for (int t = 0; t < NT; ++t) {
        const int buf = t & 1;
        if (t + 1 < NT) ATT_GLOAD(t + 1);
        const int kvt = 64 * t;
        if (kvt <= qw0) {
            const bool band = (kvt + 63 > qw0);
#pragma unroll
            for (int mp = 0; mp < NMAP; ++mp) {
                f32x16 s0, s1;
#pragma unroll
                for (int c = 0; c < NC; ++c) {
                    const bf16x8 kf0 = *(const LAS bf16x8*)(Kb + buf * KBUF + r32 * KS + (mp * DKM + 16 * c + 8 * hi) * 2);
                    const bf16x8 kf1 = *(const LAS bf16x8*)(Kb + buf * KBUF + (32 + r32) * KS + (mp * DKM + 16 * c + 8 * hi) * 2);
                    if (c == 0) { s0 = __builtin_amdgcn_mfma_f32_32x32x16_bf16(kf0, qf[mp][0], negm[mp], 0, 0, 0); s1 = __builtin_amdgcn_mfma_f32_32x32x16_bf16(kf1, qf[mp][0], negm[mp], 0, 0, 0); }
                    else { s0 = __builtin_amdgcn_mfma_f32_32x32x16_bf16(kf0, qf[mp][c], s0, 0, 0, 0); s1 = __builtin_amdgcn_mfma_f32_32x32x16_bf16(kf1, qf[mp][c], s1, 0, 0, 0); }
                }
                if (band) {
                    const int qd = qw0 + r32 - kvt;
#pragma unroll
                    for (int r = 0; r < 16; ++r) { const int kv = crow(r, hi); if (kv > qd) s0[r] = -INFINITY; if (kv + 32 > qd) s1[r] = -INFINITY; }
                }
                float mx = fmaxf(s0[0], s1[0]);
#pragma unroll
                for (int r = 1; r < 16; ++r) mx = fmaxf(mx, fmaxf(s0[r], s1[r]));
                mx = fmaxf(mx, __shfl_xor(mx, 32));
                if (__any(t == 0 || mx > 8.0f)) {
                    const float dl = (t == 0) ? mx : fmaxf(mx, 0.f), alpha = fast_exp2(-dl);
                    lrow[mp] *= alpha;
#pragma unroll
                    for (int r = 0; r < 16; ++r) { s0[r] -= dl; s1[r] -= dl; negm[mp][r] -= dl; }
#pragma unroll
                    for (int db = 0; db < NDB; ++db)
#pragma unroll
                        for (int r = 0; r < 16; ++r) o[mp][db][r] *= alpha;
                }
                float ls = 0.f;
#pragma unroll
                for (int kb = 0; kb < 2; ++kb) {
                    f32x16& s = kb ? s1 : s0;
                    bf16x8 vf[NDB][2];
#pragma unroll
                    for (int db = 0; db < NDB; ++db)
#pragma unroll
                        for (int j = 0; j < 2; ++j) { const LAS unsigned char* vp = Vb + buf * VBUF + (32 * db + r32) * VS + (32 * kb + 16 * j + 4 * hi) * 2;
                            const s16x4 lo = *(const LAS s16x4*)vp, hh = *(const LAS s16x4*)(vp + 16);
                            vf[db][j] = (bf16x8){lo[0], lo[1], lo[2], lo[3], hh[0], hh[1], hh[2], hh[3]}; }
#pragma unroll
                    for (int r = 0; r < 16; ++r) { s[r] = fast_exp2(s[r]); ls += s[r]; }
                    bf16x8 pa[2];
#pragma unroll
                    for (int j = 0; j < 2; ++j) { u32x4 w; w.x = cvtpk(s[8 * j + 0], s[8 * j + 1]); w.y = cvtpk(s[8 * j + 2], s[8 * j + 3]); w.z = cvtpk(s[8 * j + 4], s[8 * j + 5]); w.w = cvtpk(s[8 * j + 6], s[8 * j + 7]); pa[j] = __builtin_bit_cast(bf16x8, w); }
#pragma unroll
                    for (int db = 0; db < NDB; ++db)
#pragma unroll
                        for (int j = 0; j < 2; ++j) o[mp][db] = __builtin_amdgcn_mfma_f32_32x32x16_bf16(vf[db][j], pa[j], o[mp][db], 0, 0, 0);
                }
                lrow[mp] += ls;
                if (NMAP > 1) __builtin_amdgcn_sched_barrier(0);
            }
        }
        if (t + 1 < NT) ATT_LWRITE(buf ^ 1);
        __syncthreads();
    }
#undef ATT_GLOAD
#undef ATT_LWRITE
    float inv[NMAP];
#pragma unroll
    for (int mp = 0; mp < NMAP; ++mp) { const float lt = lrow[mp] + __shfl_xor(lrow[mp], 32); inv[mp] = 1.0f / lt; }
    bf16_t* orow = O + (size_t)(q0 + wid * 32 + r32) * ldo;
    if constexpr (NMAP == 1) {
#pragma unroll
        for (int db = 0; db < NDB; ++db)
#pragma unroll
            for (int g = 0; g < 4; ++g) { f32x4 v; for (int i = 0; i < 4; ++i) v[i] = o[0][db][4 * g + i] * inv[0]; store4bf(orow + 32 * db + 8 * g + 4 * hi, v); }
    } else {
        float ss = 0.f;
#pragma unroll
        for (int db = 0; db < NDB; ++db)
#pragma unroll
            for (int r = 0; r < 16; ++r) { const float v = o[0][db][r] * inv[0] - lam * (o[1][db][r] * inv[1]); o[0][db][r] = v; ss += v * v; }
        ss += __shfl_xor(ss, 32);
        const float rstd = __builtin_amdgcn_rsqf(ss * (1.0f / DV) + NORM_EPS) * outscale;
#pragma unroll
        for (int db = 0; db < NDB; ++db)
#pragma unroll
            for (int g = 0; g < 4; ++g) { const f32x4 gn = *(const f32x4*)(subln + 32 * db + 8 * g + 4 * hi); f32x4 v; for (int i = 0; i < 4; ++i) v[i] = o[0][db][4 * g + i] * rstd * gn[i]; store4bf(orow + 32 * db + 8 * g + 4 * hi, v); }
    }
}

__device__ __forceinline__ float wave_sum(float v) {
#pragma unroll
    for (int o = 1; o < 64; o <<= 1) v += __shfl_xor(v, o);
    return v;
}
__device__ __forceinline__ void transpose_block(const float* __restrict__ W, int ldw, int src_col0, const float* __restrict__ gain, bf16_t* WT, int K, int dst_row0, int k0, LAS float* scr, int lane) {
#pragma unroll 8
    for (int i = 0; i < 32; ++i) { const int kk = 2 * i + (lane >> 5); float v = W[(size_t)(k0 + kk) * ldw + src_col0 + (lane & 31)]; if (gain) v *= gain[k0 + kk]; scr[kk * 33 + (lane & 31)] = v; }
    asm volatile("s_waitcnt lgkmcnt(0)" ::: "memory");
    const int c = lane & 7;
#pragma unroll
    for (int j = 0; j < 4; ++j) { const int n = (lane >> 3) + 8 * j; const LAS float* s = scr + (8 * c) * 33 + n;
        u32x4 ov; ov.x = cvtpk(s[0 * 33], s[1 * 33]); ov.y = cvtpk(s[2 * 33], s[3 * 33]); ov.z = cvtpk(s[4 * 33], s[5 * 33]); ov.w = cvtpk(s[6 * 33], s[7 * 33]);
        *(u32x4*)(WT + (size_t)(dst_row0 + n) * K + k0 + 8 * c) = ov; }
    asm volatile("s_waitcnt lgkmcnt(0)" ::: "memory");
}

#define XB_TMO      128
#define XB_XCNT(j)  (256  + 64 * (j))
#define XB_XSUB(j)  (1280 + 64 * (j))
#define XB_XGEN(j)  (2304 + 64 * (j))
#define XB_TOP      3328
#define XB_TOPGEN   3392
#define XCD_BAR_WORDS 3456
#define XB_SPIN_CAP (1u << 18)

__device__ __forceinline__ unsigned xb_ld(unsigned* p)              { return __hip_atomic_load(p, __ATOMIC_RELAXED, __HIP_MEMORY_SCOPE_AGENT); }
__device__ __forceinline__ unsigned xb_add(unsigned* p, unsigned v) { return __hip_atomic_fetch_add(p, v, __ATOMIC_RELAXED, __HIP_MEMORY_SCOPE_AGENT); }
__device__ __forceinline__ unsigned xb_xcc_id() { return (unsigned)__builtin_amdgcn_s_getreg((3 << 11) | 20) & 0xFu; }
#define XB_SPIN(cond, bar) do { unsigned _sp = 0; while (cond) { __builtin_amdgcn_s_sleep(1); \
    if ((++_sp & 255u) == 0u) { if (xb_ld(&(bar)[XB_TMO])) break; if (_sp > XB_SPIN_CAP) { atomicAdd(&(bar)[XB_TMO], 1u); break; } } } } while (0)

struct XcdBarrier {
    unsigned* bar; unsigned x;
    volatile LAS unsigned* st;
};

__device__ __forceinline__ XcdBarrier xcd_barrier_post(unsigned* bar, volatile LAS unsigned* st) {
    XcdBarrier b; b.bar = bar; b.x = xb_xcc_id(); b.st = st;
    if (threadIdx.x == 0) (void)xb_add(&bar[XB_XCNT(b.x)], 1u);
    return b;
}
__device__ __forceinline__ void xcd_barrier_complete(unsigned* bar, unsigned x, unsigned& nloc, unsigned& nx) {
    const unsigned G = gridDim.x * gridDim.y * gridDim.z;
    unsigned sum, cnt, mine, sp = 0u;
    for (;;) {
        sum = 0u; cnt = 0u; mine = 0u;
#pragma unroll
        for (unsigned j = 0; j < 16; ++j) { const unsigned c = xb_ld(&bar[XB_XCNT(j)]); sum += c; cnt += (c > 0u) ? 1u : 0u; mine = (j == x) ? c : mine; }
        if (sum == G) break;
        __builtin_amdgcn_s_sleep(1);
        if ((++sp & 255u) == 0u) { if (xb_ld(&bar[XB_TMO])) break; if (sp > XB_SPIN_CAP) { atomicAdd(&bar[XB_TMO], 1u); break; } }
    }
    nloc = mine > 0u ? mine : 1u; nx = cnt > 0u ? cnt : 1u;
}

__device__ __forceinline__ void xcd_barrier(const XcdBarrier& b) {
    asm volatile("s_waitcnt vmcnt(0)" ::: "memory");
    __syncthreads();
    if (threadIdx.x == 0) {
        unsigned* bar = b.bar;
        __builtin_amdgcn_s_waitcnt(0);
        unsigned nloc = b.st[0], nx = b.st[1];
        if (nloc == 0u) { xcd_barrier_complete(bar, b.x, nloc, nx); b.st[0] = nloc; b.st[1] = nx; }
        const unsigned old = xb_add(&bar[XB_XSUB(b.x)], 1u);
        const unsigned gen = old / nloc;
        if (old + 1u == (gen + 1u) * nloc) {
            __builtin_amdgcn_fence(__ATOMIC_RELEASE, "agent");
            asm volatile("s_waitcnt vmcnt(0)" ::: "memory");
            const unsigned og = xb_add(&bar[XB_TOP], 1u);
            const unsigned tg = og / nx;
            if (og + 1u == (tg + 1u) * nx) xb_add(&bar[XB_TOPGEN], 1u);
            else XB_SPIN(xb_ld(&bar[XB_TOPGEN]) == tg, bar);
            __builtin_amdgcn_fence(__ATOMIC_ACQUIRE, "agent");
            xb_add(&bar[XB_XGEN(b.x)], 1u);
            asm volatile("s_waitcnt vmcnt(0)" ::: "memory");
        } else {
            XB_SPIN(xb_ld(&bar[XB_XGEN(b.x)]) == gen, bar);
            __builtin_amdgcn_fence(__ATOMIC_ACQUIRE, "agent");
            asm volatile("s_waitcnt vmcnt(0)" ::: "memory");
        }
    }
    __syncthreads();
}


struct Args { const float* in[20]; float* out; unsigned char* ws; int ph_lo, ph_hi, coop, pad; float lam_init[4]; };

__global__ void __launch_bounds__(512, 2) hybrid_fwd(Args a) {
    extern __shared__ __attribute__((aligned(16))) unsigned char lds_raw[];
    LAS unsigned char* lds = (LAS unsigned char*)lds_raw;
    const float* x_in = a.in[0]; const float* mem = a.in[1]; const int* positions = (const int*)a.in[2];
    const float* norm_pre = a.in[3]; const float* norm_post = a.in[4]; const float* w_in = a.in[5]; const float* q_norm = a.in[6]; const float* w_uq = a.in[7];
    const float* kv_norm = a.in[8]; const float* w_ukv = a.in[9]; const float* lq1 = a.in[10]; const float* lk1 = a.in[11]; const float* lq2 = a.in[12]; const float* lk2 = a.in[13];
    const float* diff_subln = a.in[14]; const float* mem_norm = a.in[15]; const float* w_mem_kv = a.in[16]; const float* b_gate = a.in[17]; const float* w_branch = a.in[18]; const float* w_out = a.in[19];
#define P_WT ((bf16_t*)(ws + OFF_W))
#define P_COS ((float*)(ws + OFF_COS))
#define P_SIN ((float*)(ws + OFF_SIN))
#define P_SSQq ((float*)(ws + OFF_SSQQ))
#define P_SSQkv ((float*)(ws + OFF_SSQKV))
#define P_MN ((bf16_t*)(ws + OFF_MN))
#define P_KM ((bf16_t*)(ws + OFF_KM))
#define P_VMT ((bf16_t*)(ws + OFF_VMT))
#define P_XN ((bf16_t*)(ws + OFF_XN))
#define P_OB ((bf16_t*)(ws + OFF_O))
#define P_CQ ((bf16_t*)(ws + OFF_CQ))
#define P_CKV ((bf16_t*)(ws + OFF_CKV))
#define P_KPE ((bf16_t*)(ws + OFF_KPE))
#define P_QD ((bf16_t*)(ws + OFF_QD))
#define P_KD ((bf16_t*)(ws + OFF_KD))
#define P_VDT ((bf16_t*)(ws + OFF_VDT))
#define P_QX ((bf16_t*)(ws + OFF_QX))
#define P_QA ((bf16_t*)(ws + OFF_QA))
#define P_KN ((bf16_t*)(ws + OFF_KN))
#define P_VAT ((bf16_t*)(ws + OFF_VAT))
#define P_SB ((bf16_t*)(ws + OFF_S))
#define P_MG ((bf16_t*)(ws + OFF_MERGED))
#define P_OUTB ((float*)(ws + OFF_OUT))

    volatile LAS unsigned* bst = (volatile LAS unsigned*)(lds + LDS_BYTES - 16);
    if (threadIdx.x < 4) bst[threadIdx.x] = 0u;
    __syncthreads();
    XcdBarrier xbar; xbar.bar = (unsigned*)(a.ws + OFF_BAR); xbar.x = 0; xbar.st = bst;
    if (a.coop) xbar = xcd_barrier_post((unsigned*)(a.ws + OFF_BAR), bst);
    for (int ph = a.ph_lo; ph < a.ph_hi; ++ph) {
        __attribute__((address_space(1))) unsigned char* ws = (__attribute__((address_space(1))) unsigned char*)a.ws; asm volatile("" : "+s"(ws));
        int tid = threadIdx.x; asm volatile("" : "+v"(tid)); const int lane = tid & 63, wave = __builtin_amdgcn_readfirstlane(tid >> 6);
        int G = gridDim.x, bx = blockIdx.x; asm volatile("" : "+s"(G), "+s"(bx));
        const int vcu = (G % 8 == 0) ? (bx % 8) * (G / 8) + bx / 8 : bx;
        const int gw = vcu * 8 + wave, NGW = G * 8;
        if (ph == 0) {
#if PHSEL & 1
            LAS float* scr = (LAS float*)(lds + wave * 16384);
            constexpr int I_IN = 16 * 221, I_UQ = 4 * 24, I_UKV = 2 * 32, I_MEM = 16 * 32, I_BR = 3 * 256, I_OUT = 16 * 32;
            constexpr int I_L = I_IN + I_UQ + I_UKV + I_MEM + I_BR + I_OUT;
            for (int it = gw; it < DEPTH * I_L; it += NGW) {
                const int l = it / I_L; int r = it - l * I_L; bf16_t* wl = P_WT + (size_t)l * WL_TOTAL;
                if (r < I_IN) { const int kb = r / 221, nb = r - kb * 221, n = nb * 32; int dr;
                    if (n < 416) dr = n; else if (n < 1440) dr = n + 96; else if (n < 1952) dr = n - 1440 + 2048; else if (n < 2464) dr = n - 1952 + 1536; else dr = n + 96;
                    transpose_block(w_in + (size_t)l * 1024 * IN_WIDTH, IN_WIDTH, n, norm_pre + l * 1024, wl + WL_IN, 1024, dr, kb * 64, scr, lane); continue; }
                r -= I_IN;
                if (r < I_UQ) { const int kb = r / 24, nb = r - kb * 24, n = nb * 32, h = n / 96, w = n - h * 96; const int dr = (w < 64) ? h * 64 + w : 512 + h * 32 + (w - 64);
                    transpose_block(w_uq + (size_t)l * 256 * 768, 768, n, q_norm + l * 256, wl + WL_UQ, 256, dr, kb * 64, scr, lane); continue; }
                r -= I_UQ;
                if (r < I_UKV) { const int kb = r / 32, nb = r - kb * 32, n = nb * 32, h = n / 128, w = n - h * 128; const int dr = (w < 64) ? h * 64 + w : 512 + h * 64 + (w - 64);
                    transpose_block(w_ukv + (size_t)l * 128 * 1024, 1024, n, kv_norm + l * 128, wl + WL_UKV, 128, dr, kb * 64, scr, lane); continue; }
                r -= I_UKV;
                if (r < I_MEM) { const int kb = r / 32, nb = r - kb * 32;
                    transpose_block(w_mem_kv + (size_t)l * 1024 * 1024, 1024, nb * 32, mem_norm + l * 1024, wl + WL_MEM, 1024, nb * 32, kb * 64, scr, lane); continue; }
                r -= I_MEM;
                if (r < I_BR) { const int i = r / 256, rr = r - i * 256, kb = rr / 32, nb = rr - kb * 32;
                    transpose_block(w_branch + (size_t)(l * 3 + i) * 512 * 1024, 1024, nb * 32, nullptr, wl + WL_BR + (size_t)i * 1024 * 512, 512, nb * 32, kb * 64, scr, lane); continue; }
                r -= I_BR;
                { const int kb = r / 32, nb = r - kb * 32;
                    transpose_block(w_out + (size_t)l * 1024 * 1024, 1024, nb * 32, nullptr, wl + WL_OUT, 1024, nb * 32, kb * 64, scr, lane); }
            }
            for (int i = bx * 512 + tid; i < DEPTH * 96 * 1024 / 8; i += G * 512) { const int l = i / (96 * 1024 / 8), rr = i - l * (96 * 1024 / 8);
                *(u32x4*)(P_WT + (size_t)l * WL_TOTAL + WL_IN + (size_t)416 * 1024 + (size_t)rr * 8) = (u32x4){0u, 0u, 0u, 0u}; }
            for (int i = bx * 512 + tid; i < SEQ * 16; i += G * 512) { const int s = i >> 4, j = i & 15;
                const float invf = powf(10000.0f, -(float)j / 16.0f); const float ang = (float)positions[s] * invf;
                double rv = (double)ang * 0.15915494309189535; rv -= floor(rv); const float f = (float)rv;
                P_COS[i] = __builtin_amdgcn_cosf(f); P_SIN[i] = __builtin_amdgcn_sinf(f); }
            for (int m = gw; m < MMEM + MTOK; m += NGW) {
                const float* src = (m < MMEM) ? mem + (size_t)m * 1024 : x_in + (size_t)(m - MMEM) * 1024; bf16_t* dst = (m < MMEM) ? P_MN + (size_t)m * 1024 : P_XN + (size_t)(m - MMEM) * 1024;
                f32x4 v[4]; float s = 0.f;
#pragma unroll
                for (int j = 0; j < 4; ++j) { v[j] = ((const f32x4*)src)[64 * j + lane]; s += (v[j][0] * v[j][0] + v[j][1] * v[j][1]) + (v[j][2] * v[j][2] + v[j][3] * v[j][3]); }
                const float rstd = __builtin_amdgcn_rsqf(wave_sum(s) * (1.0f / 1024.0f) + NORM_EPS);
#pragma unroll
                for (int j = 0; j < 4; ++j) store4bf(dst + 4 * (64 * j + lane), v[j] * rstd);
            }
#endif
        } else {
            const int l = (ph - 1) / 7, sub = (ph - 1) % 7;
            const bf16_t* wl = P_WT + (size_t)l * WL_TOTAL;
            if (sub == 0) {
#if PHSEL & 2
#if GSEL & 1
                { pg8::Gemm g{P_XN, wl + WL_IN, MTOK, 2048, 1024, 1024, 1024, 0, 0}; pg8::StaticOrder S; S.init(MTOK, 2048, G, bx);
                  pg8::Epi1 E{P_CQ, P_CKV, P_KPE, P_QD, P_KD, P_QX, P_SSQq, P_SSQkv, P_COS, P_SIN, 0.17677669529663687f * LOG2E, 0.08838834764831845f * LOG2E};
                  pg8::gemm_phase(lds, g, S, E); }
#endif
#if GSEL & 2
                { pg8::Gemm g{wl + WL_IN + (size_t)2048 * 1024, P_XN, 512, MTOK, 1024, 1024, 1024, 0, 0}; pg8::StaticOrder S; S.init(512, MTOK, G, bx);
                  pg8::EpiT E{P_VDT, (size_t)MTOK, 0, nullptr, 0.f, nullptr};
                  pg8::gemm_phase(lds, g, S, E); }
#endif
                if (l == 0) {
#if GSEL & 4
                    { pg8::Gemm g{P_MN, P_WT + WL_MEM, MMEM, 512, 1024, 1024, 1024, 0, WL_TOTAL}; pg8::StaticOrder S; S.init(MMEM, 512, G, bx, DEPTH);
                      pg8::EpiRow E{P_KM, 512, (size_t)MMEM * 512, nullptr, 0.f};
                      pg8::gemm_phase(lds, g, S, E); }
#endif
#if GSEL & 8
                    { pg8::Gemm g{P_WT + WL_MEM + (size_t)512 * 1024, P_MN, 512, MMEM, 1024, 1024, 1024, WL_TOTAL, 0}; pg8::StaticOrder S; S.init(512, MMEM, G, bx, DEPTH);
                      pg8::EpiT E{P_VMT, (size_t)MMEM, (size_t)512 * MMEM, nullptr, 0.f, nullptr};
                      pg8::gemm_phase(lds, g, S, E); }
#endif
                }
#endif
            } else if (sub == 1) {
#if PHSEL & 4
#if GSEL & 16
                { pg8::Gemm g{P_CQ, wl + WL_UQ, MTOK, 768, 256, 256, 256, 0, 0}; pg8::StaticOrder S; S.init(MTOK, 768, G, bx);
                  pg8::Epi2 E{P_QA, P_SSQq, P_COS, P_SIN, 0.10206207261596575f * LOG2E};
                  pg8::gemm_phase(lds, g, S, E); }
#endif
#if GSEL & 32
                { pg8::Gemm g{P_CKV, wl + WL_UKV, MTOK, 512, 128, 128, 128, 0, 0}; pg8::StaticOrder S; S.init(MTOK, 512, G, bx);
                  pg8::EpiRow E{P_KN, 512, 0, P_SSQkv, 1.0f / 128.0f};
                  pg8::gemm_phase(lds, g, S, E); }
#endif
#if GSEL & 64
                { pg8::Gemm g{wl + WL_UKV + (size_t)512 * 128, P_CKV, 512, MTOK, 128, 128, 128, 0, 0}; pg8::StaticOrder S; S.init(512, MTOK, G, bx);
                  pg8::EpiT E{P_VAT, (size_t)MTOK, 0, P_SSQkv, 1.0f / 128.0f, nullptr};
                  pg8::gemm_phase(lds, g, S, E); }
#endif
#endif
            } else if (sub == 2) {
#if PHSEL & 8
                const float d1 = wave_sum(lane < 32 ? lq1[l * 32 + lane] * lk1[l * 32 + lane] : 0.f), d2 = wave_sum(lane < 32 ? lq2[l * 32 + lane] * lk2[l * 32 + lane] : 0.f);
                const float lam_init = a.lam_init[l]; const float lam = expf(d1) - expf(d2) + lam_init;
#if ATTSEL & 1
                for (int P = vcu; P < 1024; P += G) { const int bh = P >> 3, s = P & 7, b = bh >> 3, h = bh & 7; const size_t rb = (size_t)b * SEQ;
                    for (int k = 0; k < 2; ++k) { const int qb = k ? s : 15 - s;
                        attn_unit2<1, 96, 64, 64, 32>(lds, P_QA + rb * 768 + h * 96, 768, P_KN + rb * 512 + h * 64, 512, P_KPE + rb * 32, 32, P_VAT + (size_t)(h * 64) * MTOK + rb, (size_t)MTOK,
                                                            qb * 256, 4 * (qb + 1), P_OB + rb * 1536 + h * 64, 1536, 0.f, nullptr, 1.f); } }
#endif
                asm volatile("" ::: "memory"); __builtin_amdgcn_sched_barrier(0);
#if ATTSEL & 2
                for (int P = vcu; P < 1024; P += G) { const int bh = P >> 3, s = P & 7, b = bh >> 3, h = bh & 7; const size_t rb = (size_t)b * SEQ;
                    for (int k = 0; k < 2; ++k) { const int qb = k ? s : 15 - s;
                        attn_unit2<2, 32, 64, 64, 0>(lds, P_QD + rb * 512 + h * 64, 512, P_KD + rb * 512 + h * 64, 512, nullptr, 0, P_VDT + (size_t)(h * 64) * MTOK + rb, (size_t)MTOK,
                                                           qb * 256, 4 * (qb + 1), P_OB + rb * 1536 + 512 + h * 64, 1536, lam, diff_subln + l * 64, 1.0f - lam_init); } }
#endif
                asm volatile("" ::: "memory"); __builtin_amdgcn_sched_barrier(0);
#if ATTSEL & 4
                for (int X = vcu; X < 1024; X += G) { const int bh = X >> 4, qb = X & 15, b = bh >> 2, h = bh & 3; const size_t rb = (size_t)b * SEQ;
                    attn_unit<1, 128, 128, false, 128, 0>(lds, P_QX + rb * 512 + h * 128, 512, P_KM + (size_t)l * MMEM * 512 + (size_t)b * MEMT * 512 + h * 128, 512, nullptr, 0,
                                                           P_VMT + (size_t)l * 512 * MMEM + (size_t)(h * 128) * MMEM + (size_t)b * MEMT, (size_t)MMEM,
                                                           qb * 256, 4, P_OB + rb * 1536 + 1024 + h * 128, 1536, 0.f, nullptr, 1.f); }
#endif
#endif
            } else if (sub == 3) {
#if PHSEL & 16
                { pg8::Gemm g{P_XN, wl + WL_IN + (size_t)2560 * 1024, MTOK, 1536, 1024, 1024, 1024, 0, 0}; pg8::StaticOrder S; S.init(MTOK, 1536, G, bx);
                  pg8::EpiSG E{P_OB};
                  pg8::gemm_phase(lds, g, S, E); }
                { pg8::Gemm g{P_XN, wl + WL_IN + (size_t)4096 * 1024, MTOK, 3072, 1024, 1024, 1024, 0, 0}; pg8::StaticOrder S; S.init(MTOK, 3072, G, bx);
                  pg8::EpiGL E{P_SB, b_gate + l * 3072};
                  pg8::gemm_phase(lds, g, S, E); }
#endif
            } else if (sub == 4) {
#if PHSEL & 32
                pg8::Gemm g{P_OB, wl + WL_BR, MTOK, 1024, 512, 1536, 512, 512, (size_t)1024 * 512}; pg8::StaticOrder S; S.init(MTOK, 1024, G, bx, 3);
                pg8::EpiBR E{P_SB, P_MG};
                pg8::gemm_phase(lds, g, S, E);
#endif
            } else if (sub == 5) {
#if PHSEL & 64
                pg8::Gemm g{P_MG, wl + WL_OUT, MTOK, 1024, 1024, 1024, 1024, 0, 0}; pg8::StaticOrder S; S.init(MTOK, 1024, G, bx);
                pg8::EpiRow E{(bf16_t*)P_OUTB, 1024, 0, nullptr, 0.f};
                pg8::gemm_phase(lds, g, S, E);
#endif
            } else {
#if PHSEL & 128
                const float* xo = (l == 0) ? x_in : a.out; const float* gp = norm_post + l * 1024;
                for (int m = gw; m < MTOK; m += NGW) {
                    f32x4 v[4]; float s = 0.f;
#pragma unroll
                    for (int j = 0; j < 4; ++j) { v[j] = unpack4bf(((const u32x2*)((const bf16_t*)P_OUTB + (size_t)m * 1024))[64 * j + lane]); s += (v[j][0] * v[j][0] + v[j][1] * v[j][1]) + (v[j][2] * v[j][2] + v[j][3] * v[j][3]); }
                    const float rstd = __builtin_amdgcn_rsqf(wave_sum(s) * (1.0f / 1024.0f) + NORM_EPS); float s2 = 0.f;
#pragma unroll
                    for (int j = 0; j < 4; ++j) { const f32x4 xv = ((const f32x4*)(xo + (size_t)m * 1024))[64 * j + lane]; const f32x4 gv = ((const f32x4*)gp)[64 * j + lane];
                        v[j] = xv + v[j] * rstd * gv; ((f32x4*)(a.out + (size_t)m * 1024))[64 * j + lane] = v[j];
                        s2 += (v[j][0] * v[j][0] + v[j][1] * v[j][1]) + (v[j][2] * v[j][2] + v[j][3] * v[j][3]); }
                    if (l + 1 < DEPTH) { const float rstd2 = __builtin_amdgcn_rsqf(wave_sum(s2) * (1.0f / 1024.0f) + NORM_EPS);
#pragma unroll
                        for (int j = 0; j < 4; ++j) store4bf(P_XN + (size_t)m * 1024 + 4 * (64 * j + lane), v[j] * rstd2); }
                }
#endif
            }
        }
        if (ph + 1 < a.ph_hi) { if (a.coop) { if (ph == 0) cg::this_grid().sync(); else xcd_barrier(xbar); } }
    }
#ifdef DBG_NPH
    if (a.pad) {
        if (a.coop) cg::this_grid().sync();
        const unsigned short* w16 = (const unsigned short*)(a.ws + OFF_MN);
        const size_t n16 = (WS_END - OFF_MN) / 2, nout = (size_t)MTOK * 1024;
        for (size_t i = (size_t)blockIdx.x * 512 + threadIdx.x; i < nout; i += (size_t)gridDim.x * 512) {
            unsigned x = 0; for (size_t k = i; k < n16; k += nout) x ^= w16[k];
            const unsigned short* w2 = (const unsigned short*)(a.ws + OFF_COS); if (i < (size_t)(4 * MiB) / 2) x ^= w2[i];
            a.out[i] = (float)x;
        }
    }
#endif
}

extern "C" void kernel_launch(void* const* d_in, const int* in_sizes, int n_in, void* d_out, int out_size, void* d_ws, size_t ws_size, hipStream_t stream) {
    static int grid = 0;
    if (grid == 0) {
        if (n_in != 20 || ws_size < WS_END) { fprintf(stderr, "kernel_launch: need 20 inputs and >= %zu bytes of workspace (got %d, %zu)\n", (size_t)WS_END, n_in, ws_size); grid = -1; return; }
        int dev = 0, cus = 0, per_cu = 0;
        hipGetDevice(&dev); hipDeviceGetAttribute(&cus, hipDeviceAttributeMultiprocessorCount, dev);
        if (hipFuncSetAttribute((const void*)hybrid_fwd, hipFuncAttributeMaxDynamicSharedMemorySize, LDS_BYTES) != hipSuccess) { fprintf(stderr, "kernel_launch: hipFuncSetAttribute failed\n"); grid = -1; return; }
        if (hipOccupancyMaxActiveBlocksPerMultiprocessor(&per_cu, (const void*)hybrid_fwd, 512, LDS_BYTES) != hipSuccess || per_cu < 1) per_cu = 1;
        (void)hipGetLastError();
        grid = cus * 1;
    }
    if (grid < 0) return;
    if (hipMemsetAsync((char*)d_ws + OFF_BAR, 0, 16384, stream) != hipSuccess) { fprintf(stderr, "kernel_launch: hipMemsetAsync failed\n"); return; }
    Args a{};
    for (int i = 0; i < 20; ++i) a.in[i] = (const float*)d_in[i];
    a.out = (float*)d_out; a.ws = (unsigned char*)d_ws; a.pad = 0;
    a.lam_init[0] = 0.2f; a.lam_init[1] = 0.35550906759096926f; a.lam_init[2] = 0.47071301834358424f; a.lam_init[3] = 0.55605820415654f;
#if MK_ONE_LAUNCH
#ifdef DBG_NPH
    a.ph_lo = 0; a.ph_hi = DBG_NPH; a.coop = 1; a.pad = 1;
#else
    a.ph_lo = 0; a.ph_hi = NPHASE; a.coop = 1;
#endif
    void* args[] = {&a};
    hipError_t e = hipLaunchCooperativeKernel((const void*)hybrid_fwd, dim3(grid), dim3(512), args, LDS_BYTES, stream);
    if (e != hipSuccess) fprintf(stderr, "cooperative launch failed: %s (grid %d)\n", hipGetErrorString(e), grid);
#else
    for (int ph = 0; ph < NPHASE; ++ph) { a.ph_lo = ph; a.ph_hi = ph + 1; a.coop = 0;
        hipLaunchKernelGGL(hybrid_fwd, dim3(grid), dim3(512), LDS_BYTES, stream, a); }
#endif
}
```

```cpp
#include <hip/hip_runtime.h>
#include <hip/hip_cooperative_groups.h>
#include <cstdio>
#include <cstdint>
namespace cg = cooperative_groups;

#ifndef ATTSEL
#define ATTSEL 7
#endif
#ifndef GSEL
#define GSEL 0xFFFF
#endif
#ifndef PHSEL
#define PHSEL 0xFFFF
#endif
#ifndef MK_ONE_LAUNCH
#define MK_ONE_LAUNCH 1
#endif

#define LAS __attribute__((address_space(3)))
typedef unsigned short bf16_t;
typedef short bf16x8 __attribute__((ext_vector_type(8)));
typedef short s16x4 __attribute__((ext_vector_type(4)));
typedef float f32x4 __attribute__((ext_vector_type(4)));
typedef float f32x16 __attribute__((ext_vector_type(16)));
typedef unsigned u32x4 __attribute__((ext_vector_type(4)));
typedef unsigned u32x2 __attribute__((ext_vector_type(2)));
typedef float f32x2_t __attribute__((ext_vector_type(2)));
typedef __bf16 bf16x2_t __attribute__((ext_vector_type(2)));

constexpr int D_MODEL = 1024, BATCH = 16, SEQ = 4096, DEPTH = 4, MEMT = 256;
constexpr int MTOK = BATCH * SEQ;
constexpr int MMEM = BATCH * MEMT;
constexpr int IN_WIDTH = 7072;
constexpr float NORM_EPS = 1e-6f;
constexpr float LOG2E = 1.4426950408889634f;

constexpr size_t WL_IN = 0;
constexpr size_t WL_UQ = WL_IN + (size_t)7168 * 1024;
constexpr size_t WL_UKV = WL_UQ + (size_t)768 * 256;
constexpr size_t WL_MEM = WL_UKV + (size_t)1024 * 128;
constexpr size_t WL_BR = WL_MEM + (size_t)1024 * 1024;
constexpr size_t WL_OUT = WL_BR + (size_t)3 * 1024 * 512;
constexpr size_t WL_TOTAL = WL_OUT + (size_t)1024 * 3072;

constexpr size_t MiB = 1u << 20;
constexpr size_t OFF_W = 0;
constexpr size_t OFF_COS = 104 * MiB, OFF_SIN = OFF_COS + 256 * 1024;
constexpr size_t OFF_SSQQ = 105 * MiB, OFF_SSQKV = 106 * MiB;
constexpr size_t OFF_BAR = 107 * MiB;
constexpr size_t OFF_MN = 108 * MiB;
constexpr size_t OFF_KM = 116 * MiB;
constexpr size_t OFF_VMT = 132 * MiB;
constexpr size_t OFF_XN = 148 * MiB;
constexpr size_t OFF_O = 276 * MiB;
constexpr size_t OFF_R = 468 * MiB;
constexpr size_t OFF_CQ = OFF_R;
constexpr size_t OFF_CKV = OFF_CQ + 32 * MiB;
constexpr size_t OFF_KPE = OFF_CKV + 16 * MiB;
constexpr size_t OFF_QD = OFF_KPE + 4 * MiB;
constexpr size_t OFF_KD = OFF_QD + 64 * MiB;
constexpr size_t OFF_VDT = OFF_KD + 64 * MiB;
constexpr size_t OFF_QX = OFF_VDT + 64 * MiB;
constexpr size_t OFF_QA = OFF_QX + 64 * MiB;
constexpr size_t OFF_KN = OFF_QA + 96 * MiB;
constexpr size_t OFF_VAT = OFF_KN + 64 * MiB;
constexpr size_t WS_END = OFF_VAT + 64 * MiB;
constexpr size_t OFF_S = OFF_R;
constexpr size_t OFF_MERGED = OFF_R + 384 * MiB;
constexpr size_t OFF_OUT = OFF_R;
static_assert(4 * WL_TOTAL * 2 <= OFF_COS && OFF_MERGED + 128 * MiB <= WS_END, "ws map");

constexpr int LDS_BYTES = 147456;
constexpr int NPHASE = 1 + 7 * DEPTH;

__device__ __forceinline__ unsigned cvtpk(float lo, float hi) { f32x2_t v = {lo, hi}; bf16x2_t b = __builtin_convertvector(v, bf16x2_t); return __builtin_bit_cast(unsigned, b); }
__device__ __forceinline__ void store4bf(bf16_t* p, f32x4 v) { u32x2 w; w.x = cvtpk(v[0], v[1]); w.y = cvtpk(v[2], v[3]); *(u32x2*)p = w; }
__device__ __forceinline__ f32x4 unpack4bf(u32x2 w) { f32x4 r; r[0] = __uint_as_float(w.x << 16); r[1] = __uint_as_float(w.x & 0xffff0000u); r[2] = __uint_as_float(w.y << 16); r[3] = __uint_as_float(w.y & 0xffff0000u); return r; }
__device__ __forceinline__ float fast_rcp(float x) { return __builtin_amdgcn_rcpf(x); }
__device__ __forceinline__ float fast_exp2(float x) { return __builtin_amdgcn_exp2f(x); }
__device__ __forceinline__ float sigmoidf_(float v) { return fast_rcp(1.0f + fast_exp2(-v * LOG2E)); }

namespace pg8 {
constexpr int BM = 256, BK = 64, HALF = 128, HTB = HALF * BK * 2, STAGE_BYTES = 8 * HTB, NXCD = 8, WGM = 8;
__host__ __device__ __forceinline__ int lds_byte(int r, int c) { const int st = (r >> 4) * 2 + (c >> 5), rr = r & 15, cc = c & 31, ob = rr * 64 + cc * 2; return st * 1024 + (ob ^ (((ob >> 9) & 1) << 5)); }
__host__ __device__ __forceinline__ void stage_rc(int b, int& R, int& C) { const int st = b / 1024, sb = b % 1024, swz = sb ^ (((sb >> 9) & 1) << 5); R = (st >> 1) * 16 + swz / 64; C = (st & 1) * 32 + (swz % 64) / 2; }

struct Unit { int pm, pn, z; };
struct Gemm { const bf16_t* A; const bf16_t* Bt; int M, N, K, lda, ldb; size_t zA, zB; };

struct StaticOrder {
    int nM, nN, nwg, G, c, nz;
    __device__ void init(int M, int N, int G_, int c_, int nz_ = 1) { nM = M / BM; nN = N / BM; nwg = nM * nN; G = G_; c = c_; nz = nz_; }
    __device__ bool next(int i, Unit& u) const {
        const int ib = i / nz; u.z = i - ib * nz;
        const long L = (long)ib * G + c; if (L >= nwg) return false;
        int wgid = (int)L; { const int q = nwg / NXCD, r = nwg % NXCD, xcd = wgid % NXCD, off = wgid / NXCD; wgid = (xcd < r ? xcd * (q + 1) : r * (q + 1) + (xcd - r) * q) + off; }
        const int nig = WGM * nN, gid = wgid / nig, fm = gid * WGM, gsz = (nM - fm) < WGM ? (nM - fm) : WGM;
        u.pm = fm + ((wgid % nig) % gsz); u.pn = (wgid % nig) / gsz; return true;
    }
};

template <class Epi>
__device__ __forceinline__ void gemm_phase(LAS unsigned char* lds, const Gemm g, const StaticOrder& S, const Epi& E) {
    int tid = threadIdx.x; asm volatile("" : "+v"(tid));
    const int wid = __builtin_amdgcn_readfirstlane(tid >> 6), lane = tid & 63, wr = wid >> 2, wc = wid & 3, fr = lane & 15, fq = lane >> 4;
    int K = g.K; asm volatile("" : "+s"(K)); const int nt = K / BK;
    unsigned voffA[2], voffB[2];
#pragma unroll
    for (int i = 0; i < 2; ++i) { int R, C; stage_rc(tid * 16 + i * 8192, R, C);
        voffA[i] = (unsigned)(R * g.lda + C) * 2u; voffB[i] = (unsigned)(R * g.ldb + C) * 2u; }
    const size_t kstep = (size_t)(BK * 2);
    const size_t hstepA = (size_t)HALF * g.lda * 2, hstepB = (size_t)HALF * g.ldb * 2;
    const size_t tstepA = 2 * hstepA, tstepB = 2 * hstepB;
    const unsigned ldsw = (unsigned)wid * 1024u;
    const int aoff = lds_byte(wr * 64 + fr, fq * 8), boff = lds_byte(wc * 32 + fr, fq * 8);
#define PG8_SA(b, h) (((b) * 2 + (h)) * HTB)
#define PG8_SB(b, h) ((4 + (b) * 2 + (h)) * HTB)
#define PG8_STAGE(bufoff, gbase, voff) do { _Pragma("unroll") for (int _i = 0; _i < 2; ++_i) \
        __builtin_amdgcn_global_load_lds((const unsigned*)((const char*)(gbase) + (voff)[_i]), (LAS unsigned*)(lds + (bufoff) + ldsw + _i * 8192), 16, 0, 0); } while (0)
#define PG8_LDA(dst, b, h) do { _Pragma("unroll") for (int m = 0; m < 4; ++m) _Pragma("unroll") for (int k = 0; k < 2; ++k) dst[m][k] = *(const LAS bf16x8*)(lds + PG8_SA(b, h) + aoff + m * 2048 + k * 1024); } while (0)
#define PG8_LDB(dst, b, h) do { _Pragma("unroll") for (int n = 0; n < 2; ++n) _Pragma("unroll") for (int k = 0; k < 2; ++k) dst[n][k] = *(const LAS bf16x8*)(lds + PG8_SB(b, h) + boff + n * 2048 + k * 1024); } while (0)
#define PG8_MMA(ai, bj, At, Bt) do { __builtin_amdgcn_s_setprio(1); _Pragma("unroll") for (int m = 0; m < 4; ++m) _Pragma("unroll") for (int n = 0; n < 2; ++n) _Pragma("unroll") for (int k = 0; k < 2; ++k) \
        acc[ai][bj][m][n] = __builtin_amdgcn_mfma_f32_16x16x32_bf16(Bt[n][k], At[m][k], acc[ai][bj][m][n], 0, 0, 0); __builtin_amdgcn_s_setprio(0); } while (0)
#define PG8_WAIT_V(n) asm volatile("s_waitcnt vmcnt(" #n ")" ::: "memory")
#define PG8_WAIT_L(n) asm volatile("s_waitcnt lgkmcnt(" #n ")" ::: "memory")
#define PG8_BAR __builtin_amdgcn_s_barrier()
#define PG8_SCHED __builtin_amdgcn_sched_barrier(0)
    Unit cur, nxt; int ui = 0;
    if (!S.next(0, cur)) return;
    f32x4 acc[2][2][4][2];
#pragma unroll
    for (int a = 0; a < 2; ++a)
#pragma unroll
        for (int b = 0; b < 2; ++b)
#pragma unroll
            for (int m = 0; m < 4; ++m)
#pragma unroll
                for (int n = 0; n < 2; ++n) acc[a][b][m][n] = (f32x4){0.f, 0.f, 0.f, 0.f};
    bf16x8 At[4][2], B0[2][2], B1[2][2];
    const char* cA = (const char*)g.A + ((size_t)cur.z * g.zA) * 2 + (size_t)cur.pm * tstepA;
    const char* cB = (const char*)g.Bt + ((size_t)cur.z * g.zB) * 2 + (size_t)cur.pn * tstepB;
    PG8_STAGE(PG8_SB(0, 0), cB, voffB); PG8_STAGE(PG8_SB(0, 1), cB + hstepB, voffB); PG8_STAGE(PG8_SA(0, 0), cA, voffA); PG8_STAGE(PG8_SA(0, 1), cA + hstepA, voffA);
    if (wr == 1) PG8_BAR;
    PG8_WAIT_V(2); PG8_BAR;
    PG8_STAGE(PG8_SB(1, 0), cB + kstep, voffB); PG8_STAGE(PG8_SA(1, 0), cA + kstep, voffA); PG8_STAGE(PG8_SB(1, 1), cB + hstepB + kstep, voffB);
    PG8_WAIT_V(6); PG8_BAR;
    for (;;) {
        const bool has_next = S.next(ui + 1, nxt);
        const char* nA = has_next ? (const char*)g.A + ((size_t)nxt.z * g.zA) * 2 + (size_t)nxt.pm * tstepA : cA;
        const char* nB = has_next ? (const char*)g.Bt + ((size_t)nxt.z * g.zB) * 2 + (size_t)nxt.pn * tstepB : cB;
        for (int t = 0; t < nt; t += 2) {
            const bool last = (t == nt - 2);
            const char* a1 = cA + (size_t)(t + 1) * kstep;
            const char* a2 = last ? nA : cA + (size_t)(t + 2) * kstep; const char* b2 = last ? nB : cB + (size_t)(t + 2) * kstep;
            const char* a3 = a2 + kstep; const char* b3 = b2 + kstep;
            PG8_LDB(B0, 0, 0); PG8_LDB(B1, 0, 1); PG8_SCHED; PG8_LDA(At, 0, 0); PG8_STAGE(PG8_SA(1, 1), a1 + hstepA, voffA);
            PG8_WAIT_V(8); PG8_WAIT_L(0); PG8_BAR; PG8_MMA(0, 0, At, B0); PG8_MMA(0, 1, At, B1); PG8_BAR; PG8_SCHED;
            PG8_LDA(At, 0, 1); PG8_STAGE(PG8_SB(0, 0), b2, voffB); PG8_STAGE(PG8_SB(0, 1), b2 + hstepB, voffB); PG8_STAGE(PG8_SA(0, 0), a2, voffA);
            PG8_WAIT_V(8); PG8_WAIT_L(0); PG8_BAR; PG8_MMA(1, 0, At, B0); PG8_MMA(1, 1, At, B1); PG8_BAR; PG8_SCHED;
            PG8_LDB(B0, 1, 0); PG8_LDB(B1, 1, 1); PG8_SCHED; PG8_LDA(At, 1, 0); PG8_STAGE(PG8_SA(0, 1), a2 + hstepA, voffA);
            PG8_WAIT_V(8); PG8_WAIT_L(0); PG8_BAR; PG8_MMA(0, 0, At, B0); PG8_MMA(0, 1, At, B1); PG8_BAR; PG8_SCHED;
            PG8_LDA(At, 1, 1); PG8_STAGE(PG8_SB(1, 0), b3, voffB); PG8_STAGE(PG8_SB(1, 1), b3 + hstepB, voffB); PG8_STAGE(PG8_SA(1, 0), a3, voffA);
            PG8_WAIT_V(8); PG8_WAIT_L(0); PG8_BAR; PG8_MMA(1, 0, At, B0); PG8_MMA(1, 1, At, B1); PG8_BAR; PG8_SCHED;
        }
        if (wr == 0) PG8_BAR;
        E(acc, cur, wr, wc, fr, fq);
        if (!has_next) break;
#pragma unroll
        for (int a = 0; a < 2; ++a)
#pragma unroll
            for (int b = 0; b < 2; ++b)
#pragma unroll
                for (int m = 0; m < 4; ++m)
#pragma unroll
                    for (int n = 0; n < 2; ++n) acc[a][b][m][n] = (f32x4){0.f, 0.f, 0.f, 0.f};
        cur = nxt; cA = nA; cB = nB; ++ui;
        if (wr == 1) PG8_BAR;
    }
    PG8_WAIT_V(0);
    PG8_BAR;
    asm volatile("" ::: "memory"); PG8_SCHED;
#undef PG8_SA
#undef PG8_SB
#undef PG8_STAGE
#undef PG8_LDA
#undef PG8_LDB
#undef PG8_MMA
#undef PG8_WAIT_V
#undef PG8_WAIT_L
#undef PG8_BAR
#undef PG8_SCHED
}

#define EPI_ROWS_BEGIN _Pragma("unroll") for (int ai = 0; ai < 2; ++ai) _Pragma("unroll") for (int m = 0; m < 4; ++m) { const int row = u.pm * BM + ai * HALF + wr * 64 + m * 16 + fr;
#define EPI_ROWS_END if (m & 1) asm volatile("" ::: "memory"); }
#define EPI_COLS_BEGIN _Pragma("unroll") for (int bj = 0; bj < 2; ++bj) _Pragma("unroll") for (int n = 0; n < 2; ++n) { const int colt = bj * HALF + wc * 32 + n * 16 + 4 * fq;
#define EPI_COLS_END }
typedef f32x4 Acc[2][2][4][2];

__device__ __forceinline__ float rstd4(const float* ssq, int row, float inv_dim) { const f32x4 p = *(const f32x4*)(ssq + (size_t)row * 4); return __builtin_amdgcn_rsqf(((p[0] + p[1]) + (p[2] + p[3])) * inv_dim + NORM_EPS); }

struct Epi1 {
    bf16_t *CQ, *CKV, *KPE, *QD, *KD, *QX; float *SSQq, *SSQkv; const float *COS, *SIN; float sc_d, sc_x;
    __device__ __forceinline__ void operator()(const Acc& acc, const Unit& u, int wr, int wc, int fr, int fq) const {
        const int pn = u.pn;
        EPI_ROWS_BEGIN
            const float r = 1.0f;
            if (pn == 0) {
                float ss = 0.f;
                EPI_COLS_BEGIN const f32x4 v = acc[ai][bj][m][n] * r; ss += (v[0] * v[0] + v[1] * v[1]) + (v[2] * v[2] + v[3] * v[3]); store4bf(CQ + (size_t)row * 256 + colt, v); EPI_COLS_END
                ss += __shfl_xor(ss, 16); ss += __shfl_xor(ss, 32);
                if (fq == 0) SSQq[(size_t)row * 4 + wc] = ss;
            } else if (pn == 1) {
                float ss = 0.f;
#pragma unroll
                for (int n = 0; n < 2; ++n) { const f32x4 v = acc[ai][0][m][n] * r; ss += (v[0] * v[0] + v[1] * v[1]) + (v[2] * v[2] + v[3] * v[3]); store4bf(CKV + (size_t)row * 128 + wc * 32 + n * 16 + 4 * fq, v); }
                ss += __shfl_xor(ss, 16); ss += __shfl_xor(ss, 32);
                if (fq == 0) SSQkv[(size_t)row * 4 + wc] = ss;
                if (wc == 0) {
                    const int s = row & (SEQ - 1); const f32x4 cs = *(const f32x4*)(COS + s * 16 + 4 * fq), sn = *(const f32x4*)(SIN + s * 16 + 4 * fq);
                    const f32x4 x1 = acc[ai][1][m][0] * r, x2 = acc[ai][1][m][1] * r;
                    store4bf(KPE + (size_t)row * 32 + 4 * fq, x1 * cs - x2 * sn); store4bf(KPE + (size_t)row * 32 + 16 + 4 * fq, x2 * cs + x1 * sn);
                }
            } else if (pn < 6) {
                bf16_t* dst = (pn < 4 ? QD : KD) + (size_t)row * 512 + (pn & 1) * 256 + wc * 32 + 4 * fq; const float sc = (pn < 4 ? sc_d : 1.0f) * r;
                const int s = row & (SEQ - 1); const f32x4 cs = *(const f32x4*)(COS + s * 16 + 4 * fq), sn = *(const f32x4*)(SIN + s * 16 + 4 * fq);
#pragma unroll
                for (int bj = 0; bj < 2; ++bj) { const f32x4 x1 = acc[ai][bj][m][0] * sc, x2 = acc[ai][bj][m][1] * sc;
                    store4bf(dst + bj * HALF, x1 * cs - x2 * sn); store4bf(dst + bj * HALF + 16, x2 * cs + x1 * sn); }
            } else {
                const float sc = sc_x * r;
                EPI_COLS_BEGIN store4bf(QX + (size_t)row * 512 + (pn - 6) * 256 + colt, acc[ai][bj][m][n] * sc); EPI_COLS_END
            }
        EPI_ROWS_END
    }
};
struct EpiT {
    bf16_t* O; size_t ldc; size_t zO; const float* ssq; float inv_dim; const float* colscale;
    __device__ __forceinline__ void operator()(const Acc& acc, const Unit& u, int wr, int wc, int fr, int fq) const {
        f32x4 cs[2][2];
        EPI_COLS_BEGIN
            const int col = u.pn * BM + colt;
            if (ssq) { for (int i = 0; i < 4; ++i) cs[bj][n][i] = rstd4(ssq, col + i, inv_dim); }
            else if (colscale) cs[bj][n] = *(const f32x4*)(colscale + col);
            else cs[bj][n] = (f32x4){1.f, 1.f, 1.f, 1.f};
        EPI_COLS_END
        bf16_t* base = O + (size_t)u.z * zO;
        EPI_ROWS_BEGIN
            EPI_COLS_BEGIN store4bf(base + (size_t)row * ldc + u.pn * BM + colt, acc[ai][bj][m][n] * cs[bj][n]); EPI_COLS_END
        EPI_ROWS_END
    }
};
struct EpiRow {
    bf16_t* O; size_t ldc; size_t zO; const float* ssq; float inv_dim;
    __device__ __forceinline__ void operator()(const Acc& acc, const Unit& u, int wr, int wc, int fr, int fq) const {
        bf16_t* base = O + (size_t)u.z * zO;
        EPI_ROWS_BEGIN
            const float sc = ssq ? rstd4(ssq, row, inv_dim) : 1.0f;
            EPI_COLS_BEGIN store4bf(base + (size_t)row * ldc + u.pn * BM + colt, acc[ai][bj][m][n] * sc); EPI_COLS_END
        EPI_ROWS_END
    }
};
struct Epi2 {
    bf16_t* QA; const float* SSQq; const float *COS, *SIN; float sc_a;
    __device__ __forceinline__ void operator()(const Acc& acc, const Unit& u, int wr, int wc, int fr, int fq) const {
        EPI_ROWS_BEGIN
            const float sc = rstd4(SSQq, row, 1.0f / 256.0f) * sc_a;
            if (u.pn < 2) {
                EPI_COLS_BEGIN const int nn = u.pn * BM + colt; store4bf(QA + (size_t)row * 768 + (nn >> 6) * 96 + (nn & 63), acc[ai][bj][m][n] * sc); EPI_COLS_END
            } else {
                const int s = row & (SEQ - 1); const f32x4 cs = *(const f32x4*)(COS + s * 16 + 4 * fq), sn = *(const f32x4*)(SIN + s * 16 + 4 * fq);
#pragma unroll
                for (int bj = 0; bj < 2; ++bj) { const f32x4 x1 = acc[ai][bj][m][0] * sc, x2 = acc[ai][bj][m][1] * sc; bf16_t* dst = QA + (size_t)row * 768 + (4 * bj + wc) * 96 + 64 + 4 * fq;
                    store4bf(dst, x1 * cs - x2 * sn); store4bf(dst + 16, x2 * cs + x1 * sn); }
            }
        EPI_ROWS_END
    }
};
struct EpiSG {
    bf16_t* O;
    __device__ __forceinline__ void operator()(const Acc& acc, const Unit& u, int wr, int wc, int fr, int fq) const {
#pragma unroll
        for (int ai = 0; ai < 2; ++ai) {
            u32x2 ov[4][2][2];
#pragma unroll
            for (int m = 0; m < 4; ++m) { const int row = u.pm * BM + ai * HALF + wr * 64 + m * 16 + fr;
                EPI_COLS_BEGIN ov[m][bj][n] = *(const u32x2*)(O + (size_t)row * 1536 + u.pn * BM + colt); EPI_COLS_END }
#pragma unroll
            for (int m = 0; m < 4; ++m) { const int row = u.pm * BM + ai * HALF + wr * 64 + m * 16 + fr;
                EPI_COLS_BEGIN const f32x4 o = unpack4bf(ov[m][bj][n]); const f32x4 g = acc[ai][bj][m][n]; f32x4 v;
#pragma unroll
                    for (int i = 0; i < 4; ++i) v[i] = o[i] * g[i] * sigmoidf_(g[i]);
                    store4bf(O + (size_t)row * 1536 + u.pn * BM + colt, v); EPI_COLS_END }
            asm volatile("" ::: "memory");
        }
    }
};
struct EpiGL {
    bf16_t* S; const float* bias;
    __device__ __forceinline__ void operator()(const Acc& acc, const Unit& u, int wr, int wc, int fr, int fq) const {
        f32x4 bv[2][2];
        EPI_COLS_BEGIN bv[bj][n] = *(const f32x4*)(bias + u.pn * BM + colt); EPI_COLS_END
        EPI_ROWS_BEGIN
            const float r = 1.0f;
            EPI_COLS_BEGIN const f32x4 g = acc[ai][bj][m][n] * r + bv[bj][n]; f32x4 v;
#pragma unroll
                for (int i = 0; i < 4; ++i) v[i] = sigmoidf_(g[i]);
                store4bf(S + (size_t)row * 3072 + u.pn * BM + colt, v); EPI_COLS_END
        EPI_ROWS_END
    }
};
struct EpiBR {
    const bf16_t* S; bf16_t* MG;
    __device__ __forceinline__ void operator()(const Acc& acc, const Unit& u, int wr, int wc, int fr, int fq) const {
#pragma unroll
        for (int ai = 0; ai < 2; ++ai) {
            u32x2 sv[4][2][2]; unsigned long long mv[4][2][2];
#pragma unroll
            for (int m = 0; m < 4; ++m) { const int row = u.pm * BM + ai * HALF + wr * 64 + m * 16 + fr;
                EPI_COLS_BEGIN const int col = u.pn * BM + colt; sv[m][bj][n] = *(const u32x2*)(S + (size_t)row * 3072 + u.z * 1024 + col);
                    mv[m][bj][n] = (u.z > 0) ? __hip_atomic_load((const unsigned long long*)(MG + (size_t)row * 1024 + col), __ATOMIC_RELAXED, __HIP_MEMORY_SCOPE_AGENT) : 0ull; EPI_COLS_END }
#pragma unroll
            for (int m = 0; m < 4; ++m) { const int row = u.pm * BM + ai * HALF + wr * 64 + m * 16 + fr;
                EPI_COLS_BEGIN const int col = u.pn * BM + colt; f32x4 v = unpack4bf(sv[m][bj][n]) * acc[ai][bj][m][n];
                    u32x2 ww; ww.x = (unsigned)mv[m][bj][n]; ww.y = (unsigned)(mv[m][bj][n] >> 32); v += unpack4bf(ww);
                    store4bf(MG + (size_t)row * 1024 + col, v); EPI_COLS_END }
            asm volatile("" ::: "memory");
        }
    }
};
struct EpiOut {
    float* OUT;
    __device__ __forceinline__ void operator()(const Acc& acc, const Unit& u, int wr, int wc, int fr, int fq) const {
        EPI_ROWS_BEGIN
            EPI_COLS_BEGIN *(f32x4*)(OUT + (size_t)row * 1024 + u.pn * BM + colt) = acc[ai][bj][m][n]; EPI_COLS_END
        EPI_ROWS_END
    }
};
}

__device__ __forceinline__ int crow(int r, int hi) { return (r & 3) + 8 * (r >> 2) + 4 * hi; }

template <int NMAP, int DKM, int DV, bool CAUSAL, int W0, int W1>
__device__ __forceinline__ void attn_unit(LAS unsigned char* lds, const bf16_t* __restrict__ Q, int ldq, const bf16_t* __restrict__ K0, int ldk0, const bf16_t* __restrict__ K1, int ldk1,
                                          const bf16_t* __restrict__ Vt, size_t ldv, int q0, int NT, bf16_t* O, int ldo, float lam, const float* subln, float outscale) {
    constexpr int DKT = NMAP * DKM, KS = DKT * 2 + 16, VS = 136, KBUF = 64 * KS, VBUF = DV * VS;
    constexpr int NC = DKM / 16, NDB = DV / 32;
    constexpr int K0C = W0 / 8, K0N = (64 * K0C) / 512, K1C = W1 / 8, VN = (DV * 8) / 512;
    static_assert(W0 + W1 == DKT && K0N >= 1 && VN >= 1, "attention staging geometry");
    int tid = threadIdx.x; asm volatile("" : "+v"(tid));
    const int lane = tid & 63, wid = __builtin_amdgcn_readfirstlane(tid >> 6), r32 = lane & 31, hi = lane >> 5;
    LAS unsigned char* Kb = lds; LAS unsigned char* Vb = lds + 2 * KBUF;
    bf16x8 qf[NMAP][NC];
    { const bf16_t* qrow = Q + (size_t)(q0 + wid * 32 + r32) * ldq;
#pragma unroll
      for (int mp = 0; mp < NMAP; ++mp)
#pragma unroll
          for (int c = 0; c < NC; ++c) qf[mp][c] = *(const bf16x8*)(qrow + mp * DKM + 16 * c + 8 * hi); }
    f32x16 o[NMAP][NDB]; float mrow[NMAP], lrow[NMAP];
#pragma unroll
    for (int mp = 0; mp < NMAP; ++mp) { mrow[mp] = -INFINITY; lrow[mp] = 0.f;
#pragma unroll
        for (int db = 0; db < NDB; ++db)
#pragma unroll
            for (int r = 0; r < 16; ++r) o[mp][db][r] = 0.f; }
    u32x4 kreg[K0N], k1reg = {0u, 0u, 0u, 0u}, vreg[VN];
#define ATT_GLOAD(t) do { \
    _Pragma("unroll") for (int i = 0; i < K0N; ++i) { const int idx = tid + 512 * i, rr = idx / K0C, cc = idx % K0C; kreg[i] = *(const u32x4*)(K0 + (size_t)(64 * (t) + rr) * ldk0 + cc * 8); } \
    if (W1 > 0) { if (tid < 64 * K1C) { const int rr = tid / (K1C > 0 ? K1C : 1), cc = tid % (K1C > 0 ? K1C : 1); k1reg = *(const u32x4*)(K1 + (size_t)(64 * (t) + rr) * ldk1 + cc * 8); } } \
    _Pragma("unroll") for (int i = 0; i < VN; ++i) { const int idx = tid + 512 * i, dd = idx >> 3, cc = idx & 7; vreg[i] = *(const u32x4*)(Vt + (size_t)dd * ldv + 64 * (t) + cc * 8); } } while (0)
#define ATT_LWRITE(buf) do { \
    _Pragma("unroll") for (int i = 0; i < K0N; ++i) { const int idx = tid + 512 * i, rr = idx / K0C, cc = idx % K0C; *(LAS u32x4*)(Kb + (buf) * KBUF + rr * KS + cc * 16) = kreg[i]; } \
    if (W1 > 0) { if (tid < 64 * K1C) { const int rr = tid / (K1C > 0 ? K1C : 1), cc = tid % (K1C > 0 ? K1C : 1); *(LAS u32x4*)(Kb + (buf) * KBUF + rr * KS + W0 * 2 + cc * 16) = k1reg; } } \
    _Pragma("unroll") for (int i = 0; i < VN; ++i) { const int idx = tid + 512 * i, dd = idx >> 3, cc = idx & 7; LAS u32x2* vp = (LAS u32x2*)(Vb + (buf) * VBUF + dd * VS + cc * 16); \
        u32x2 lo_; lo_.x = vreg[i].x; lo_.y = vreg[i].y; u32x2 hi_; hi_.x = vreg[i].z; hi_.y = vreg[i].w; vp[0] = lo_; vp[1] = hi_; } } while (0)
    ATT_GLOAD(0);
    ATT_LWRITE(0);
    __syncthreads();
    const int qw0 = q0 + wid * 32;
    for (int t = 0; t < NT; ++t) {
        const int buf = t & 1;
        if (t + 1 < NT) ATT_GLOAD(t + 1);
#pragma unroll
        for (int kb = 0; kb < 2; ++kb) {
            const int kv0 = 64 * t + 32 * kb;
            if (CAUSAL && kv0 > qw0) continue;
            const bool diag = CAUSAL && (kv0 == qw0);
            bf16x8 vf[NDB][2];
#pragma unroll
            for (int db = 0; db < NDB; ++db)
#pragma unroll
                for (int j = 0; j < 2; ++j) { const LAS unsigned char* vp = Vb + buf * VBUF + (32 * db + r32) * VS + (32 * kb + 16 * j + 4 * hi) * 2;
                    const s16x4 lo = *(const LAS s16x4*)vp, hh = *(const LAS s16x4*)(vp + 16);
                    vf[db][j] = (bf16x8){lo[0], lo[1], lo[2], lo[3], hh[0], hh[1], hh[2], hh[3]}; }
#pragma unroll
            for (int mp = 0; mp < NMAP; ++mp) {
                f32x16 s;
#pragma unroll
                for (int r = 0; r < 16; ++r) s[r] = 0.f;
#pragma unroll
                for (int c = 0; c < NC; ++c) { const bf16x8 kf = *(const LAS bf16x8*)(Kb + buf * KBUF + (32 * kb + r32) * KS + (mp * DKM + 16 * c + 8 * hi) * 2);
                    s = __builtin_amdgcn_mfma_f32_32x32x16_bf16(kf, qf[mp][c], s, 0, 0, 0); }
                if (diag) {
#pragma unroll
                    for (int r = 0; r < 16; ++r) if (crow(r, hi) > r32) s[r] = -INFINITY;
                }
                float mx = s[0];
#pragma unroll
                for (int r = 1; r < 16; ++r) mx = fmaxf(mx, s[r]);
                mx = fmaxf(mx, __shfl_xor(mx, 32));
                if (__any(mx > mrow[mp])) {
                    const float mnew = fmaxf(mrow[mp], mx), alpha = fast_exp2(mrow[mp] - mnew);
                    mrow[mp] = mnew; lrow[mp] *= alpha;
#pragma unroll
                    for (int db = 0; db < NDB; ++db)
#pragma unroll
                        for (int r = 0; r < 16; ++r) o[mp][db][r] *= alpha;
                }
                const float mcur = mrow[mp]; float ls = 0.f;
#pragma unroll
                for (int r = 0; r < 16; ++r) { s[r] = fast_exp2(s[r] - mcur); ls += s[r]; }
                lrow[mp] += ls;
                bf16x8 pa[2];
#pragma unroll
                for (int j = 0; j < 2; ++j) { u32x4 w; w.x = cvtpk(s[8 * j + 0], s[8 * j + 1]); w.y = cvtpk(s[8 * j + 2], s[8 * j + 3]); w.z = cvtpk(s[8 * j + 4], s[8 * j + 5]); w.w = cvtpk(s[8 * j + 6], s[8 * j + 7]); pa[j] = __builtin_bit_cast(bf16x8, w); }
#pragma unroll
                for (int db = 0; db < NDB; ++db)
#pragma unroll
                    for (int j = 0; j < 2; ++j) o[mp][db] = __builtin_amdgcn_mfma_f32_32x32x16_bf16(vf[db][j], pa[j], o[mp][db], 0, 0, 0);
            }
        }
        if (t + 1 < NT) ATT_LWRITE(buf ^ 1);
        __syncthreads();
    }
#undef ATT_GLOAD
#undef ATT_LWRITE
    float inv[NMAP];
#pragma unroll
    for (int mp = 0; mp < NMAP; ++mp) { const float lt = lrow[mp] + __shfl_xor(lrow[mp], 32); inv[mp] = 1.0f / lt; }
    bf16_t* orow = O + (size_t)(q0 + wid * 32 + r32) * ldo;
    if constexpr (NMAP == 1) {
#pragma unroll
        for (int db = 0; db < NDB; ++db)
#pragma unroll
            for (int g = 0; g < 4; ++g) { f32x4 v; for (int i = 0; i < 4; ++i) v[i] = o[0][db][4 * g + i] * inv[0]; store4bf(orow + 32 * db + 8 * g + 4 * hi, v); }
    } else {
        float ss = 0.f;
#pragma unroll
        for (int db = 0; db < NDB; ++db)
#pragma unroll
            for (int r = 0; r < 16; ++r) { const float v = o[0][db][r] * inv[0] - lam * (o[1][db][r] * inv[1]); o[0][db][r] = v; ss += v * v; }
        ss += __shfl_xor(ss, 32);
        const float rstd = __builtin_amdgcn_rsqf(ss * (1.0f / DV) + NORM_EPS) * outscale;
#pragma unroll
        for (int db = 0; db < NDB; ++db)
#pragma unroll
            for (int g = 0; g < 4; ++g) { const f32x4 gn = *(const f32x4*)(subln + 32 * db + 8 * g + 4 * hi); f32x4 v; for (int i = 0; i < 4; ++i) v[i] = o[0][db][4 * g + i] * rstd * gn[i]; store4bf(orow + 32 * db + 8 * g + 4 * hi, v); }
    }
}

template <int NMAP, int DKM, int DV, int W0, int W1>
__device__ __forceinline__ void attn_unit2(LAS unsigned char* lds, const bf16_t* __restrict__ Q, int ldq, const bf16_t* __restrict__ K0, int ldk0, const bf16_t* __restrict__ K1, int ldk1,
                                           const bf16_t* __restrict__ Vt, size_t ldv, int q0, int NT, bf16_t* O, int ldo, float lam, const float* subln, float outscale) {
    constexpr int DKT = NMAP * DKM, KS = DKT * 2 + 16, VS = 136, KBUF = 64 * KS, VBUF = DV * VS;
    constexpr int NC = DKM / 16, NDB = DV / 32;
    constexpr int K0C = W0 / 8, K0N = (64 * K0C) / 512, K1C = W1 / 8, VN = (DV * 8) / 512;
    static_assert(W0 + W1 == DKT && K0N >= 1 && VN >= 1, "attention staging geometry");
    int tid = threadIdx.x; asm volatile("" : "+v"(tid));
    const int lane = tid & 63, wid = __builtin_amdgcn_readfirstlane(tid >> 6), r32 = lane & 31, hi = lane >> 5;
    LAS unsigned char* Kb = lds; LAS unsigned char* Vb = lds + 2 * KBUF;
    bf16x8 qf[NMAP][NC];
    { const bf16_t* qrow = Q + (size_t)(q0 + wid * 32 + r32) * ldq;
#pragma unroll
      for (int mp = 0; mp < NMAP; ++mp)
#pragma unroll
          for (int c = 0; c < NC; ++c) qf[mp][c] = *(const bf16x8*)(qrow + mp * DKM + 16 * c + 8 * hi); }
    f32x16 o[NMAP][NDB], negm[NMAP]; float lrow[NMAP];
#pragma unroll
    for (int mp = 0; mp < NMAP; ++mp) { lrow[mp] = 0.f;
#pragma unroll
        for (int r = 0; r < 16; ++r) negm[mp][r] = 0.f;
#pragma unroll
        for (int db = 0; db < NDB; ++db)
#pragma unroll
            for (int r = 0; r < 16; ++r) o[mp][db][r] = 0.f; }
    u32x4 kreg[K0N], k1reg = {0u, 0u, 0u, 0u}, vreg[VN];
#define ATT_GLOAD(t) do { \
    _Pragma("unroll") for (int i = 0; i < K0N; ++i) { const int idx = tid + 512 * i, rr = idx / K0C, cc = idx % K0C; kreg[i] = *(const u32x4*)(K0 + (size_t)(64 * (t) + rr) * ldk0 + cc * 8); } \
    if (W1 > 0) { if (tid < 64 * K1C) { const int rr = tid / (K1C > 0 ? K1C : 1), cc = tid % (K1C > 0 ? K1C : 1); k1reg = *(const u32x4*)(K1 + (size_t)(64 * (t) + rr) * ldk1 + cc * 8); } } \
    _Pragma("unroll") for (int i = 0; i < VN; ++i) { const int idx = tid + 512 * i, dd = idx >> 3, cc = idx & 7; vreg[i] = *(const u32x4*)(Vt + (size_t)dd * ldv + 64 * (t) + cc * 8); } } while (0)
#define ATT_LWRITE(buf) do { \
    _Pragma("unroll") for (int i = 0; i < K0N; ++i) { const int idx = tid + 512 * i, rr = idx / K0C, cc = idx % K0C; *(LAS u32x4*)(Kb + (buf) * KBUF + rr * KS + cc * 16) = kreg[i]; } \
    if (W1 > 0) { if (tid < 64 * K1C) { const int rr = tid / (K1C > 0 ? K1C : 1), cc = tid % (K1C > 0 ? K1C : 1); *(LAS u32x4*)(Kb + (buf) * KBUF + rr * KS + W0 * 2 + cc * 16) = k1reg; } } \
    _Pragma("unroll") for (int i = 0; i < VN; ++i) { const int idx = tid + 512 * i, dd = idx >> 3, cc = idx & 7; LAS u32x2* vp = (LAS u32x2*)(Vb + (buf) * VBUF + dd * VS + cc * 16); \
        u32x2 lo_; lo_.x = vreg[i].x; lo_.y = vreg[i].y; u32x2 hi_; hi_.x = vreg[i].z; hi_.y = vreg[i].w; vp[0] = lo_; vp[1] = hi_; } } while (0)
    ATT_GLOAD(0);
    ATT_LWRITE(0);
    __syncthreads();
    const int qw0 = q0 + wid * 32;
    for (int t = 0; t < NT; ++t) {
        const int buf = t & 1;
        if (t + 1 < NT) ATT_GLOAD(t + 1);
        const int kvt = 64 * t;
        if (kvt <= qw0) {
            const bool band = (kvt + 63 > qw0);
#pragma unroll
            for (int mp = 0; mp < NMAP; ++mp) {
                f32x16 s0, s1;
#pragma unroll
                for (int c = 0; c < NC; ++c) {
                    const bf16x8 kf0 = *(const LAS bf16x8*)(Kb + buf * KBUF + r32 * KS + (mp * DKM + 16 * c + 8 * hi) * 2);
                    const bf16x8 kf1 = *(const LAS bf16x8*)(Kb + buf * KBUF + (32 + r32) * KS + (mp * DKM + 16 * c + 8 * hi) * 2);
                    if (c == 0) { s0 = __builtin_amdgcn_mfma_f32_32x32x16_bf16(kf0, qf[mp][0], negm[mp], 0, 0, 0); s1 = __builtin_amdgcn_mfma_f32_32x32x16_bf16(kf1, qf[mp][0], negm[mp], 0, 0, 0); }
                    else { s0 = __builtin_amdgcn_mfma_f32_32x32x16_bf16(kf0, qf[mp][c], s0, 0, 0, 0); s1 = __builtin_amdgcn_mfma_f32_32x32x16_bf16(kf1, qf[mp][c], s1, 0, 0, 0); }
                }
                if (band) {
                    const int qd = qw0 + r32 - kvt;
#pragma unroll
                    for (int r = 0; r < 16; ++r) { const int kv = crow(r, hi); if (kv > qd) s0[r] = -INFINITY; if (kv + 32 > qd) s1[r] = -INFINITY; }
                }
                float mx = fmaxf(s0[0], s1[0]);
#pragma unroll
                for (int r = 1; r < 16; ++r) mx = fmaxf(mx, fmaxf(s0[r], s1[r]));
                mx = fmaxf(mx, __shfl_xor(mx, 32));
                if (__any(t == 0 || mx > 8.0f)) {
                    const float dl = (t == 0) ? mx : fmaxf(mx, 0.f), alpha = fast_exp2(-dl);
                    lrow[mp] *= alpha;
#pragma unroll
                    for (int r = 0; r < 16; ++r) { s0[r] -= dl; s1[r] -= dl; negm[mp][r] -= dl; }
#pragma unroll
                    for (int db = 0; db < NDB; ++db)
#pragma unroll
                        for (int r = 0; r < 16; ++r) o[mp][db][r] *= alpha;
                }
                float ls = 0.f;
#pragma unroll
                for (int kb = 0; kb < 2; ++kb) {
                    f32x16& s = kb ? s1 : s0;
                    bf16x8 vf[NDB][2];
#pragma unroll
                    for (int db = 0; db < NDB; ++db)
#pragma unroll
                        for (int j = 0; j < 2; ++j) { const LAS unsigned char* vp = Vb + buf * VBUF + (32 * db + r32) * VS + (32 * kb + 16 * j + 4 * hi) * 2;
                            const s16x4 lo = *(const LAS s16x4*)vp, hh = *(const LAS s16x4*)(vp + 16);
                            vf[db][j] = (bf16x8){lo[0], lo[1], lo[2], lo[3], hh[0], hh[1], hh[2], hh[3]}; }
#pragma unroll
                    for (int r = 0; r < 16; ++r) { s[r] = fast_exp2(s[r]); ls += s[r]; }
                    bf16x8 pa[2];
#pragma unroll
                    for (int j = 0; j < 2; ++j) { u32x4 w; w.x = cvtpk(s[8 * j + 0], s[8 * j + 1]); w.y = cvtpk(s[8 * j + 2], s[8 * j + 3]); w.z = cvtpk(s[8 * j + 4], s[8 * j + 5]); w.w = cvtpk(s[8 * j + 6], s[8 * j + 7]); pa[j] = __builtin_bit_cast(bf16x8, w); }
#pragma unroll
                    for (int db = 0; db < NDB; ++db)
#pragma unroll
                        for (int j = 0; j < 2; ++j) o[mp][db] = __builtin_amdgcn_mfma_f32_32x32x16_bf16(vf[db][j], pa[j], o[mp][db], 0, 0, 0);
                }
                lrow[mp] += ls;
                if (NMAP > 1) __builtin_amdgcn_sched_barrier(0);
            }
        }
        if (t + 1 < NT) ATT_LWRITE(buf ^ 1);
        __syncthreads();
    }
#undef ATT_GLOAD
#undef ATT_LWRITE
    float inv[NMAP];
#pragma unroll
    for (int mp = 0; mp < NMAP; ++mp) { const float lt = lrow[mp] + __shfl_xor(lrow[mp], 32); inv[mp] = 1.0f / lt; }
    bf16_t* orow = O + (size_t)(q0 + wid * 32 + r32) * ldo;
    if constexpr (NMAP == 1) {
#pragma unroll
        for (int db = 0; db < NDB; ++db)
#pragma unroll
            for (int g = 0; g < 4; ++g) { f32x4 v; for (int i = 0; i < 4; ++i) v[i] = o[0][db][4 * g + i] * inv[0]; store4bf(orow + 32 * db + 8 * g + 4 * hi, v); }
    } else {
        float ss = 0.f;
#pragma unroll
        for (int db = 0; db < NDB; ++db)
#pragma unroll
            for (int r = 0; r < 16; ++r) { const float v = o[0][db][r] * inv[0] - lam * (o[1][db][r] * inv[1]); o[0][db][r] = v; ss += v * v; }
        ss += __shfl_xor(ss, 32);
        const float rstd = __builtin_amdgcn_rsqf(ss * (1.0f / DV) + NORM_EPS) * outscale;
#pragma unroll
        for (int db = 0; db < NDB; ++db)
#pragma unroll
            for (int g = 0; g < 4; ++g) { const f32x4 gn = *(const f32x4*)(subln + 32 * db + 8 * g + 4 * hi); f32x4 v; for (int i = 0; i < 4; ++i) v[i] = o[0][db][4 * g + i] * rstd * gn[i]; store4bf(orow + 32 * db + 8 * g + 4 * hi, v); }
    }
}

__device__ __forceinline__ float wave_sum(float v) {
#pragma unroll
    for (int o = 1; o < 64; o <<= 1) v += __shfl_xor(v, o);
    return v;
}
__device__ __forceinline__ void transpose_block(const float* __restrict__ W, int ldw, int src_col0, const float* __restrict__ gain, bf16_t* WT, int K, int dst_row0, int k0, LAS float* scr, int lane) {
#pragma unroll 8
    for (int i = 0; i < 32; ++i) { const int kk = 2 * i + (lane >> 5); float v = W[(size_t)(k0 + kk) * ldw + src_col0 + (lane & 31)]; if (gain) v *= gain[k0 + kk]; scr[kk * 33 + (lane & 31)] = v; }
    asm volatile("s_waitcnt lgkmcnt(0)" ::: "memory");
    const int c = lane & 7;
#pragma unroll
    for (int j = 0; j < 4; ++j) { const int n = (lane >> 3) + 8 * j; const LAS float* s = scr + (8 * c) * 33 + n;
        u32x4 ov; ov.x = cvtpk(s[0 * 33], s[1 * 33]); ov.y = cvtpk(s[2 * 33], s[3 * 33]); ov.z = cvtpk(s[4 * 33], s[5 * 33]); ov.w = cvtpk(s[6 * 33], s[7 * 33]);
        *(u32x4*)(WT + (size_t)(dst_row0 + n) * K + k0 + 8 * c) = ov; }
    asm volatile("s_waitcnt lgkmcnt(0)" ::: "memory");
}

#define XB_TMO      128
#define XB_XCNT(j)  (256  + 64 * (j))
#define XB_XSUB(j)  (1280 + 64 * (j))
#define XB_XGEN(j)  (2304 + 64 * (j))
#define XB_TOP      3328
#define XB_TOPGEN   3392
#define XCD_BAR_WORDS 3456
#define XB_SPIN_CAP (1u << 18)

__device__ __forceinline__ unsigned xb_ld(unsigned* p)              { return __hip_atomic_load(p, __ATOMIC_RELAXED, __HIP_MEMORY_SCOPE_AGENT); }
__device__ __forceinline__ unsigned xb_add(unsigned* p, unsigned v) { return __hip_atomic_fetch_add(p, v, __ATOMIC_RELAXED, __HIP_MEMORY_SCOPE_AGENT); }
__device__ __forceinline__ unsigned xb_xcc_id() { return (unsigned)__builtin_amdgcn_s_getreg((3 << 11) | 20) & 0xFu; }
#define XB_SPIN(cond, bar) do { unsigned _sp = 0; while (cond) { __builtin_amdgcn_s_sleep(1); \
    if ((++_sp & 255u) == 0u) { if (xb_ld(&(bar)[XB_TMO])) break; if (_sp > XB_SPIN_CAP) { atomicAdd(&(bar)[XB_TMO], 1u); break; } } } } while (0)

struct XcdBarrier {
    unsigned* bar; unsigned x;
    volatile LAS unsigned* st;
};

__device__ __forceinline__ XcdBarrier xcd_barrier_post(unsigned* bar, volatile LAS unsigned* st) {
    XcdBarrier b; b.bar = bar; b.x = xb_xcc_id(); b.st = st;
    if (threadIdx.x == 0) (void)xb_add(&bar[XB_XCNT(b.x)], 1u);
    return b;
}
__device__ __forceinline__ void xcd_barrier_complete(unsigned* bar, unsigned x, unsigned& nloc, unsigned& nx) {
    const unsigned G = gridDim.x * gridDim.y * gridDim.z;
    unsigned sum, cnt, mine, sp = 0u;
    for (;;) {
        sum = 0u; cnt = 0u; mine = 0u;
#pragma unroll
        for (unsigned j = 0; j < 16; ++j) { const unsigned c = xb_ld(&bar[XB_XCNT(j)]); sum += c; cnt += (c > 0u) ? 1u : 0u; mine = (j == x) ? c : mine; }
        if (sum == G) break;
        __builtin_amdgcn_s_sleep(1);
        if ((++sp & 255u) == 0u) { if (xb_ld(&bar[XB_TMO])) break; if (sp > XB_SPIN_CAP) { atomicAdd(&bar[XB_TMO], 1u); break; } }
    }
    nloc = mine > 0u ? mine : 1u; nx = cnt > 0u ? cnt : 1u;
}

__device__ __forceinline__ void xcd_barrier(const XcdBarrier& b) {
    asm volatile("s_waitcnt vmcnt(0)" ::: "memory");
    __syncthreads();
    if (threadIdx.x == 0) {
        unsigned* bar = b.bar;
        __builtin_amdgcn_s_waitcnt(0);
        unsigned nloc = b.st[0], nx = b.st[1];
        if (nloc == 0u) { xcd_barrier_complete(bar, b.x, nloc, nx); b.st[0] = nloc; b.st[1] = nx; }
        const unsigned old = xb_add(&bar[XB_XSUB(b.x)], 1u);
        const unsigned gen = old / nloc;
        if (old + 1u == (gen + 1u) * nloc) {
            __builtin_amdgcn_fence(__ATOMIC_RELEASE, "agent");
            asm volatile("s_waitcnt vmcnt(0)" ::: "memory");
            const unsigned og = xb_add(&bar[XB_TOP], 1u);
            const unsigned tg = og / nx;
            if (og + 1u == (tg + 1u) * nx) xb_add(&bar[XB_TOPGEN], 1u);
            else XB_SPIN(xb_ld(&bar[XB_TOPGEN]) == tg, bar);
            __builtin_amdgcn_fence(__ATOMIC_ACQUIRE, "agent");
            xb_add(&bar[XB_XGEN(b.x)], 1u);
            asm volatile("s_waitcnt vmcnt(0)" ::: "memory");
        } else {
            XB_SPIN(xb_ld(&bar[XB_XGEN(b.x)]) == gen, bar);
            __builtin_amdgcn_fence(__ATOMIC_ACQUIRE, "agent");
            asm volatile("s_waitcnt vmcnt(0)" ::: "memory");
        }
    }
    __syncthreads();
}


struct Args { const float* in[20]; float* out; unsigned char* ws; int ph_lo, ph_hi, coop, pad; float lam_init[4]; };

__global__ void __launch_bounds__(512, 2) hybrid_fwd(Args a) {
    extern __shared__ __attribute__((aligned(16))) unsigned char lds_raw[];
    LAS unsigned char* lds = (LAS unsigned char*)lds_raw;
    const float* x_in = a.in[0]; const float* mem = a.in[1]; const int* positions = (const int*)a.in[2];
    const float* norm_pre = a.in[3]; const float* norm_post = a.in[4]; const float* w_in = a.in[5]; const float* q_norm = a.in[6]; const float* w_uq = a.in[7];
    const float* kv_norm = a.in[8]; const float* w_ukv = a.in[9]; const float* lq1 = a.in[10]; const float* lk1 = a.in[11]; const float* lq2 = a.in[12]; const float* lk2 = a.in[13];
    const float* diff_subln = a.in[14]; const float* mem_norm = a.in[15]; const float* w_mem_kv = a.in[16]; const float* b_gate = a.in[17]; const float* w_branch = a.in[18]; const float* w_out = a.in[19];
#define P_WT ((bf16_t*)(ws + OFF_W))
#define P_COS ((float*)(ws + OFF_COS))
#define P_SIN ((float*)(ws + OFF_SIN))
#define P_SSQq ((float*)(ws + OFF_SSQQ))
#define P_SSQkv ((float*)(ws + OFF_SSQKV))
#define P_MN ((bf16_t*)(ws + OFF_MN))
#define P_KM ((bf16_t*)(ws + OFF_KM))
#define P_VMT ((bf16_t*)(ws + OFF_VMT))
#define P_XN ((bf16_t*)(ws + OFF_XN))
#define P_OB ((bf16_t*)(ws + OFF_O))
#define P_CQ ((bf16_t*)(ws + OFF_CQ))
#define P_CKV ((bf16_t*)(ws + OFF_CKV))
#define P_KPE ((bf16_t*)(ws + OFF_KPE))
#define P_QD ((bf16_t*)(ws + OFF_QD))
#define P_KD ((bf16_t*)(ws + OFF_KD))
#define P_VDT ((bf16_t*)(ws + OFF_VDT))
#define P_QX ((bf16_t*)(ws + OFF_QX))
#define P_QA ((bf16_t*)(ws + OFF_QA))
#define P_KN ((bf16_t*)(ws + OFF_KN))
#define P_VAT ((bf16_t*)(ws + OFF_VAT))
#define P_SB ((bf16_t*)(ws + OFF_S))
#define P_MG ((bf16_t*)(ws + OFF_MERGED))
#define P_OUTB ((float*)(ws + OFF_OUT))

    volatile LAS unsigned* bst = (volatile LAS unsigned*)(lds + LDS_BYTES - 16);
    if (threadIdx.x < 4) bst[threadIdx.x] = 0u;
    __syncthreads();
    XcdBarrier xbar; xbar.bar = (unsigned*)(a.ws + OFF_BAR); xbar.x = 0; xbar.st = bst;
    if (a.coop) xbar = xcd_barrier_post((unsigned*)(a.ws + OFF_BAR), bst);
    for (int ph = a.ph_lo; ph < a.ph_hi; ++ph) {
        __attribute__((address_space(1))) unsigned char* ws = (__attribute__((address_space(1))) unsigned char*)a.ws; asm volatile("" : "+s"(ws));
        int tid = threadIdx.x; asm volatile("" : "+v"(tid)); const int lane = tid & 63, wave = __builtin_amdgcn_readfirstlane(tid >> 6);
        int G = gridDim.x, bx = blockIdx.x; asm volatile("" : "+s"(G), "+s"(bx));
        const int vcu = (G % 8 == 0) ? (bx % 8) * (G / 8) + bx / 8 : bx;
        const int gw = vcu * 8 + wave, NGW = G * 8;
        if (ph == 0) {
#if PHSEL & 1
            LAS float* scr = (LAS float*)(lds + wave * 16384);
            constexpr int I_IN = 16 * 221, I_UQ = 4 * 24, I_UKV = 2 * 32, I_MEM = 16 * 32, I_BR = 3 * 256, I_OUT = 16 * 32;
            constexpr int I_L = I_IN + I_UQ + I_UKV + I_MEM + I_BR + I_OUT;
            for (int it = gw; it < DEPTH * I_L; it += NGW) {
                const int l = it / I_L; int r = it - l * I_L; bf16_t* wl = P_WT + (size_t)l * WL_TOTAL;
                if (r < I_IN) { const int kb = r / 221, nb = r - kb * 221, n = nb * 32; int dr;
                    if (n < 416) dr = n; else if (n < 1440) dr = n + 96; else if (n < 1952) dr = n - 1440 + 2048; else if (n < 2464) dr = n - 1952 + 1536; else dr = n + 96;
                    transpose_block(w_in + (size_t)l * 1024 * IN_WIDTH, IN_WIDTH, n, norm_pre + l * 1024, wl + WL_IN, 1024, dr, kb * 64, scr, lane); continue; }
                r -= I_IN;
                if (r < I_UQ) { const int kb = r / 24, nb = r - kb * 24, n = nb * 32, h = n / 96, w = n - h * 96; const int dr = (w < 64) ? h * 64 + w : 512 + h * 32 + (w - 64);
                    transpose_block(w_uq + (size_t)l * 256 * 768, 768, n, q_norm + l * 256, wl + WL_UQ, 256, dr, kb * 64, scr, lane); continue; }
                r -= I_UQ;
                if (r < I_UKV) { const int kb = r / 32, nb = r - kb * 32, n = nb * 32, h = n / 128, w = n - h * 128; const int dr = (w < 64) ? h * 64 + w : 512 + h * 64 + (w - 64);
                    transpose_block(w_ukv + (size_t)l * 128 * 1024, 1024, n, kv_norm + l * 128, wl + WL_UKV, 128, dr, kb * 64, scr, lane); continue; }
                r -= I_UKV;
                if (r < I_MEM) { const int kb = r / 32, nb = r - kb * 32;
                    transpose_block(w_mem_kv + (size_t)l * 1024 * 1024, 1024, nb * 32, mem_norm + l * 1024, wl + WL_MEM, 1024, nb * 32, kb * 64, scr, lane); continue; }
                r -= I_MEM;
                if (r < I_BR) { const int i = r / 256, rr = r - i * 256, kb = rr / 32, nb = rr - kb * 32;
                    transpose_block(w_branch + (size_t)(l * 3 + i) * 512 * 1024, 1024, nb * 32, nullptr, wl + WL_BR + (size_t)i * 1024 * 512, 512, nb * 32, kb * 64, scr, lane); continue; }
                r -= I_BR;
                { const int kb = r / 32, nb = r - kb * 32;
                    transpose_block(w_out + (size_t)l * 1024 * 1024, 1024, nb * 32, nullptr, wl + WL_OUT, 1024, nb * 32, kb * 64, scr, lane); }
            }
            for (int i = bx * 512 + tid; i < DEPTH * 96 * 1024 / 8; i += G * 512) { const int l = i / (96 * 1024 / 8), rr = i - l * (96 * 1024 / 8);
                *(u32x4*)(P_WT + (size_t)l * WL_TOTAL + WL_IN + (size_t)416 * 1024 + (size_t)rr * 8) = (u32x4){0u, 0u, 0u, 0u}; }
            for (int i = bx * 512 + tid; i < SEQ * 16; i += G * 512) { const int s = i >> 4, j = i & 15;
                const float invf = powf(10000.0f, -(float)j / 16.0f); const float ang = (float)positions[s] * invf;
                double rv = (double)ang * 0.15915494309189535; rv -= floor(rv); const float f = (float)rv;
                P_COS[i] = __builtin_amdgcn_cosf(f); P_SIN[i] = __builtin_amdgcn_sinf(f); }
            for (int m = gw; m < MMEM + MTOK; m += NGW) {
                const float* src = (m < MMEM) ? mem + (size_t)m * 1024 : x_in + (size_t)(m - MMEM) * 1024; bf16_t* dst = (m < MMEM) ? P_MN + (size_t)m * 1024 : P_XN + (size_t)(m - MMEM) * 1024;
                f32x4 v[4]; float s = 0.f;
#pragma unroll
                for (int j = 0; j < 4; ++j) { v[j] = ((const f32x4*)src)[64 * j + lane]; s += (v[j][0] * v[j][0] + v[j][1] * v[j][1]) + (v[j][2] * v[j][2] + v[j][3] * v[j][3]); }
                const float rstd = __builtin_amdgcn_rsqf(wave_sum(s) * (1.0f / 1024.0f) + NORM_EPS);
#pragma unroll
                for (int j = 0; j < 4; ++j) store4bf(dst + 4 * (64 * j + lane), v[j] * rstd);
            }
#endif
        } else {
            const int l = (ph - 1) / 7, sub = (ph - 1) % 7;
            const bf16_t* wl = P_WT + (size_t)l * WL_TOTAL;
            if (sub == 0) {
#if PHSEL & 2
#if GSEL & 1
                { pg8::Gemm g{P_XN, wl + WL_IN, MTOK, 2048, 1024, 1024, 1024, 0, 0}; pg8::StaticOrder S; S.init(MTOK, 2048, G, bx);
                  pg8::Epi1 E{P_CQ, P_CKV, P_KPE, P_QD, P_KD, P_QX, P_SSQq, P_SSQkv, P_COS, P_SIN, 0.17677669529663687f * LOG2E, 0.08838834764831845f * LOG2E};
                  pg8::gemm_phase(lds, g, S, E); }
#endif
#if GSEL & 2
                { pg8::Gemm g{wl + WL_IN + (size_t)2048 * 1024, P_XN, 512, MTOK, 1024, 1024, 1024, 0, 0}; pg8::StaticOrder S; S.init(512, MTOK, G, bx);
                  pg8::EpiT E{P_VDT, (size_t)MTOK, 0, nullptr, 0.f, nullptr};
                  pg8::gemm_phase(lds, g, S, E); }
#endif
                if (l == 0) {
#if GSEL & 4
                    { pg8::Gemm g{P_MN, P_WT + WL_MEM, MMEM, 512, 1024, 1024, 1024, 0, WL_TOTAL}; pg8::StaticOrder S; S.init(MMEM, 512, G, bx, DEPTH);
                      pg8::EpiRow E{P_KM, 512, (size_t)MMEM * 512, nullptr, 0.f};
                      pg8::gemm_phase(lds, g, S, E); }
#endif
#if GSEL & 8
                    { pg8::Gemm g{P_WT + WL_MEM + (size_t)512 * 1024, P_MN, 512, MMEM, 1024, 1024, 1024, WL_TOTAL, 0}; pg8::StaticOrder S; S.init(512, MMEM, G, bx, DEPTH);
                      pg8::EpiT E{P_VMT, (size_t)MMEM, (size_t)512 * MMEM, nullptr, 0.f, nullptr};
                      pg8::gemm_phase(lds, g, S, E); }
#endif
                }
#endif
            } else if (sub == 1) {
#if PHSEL & 4
#if GSEL & 16
                { pg8::Gemm g{P_CQ, wl + WL_UQ, MTOK, 768, 256, 256, 256, 0, 0}; pg8::StaticOrder S; S.init(MTOK, 768, G, bx);
                  pg8::Epi2 E{P_QA, P_SSQq, P_COS, P_SIN, 0.10206207261596575f * LOG2E};
                  pg8::gemm_phase(lds, g, S, E); }
#endif
#if GSEL & 32
                { pg8::Gemm g{P_CKV, wl + WL_UKV, MTOK, 512, 128, 128, 128, 0, 0}; pg8::StaticOrder S; S.init(MTOK, 512, G, bx);
                  pg8::EpiRow E{P_KN, 512, 0, P_SSQkv, 1.0f / 128.0f};
                  pg8::gemm_phase(lds, g, S, E); }
#endif
#if GSEL & 64
                { pg8::Gemm g{wl + WL_UKV + (size_t)512 * 128, P_CKV, 512, MTOK, 128, 128, 128, 0, 0}; pg8::StaticOrder S; S.init(512, MTOK, G, bx);
                  pg8::EpiT E{P_VAT, (size_t)MTOK, 0, P_SSQkv, 1.0f / 128.0f, nullptr};
                  pg8::gemm_phase(lds, g, S, E); }
#endif
#endif
            } else if (sub == 2) {
#if PHSEL & 8
                const float d1 = wave_sum(lane < 32 ? lq1[l * 32 + lane] * lk1[l * 32 + lane] : 0.f), d2 = wave_sum(lane < 32 ? lq2[l * 32 + lane] * lk2[l * 32 + lane] : 0.f);
                const float lam_init = a.lam_init[l]; const float lam = expf(d1) - expf(d2) + lam_init;
#if ATTSEL & 1
                for (int P = vcu; P < 1024; P += G) { const int bh = P >> 3, s = P & 7, b = bh >> 3, h = bh & 7; const size_t rb = (size_t)b * SEQ;
                    for (int k = 0; k < 2; ++k) { const int qb = k ? s : 15 - s;
                        attn_unit2<1, 96, 64, 64, 32>(lds, P_QA + rb * 768 + h * 96, 768, P_KN + rb * 512 + h * 64, 512, P_KPE + rb * 32, 32, P_VAT + (size_t)(h * 64) * MTOK + rb, (size_t)MTOK,
                                                            qb * 256, 4 * (qb + 1), P_OB + rb * 1536 + h * 64, 1536, 0.f, nullptr, 1.f); } }
#endif
                asm volatile("" ::: "memory"); __builtin_amdgcn_sched_barrier(0);
#if ATTSEL & 2
                for (int P = vcu; P < 1024; P += G) { const int bh = P >> 3, s = P & 7, b = bh >> 3, h = bh & 7; const size_t rb = (size_t)b * SEQ;
                    for (int k = 0; k < 2; ++k) { const int qb = k ? s : 15 - s;
                        attn_unit2<2, 32, 64, 64, 0>(lds, P_QD + rb * 512 + h * 64, 512, P_KD + rb * 512 + h * 64, 512, nullptr, 0, P_VDT + (size_t)(h * 64) * MTOK + rb, (size_t)MTOK,
                                                           qb * 256, 4 * (qb + 1), P_OB + rb * 1536 + 512 + h * 64, 1536, lam, diff_subln + l * 64, 1.0f - lam_init); } }
#endif
                asm volatile("" ::: "memory"); __builtin_amdgcn_sched_barrier(0);
#if ATTSEL & 4
                for (int X = vcu; X < 1024; X += G) { const int bh = X >> 4, qb = X & 15, b = bh >> 2, h = bh & 3; const size_t rb = (size_t)b * SEQ;
                    attn_unit<1, 128, 128, false, 128, 0>(lds, P_QX + rb * 512 + h * 128, 512, P_KM + (size_t)l * MMEM * 512 + (size_t)b * MEMT * 512 + h * 128, 512, nullptr, 0,
                                                           P_VMT + (size_t)l * 512 * MMEM + (size_t)(h * 128) * MMEM + (size_t)b * MEMT, (size_t)MMEM,
                                                           qb * 256, 4, P_OB + rb * 1536 + 1024 + h * 128, 1536, 0.f, nullptr, 1.f); }
#endif
#endif
            } else if (sub == 3) {
#if PHSEL & 16
                { pg8::Gemm g{P_XN, wl + WL_IN + (size_t)2560 * 1024, MTOK, 1536, 1024, 1024, 1024, 0, 0}; pg8::StaticOrder S; S.init(MTOK, 1536, G, bx);
                  pg8::EpiSG E{P_OB};
                  pg8::gemm_phase(lds, g, S, E); }
                { pg8::Gemm g{P_XN, wl + WL_IN + (size_t)4096 * 1024, MTOK, 3072, 1024, 1024, 1024, 0, 0}; pg8::StaticOrder S; S.init(MTOK, 3072, G, bx);
                  pg8::EpiGL E{P_SB, b_gate + l * 3072};
                  pg8::gemm_phase(lds, g, S, E); }
#endif
            } else if (sub == 4) {
#if PHSEL & 32
                pg8::Gemm g{P_OB, wl + WL_BR, MTOK, 1024, 512, 1536, 512, 512, (size_t)1024 * 512}; pg8::StaticOrder S; S.init(MTOK, 1024, G, bx, 3);
                pg8::EpiBR E{P_SB, P_MG};
                pg8::gemm_phase(lds, g, S, E);
#endif
            } else if (sub == 5) {
#if PHSEL & 64
                pg8::Gemm g{P_MG, wl + WL_OUT, MTOK, 1024, 1024, 1024, 1024, 0, 0}; pg8::StaticOrder S; S.init(MTOK, 1024, G, bx);
                pg8::EpiRow E{(bf16_t*)P_OUTB, 1024, 0, nullptr, 0.f};
                pg8::gemm_phase(lds, g, S, E);
#endif
            } else {
#if PHSEL & 128
                const float* xo = (l == 0) ? x_in : a.out; const float* gp = norm_post + l * 1024;
                for (int m = gw; m < MTOK; m += NGW) {
                    f32x4 v[4]; float s = 0.f;
#pragma unroll
                    for (int j = 0; j < 4; ++j) { v[j] = unpack4bf(((const u32x2*)((const bf16_t*)P_OUTB + (size_t)m * 1024))[64 * j + lane]); s += (v[j][0] * v[j][0] + v[j][1] * v[j][1]) + (v[j][2] * v[j][2] + v[j][3] * v[j][3]); }
                    const float rstd = __builtin_amdgcn_rsqf(wave_sum(s) * (1.0f / 1024.0f) + NORM_EPS); float s2 = 0.f;
#pragma unroll
                    for (int j = 0; j < 4; ++j) { const f32x4 xv = ((const f32x4*)(xo + (size_t)m * 1024))[64 * j + lane]; const f32x4 gv = ((const f32x4*)gp)[64 * j + lane];
                        v[j] = xv + v[j] * rstd * gv; ((f32x4*)(a.out + (size_t)m * 1024))[64 * j + lane] = v[j];
                        s2 += (v[j][0] * v[j][0] + v[j][1] * v[j][1]) + (v[j][2] * v[j][2] + v[j][3] * v[j][3]); }
                    if (l + 1 < DEPTH) { const float rstd2 = __builtin_amdgcn_rsqf(wave_sum(s2) * (1.0f / 1024.0f) + NORM_EPS);
#pragma unroll
                        for (int j = 0; j < 4; ++j) store4bf(P_XN + (size_t)m * 1024 + 4 * (64 * j + lane), v[j] * rstd2); }
                }
#endif
            }
        }
        if (ph + 1 < a.ph_hi) { if (a.coop) { if (ph == 0) cg::this_grid().sync(); else xcd_barrier(xbar); } }
    }
#ifdef DBG_NPH
    if (a.pad) {
        if (a.coop) cg::this_grid().sync();
        const unsigned short* w16 = (const unsigned short*)(a.ws + OFF_MN);
        const size_t n16 = (WS_END - OFF_MN) / 2, nout = (size_t)MTOK * 1024;
        for (size_t i = (size_t)blockIdx.x * 512 + threadIdx.x; i < nout; i += (size_t)gridDim.x * 512) {
            unsigned x = 0; for (size_t k = i; k < n16; k += nout) x ^= w16[k];
            const unsigned short* w2 = (const unsigned short*)(a.ws + OFF_COS); if (i < (size_t)(4 * MiB) / 2) x ^= w2[i];
            a.out[i] = (float)x;
        }
    }
#endif
}

extern "C" void kernel_launch(void* const* d_in, const int* in_sizes, int n_in, void* d_out, int out_size, void* d_ws, size_t ws_size, hipStream_t stream) {
    static int grid = 0;
    if (grid == 0) {
        if (n_in != 20 || ws_size < WS_END) { fprintf(stderr, "kernel_launch: need 20 inputs and >= %zu bytes of workspace (got %d, %zu)\n", (size_t)WS_END, n_in, ws_size); grid = -1; return; }
        int dev = 0, cus = 0, per_cu = 0;
        hipGetDevice(&dev); hipDeviceGetAttribute(&cus, hipDeviceAttributeMultiprocessorCount, dev);
        if (hipFuncSetAttribute((const void*)hybrid_fwd, hipFuncAttributeMaxDynamicSharedMemorySize, LDS_BYTES) != hipSuccess) { fprintf(stderr, "kernel_launch: hipFuncSetAttribute failed\n"); grid = -1; return; }
        if (hipOccupancyMaxActiveBlocksPerMultiprocessor(&per_cu, (const void*)hybrid_fwd, 512, LDS_BYTES) != hipSuccess || per_cu < 1) per_cu = 1;
        (void)hipGetLastError();
        grid = cus * 1;
    }
    if (grid < 0) return;
    if (hipMemsetAsync((char*)d_ws + OFF_BAR, 0, 16384, stream) != hipSuccess) { fprintf(stderr, "kernel_launch: hipMemsetAsync failed\n"); return; }
    Args a{};
    for (int i = 0; i < 20; ++i) a.in[i] = (const float*)d_in[i];
    a.out = (float*)d_out; a.ws = (unsigned char*)d_ws; a.pad = 0;
    a.lam_init[0] = 0.2f; a.lam_init[1] = 0.35550906759096926f; a.lam_init[2] = 0.47071301834358424f; a.lam_init[3] = 0.55605820415654f;
#if MK_ONE_LAUNCH
#ifdef DBG_NPH
    a.ph_lo = 0; a.ph_hi = DBG_NPH; a.coop = 1; a.pad = 1;
#else
    a.ph_lo = 0; a.ph_hi = NPHASE; a.coop = 1;
#endif
    void* args[] = {&a};
    hipError_t e = hipLaunchCooperativeKernel((const void*)hybrid_fwd, dim3(grid), dim3(512), args, LDS_BYTES, stream);
    if (e != hipSuccess) fprintf(stderr, "cooperative launch failed: %s (grid %d)\n", hipGetErrorString(e), grid);
#else
    for (int ph = 0; ph < NPHASE; ++ph) { a.ph_lo = ph; a.ph_hi = ph + 1; a.coop = 0;
        hipLaunchKernelGGL(hybrid_fwd, dim3(grid), dim3(512), LDS_BYTES, stream, a); }
#endif
}
```

```cpp
#include <hip/hip_runtime.h>
#include <hip/hip_cooperative_groups.h>
#include <cstdio>
#include <cstdint>
namespace cg = cooperative_groups;

#ifndef ATTSEL
#define ATTSEL 7
#endif
#ifndef GSEL
#define GSEL 0xFFFF
#endif
#ifndef PHSEL
#define PHSEL 0xFFFF
#endif
#ifndef MK_ONE_LAUNCH
#define MK_ONE_LAUNCH 1
#endif

#define LAS __attribute__((address_space(3)))
typedef unsigned short bf16_t;
typedef short bf16x8 __attribute__((ext_vector_type(8)));
typedef short s16x4 __attribute__((ext_vector_type(4)));
typedef float f32x4 __attribute__((ext_vector_type(4)));
typedef float f32x16 __attribute__((ext_vector_type(16)));
typedef unsigned u32x4 __attribute__((ext_vector_type(4)));
typedef unsigned u32x2 __attribute__((ext_vector_type(2)));
typedef float f32x2_t __attribute__((ext_vector_type(2)));
typedef __bf16 bf16x2_t __attribute__((ext_vector_type(2)));

constexpr int D_MODEL = 1024, BATCH = 16, SEQ = 4096, DEPTH = 4, MEMT = 256;
constexpr int MTOK = BATCH * SEQ;
constexpr int MMEM = BATCH * MEMT;
constexpr int IN_WIDTH = 7072;
constexpr float NORM_EPS = 1e-6f;
constexpr float LOG2E = 1.4426950408889634f;

constexpr size_t WL_IN = 0;
constexpr size_t WL_UQ = WL_IN + (size_t)7168 * 1024;
constexpr size_t WL_UKV = WL_UQ + (size_t)768 * 256;
constexpr size_t WL_MEM = WL_UKV + (size_t)1024 * 128;
constexpr size_t WL_BR = WL_MEM + (size_t)1024 * 1024;
constexpr size_t WL_OUT = WL_BR + (size_t)3 * 1024 * 512;
constexpr size_t WL_TOTAL = WL_OUT + (size_t)1024 * 3072;

constexpr size_t MiB = 1u << 20;
constexpr size_t OFF_W = 0;
constexpr size_t OFF_COS = 104 * MiB, OFF_SIN = OFF_COS + 256 * 1024;
constexpr size_t OFF_SSQQ = 105 * MiB, OFF_SSQKV = 106 * MiB;
constexpr size_t OFF_BAR = 107 * MiB;
constexpr size_t OFF_MN = 108 * MiB;
constexpr size_t OFF_KM = 116 * MiB;
constexpr size_t OFF_VMT = 132 * MiB;
constexpr size_t OFF_XN = 148 * MiB;
constexpr size_t OFF_O = 276 * MiB;
constexpr size_t OFF_R = 468 * MiB;
constexpr size_t OFF_CQ = OFF_R;
constexpr size_t OFF_CKV = OFF_CQ + 32 * MiB;
constexpr size_t OFF_KPE = OFF_CKV + 16 * MiB;
constexpr size_t OFF_QD = OFF_KPE + 4 * MiB;
constexpr size_t OFF_KD = OFF_QD + 64 * MiB;
constexpr size_t OFF_VDT = OFF_KD + 64 * MiB;
constexpr size_t OFF_QX = OFF_VDT + 64 * MiB;
constexpr size_t OFF_QA = OFF_QX + 64 * MiB;
constexpr size_t OFF_KN = OFF_QA + 96 * MiB;
constexpr size_t OFF_VAT = OFF_KN + 64 * MiB;
constexpr size_t WS_END = OFF_VAT + 64 * MiB;
constexpr size_t OFF_S = OFF_R;
constexpr size_t OFF_MERGED = OFF_R + 384 * MiB;
constexpr size_t OFF_OUT = OFF_R;
static_assert(4 * WL_TOTAL * 2 <= OFF_COS && OFF_MERGED + 128 * MiB <= WS_END, "ws map");

constexpr int LDS_BYTES = 147456;
constexpr int NPHASE = 1 + 7 * DEPTH;

__device__ __forceinline__ unsigned cvtpk(float lo, float hi) { f32x2_t v = {lo, hi}; bf16x2_t b = __builtin_convertvector(v, bf16x2_t); return __builtin_bit_cast(unsigned, b); }
__device__ __forceinline__ void store4bf(bf16_t* p, f32x4 v) { u32x2 w; w.x = cvtpk(v[0], v[1]); w.y = cvtpk(v[2], v[3]); *(u32x2*)p = w; }
__device__ __forceinline__ f32x4 unpack4bf(u32x2 w) { f32x4 r; r[0] = __uint_as_float(w.x << 16); r[1] = __uint_as_float(w.x & 0xffff0000u); r[2] = __uint_as_float(w.y << 16); r[3] = __uint_as_float(w.y & 0xffff0000u); return r; }
__device__ __forceinline__ void store8bf(bf16_t* p, f32x4 a, f32x4 b) { u32x4 w; w.x = cvtpk(a[0], a[1]); w.y = cvtpk(a[2], a[3]); w.z = cvtpk(b[0], b[1]); w.w = cvtpk(b[2], b[3]); *(u32x4*)p = w; }
__device__ __forceinline__ float fast_rcp(float x) { return __builtin_amdgcn_rcpf(x); }
__device__ __forceinline__ float fast_exp2(float x) { return __builtin_amdgcn_exp2f(x); }
__device__ __forceinline__ float sigmoidf_(float v) { return fast_rcp(1.0f + fast_exp2(-v * LOG2E)); }

namespace pg8 {
constexpr int BM = 256, BK = 64, HALF = 128, HTB = HALF * BK * 2, STAGE_BYTES = 8 * HTB, NXCD = 8, WGM = 8;
__host__ __device__ __forceinline__ int lds_byte(int r, int c) { const int st = (r >> 4) * 2 + (c >> 5), rr = r & 15, cc = c & 31, ob = rr * 64 + cc * 2; return st * 1024 + (ob ^ (((ob >> 9) & 1) << 5)); }
__host__ __device__ __forceinline__ void stage_rc(int b, int& R, int& C) { const int st = b / 1024, sb = b % 1024, swz = sb ^ (((sb >> 9) & 1) << 5); R = (st >> 1) * 16 + swz / 64; C = (st & 1) * 32 + (swz % 64) / 2; }

__host__ __device__ __forceinline__ int perm32(int rho) { const int n = rho >> 4, i = rho & 15; return 8 * (i >> 2) + 4 * n + (i & 3); }
struct Unit { int pm, pn, z; };
struct Gemm { const bf16_t* A; const bf16_t* Bt; int M, N, K, lda, ldb; size_t zA, zB; };

struct StaticOrder {
    int nM, nN, nwg, G, c, nz;
    __device__ void init(int M, int N, int G_, int c_, int nz_ = 1) { nM = M / BM; nN = N / BM; nwg = nM * nN; G = G_; c = c_; nz = nz_; }
    __device__ bool next(int i, Unit& u) const {
        const int ib = i / nz; u.z = i - ib * nz;
        const long L = (long)ib * G + c; if (L >= nwg) return false;
        int wgid = (int)L; { const int q = nwg / NXCD, r = nwg % NXCD, xcd = wgid % NXCD, off = wgid / NXCD; wgid = (xcd < r ? xcd * (q + 1) : r * (q + 1) + (xcd - r) * q) + off; }
        const int nig = WGM * nN, gid = wgid / nig, fm = gid * WGM, gsz = (nM - fm) < WGM ? (nM - fm) : WGM;
        u.pm = fm + ((wgid % nig) % gsz); u.pn = (wgid % nig) / gsz; return true;
    }
};

template <class Epi>
__device__ __forceinline__ void gemm_phase(LAS unsigned char* lds, const Gemm g, const StaticOrder& S, const Epi& E) {
    int tid = threadIdx.x; asm volatile("" : "+v"(tid));
    const int wid = __builtin_amdgcn_readfirstlane(tid >> 6), lane = tid & 63, wr = wid >> 2, wc = wid & 3, fr = lane & 15, fq = lane >> 4;
    int K = g.K; asm volatile("" : "+s"(K)); const int nt = K / BK;
    unsigned voffA[2], voffB[2];
#pragma unroll
    for (int i = 0; i < 2; ++i) { int R, C; stage_rc(tid * 16 + i * 8192, R, C);
        const int Rb = Epi::PERM ? ((R & ~31) + perm32(R & 31)) : R;
        voffA[i] = (unsigned)(R * g.lda + C) * 2u; voffB[i] = (unsigned)(Rb * g.ldb + C) * 2u; }
    const size_t kstep = (size_t)(BK * 2);
    const size_t hstepA = (size_t)HALF * g.lda * 2, hstepB = (size_t)HALF * g.ldb * 2;
    const size_t tstepA = 2 * hstepA, tstepB = 2 * hstepB;
    const unsigned ldsw = (unsigned)wid * 1024u;
    const int aoff = lds_byte(wr * 64 + fr, fq * 8), boff = lds_byte(wc * 32 + fr, fq * 8);
#define PG8_SA(b, h) (((b) * 2 + (h)) * HTB)
#define PG8_SB(b, h) ((4 + (b) * 2 + (h)) * HTB)
#define PG8_STAGE(bufoff, gbase, voff) do { _Pragma("unroll") for (int _i = 0; _i < 2; ++_i) \
        __builtin_amdgcn_global_load_lds((const unsigned*)((const char*)(gbase) + (voff)[_i]), (LAS unsigned*)(lds + (bufoff) + ldsw + _i * 8192), 16, 0, 0); } while (0)
#define PG8_LDA(dst, b, h) do { _Pragma("unroll") for (int m = 0; m < 4; ++m) _Pragma("unroll") for (int k = 0; k < 2; ++k) dst[m][k] = *(const LAS bf16x8*)(lds + PG8_SA(b, h) + aoff + m * 2048 + k * 1024); } while (0)
#define PG8_LDB(dst, b, h) do { _Pragma("unroll") for (int n = 0; n < 2; ++n) _Pragma("unroll") for (int k = 0; k < 2; ++k) dst[n][k] = *(const LAS bf16x8*)(lds + PG8_SB(b, h) + boff + n * 2048 + k * 1024); } while (0)
#define PG8_MMA(ai, bj, At, Bt) do { __builtin_amdgcn_s_setprio(1); _Pragma("unroll") for (int m = 0; m < 4; ++m) _Pragma("unroll") for (int n = 0; n < 2; ++n) _Pragma("unroll") for (int k = 0; k < 2; ++k) \
        acc[ai][bj][m][n] = __builtin_amdgcn_mfma_f32_16x16x32_bf16(Bt[n][k], At[m][k], acc[ai][bj][m][n], 0, 0, 0); __builtin_amdgcn_s_setprio(0); } while (0)
#define PG8_WAIT_V(n) asm volatile("s_waitcnt vmcnt(" #n ")" ::: "memory")
#define PG8_WAIT_L(n) asm volatile("s_waitcnt lgkmcnt(" #n ")" ::: "memory")
#define PG8_BAR __builtin_amdgcn_s_barrier()
#define PG8_SCHED __builtin_amdgcn_sched_barrier(0)
    Unit cur, nxt; int ui = 0;
    if (!S.next(0, cur)) return;
    f32x4 acc[2][2][4][2];
#pragma unroll
    for (int a = 0; a < 2; ++a)
#pragma unroll
        for (int b = 0; b < 2; ++b)
#pragma unroll
            for (int m = 0; m < 4; ++m)
#pragma unroll
                for (int n = 0; n < 2; ++n) acc[a][b][m][n] = (f32x4){0.f, 0.f, 0.f, 0.f};
    bf16x8 At[4][2], B0[2][2], B1[2][2];
    const char* cA = (const char*)g.A + ((size_t)cur.z * g.zA) * 2 + (size_t)cur.pm * tstepA;
    const char* cB = (const char*)g.Bt + ((size_t)cur.z * g.zB) * 2 + (size_t)cur.pn * tstepB;
    PG8_STAGE(PG8_SB(0, 0), cB, voffB); PG8_STAGE(PG8_SB(0, 1), cB + hstepB, voffB); PG8_STAGE(PG8_SA(0, 0), cA, voffA); PG8_STAGE(PG8_SA(0, 1), cA + hstepA, voffA);
    if (wr == 1) PG8_BAR;
    PG8_WAIT_V(2); PG8_BAR;
    PG8_STAGE(PG8_SB(1, 0), cB + kstep, voffB); PG8_STAGE(PG8_SA(1, 0), cA + kstep, voffA); PG8_STAGE(PG8_SB(1, 1), cB + hstepB + kstep, voffB);
    PG8_WAIT_V(6); PG8_BAR;
    for (;;) {
        const bool has_next = S.next(ui + 1, nxt);
        const char* nA = has_next ? (const char*)g.A + ((size_t)nxt.z * g.zA) * 2 + (size_t)nxt.pm * tstepA : cA;
        const char* nB = has_next ? (const char*)g.Bt + ((size_t)nxt.z * g.zB) * 2 + (size_t)nxt.pn * tstepB : cB;
        for (int t = 0; t < nt; t += 2) {
            const bool last = (t == nt - 2);
            const char* a1 = cA + (size_t)(t + 1) * kstep;
            const char* a2 = last ? nA : cA + (size_t)(t + 2) * kstep; const char* b2 = last ? nB : cB + (size_t)(t + 2) * kstep;
            const char* a3 = a2 + kstep; const char* b3 = b2 + kstep;
            PG8_LDB(B0, 0, 0); PG8_LDB(B1, 0, 1); PG8_SCHED; PG8_LDA(At, 0, 0); PG8_STAGE(PG8_SA(1, 1), a1 + hstepA, voffA);
            PG8_WAIT_V(8); PG8_WAIT_L(0); PG8_BAR; PG8_MMA(0, 0, At, B0); PG8_MMA(0, 1, At, B1); PG8_BAR; PG8_SCHED;
            PG8_LDA(At, 0, 1); PG8_STAGE(PG8_SB(0, 0), b2, voffB); PG8_STAGE(PG8_SB(0, 1), b2 + hstepB, voffB); PG8_STAGE(PG8_SA(0, 0), a2, voffA);
            PG8_WAIT_V(8); PG8_WAIT_L(0); PG8_BAR; PG8_MMA(1, 0, At, B0); PG8_MMA(1, 1, At, B1); PG8_BAR; PG8_SCHED;
            PG8_LDB(B0, 1, 0); PG8_LDB(B1, 1, 1); PG8_SCHED; PG8_LDA(At, 1, 0); PG8_STAGE(PG8_SA(0, 1), a2 + hstepA, voffA);
            PG8_WAIT_V(8); PG8_WAIT_L(0); PG8_BAR; PG8_MMA(0, 0, At, B0); PG8_MMA(0, 1, At, B1); PG8_BAR; PG8_SCHED;
            PG8_LDA(At, 1, 1); PG8_STAGE(PG8_SB(1, 0), b3, voffB); PG8_STAGE(PG8_SB(1, 1), b3 + hstepB, voffB); PG8_STAGE(PG8_SA(1, 0), a3, voffA);
            PG8_WAIT_V(8); PG8_WAIT_L(0); PG8_BAR; PG8_MMA(1, 0, At, B0); PG8_MMA(1, 1, At, B1); PG8_BAR; PG8_SCHED;
        }
        if (wr == 0) PG8_BAR;
        E(acc, cur, wr, wc, fr, fq);
        if (!has_next) break;
#pragma unroll
        for (int a = 0; a < 2; ++a)
#pragma unroll
            for (int b = 0; b < 2; ++b)
#pragma unroll
                for (int m = 0; m < 4; ++m)
#pragma unroll
                    for (int n = 0; n < 2; ++n) acc[a][b][m][n] = (f32x4){0.f, 0.f, 0.f, 0.f};
        cur = nxt; cA = nA; cB = nB; ++ui;
        if (wr == 1) PG8_BAR;
    }
    PG8_WAIT_V(0);
    PG8_BAR;
    asm volatile("" ::: "memory"); PG8_SCHED;
#undef PG8_SA
#undef PG8_SB
#undef PG8_STAGE
#undef PG8_LDA
#undef PG8_LDB
#undef PG8_MMA
#undef PG8_WAIT_V
#undef PG8_WAIT_L
#undef PG8_BAR
#undef PG8_SCHED
}

#define EPI_ROWS_BEGIN _Pragma("unroll") for (int ai = 0; ai < 2; ++ai) _Pragma("unroll") for (int m = 0; m < 4; ++m) { const int row = u.pm * BM + ai * HALF + wr * 64 + m * 16 + fr;
#define EPI_ROWS_END if (m & 1) asm volatile("" ::: "memory"); }
#define EPI_COLS_BEGIN _Pragma("unroll") for (int bj = 0; bj < 2; ++bj) _Pragma("unroll") for (int n = 0; n < 2; ++n) { const int colt = bj * HALF + wc * 32 + n * 16 + 4 * fq;
#define EPI_COLS_END }
typedef f32x4 Acc[2][2][4][2];

__device__ __forceinline__ float rstd4(const float* ssq, int row, float inv_dim) { const f32x4 p = *(const f32x4*)(ssq + (size_t)row * 4); return __builtin_amdgcn_rsqf(((p[0] + p[1]) + (p[2] + p[3])) * inv_dim + NORM_EPS); }

struct Epi1 {
    static constexpr bool PERM = false;
    bf16_t *CQ, *CKV, *KPE, *QD, *KD, *QX; float *SSQq, *SSQkv; const float *COS, *SIN; float sc_d, sc_x;
    __device__ __forceinline__ void operator()(const Acc& acc, const Unit& u, int wr, int wc, int fr, int fq) const {
        const int pn = u.pn;
        EPI_ROWS_BEGIN
            const float r = 1.0f;
            if (pn == 0) {
                float ss = 0.f;
                EPI_COLS_BEGIN const f32x4 v = acc[ai][bj][m][n] * r; ss += (v[0] * v[0] + v[1] * v[1]) + (v[2] * v[2] + v[3] * v[3]); store4bf(CQ + (size_t)row * 256 + colt, v); EPI_COLS_END
                ss += __shfl_xor(ss, 16); ss += __shfl_xor(ss, 32);
                if (fq == 0) SSQq[(size_t)row * 4 + wc] = ss;
            } else if (pn == 1) {
                float ss = 0.f;
#pragma unroll
                for (int n = 0; n < 2; ++n) { const f32x4 v = acc[ai][0][m][n] * r; ss += (v[0] * v[0] + v[1] * v[1]) + (v[2] * v[2] + v[3] * v[3]); store4bf(CKV + (size_t)row * 128 + wc * 32 + n * 16 + 4 * fq, v); }
                ss += __shfl_xor(ss, 16); ss += __shfl_xor(ss, 32);
                if (fq == 0) SSQkv[(size_t)row * 4 + wc] = ss;
                if (wc == 0) {
                    const int s = row & (SEQ - 1); const f32x4 cs = *(const f32x4*)(COS + s * 16 + 4 * fq), sn = *(const f32x4*)(SIN + s * 16 + 4 * fq);
                    const f32x4 x1 = acc[ai][1][m][0] * r, x2 = acc[ai][1][m][1] * r;
                    store4bf(KPE + (size_t)row * 32 + 4 * fq, x1 * cs - x2 * sn); store4bf(KPE + (size_t)row * 32 + 16 + 4 * fq, x2 * cs + x1 * sn);
                }
            } else if (pn < 6) {
                bf16_t* dst = (pn < 4 ? QD : KD) + (size_t)row * 512 + (pn & 1) * 256 + wc * 32 + 4 * fq; const float sc = (pn < 4 ? sc_d : 1.0f) * r;
                const int s = row & (SEQ - 1); const f32x4 cs = *(const f32x4*)(COS + s * 16 + 4 * fq), sn = *(const f32x4*)(SIN + s * 16 + 4 * fq);
#pragma unroll
                for (int bj = 0; bj < 2; ++bj) { const f32x4 x1 = acc[ai][bj][m][0] * sc, x2 = acc[ai][bj][m][1] * sc;
                    store4bf(dst + bj * HALF, x1 * cs - x2 * sn); store4bf(dst + bj * HALF + 16, x2 * cs + x1 * sn); }
            } else {
                const float sc = sc_x * r;
                EPI_COLS_BEGIN store4bf(QX + (size_t)row * 512 + (pn - 6) * 256 + colt, acc[ai][bj][m][n] * sc); EPI_COLS_END
            }
        EPI_ROWS_END
    }
};
#define EPIP_BJ_BEGIN _Pragma("unroll") for (int bj = 0; bj < 2; ++bj) { const int colt = bj * HALF + wc * 32 + 8 * fq;
#define EPIP_BJ_END }
struct EpiT {
    static constexpr bool PERM = true;
    bf16_t* O; size_t ldc; size_t zO; const float* ssq; float inv_dim; const float* colscale;
    __device__ __forceinline__ void operator()(const Acc& acc, const Unit& u, int wr, int wc, int fr, int fq) const {
        f32x4 cs[2][2];
        EPIP_BJ_BEGIN
            const int col = u.pn * BM + colt;
#pragma unroll
            for (int n = 0; n < 2; ++n) {
                if (ssq) { for (int i = 0; i < 4; ++i) cs[bj][n][i] = rstd4(ssq, col + 4 * n + i, inv_dim); }
                else cs[bj][n] = (f32x4){1.f, 1.f, 1.f, 1.f}; }
        EPIP_BJ_END
        bf16_t* base = O + (size_t)u.z * zO;
        EPI_ROWS_BEGIN
            EPIP_BJ_BEGIN store8bf(base + (size_t)row * ldc + u.pn * BM + colt, acc[ai][bj][m][0] * cs[bj][0], acc[ai][bj][m][1] * cs[bj][1]); EPIP_BJ_END
        EPI_ROWS_END
    }
};
struct EpiRow {
    static constexpr bool PERM = true;
    bf16_t* O; size_t ldc; size_t zO; const float* ssq; float inv_dim;
    __device__ __forceinline__ void operator()(const Acc& acc, const Unit& u, int wr, int wc, int fr, int fq) const {
        bf16_t* base = O + (size_t)u.z * zO;
        EPI_ROWS_BEGIN
            const float sc = ssq ? rstd4(ssq, row, inv_dim) : 1.0f;
            EPIP_BJ_BEGIN store8bf(base + (size_t)row * ldc + u.pn * BM + colt, acc[ai][bj][m][0] * sc, acc[ai][bj][m][1] * sc); EPIP_BJ_END
        EPI_ROWS_END
    }
};
struct Epi2 {
    static constexpr bool PERM = false;
    bf16_t* QA; const float* SSQq; const float *COS, *SIN; float sc_a;
    __device__ __forceinline__ void operator()(const Acc& acc, const Unit& u, int wr, int wc, int fr, int fq) const {
        EPI_ROWS_BEGIN
            const float sc = rstd4(SSQq, row, 1.0f / 256.0f) * sc_a;
            if (u.pn < 2) {
                EPI_COLS_BEGIN const int nn = u.pn * BM + colt; store4bf(QA + (size_t)row * 768 + (nn >> 6) * 96 + (nn & 63), acc[ai][bj][m][n] * sc); EPI_COLS_END
            } else {
                const int s = row & (SEQ - 1); const f32x4 cs = *(const f32x4*)(COS + s * 16 + 4 * fq), sn = *(const f32x4*)(SIN + s * 16 + 4 * fq);
#pragma unroll
                for (int bj = 0; bj < 2; ++bj) { const f32x4 x1 = acc[ai][bj][m][0] * sc, x2 = acc[ai][bj][m][1] * sc; bf16_t* dst = QA + (size_t)row * 768 + (4 * bj + wc) * 96 + 64 + 4 * fq;
                    store4bf(dst, x1 * cs - x2 * sn); store4bf(dst + 16, x2 * cs + x1 * sn); }
            }
        EPI_ROWS_END
    }
};
struct EpiSG {
    static constexpr bool PERM = true;
    bf16_t* O;
    __device__ __forceinline__ void operator()(const Acc& acc, const Unit& u, int wr, int wc, int fr, int fq) const {
#pragma unroll
        for (int ai = 0; ai < 2; ++ai) {
            u32x4 ov[4][2];
#pragma unroll
            for (int m = 0; m < 4; ++m) { const int row = u.pm * BM + ai * HALF + wr * 64 + m * 16 + fr;
                EPIP_BJ_BEGIN ov[m][bj] = *(const u32x4*)(O + (size_t)row * 1536 + u.pn * BM + colt); EPIP_BJ_END }
#pragma unroll
            for (int m = 0; m < 4; ++m) { const int row = u.pm * BM + ai * HALF + wr * 64 + m * 16 + fr;
                EPIP_BJ_BEGIN u32x2 lo_, hi_; lo_.x = ov[m][bj].x; lo_.y = ov[m][bj].y; hi_.x = ov[m][bj].z; hi_.y = ov[m][bj].w;
                    const f32x4 o0 = unpack4bf(lo_), o1 = unpack4bf(hi_); const f32x4 g0 = acc[ai][bj][m][0], g1 = acc[ai][bj][m][1]; f32x4 v0, v1;
#pragma unroll
                    for (int i = 0; i < 4; ++i) { v0[i] = o0[i] * g0[i] * sigmoidf_(g0[i]); v1[i] = o1[i] * g1[i] * sigmoidf_(g1[i]); }
                    store8bf(O + (size_t)row * 1536 + u.pn * BM + colt, v0, v1); EPIP_BJ_END }
            asm volatile("" ::: "memory");
        }
    }
};
struct EpiGL {
    static constexpr bool PERM = true;
    bf16_t* S; const float* bias;
    __device__ __forceinline__ void operator()(const Acc& acc, const Unit& u, int wr, int wc, int fr, int fq) const {
        f32x4 bv[2][2];
        EPIP_BJ_BEGIN bv[bj][0] = *(const f32x4*)(bias + u.pn * BM + colt); bv[bj][1] = *(const f32x4*)(bias + u.pn * BM + colt + 4); EPIP_BJ_END
        EPI_ROWS_BEGIN
            EPIP_BJ_BEGIN const f32x4 g0 = acc[ai][bj][m][0] + bv[bj][0], g1 = acc[ai][bj][m][1] + bv[bj][1]; f32x4 v0, v1;
#pragma unroll
                for (int i = 0; i < 4; ++i) { v0[i] = sigmoidf_(g0[i]); v1[i] = sigmoidf_(g1[i]); }
                store8bf(S + (size_t)row * 3072 + u.pn * BM + colt, v0, v1); EPIP_BJ_END
        EPI_ROWS_END
    }
};
struct EpiBR {
    static constexpr bool PERM = true;
    const bf16_t* S; bf16_t* MG;
    __device__ __forceinline__ void operator()(const Acc& acc, const Unit& u, int wr, int wc, int fr, int fq) const {
#pragma unroll
        for (int ai = 0; ai < 2; ++ai) {
            u32x4 sv[4][2]; unsigned long long mv[4][2][2];
#pragma unroll
            for (int m = 0; m < 4; ++m) { const int row = u.pm * BM + ai * HALF + wr * 64 + m * 16 + fr;
                EPIP_BJ_BEGIN const int col = u.pn * BM + colt; sv[m][bj] = *(const u32x4*)(S + (size_t)row * 3072 + u.z * 1024 + col);
                    const unsigned long long* mp_ = (const unsigned long long*)(MG + (size_t)row * 1024 + col);
                    mv[m][bj][0] = (u.z > 0) ? __hip_atomic_load(mp_, __ATOMIC_RELAXED, __HIP_MEMORY_SCOPE_AGENT) : 0ull;
                    mv[m][bj][1] = (u.z > 0) ? __hip_atomic_load(mp_ + 1, __ATOMIC_RELAXED, __HIP_MEMORY_SCOPE_AGENT) : 0ull; EPIP_BJ_END }
#pragma unroll
            for (int m = 0; m < 4; ++m) { const int row = u.pm * BM + ai * HALF + wr * 64 + m * 16 + fr;
                EPIP_BJ_BEGIN const int col = u.pn * BM + colt; u32x2 lo_, hi_; lo_.x = sv[m][bj].x; lo_.y = sv[m][bj].y; hi_.x = sv[m][bj].z; hi_.y = sv[m][bj].w;
                    f32x4 v0 = unpack4bf(lo_) * acc[ai][bj][m][0], v1 = unpack4bf(hi_) * acc[ai][bj][m][1];
                    u32x2 w0, w1; w0.x = (unsigned)mv[m][bj][0]; w0.y = (unsigned)(mv[m][bj][0] >> 32); w1.x = (unsigned)mv[m][bj][1]; w1.y = (unsigned)(mv[m][bj][1] >> 32);
                    v0 += unpack4bf(w0); v1 += unpack4bf(w1);
                    store8bf(MG + (size_t)row * 1024 + col, v0, v1); EPIP_BJ_END }
            asm volatile("" ::: "memory");
        }
    }
};
struct EpiOut {
    static constexpr bool PERM = false;
    float* OUT;
    __device__ __forceinline__ void operator()(const Acc& acc, const Unit& u, int wr, int wc, int fr, int fq) const {
        EPI_ROWS_BEGIN
            EPI_COLS_BEGIN *(f32x4*)(OUT + (size_t)row * 1024 + u.pn * BM + colt) = acc[ai][bj][m][n]; EPI_COLS_END
        EPI_ROWS_END
    }
};
}

__device__ __forceinline__ int crow(int r, int hi) { return (r & 3) + 8 * (r >> 2) + 4 * hi; }

template <int NMAP, int DKM, int DV, bool CAUSAL, int W0, int W1>
__device__ __forceinline__ void attn_unit(LAS unsigned char* lds, const bf16_t* __restrict__ Q, int ldq, const bf16_t* __restrict__ K0, int ldk0, const bf16_t* __restrict__ K1, int ldk1,
                                          const bf16_t* __restrict__ Vt, size_t ldv, int q0, int NT, bf16_t* O, int ldo, float lam, const float* subln, float outscale) {
    constexpr int DKT = NMAP * DKM, KS = DKT * 2 + 16, VS = 136, KBUF = 64 * KS, VBUF = DV * VS;
    constexpr int NC = DKM / 16, NDB = DV / 32;
    constexpr int K0C = W0 / 8, K0N = (64 * K0C) / 512, K1C = W1 / 8, VN = (DV * 8) / 512;
    static_assert(W0 + W1 == DKT && K0N >= 1 && VN >= 1, "attention staging geometry");
    int tid = threadIdx.x; asm volatile("" : "+v"(tid));
    const int lane = tid & 63, wid = __builtin_amdgcn_readfirstlane(tid >> 6), r32 = lane & 31, hi = lane >> 5;
    LAS unsigned char* Kb = lds; LAS unsigned char* Vb = lds + 2 * KBUF;
    bf16x8 qf[NMAP][NC];
    { const bf16_t* qrow = Q + (size_t)(q0 + wid * 32 + r32) * ldq;
#pragma unroll
      for (int mp = 0; mp < NMAP; ++mp)
#pragma unroll
          for (int c = 0; c < NC; ++c) qf[mp][c] = *(const bf16x8*)(qrow + mp * DKM + 16 * c + 8 * hi); }
    f32x16 o[NMAP][NDB]; float mrow[NMAP], lrow[NMAP];
#pragma unroll
    for (int mp = 0; mp < NMAP; ++mp) { mrow[mp] = -INFINITY; lrow[mp] = 0.f;
#pragma unroll
        for (int db = 0; db < NDB; ++db)
#pragma unroll
            for (int r = 0; r < 16; ++r) o[mp][db][r] = 0.f; }
    u32x4 kreg[K0N], k1reg = {0u, 0u, 0u, 0u}, vreg[VN];
#define ATT_GLOAD(t) do { \
    _Pragma("unroll") for (int i = 0; i < K0N; ++i) { const int idx = tid + 512 * i, rr = idx / K0C, cc = idx % K0C; kreg[i] = *(const u32x4*)(K0 + (size_t)(64 * (t) + rr) * ldk0 + cc * 8); } \
    if (W1 > 0) { if (tid < 64 * K1C) { const int rr = tid / (K1C > 0 ? K1C : 1), cc = tid % (K1C > 0 ? K1C : 1); k1reg = *(const u32x4*)(K1 + (size_t)(64 * (t) + rr) * ldk1 + cc * 8); } } \
    _Pragma("unroll") for (int i = 0; i < VN; ++i) { const int idx = tid + 512 * i, dd = idx >> 3, cc = idx & 7; vreg[i] = *(const u32x4*)(Vt + (size_t)dd * ldv + 64 * (t) + cc * 8); } } while (0)
#define ATT_LWRITE(buf) do { \
    _Pragma("unroll") for (int i = 0; i < K0N; ++i) { const int idx = tid + 512 * i, rr = idx / K0C, cc = idx % K0C; *(LAS u32x4*)(Kb + (buf) * KBUF + rr * KS + cc * 16) = kreg[i]; } \
    if (W1 > 0) { if (tid < 64 * K1C) { const int rr = tid / (K1C > 0 ? K1C : 1), cc = tid % (K1C > 0 ? K1C : 1); *(LAS u32x4*)(Kb + (buf) * KBUF + rr * KS + W0 * 2 + cc * 16) = k1reg; } } \
    _Pragma("unroll") for (int i = 0; i < VN; ++i) { const int idx = tid + 512 * i, dd = idx >> 3, cc = idx & 7; LAS u32x2* vp = (LAS u32x2*)(Vb + (buf) * VBUF + dd * VS + cc * 16); \
        u32x2 lo_; lo_.x = vreg[i].x; lo_.y = vreg[i].y; u32x2 hi_; hi_.x = vreg[i].z; hi_.y = vreg[i].w; vp[0] = lo_; vp[1] = hi_; } } while (0)
    ATT_GLOAD(0);
    ATT_LWRITE(0);
    __syncthreads();
    const int qw0 = q0 + wid * 32;
    for (int t = 0; t < NT; ++t) {
        const int buf = t & 1;
        if (t + 1 < NT) ATT_GLOAD(t + 1);
#pragma unroll
        for (int kb = 0; kb < 2; ++kb) {
            const int kv0 = 64 * t + 32 * kb;
            if (CAUSAL && kv0 > qw0) continue;
            const bool diag = CAUSAL && (kv0 == qw0);
            bf16x8 vf[NDB][2];
#pragma unroll
            for (int db = 0; db < NDB; ++db)
#pragma unroll
                for (int j = 0; j < 2; ++j) { const LAS unsigned char* vp = Vb + buf * VBUF + (32 * db + r32) * VS + (32 * kb + 16 * j + 4 * hi) * 2;
                    const s16x4 lo = *(const LAS s16x4*)vp, hh = *(const LAS s16x4*)(vp + 16);
                    vf[db][j] = (bf16x8){lo[0], lo[1], lo[2], lo[3], hh[0], hh[1], hh[2], hh[3]}; }
#pragma unroll
            for (int mp = 0; mp < NMAP; ++mp) {
                f32x16 s;
#pragma unroll
                for (int r = 0; r < 16; ++r) s[r] = 0.f;
#pragma unroll
                for (int c = 0; c < NC; ++c) { const bf16x8 kf = *(const LAS bf16x8*)(Kb + buf * KBUF + (32 * kb + r32) * KS + (mp * DKM + 16 * c + 8 * hi) * 2);
                    s = __builtin_amdgcn_mfma_f32_32x32x16_bf16(kf, qf[mp][c], s, 0, 0, 0); }
                if (diag) {
#pragma unroll
                    for (int r = 0; r < 16; ++r) if (crow(r, hi) > r32) s[r] = -INFINITY;
                }
                float mx = s[0];
#pragma unroll
                for (int r = 1; r < 16; ++r) mx = fmaxf(mx, s[r]);
                mx = fmaxf(mx, __shfl_xor(mx, 32));
                if (__any(mx > mrow[mp])) {
                    const float mnew = fmaxf(mrow[mp], mx), alpha = fast_exp2(mrow[mp] - mnew);
                    mrow[mp] = mnew; lrow[mp] *= alpha;
#pragma unroll
                    for (int db = 0; db < NDB; ++db)
#pragma unroll
                        for (int r = 0; r < 16; ++r) o[mp][db][r] *= alpha;
                }
                const float mcur = mrow[mp]; float ls = 0.f;
#pragma unroll
                for (int r = 0; r < 16; ++r) { s[r] = fast_exp2(s[r] - mcur); ls += s[r]; }
                lrow[mp] += ls;
                bf16x8 pa[2];
#pragma unroll
                for (int j = 0; j < 2; ++j) { u32x4 w; w.x = cvtpk(s[8 * j + 0], s[8 * j + 1]); w.y = cvtpk(s[8 * j + 2], s[8 * j + 3]); w.z = cvtpk(s[8 * j + 4], s[8 * j + 5]); w.w = cvtpk(s[8 * j + 6], s[8 * j + 7]); pa[j] = __builtin_bit_cast(bf16x8, w); }
#pragma unroll
                for (int db = 0; db < NDB; ++db)
#pragma unroll
                    for (int j = 0; j < 2; ++j) o[mp][db] = __builtin_amdgcn_mfma_f32_32x32x16_bf16(vf[db][j], pa[j], o[mp][db], 0, 0, 0);
            }
        }
        if (t + 1 < NT) ATT_LWRITE(buf ^ 1);
        __syncthreads();
    }
#undef ATT_GLOAD
#undef ATT_LWRITE
    float inv[NMAP];
#pragma unroll
    for (int mp = 0; mp < NMAP; ++mp) { const float lt = lrow[mp] + __shfl_xor(lrow[mp], 32); inv[mp] = 1.0f / lt; }
    bf16_t* orow = O + (size_t)(q0 + wid * 32 + r32) * ldo;
    if constexpr (NMAP == 1) {
#pragma unroll
        for (int db = 0; db < NDB; ++db)
#pragma unroll
            for (int g = 0; g < 4; ++g) { f32x4 v; for (int i = 0; i < 4; ++i) v[i] = o[0][db][4 * g + i] * inv[0]; store4bf(orow + 32 * db + 8 * g + 4 * hi, v); }
    } else {
        float ss = 0.f;
#pragma unroll
        for (int db = 0; db < NDB; ++db)
#pragma unroll
            for (int r = 0; r < 16; ++r) { const float v = o[0][db][r] * inv[0] - lam * (o[1][db][r] * inv[1]); o[0][db][r] = v; ss += v * v; }
        ss += __shfl_xor(ss, 32);
        const float rstd = __builtin_amdgcn_rsqf(ss * (1.0f / DV) + NORM_EPS) * outscale;
#pragma unroll
        for (int db = 0; db < NDB; ++db)
#pragma unroll
            for (int g = 0; g < 4; ++g) { const f32x4 gn = *(const f32x4*)(subln + 32 * db + 8 * g + 4 * hi); f32x4 v; for (int i = 0; i < 4; ++i) v[i] = o[0][db][4 * g + i] * rstd * gn[i]; store4bf(orow + 32 * db + 8 * g + 4 * hi, v); }
    }
}

template <int NMAP, int DKM, int DV, int W0, int W1>
__device__ __forceinline__ void attn_unit2(LAS unsigned char* lds, const bf16_t* __restrict__ Q, int ldq, const bf16_t* __restrict__ K0, int ldk0, const bf16_t* __restrict__ K1, int ldk1,
                                           const bf16_t* __restrict__ Vt, size_t ldv, int q0, int NT, bf16_t* O, int ldo, float lam, const float* subln, float outscale) {
    constexpr int DKT = NMAP * DKM, KS = DKT * 2 + 16, VS = 136, KBUF = 64 * KS, VBUF = DV * VS;
    constexpr int NC = DKM / 16, NDB = DV / 32;
    constexpr int K0C = W0 / 8, K0N = (64 * K0C) / 512, K1C = W1 / 8, VN = (DV * 8) / 512;
    static_assert(W0 + W1 == DKT && K0N >= 1 && VN >= 1, "attention staging geometry");
    int tid = threadIdx.x; asm volatile("" : "+v"(tid));
    const int lane = tid & 63, wid = __builtin_amdgcn_readfirstlane(tid >> 6), r32 = lane & 31, hi = lane >> 5;
    LAS unsigned char* Kb = lds; LAS unsigned char* Vb = lds + 2 * KBUF;
    bf16x8 qf[NMAP][NC];
    { const bf16_t* qrow = Q + (size_t)(q0 + wid * 32 + r32) * ldq;
#pragma unroll
      for (int mp = 0; mp < NMAP; ++mp)
#pragma unroll
          for (int c = 0; c < NC; ++c) qf[mp][c] = *(const bf16x8*)(qrow + mp * DKM + 16 * c + 8 * hi); }
    f32x16 o[NMAP][NDB], negm[NMAP]; float lrow[NMAP];
#pragma unroll
    for (int mp = 0; mp < NMAP; ++mp) { lrow[mp] = 0.f;
#pragma unroll
        for (int r = 0; r < 16; ++r) negm[mp][r] = 0.f;
#pragma unroll
        for (int db = 0; db < NDB; ++db)
#pragma unroll
            for (int r = 0; r < 16; ++r) o[mp][db][r] = 0.f; }
    u32x4 kreg[K0N], k1reg = {0u, 0u, 0u, 0u}, vreg[VN];
#define ATT_GLOAD(t) do { \
    _Pragma("unroll") for (int i = 0; i < K0N; ++i) { const int idx = tid + 512 * i, rr = idx / K0C, cc = idx % K0C; kreg[i] = *(const u32x4*)(K0 + (size_t)(64 * (t) + rr) * ldk0 + cc * 8); } \
    if (W1 > 0) { if (tid < 64 * K1C) { const int rr = tid / (K1C > 0 ? K1C : 1), cc = tid % (K1C > 0 ? K1C : 1); k1reg = *(const u32x4*)(K1 + (size_t)(64 * (t) + rr) * ldk1 + cc * 8); } } \
    _Pragma("unroll") for (int i = 0; i < VN; ++i) { const int idx = tid + 512 * i, dd = idx >> 3, cc = idx & 7; vreg[i] = *(const u32x4*)(Vt + (size_t)dd * ldv + 64 * (t) + cc * 8); } } while (0)
#define ATT_LWRITE(buf) do { \
    _Pragma("unroll") for (int i = 0; i < K0N; ++i) { const int idx = tid + 512 * i, rr = idx / K0C, cc = idx % K0C; *(LAS u32x4*)(Kb + (buf) * KBUF + rr * KS + cc * 16) = kreg[i]; } \
    if (W1 > 0) { if (tid < 64 * K1C) { const int rr = tid / (K1C > 0 ? K1C : 1), cc = tid % (K1C > 0 ? K1C : 1); *(LAS u32x4*)(Kb + (buf) * KBUF + rr * KS + W0 * 2 + cc * 16) = k1reg; } } \
    _Pragma("unroll") for (int i = 0; i < VN; ++i) { const int idx = tid + 512 * i, dd = idx >> 3, cc = idx & 7; LAS u32x2* vp = (LAS u32x2*)(Vb + (buf) * VBUF + dd * VS + cc * 16); \
        u32x2 lo_; lo_.x = vreg[i].x; lo_.y = vreg[i].y; u32x2 hi_; hi_.x = vreg[i].z; hi_.y = vreg[i].w; vp[0] = lo_; vp[1] = hi_; } } while (0)
    ATT_GLOAD(0);
    ATT_LWRITE(0);
    __syncthreads();
    const int qw0 = q0 + wid * 32;
    for (int t = 0; t < NT; ++t) {
        const int buf = t & 1;
        if (t + 1 < NT) ATT_GLOAD(t + 1);
        const int kvt = 64 * t;
        if (kvt <= qw0) {
            const bool band = (kvt + 63 > qw0);
#pragma unroll
            for (int mp = 0; mp < NMAP; ++mp) {
                f32x16 s0, s1;
#pragma unroll
                for (int c = 0; c < NC; ++c) {
                    const bf16x8 kf0 = *(const LAS bf16x8*)(Kb + buf * KBUF + r32 * KS + (mp * DKM + 16 * c + 8 * hi) * 2);
                    const bf16x8 kf1 = *(const LAS bf16x8*)(Kb + buf * KBUF + (32 + r32) * KS + (mp * DKM + 16 * c + 8 * hi) * 2);
                    if (c == 0) { s0 = __builtin_amdgcn_mfma_f32_32x32x16_bf16(kf0, qf[mp][0], negm[mp], 0, 0, 0); s1 = __builtin_amdgcn_mfma_f32_32x32x16_bf16(kf1, qf[mp][0], negm[mp], 0, 0, 0); }
                    else { s0 = __builtin_amdgcn_mfma_f32_32x32x16_bf16(kf0, qf[mp][c], s0, 0, 0, 0); s1 = __builtin_amdgcn_mfma_f32_32x32x16_bf16(kf1, qf[mp][c], s1, 0, 0, 0); }
                }
                if (band) {
                    const int qd = qw0 + r32 - kvt;
#pragma unroll
                    for (int r = 0; r < 16; ++r) { const int kv = crow(r, hi); if (kv > qd) s0[r] = -INFINITY; if (kv + 32 > qd) s1[r] = -INFINITY; }
                }
                float mx = fmaxf(s0[0], s1[0]);
#pragma unroll
                for (int r = 1; r < 16; ++r) mx = fmaxf(mx, fmaxf(s0[r], s1[r]));
                mx = fmaxf(mx, __shfl_xor(mx, 32));
                if (__any(t == 0 || mx > 8.0f)) {
                    const float dl = (t == 0) ? mx : fmaxf(mx, 0.f), alpha = fast_exp2(-dl);
                    lrow[mp] *= alpha;
#pragma unroll
                    for (int r = 0; r < 16; ++r) { s0[r] -= dl; s1[r] -= dl; negm[mp][r] -= dl; }
#pragma unroll
                    for (int db = 0; db < NDB; ++db)
#pragma unroll
                        for (int r = 0; r < 16; ++r) o[mp][db][r] *= alpha;
                }
                float ls = 0.f;
#pragma unroll
                for (int kb = 0; kb < 2; ++kb) {
                    f32x16& s = kb ? s1 : s0;
                    bf16x8 vf[NDB][2];
#pragma unroll
                    for (int db = 0; db < NDB; ++db)
#pragma unroll
                        for (int j = 0; j < 2; ++j) { const LAS unsigned char* vp = Vb + buf * VBUF + (32 * db + r32) * VS + (32 * kb + 16 * j + 4 * hi) * 2;
                            const s16x4 lo = *(const LAS s16x4*)vp, hh = *(const LAS s16x4*)(vp + 16);
                            vf[db][j] = (bf16x8){lo[0], lo[1], lo[2], lo[3], hh[0], hh[1], hh[2], hh[3]}; }
#pragma unroll
                    for (int r = 0; r < 16; ++r) { s[r] = fast_exp2(s[r]); ls += s[r]; }
                    bf16x8 pa[2];
#pragma unroll
                    for (int j = 0; j < 2; ++j) { u32x4 w; w.x = cvtpk(s[8 * j + 0], s[8 * j + 1]); w.y = cvtpk(s[8 * j + 2], s[8 * j + 3]); w.z = cvtpk(s[8 * j + 4], s[8 * j + 5]); w.w = cvtpk(s[8 * j + 6], s[8 * j + 7]); pa[j] = __builtin_bit_cast(bf16x8, w); }
#pragma unroll
                    for (int db = 0; db < NDB; ++db)
#pragma unroll
                        for (int j = 0; j < 2; ++j) o[mp][db] = __builtin_amdgcn_mfma_f32_32x32x16_bf16(vf[db][j], pa[j], o[mp][db], 0, 0, 0);
                }
                lrow[mp] += ls;
                if (NMAP > 1) __builtin_amdgcn_sched_barrier(0);
            }
        }
        if (t + 1 < NT) ATT_LWRITE(buf ^ 1);
        __syncthreads();
    }
#undef ATT_GLOAD
#undef ATT_LWRITE
    float inv[NMAP];
#pragma unroll
    for (int mp = 0; mp < NMAP; ++mp) { const float lt = lrow[mp] + __shfl_xor(lrow[mp], 32); inv[mp] = 1.0f / lt; }
    bf16_t* orow = O + (size_t)(q0 + wid * 32 + r32) * ldo;
    if constexpr (NMAP == 1) {
#pragma unroll
        for (int db = 0; db < NDB; ++db)
#pragma unroll
            for (int g = 0; g < 4; ++g) { f32x4 v; for (int i = 0; i < 4; ++i) v[i] = o[0][db][4 * g + i] * inv[0]; store4bf(orow + 32 * db + 8 * g + 4 * hi, v); }
    } else {
        float ss = 0.f;
#pragma unroll
        for (int db = 0; db < NDB; ++db)
#pragma unroll
            for (int r = 0; r < 16; ++r) { const float v = o[0][db][r] * inv[0] - lam * (o[1][db][r] * inv[1]); o[0][db][r] = v; ss += v * v; }
        ss += __shfl_xor(ss, 32);
        const float rstd = __builtin_amdgcn_rsqf(ss * (1.0f / DV) + NORM_EPS) * outscale;
#pragma unroll
        for (int db = 0; db < NDB; ++db)
#pragma unroll
            for (int g = 0; g < 4; ++g) { const f32x4 gn = *(const f32x4*)(subln + 32 * db + 8 * g + 4 * hi); f32x4 v; for (int i = 0; i < 4; ++i) v[i] = o[0][db][4 * g + i] * rstd * gn[i]; store4bf(orow + 32 * db + 8 * g + 4 * hi, v); }
    }
}

__device__ __forceinline__ float wave_sum(float v) {
#pragma unroll
    for (int o = 1; o < 64; o <<= 1) v += __shfl_xor(v, o);
    return v;
}
__device__ __forceinline__ void transpose_block(const float* __restrict__ W, int ldw, int src_col0, const float* __restrict__ gain, bf16_t* WT, int K, int dst_row0, int k0, LAS float* scr, int lane) {
#pragma unroll 8
    for (int i = 0; i < 32; ++i) { const int kk = 2 * i + (lane >> 5); float v = W[(size_t)(k0 + kk) * ldw + src_col0 + (lane & 31)]; if (gain) v *= gain[k0 + kk]; scr[kk * 33 + (lane & 31)] = v; }
    asm volatile("s_waitcnt lgkmcnt(0)" ::: "memory");
    const int c = lane & 7;
#pragma unroll
    for (int j = 0; j < 4; ++j) { const int n = (lane >> 3) + 8 * j; const LAS float* s = scr + (8 * c) * 33 + n;
        u32x4 ov; ov.x = cvtpk(s[0 * 33], s[1 * 33]); ov.y = cvtpk(s[2 * 33], s[3 * 33]); ov.z = cvtpk(s[4 * 33], s[5 * 33]); ov.w = cvtpk(s[6 * 33], s[7 * 33]);
        *(u32x4*)(WT + (size_t)(dst_row0 + n) * K + k0 + 8 * c) = ov; }
    asm volatile("s_waitcnt lgkmcnt(0)" ::: "memory");
}

#define XB_TMO      128
#define XB_XCNT(j)  (256  + 64 * (j))
#define XB_XSUB(j)  (1280 + 64 * (j))
#define XB_XGEN(j)  (2304 + 64 * (j))
#define XB_TOP      3328
#define XB_TOPGEN   3392
#define XCD_BAR_WORDS 3456
#define XB_SPIN_CAP (1u << 18)

__device__ __forceinline__ unsigned xb_ld(unsigned* p)              { return __hip_atomic_load(p, __ATOMIC_RELAXED, __HIP_MEMORY_SCOPE_AGENT); }
__device__ __forceinline__ unsigned xb_add(unsigned* p, unsigned v) { return __hip_atomic_fetch_add(p, v, __ATOMIC_RELAXED, __HIP_MEMORY_SCOPE_AGENT); }
__device__ __forceinline__ unsigned xb_xcc_id() { return (unsigned)__builtin_amdgcn_s_getreg((3 << 11) | 20) & 0xFu; }
#define XB_SPIN(cond, bar) do { unsigned _sp = 0; while (cond) { __builtin_amdgcn_s_sleep(1); \
    if ((++_sp & 255u) == 0u) { if (xb_ld(&(bar)[XB_TMO])) break; if (_sp > XB_SPIN_CAP) { atomicAdd(&(bar)[XB_TMO], 1u); break; } } } } while (0)

struct XcdBarrier {
    unsigned* bar; unsigned x;
    volatile LAS unsigned* st;
};

__device__ __forceinline__ XcdBarrier xcd_barrier_post(unsigned* bar, volatile LAS unsigned* st) {
    XcdBarrier b; b.bar = bar; b.x = xb_xcc_id(); b.st = st;
    if (threadIdx.x == 0) (void)xb_add(&bar[XB_XCNT(b.x)], 1u);
    return b;
}
__device__ __forceinline__ void xcd_barrier_complete(unsigned* bar, unsigned x, unsigned& nloc, unsigned& nx) {
    const unsigned G = gridDim.x * gridDim.y * gridDim.z;
    unsigned sum, cnt, mine, sp = 0u;
    for (;;) {
        sum = 0u; cnt = 0u; mine = 0u;
#pragma unroll
        for (unsigned j = 0; j < 16; ++j) { const unsigned c = xb_ld(&bar[XB_XCNT(j)]); sum += c; cnt += (c > 0u) ? 1u : 0u; mine = (j == x) ? c : mine; }
        if (sum == G) break;
        __builtin_amdgcn_s_sleep(1);
        if ((++sp & 255u) == 0u) { if (xb_ld(&bar[XB_TMO])) break; if (sp > XB_SPIN_CAP) { atomicAdd(&bar[XB_TMO], 1u); break; } }
    }
    nloc = mine > 0u ? mine : 1u; nx = cnt > 0u ? cnt : 1u;
}

__device__ __forceinline__ void xcd_barrier(const XcdBarrier& b) {
    asm volatile("s_waitcnt vmcnt(0)" ::: "memory");
    __syncthreads();
    if (threadIdx.x == 0) {
        unsigned* bar = b.bar;
        __builtin_amdgcn_s_waitcnt(0);
        unsigned nloc = b.st[0], nx = b.st[1];
        if (nloc == 0u) { xcd_barrier_complete(bar, b.x, nloc, nx); b.st[0] = nloc; b.st[1] = nx; }
        const unsigned old = xb_add(&bar[XB_XSUB(b.x)], 1u);
        const unsigned gen = old / nloc;
        if (old + 1u == (gen + 1u) * nloc) {
            __builtin_amdgcn_fence(__ATOMIC_RELEASE, "agent");
            asm volatile("s_waitcnt vmcnt(0)" ::: "memory");
            const unsigned og = xb_add(&bar[XB_TOP], 1u);
            const unsigned tg = og / nx;
            if (og + 1u == (tg + 1u) * nx) xb_add(&bar[XB_TOPGEN], 1u);
            else XB_SPIN(xb_ld(&bar[XB_TOPGEN]) == tg, bar);
            __builtin_amdgcn_fence(__ATOMIC_ACQUIRE, "agent");
            xb_add(&bar[XB_XGEN(b.x)], 1u);
            asm volatile("s_waitcnt vmcnt(0)" ::: "memory");
        } else {
            XB_SPIN(xb_ld(&bar[XB_XGEN(b.x)]) == gen, bar);
            __builtin_amdgcn_fence(__ATOMIC_ACQUIRE, "agent");
            asm volatile("s_waitcnt vmcnt(0)" ::: "memory");
        }
    }
    __syncthreads();
}


struct Args { const float* in[20]; float* out; unsigned char* ws; int ph_lo, ph_hi, coop, pad; float lam_init[4]; };

__global__ void __launch_bounds__(512, 2) hybrid_fwd(Args a) {
    extern __shared__ __attribute__((aligned(16))) unsigned char lds_raw[];
    LAS unsigned char* lds = (LAS unsigned char*)lds_raw;
    const float* x_in = a.in[0]; const float* mem = a.in[1]; const int* positions = (const int*)a.in[2];
    const float* norm_pre = a.in[3]; const float* norm_post = a.in[4]; const float* w_in = a.in[5]; const float* q_norm = a.in[6]; const float* w_uq = a.in[7];
    const float* kv_norm = a.in[8]; const float* w_ukv = a.in[9]; const float* lq1 = a.in[10]; const float* lk1 = a.in[11]; const float* lq2 = a.in[12]; const float* lk2 = a.in[13];
    const float* diff_subln = a.in[14]; const float* mem_norm = a.in[15]; const float* w_mem_kv = a.in[16]; const float* b_gate = a.in[17]; const float* w_branch = a.in[18]; const float* w_out = a.in[19];
#define P_WT ((bf16_t*)(ws + OFF_W))
#define P_COS ((float*)(ws + OFF_COS))
#define P_SIN ((float*)(ws + OFF_SIN))
#define P_SSQq ((float*)(ws + OFF_SSQQ))
#define P_SSQkv ((float*)(ws + OFF_SSQKV))
#define P_MN ((bf16_t*)(ws + OFF_MN))
#define P_KM ((bf16_t*)(ws + OFF_KM))
#define P_VMT ((bf16_t*)(ws + OFF_VMT))
#define P_XN ((bf16_t*)(ws + OFF_XN))
#define P_OB ((bf16_t*)(ws + OFF_O))
#define P_CQ ((bf16_t*)(ws + OFF_CQ))
#define P_CKV ((bf16_t*)(ws + OFF_CKV))
#define P_KPE ((bf16_t*)(ws + OFF_KPE))
#define P_QD ((bf16_t*)(ws + OFF_QD))
#define P_KD ((bf16_t*)(ws + OFF_KD))
#define P_VDT ((bf16_t*)(ws + OFF_VDT))
#define P_QX ((bf16_t*)(ws + OFF_QX))
#define P_QA ((bf16_t*)(ws + OFF_QA))
#define P_KN ((bf16_t*)(ws + OFF_KN))
#define P_VAT ((bf16_t*)(ws + OFF_VAT))
#define P_SB ((bf16_t*)(ws + OFF_S))
#define P_MG ((bf16_t*)(ws + OFF_MERGED))
#define P_OUTB ((float*)(ws + OFF_OUT))

    volatile LAS unsigned* bst = (volatile LAS unsigned*)(lds + LDS_BYTES - 16);
    if (threadIdx.x < 4) bst[threadIdx.x] = 0u;
    __syncthreads();
    XcdBarrier xbar; xbar.bar = (unsigned*)(a.ws + OFF_BAR); xbar.x = 0; xbar.st = bst;
    if (a.coop) xbar = xcd_barrier_post((unsigned*)(a.ws + OFF_BAR), bst);
    for (int ph = a.ph_lo; ph < a.ph_hi; ++ph) {
        __attribute__((address_space(1))) unsigned char* ws = (__attribute__((address_space(1))) unsigned char*)a.ws; asm volatile("" : "+s"(ws));
        int tid = threadIdx.x; asm volatile("" : "+v"(tid)); const int lane = tid & 63, wave = __builtin_amdgcn_readfirstlane(tid >> 6);
        int G = gridDim.x, bx = blockIdx.x; asm volatile("" : "+s"(G), "+s"(bx));
        const int vcu = (G % 8 == 0) ? (bx % 8) * (G / 8) + bx / 8 : bx;
        const int gw = vcu * 8 + wave, NGW = G * 8;
        if (ph == 0) {
#if PHSEL & 1
            LAS float* scr = (LAS float*)(lds + wave * 16384);
            constexpr int I_IN = 16 * 221, I_UQ = 4 * 24, I_UKV = 2 * 32, I_MEM = 16 * 32, I_BR = 3 * 256, I_OUT = 16 * 32;
            constexpr int I_L = I_IN + I_UQ + I_UKV + I_MEM + I_BR + I_OUT;
            for (int it = gw; it < DEPTH * I_L; it += NGW) {
                const int l = it / I_L; int r = it - l * I_L; bf16_t* wl = P_WT + (size_t)l * WL_TOTAL;
                if (r < I_IN) { const int kb = r / 221, nb = r - kb * 221, n = nb * 32; int dr;
                    if (n < 416) dr = n; else if (n < 1440) dr = n + 96; else if (n < 1952) dr = n - 1440 + 2048; else if (n < 2464) dr = n - 1952 + 1536; else dr = n + 96;
                    transpose_block(w_in + (size_t)l * 1024 * IN_WIDTH, IN_WIDTH, n, norm_pre + l * 1024, wl + WL_IN, 1024, dr, kb * 64, scr, lane); continue; }
                r -= I_IN;
                if (r < I_UQ) { const int kb = r / 24, nb = r - kb * 24, n = nb * 32, h = n / 96, w = n - h * 96; const int dr = (w < 64) ? h * 64 + w : 512 + h * 32 + (w - 64);
                    transpose_block(w_uq + (size_t)l * 256 * 768, 768, n, q_norm + l * 256, wl + WL_UQ, 256, dr, kb * 64, scr, lane); continue; }
                r -= I_UQ;
                if (r < I_UKV) { const int kb = r / 32, nb = r - kb * 32, n = nb * 32, h = n / 128, w = n - h * 128; const int dr = (w < 64) ? h * 64 + w : 512 + h * 64 + (w - 64);
                    transpose_block(w_ukv + (size_t)l * 128 * 1024, 1024, n, kv_norm + l * 128, wl + WL_UKV, 128, dr, kb * 64, scr, lane); continue; }
                r -= I_UKV;
                if (r < I_MEM) { const int kb = r / 32, nb = r - kb * 32;
                    transpose_block(w_mem_kv + (size_t)l * 1024 * 1024, 1024, nb * 32, mem_norm + l * 1024, wl + WL_MEM, 1024, nb * 32, kb * 64, scr, lane); continue; }
                r -= I_MEM;
                if (r < I_BR) { const int i = r / 256, rr = r - i * 256, kb = rr / 32, nb = rr - kb * 32;
                    transpose_block(w_branch + (size_t)(l * 3 + i) * 512 * 1024, 1024, nb * 32, nullptr, wl + WL_BR + (size_t)i * 1024 * 512, 512, nb * 32, kb * 64, scr, lane); continue; }
                r -= I_BR;
                { const int kb = r / 32, nb = r - kb * 32;
                    transpose_block(w_out + (size_t)l * 1024 * 1024, 1024, nb * 32, nullptr, wl + WL_OUT, 1024, nb * 32, kb * 64, scr, lane); }
            }
            for (int i = bx * 512 + tid; i < DEPTH * 96 * 1024 / 8; i += G * 512) { const int l = i / (96 * 1024 / 8), rr = i - l * (96 * 1024 / 8);
                *(u32x4*)(P_WT + (size_t)l * WL_TOTAL + WL_IN + (size_t)416 * 1024 + (size_t)rr * 8) = (u32x4){0u, 0u, 0u, 0u}; }
            for (int i = bx * 512 + tid; i < SEQ * 16; i += G * 512) { const int s = i >> 4, j = i & 15;
                const float invf = powf(10000.0f, -(float)j / 16.0f); const float ang = (float)positions[s] * invf;
                double rv = (double)ang * 0.15915494309189535; rv -= floor(rv); const float f = (float)rv;
                P_COS[i] = __builtin_amdgcn_cosf(f); P_SIN[i] = __builtin_amdgcn_sinf(f); }
            for (int m = gw; m < MMEM + MTOK; m += NGW) {
                const float* src = (m < MMEM) ? mem + (size_t)m * 1024 : x_in + (size_t)(m - MMEM) * 1024; bf16_t* dst = (m < MMEM) ? P_MN + (size_t)m * 1024 : P_XN + (size_t)(m - MMEM) * 1024;
                f32x4 v[4]; float s = 0.f;
#pragma unroll
                for (int j = 0; j < 4; ++j) { v[j] = ((const f32x4*)src)[64 * j + lane]; s += (v[j][0] * v[j][0] + v[j][1] * v[j][1]) + (v[j][2] * v[j][2] + v[j][3] * v[j][3]); }
                const float rstd = __builtin_amdgcn_rsqf(wave_sum(s) * (1.0f / 1024.0f) + NORM_EPS);
#pragma unroll
                for (int j = 0; j < 4; ++j) store4bf(dst + 4 * (64 * j + lane), v[j] * rstd);
            }
#endif
        } else {
            const int l = (ph - 1) / 7, sub = (ph - 1) % 7;
            const bf16_t* wl = P_WT + (size_t)l * WL_TOTAL;
            if (sub == 0) {
#if PHSEL & 2
#if GSEL & 1
                { pg8::Gemm g{P_XN, wl + WL_IN, MTOK, 2048, 1024, 1024, 1024, 0, 0}; pg8::StaticOrder S; S.init(MTOK, 2048, G, bx);
                  pg8::Epi1 E{P_CQ, P_CKV, P_KPE, P_QD, P_KD, P_QX, P_SSQq, P_SSQkv, P_COS, P_SIN, 0.17677669529663687f * LOG2E, 0.08838834764831845f * LOG2E};
                  pg8::gemm_phase(lds, g, S, E); }
#endif
#if GSEL & 2
                { pg8::Gemm g{wl + WL_IN + (size_t)2048 * 1024, P_XN, 512, MTOK, 1024, 1024, 1024, 0, 0}; pg8::StaticOrder S; S.init(512, MTOK, G, bx);
                  pg8::EpiT E{P_VDT, (size_t)MTOK, 0, nullptr, 0.f, nullptr};
                  pg8::gemm_phase(lds, g, S, E); }
#endif
                if (l == 0) {
#if GSEL & 4
                    { pg8::Gemm g{P_MN, P_WT + WL_MEM, MMEM, 512, 1024, 1024, 1024, 0, WL_TOTAL}; pg8::StaticOrder S; S.init(MMEM, 512, G, bx, DEPTH);
                      pg8::EpiRow E{P_KM, 512, (size_t)MMEM * 512, nullptr, 0.f};
                      pg8::gemm_phase(lds, g, S, E); }
#endif
#if GSEL & 8
                    { pg8::Gemm g{P_WT + WL_MEM + (size_t)512 * 1024, P_MN, 512, MMEM, 1024, 1024, 1024, WL_TOTAL, 0}; pg8::StaticOrder S; S.init(512, MMEM, G, bx, DEPTH);
                      pg8::EpiT E{P_VMT, (size_t)MMEM, (size_t)512 * MMEM, nullptr, 0.f, nullptr};
                      pg8::gemm_phase(lds, g, S, E); }
#endif
                }
#endif
            } else if (sub == 1) {
#if PHSEL & 4
#if GSEL & 16
                { pg8::Gemm g{P_CQ, wl + WL_UQ, MTOK, 768, 256, 256, 256, 0, 0}; pg8::StaticOrder S; S.init(MTOK, 768, G, bx);
                  pg8::Epi2 E{P_QA, P_SSQq, P_COS, P_SIN, 0.10206207261596575f * LOG2E};
                  pg8::gemm_phase(lds, g, S, E); }
#endif
#if GSEL & 32
                { pg8::Gemm g{P_CKV, wl + WL_UKV, MTOK, 512, 128, 128, 128, 0, 0}; pg8::StaticOrder S; S.init(MTOK, 512, G, bx);
                  pg8::EpiRow E{P_KN, 512, 0, P_SSQkv, 1.0f / 128.0f};
                  pg8::gemm_phase(lds, g, S, E); }
#endif
#if GSEL & 64
                { pg8::Gemm g{wl + WL_UKV + (size_t)512 * 128, P_CKV, 512, MTOK, 128, 128, 128, 0, 0}; pg8::StaticOrder S; S.init(512, MTOK, G, bx);
                  pg8::EpiT E{P_VAT, (size_t)MTOK, 0, P_SSQkv, 1.0f / 128.0f, nullptr};
                  pg8::gemm_phase(lds, g, S, E); }
#endif
#endif
            } else if (sub == 2) {
#if PHSEL & 8
                const float d1 = wave_sum(lane < 32 ? lq1[l * 32 + lane] * lk1[l * 32 + lane] : 0.f), d2 = wave_sum(lane < 32 ? lq2[l * 32 + lane] * lk2[l * 32 + lane] : 0.f);
                const float lam_init = a.lam_init[l]; const float lam = expf(d1) - expf(d2) + lam_init;
#if ATTSEL & 1
                for (int P = vcu; P < 1024; P += G) { const int bh = P >> 3, s = P & 7, b = bh >> 3, h = bh & 7; const size_t rb = (size_t)b * SEQ;
                    for (int k = 0; k < 2; ++k) { const int qb = k ? s : 15 - s;
                        attn_unit2<1, 96, 64, 64, 32>(lds, P_QA + rb * 768 + h * 96, 768, P_KN + rb * 512 + h * 64, 512, P_KPE + rb * 32, 32, P_VAT + (size_t)(h * 64) * MTOK + rb, (size_t)MTOK,
                                                            qb * 256, 4 * (qb + 1), P_OB + rb * 1536 + h * 64, 1536, 0.f, nullptr, 1.f); } }
#endif
                asm volatile("" ::: "memory"); __builtin_amdgcn_sched_barrier(0);
#if ATTSEL & 2
                for (int P = vcu; P < 1024; P += G) { const int bh = P >> 3, s = P & 7, b = bh >> 3, h = bh & 7; const size_t rb = (size_t)b * SEQ;
                    for (int k = 0; k < 2; ++k) { const int qb = k ? s : 15 - s;
                        attn_unit2<2, 32, 64, 64, 0>(lds, P_QD + rb * 512 + h * 64, 512, P_KD + rb * 512 + h * 64, 512, nullptr, 0, P_VDT + (size_t)(h * 64) * MTOK + rb, (size_t)MTOK,
                                                           qb * 256, 4 * (qb + 1), P_OB + rb * 1536 + 512 + h * 64, 1536, lam, diff_subln + l * 64, 1.0f - lam_init); } }
#endif
                asm volatile("" ::: "memory"); __builtin_amdgcn_sched_barrier(0);
#if ATTSEL & 4
                for (int X = vcu; X < 1024; X += G) { const int bh = X >> 4, qb = X & 15, b = bh >> 2, h = bh & 3; const size_t rb = (size_t)b * SEQ;
                    attn_unit<1, 128, 128, false, 128, 0>(lds, P_QX + rb * 512 + h * 128, 512, P_KM + (size_t)l * MMEM * 512 + (size_t)b * MEMT * 512 + h * 128, 512, nullptr, 0,
                                                           P_VMT + (size_t)l * 512 * MMEM + (size_t)(h * 128) * MMEM + (size_t)b * MEMT, (size_t)MMEM,
                                                           qb * 256, 4, P_OB + rb * 1536 + 1024 + h * 128, 1536, 0.f, nullptr, 1.f); }
#endif
#endif
            } else if (sub == 3) {
#if PHSEL & 16
                { pg8::Gemm g{P_XN, wl + WL_IN + (size_t)2560 * 1024, MTOK, 1536, 1024, 1024, 1024, 0, 0}; pg8::StaticOrder S; S.init(MTOK, 1536, G, bx);
                  pg8::EpiSG E{P_OB};
                  pg8::gemm_phase(lds, g, S, E); }
                { pg8::Gemm g{P_XN, wl + WL_IN + (size_t)4096 * 1024, MTOK, 3072, 1024, 1024, 1024, 0, 0}; pg8::StaticOrder S; S.init(MTOK, 3072, G, bx);
                  pg8::EpiGL E{P_SB, b_gate + l * 3072};
                  pg8::gemm_phase(lds, g, S, E); }
#endif
            } else if (sub == 4) {
#if PHSEL & 32
                pg8::Gemm g{P_OB, wl + WL_BR, MTOK, 1024, 512, 1536, 512, 512, (size_t)1024 * 512}; pg8::StaticOrder S; S.init(MTOK, 1024, G, bx, 3);
                pg8::EpiBR E{P_SB, P_MG};
                pg8::gemm_phase(lds, g, S, E);
#endif
            } else if (sub == 5) {
#if PHSEL & 64
                pg8::Gemm g{P_MG, wl + WL_OUT, MTOK, 1024, 1024, 1024, 1024, 0, 0}; pg8::StaticOrder S; S.init(MTOK, 1024, G, bx);
                pg8::EpiRow E{(bf16_t*)P_OUTB, 1024, 0, nullptr, 0.f};
                pg8::gemm_phase(lds, g, S, E);
#endif
            } else {
#if PHSEL & 128
                const float* xo = (l == 0) ? x_in : a.out; const float* gp = norm_post + l * 1024;
                for (int m = gw; m < MTOK; m += NGW) {
                    f32x4 v[4]; float s = 0.f;
#pragma unroll
                    for (int j = 0; j < 4; ++j) { v[j] = unpack4bf(((const u32x2*)((const bf16_t*)P_OUTB + (size_t)m * 1024))[64 * j + lane]); s += (v[j][0] * v[j][0] + v[j][1] * v[j][1]) + (v[j][2] * v[j][2] + v[j][3] * v[j][3]); }
                    const float rstd = __builtin_amdgcn_rsqf(wave_sum(s) * (1.0f / 1024.0f) + NORM_EPS); float s2 = 0.f;
#pragma unroll
                    for (int j = 0; j < 4; ++j) { const f32x4 xv = ((const f32x4*)(xo + (size_t)m * 1024))[64 * j + lane]; const f32x4 gv = ((const f32x4*)gp)[64 * j + lane];
                        v[j] = xv + v[j] * rstd * gv; ((f32x4*)(a.out + (size_t)m * 1024))[64 * j + lane] = v[j];
                        s2 += (v[j][0] * v[j][0] + v[j][1] * v[j][1]) + (v[j][2] * v[j][2] + v[j][3] * v[j][3]); }
                    if (l + 1 < DEPTH) { const float rstd2 = __builtin_amdgcn_rsqf(wave_sum(s2) * (1.0f / 1024.0f) + NORM_EPS);
#pragma unroll
                        for (int j = 0; j < 4; ++j) store4bf(P_XN + (size_t)m * 1024 + 4 * (64 * j + lane), v[j] * rstd2); }
                }
#endif
            }
        }
        if (ph + 1 < a.ph_hi) { if (a.coop) { if (ph == 0) cg::this_grid().sync(); else xcd_barrier(xbar); } }
    }
#ifdef DBG_NPH
    if (a.pad) {
        if (a.coop) cg::this_grid().sync();
        const unsigned short* w16 = (const unsigned short*)(a.ws + OFF_MN);
        const size_t n16 = (WS_END - OFF_MN) / 2, nout = (size_t)MTOK * 1024;
        for (size_t i = (size_t)blockIdx.x * 512 + threadIdx.x; i < nout; i += (size_t)gridDim.x * 512) {
            unsigned x = 0; for (size_t k = i; k < n16; k += nout) x ^= w16[k];
            const unsigned short* w2 = (const unsigned short*)(a.ws + OFF_COS); if (i < (size_t)(4 * MiB) / 2) x ^= w2[i];
            a.out[i] = (float)x;
        }
    }
#endif
}

extern "C" void kernel_launch(void* const* d_in, const int* in_sizes, int n_in, void* d_out, int out_size, void* d_ws, size_t ws_size, hipStream_t stream) {
    static int grid = 0;
    if (grid == 0) {
        if (n_in != 20 || ws_size < WS_END) { fprintf(stderr, "kernel_launch: need 20 inputs and >= %zu bytes of workspace (got %d, %zu)\n", (size_t)WS_END, n_in, ws_size); grid = -1; return; }
        int dev = 0, cus = 0, per_cu = 0;
        hipGetDevice(&dev); hipDeviceGetAttribute(&cus, hipDeviceAttributeMultiprocessorCount, dev);
        if (hipFuncSetAttribute((const void*)hybrid_fwd, hipFuncAttributeMaxDynamicSharedMemorySize, LDS_BYTES) != hipSuccess) { fprintf(stderr, "kernel_launch: hipFuncSetAttribute failed\n"); grid = -1; return; }
        if (hipOccupancyMaxActiveBlocksPerMultiprocessor(&per_cu, (const void*)hybrid_fwd, 512, LDS_BYTES) != hipSuccess || per_cu < 1) per_cu = 1;
        (void)hipGetLastError();
        grid = cus * 1;
    }
    if (grid < 0) return;
    if (hipMemsetAsync((char*)d_ws + OFF_BAR, 0, 16384, stream) != hipSuccess) { fprintf(stderr, "kernel_launch: hipMemsetAsync failed\n"); return; }
    Args a{};
    for (int i = 0; i < 20; ++i) a.in[i] = (const float*)d_in[i];
    a.out = (float*)d_out; a.ws = (unsigned char*)d_ws; a.pad = 0;
    a.lam_init[0] = 0.2f; a.lam_init[1] = 0.35550906759096926f; a.lam_init[2] = 0.47071301834358424f; a.lam_init[3] = 0.55605820415654f;
#if MK_ONE_LAUNCH
#ifdef DBG_NPH
    a.ph_lo = 0; a.ph_hi = DBG_NPH; a.coop = 1; a.pad = 1;
#else
    a.ph_lo = 0; a.ph_hi = NPHASE; a.coop = 1;
#endif
    void* args[] = {&a};
    hipError_t e = hipLaunchCooperativeKernel((const void*)hybrid_fwd, dim3(grid), dim3(512), args, LDS_BYTES, stream);
    if (e != hipSuccess) fprintf(stderr, "cooperative launch failed: %s (grid %d)\n", hipGetErrorString(e), grid);
#else
    for (int ph = 0; ph < NPHASE; ++ph) { a.ph_lo = ph; a.ph_hi = ph + 1; a.coop = 0;
        hipLaunchKernelGGL(hybrid_fwd, dim3(grid), dim3(512), LDS_BYTES, stream, a); }
#endif
}
```

```cpp
#include <hip/hip_runtime.h>
#include <hip/hip_cooperative_groups.h>
#include <cstdio>
#include <cstdint>
namespace cg = cooperative_groups;

#ifndef ATTSEL
#define ATTSEL 7
#endif
#ifndef GSEL
#define GSEL 0xFFFF
#endif
#ifndef PHSEL
#define PHSEL 0xFFFF
#endif
#ifndef MK_ONE_LAUNCH
#define MK_ONE_LAUNCH 1
#endif

#define LAS __attribute__((address_space(3)))
typedef unsigned short bf16_t;
typedef short bf16x8 __attribute__((ext_vector_type(8)));
typedef short s16x4 __attribute__((ext_vector_type(4)));
typedef float f32x4 __attribute__((ext_vector_type(4)));
typedef float f32x16 __attribute__((ext_vector_type(16)));
typedef unsigned u32x4 __attribute__((ext_vector_type(4)));
typedef unsigned u32x2 __attribute__((ext_vector_type(2)));
typedef float f32x2_t __attribute__((ext_vector_type(2)));
typedef __bf16 bf16x2_t __attribute__((ext_vector_type(2)));

constexpr int D_MODEL = 1024, BATCH = 16, SEQ = 4096, DEPTH = 4, MEMT = 256;
constexpr int MTOK = BATCH * SEQ;
constexpr int MMEM = BATCH * MEMT;
constexpr int IN_WIDTH = 7072;
constexpr float NORM_EPS = 1e-6f;
constexpr float LOG2E = 1.4426950408889634f;

constexpr size_t WL_IN = 0;
constexpr size_t WL_UQ = WL_IN + (size_t)7168 * 1024;
constexpr size_t WL_UKV = WL_UQ + (size_t)768 * 256;
constexpr size_t WL_MEM = WL_UKV + (size_t)1024 * 128;
constexpr size_t WL_BR = WL_MEM + (size_t)1024 * 1024;
constexpr size_t WL_OUT = WL_BR + (size_t)3 * 1024 * 512;
constexpr size_t WL_TOTAL = WL_OUT + (size_t)1024 * 3072;

constexpr size_t MiB = 1u << 20;
constexpr size_t OFF_W = 0;
constexpr size_t OFF_COS = 104 * MiB, OFF_SIN = OFF_COS + 256 * 1024;
constexpr size_t OFF_SSQQ = 105 * MiB, OFF_SSQKV = 106 * MiB;
constexpr size_t OFF_BAR = 107 * MiB;
constexpr size_t OFF_MN = 108 * MiB;
constexpr size_t OFF_KM = 116 * MiB;
constexpr size_t OFF_VMT = 132 * MiB;
constexpr size_t OFF_XN = 148 * MiB;
constexpr size_t OFF_O = 276 * MiB;
constexpr size_t OFF_R = 468 * MiB;
constexpr size_t OFF_CQ = OFF_R;
constexpr size_t OFF_CKV = OFF_CQ + 32 * MiB;
constexpr size_t OFF_KPE = OFF_CKV + 16 * MiB;
constexpr size_t OFF_QD = OFF_KPE + 4 * MiB;
constexpr size_t OFF_KD = OFF_QD + 64 * MiB;
constexpr size_t OFF_VDT = OFF_KD + 64 * MiB;
constexpr size_t OFF_QX = OFF_VDT + 64 * MiB;
constexpr size_t OFF_QA = OFF_QX + 64 * MiB;
constexpr size_t OFF_KN = OFF_QA + 96 * MiB;
constexpr size_t OFF_VAT = OFF_KN + 64 * MiB;
constexpr size_t WS_END = OFF_VAT + 64 * MiB;
constexpr size_t OFF_S = OFF_R;
constexpr size_t OFF_MERGED = OFF_R + 384 * MiB;
constexpr size_t OFF_OUT = OFF_R;
static_assert(4 * WL_TOTAL * 2 <= OFF_COS && OFF_MERGED + 128 * MiB <= WS_END, "ws map");

constexpr int LDS_BYTES = 163840;
constexpr int NPHASE = 1 + 7 * DEPTH;

__device__ __forceinline__ unsigned cvtpk(float lo, float hi) { f32x2_t v = {lo, hi}; bf16x2_t b = __builtin_convertvector(v, bf16x2_t); return __builtin_bit_cast(unsigned, b); }
__device__ __forceinline__ void store4bf(bf16_t* p, f32x4 v) { u32x2 w; w.x = cvtpk(v[0], v[1]); w.y = cvtpk(v[2], v[3]); *(u32x2*)p = w; }
__device__ __forceinline__ f32x4 unpack4bf(u32x2 w) { f32x4 r; r[0] = __uint_as_float(w.x << 16); r[1] = __uint_as_float(w.x & 0xffff0000u); r[2] = __uint_as_float(w.y << 16); r[3] = __uint_as_float(w.y & 0xffff0000u); return r; }
__device__ __forceinline__ void store8bf(bf16_t* p, f32x4 a, f32x4 b) { u32x4 w; w.x = cvtpk(a[0], a[1]); w.y = cvtpk(a[2], a[3]); w.z = cvtpk(b[0], b[1]); w.w = cvtpk(b[2], b[3]); *(u32x4*)p = w; }
__device__ __forceinline__ float fast_rcp(float x) { return __builtin_amdgcn_rcpf(x); }
__device__ __forceinline__ float fast_exp2(float x) { return __builtin_amdgcn_exp2f(x); }
__device__ __forceinline__ float sigmoidf_(float v) { return fast_rcp(1.0f + fast_exp2(-v * LOG2E)); }

namespace pg8 {
constexpr int BM = 256, BK = 64, HALF = 128, HTB = HALF * BK * 2, STAGE_BYTES = 8 * HTB, NXCD = 8, WGM = 8;
__host__ __device__ __forceinline__ int lds_byte(int r, int c) { const int st = (r >> 4) * 2 + (c >> 5), rr = r & 15, cc = c & 31, ob = rr * 64 + cc * 2; return st * 1024 + (ob ^ (((ob >> 9) & 1) << 5)); }
__host__ __device__ __forceinline__ void stage_rc(int b, int& R, int& C) { const int st = b / 1024, sb = b % 1024, swz = sb ^ (((sb >> 9) & 1) << 5); R = (st >> 1) * 16 + swz / 64; C = (st & 1) * 32 + (swz % 64) / 2; }

__host__ __device__ __forceinline__ int perm32(int rho) { const int n = rho >> 4, i = rho & 15; return 8 * (i >> 2) + 4 * n + (i & 3); }
struct Unit { int pm, pn, z; };
struct Gemm { const bf16_t* A; const bf16_t* Bt; int M, N, K, lda, ldb; size_t zA, zB; };

struct StaticOrder {
    int nM, nN, nwg, G, c, nz;
    __device__ void init(int M, int N, int G_, int c_, int nz_ = 1) { nM = M / BM; nN = N / BM; nwg = nM * nN; G = G_; c = c_; nz = nz_; }
    __device__ bool next(int i, Unit& u) const {
        const int ib = i / nz; u.z = i - ib * nz;
        const long L = (long)ib * G + c; if (L >= nwg) return false;
        int wgid = (int)L; { const int q = nwg / NXCD, r = nwg % NXCD, xcd = wgid % NXCD, off = wgid / NXCD; wgid = (xcd < r ? xcd * (q + 1) : r * (q + 1) + (xcd - r) * q) + off; }
        const int nig = WGM * nN, gid = wgid / nig, fm = gid * WGM, gsz = (nM - fm) < WGM ? (nM - fm) : WGM;
        u.pm = fm + ((wgid % nig) % gsz); u.pn = (wgid % nig) / gsz; return true;
    }
};

template <class Epi>
__device__ __forceinline__ void gemm_phase(LAS unsigned char* lds, const Gemm g, const StaticOrder& S, const Epi& E) {
    int tid = threadIdx.x; asm volatile("" : "+v"(tid));
    const int wid = __builtin_amdgcn_readfirstlane(tid >> 6), lane = tid & 63, wr = wid >> 2, wc = wid & 3, fr = lane & 15, fq = lane >> 4;
    int K = g.K; asm volatile("" : "+s"(K)); const int nt = K / BK;
    unsigned voffA[2], voffB[2];
#pragma unroll
    for (int i = 0; i < 2; ++i) { int R, C; stage_rc(tid * 16 + i * 8192, R, C);
        const int Rb = Epi::PERM ? ((R & ~31) + perm32(R & 31)) : R;
        voffA[i] = (unsigned)(R * g.lda + C) * 2u; voffB[i] = (unsigned)(Rb * g.ldb + C) * 2u; }
    const size_t kstep = (size_t)(BK * 2);
    const size_t hstepA = (size_t)HALF * g.lda * 2, hstepB = (size_t)HALF * g.ldb * 2;
    const size_t tstepA = 2 * hstepA, tstepB = 2 * hstepB;
    const unsigned ldsw = (unsigned)wid * 1024u;
    const int aoff = lds_byte(wr * 64 + fr, fq * 8), boff = lds_byte(wc * 32 + fr, fq * 8);
#define PG8_SA(b, h) (((b) * 2 + (h)) * HTB)
#define PG8_SB(b, h) ((4 + (b) * 2 + (h)) * HTB)
#define PG8_STAGE(bufoff, gbase, voff) do { _Pragma("unroll") for (int _i = 0; _i < 2; ++_i) \
        __builtin_amdgcn_global_load_lds((const unsigned*)((const char*)(gbase) + (voff)[_i]), (LAS unsigned*)(lds + (bufoff) + ldsw + _i * 8192), 16, 0, 0); } while (0)
#define PG8_LDA(dst, b, h) do { _Pragma("unroll") for (int m = 0; m < 4; ++m) _Pragma("unroll") for (int k = 0; k < 2; ++k) dst[m][k] = *(const LAS bf16x8*)(lds + PG8_SA(b, h) + aoff + m * 2048 + k * 1024); } while (0)
#define PG8_LDB(dst, b, h) do { _Pragma("unroll") for (int n = 0; n < 2; ++n) _Pragma("unroll") for (int k = 0; k < 2; ++k) dst[n][k] = *(const LAS bf16x8*)(lds + PG8_SB(b, h) + boff + n * 2048 + k * 1024); } while (0)
#define PG8_MMA(ai, bj, At, Bt) do { __builtin_amdgcn_s_setprio(1); _Pragma("unroll") for (int m = 0; m < 4; ++m) _Pragma("unroll") for (int n = 0; n < 2; ++n) _Pragma("unroll") for (int k = 0; k < 2; ++k) \
        acc[ai][bj][m][n] = __builtin_amdgcn_mfma_f32_16x16x32_bf16(Bt[n][k], At[m][k], acc[ai][bj][m][n], 0, 0, 0); __builtin_amdgcn_s_setprio(0); } while (0)
#define PG8_WAIT_V(n) asm volatile("s_waitcnt vmcnt(" #n ")" ::: "memory")
#define PG8_WAIT_L(n) asm volatile("s_waitcnt lgkmcnt(" #n ")" ::: "memory")
#define PG8_BAR __builtin_amdgcn_s_barrier()
#define PG8_SCHED __builtin_amdgcn_sched_barrier(0)
    Unit cur, nxt; int ui = 0;
    if (!S.next(0, cur)) return;
    f32x4 acc[2][2][4][2];
#pragma unroll
    for (int a = 0; a < 2; ++a)
#pragma unroll
        for (int b = 0; b < 2; ++b)
#pragma unroll
            for (int m = 0; m < 4; ++m)
#pragma unroll
                for (int n = 0; n < 2; ++n) acc[a][b][m][n] = (f32x4){0.f, 0.f, 0.f, 0.f};
    bf16x8 At[4][2], B0[2][2], B1[2][2];
    const char* cA = (const char*)g.A + ((size_t)cur.z * g.zA) * 2 + (size_t)cur.pm * tstepA;
    const char* cB = (const char*)g.Bt + ((size_t)cur.z * g.zB) * 2 + (size_t)cur.pn * tstepB;
    PG8_STAGE(PG8_SB(0, 0), cB, voffB); PG8_STAGE(PG8_SB(0, 1), cB + hstepB, voffB); PG8_STAGE(PG8_SA(0, 0), cA, voffA); PG8_STAGE(PG8_SA(0, 1), cA + hstepA, voffA);
    if (wr == 1) PG8_BAR;
    PG8_WAIT_V(2); PG8_BAR;
    PG8_STAGE(PG8_SB(1, 0), cB + kstep, voffB); PG8_STAGE(PG8_SA(1, 0), cA + kstep, voffA); PG8_STAGE(PG8_SB(1, 1), cB + hstepB + kstep, voffB);
    PG8_WAIT_V(6); PG8_BAR;
    for (;;) {
        const bool has_next = S.next(ui + 1, nxt);
        const char* nA = has_next ? (const char*)g.A + ((size_t)nxt.z * g.zA) * 2 + (size_t)nxt.pm * tstepA : cA;
        const char* nB = has_next ? (const char*)g.Bt + ((size_t)nxt.z * g.zB) * 2 + (size_t)nxt.pn * tstepB : cB;
        for (int t = 0; t < nt; t += 2) {
            const bool last = (t == nt - 2);
            const char* a1 = cA + (size_t)(t + 1) * kstep;
            const char* a2 = last ? nA : cA + (size_t)(t + 2) * kstep; const char* b2 = last ? nB : cB + (size_t)(t + 2) * kstep;
            const char* a3 = a2 + kstep; const char* b3 = b2 + kstep;
            PG8_LDB(B0, 0, 0); PG8_LDB(B1, 0, 1); PG8_SCHED; PG8_LDA(At, 0, 0); PG8_STAGE(PG8_SA(1, 1), a1 + hstepA, voffA);
            PG8_WAIT_V(8); PG8_WAIT_L(0); PG8_BAR; PG8_MMA(0, 0, At, B0); PG8_MMA(0, 1, At, B1); PG8_BAR; PG8_SCHED;
            PG8_LDA(At, 0, 1); PG8_STAGE(PG8_SB(0, 0), b2, voffB); PG8_STAGE(PG8_SB(0, 1), b2 + hstepB, voffB); PG8_STAGE(PG8_SA(0, 0), a2, voffA);
            PG8_WAIT_V(8); PG8_WAIT_L(0); PG8_BAR; PG8_MMA(1, 0, At, B0); PG8_MMA(1, 1, At, B1); PG8_BAR; PG8_SCHED;
            PG8_LDB(B0, 1, 0); PG8_LDB(B1, 1, 1); PG8_SCHED; PG8_LDA(At, 1, 0); PG8_STAGE(PG8_SA(0, 1), a2 + hstepA, voffA);
            PG8_WAIT_V(8); PG8_WAIT_L(0); PG8_BAR; PG8_MMA(0, 0, At, B0); PG8_MMA(0, 1, At, B1); PG8_BAR; PG8_SCHED;
            PG8_LDA(At, 1, 1); PG8_STAGE(PG8_SB(1, 0), b3, voffB); PG8_STAGE(PG8_SB(1, 1), b3 + hstepB, voffB); PG8_STAGE(PG8_SA(1, 0), a3, voffA);
            PG8_WAIT_V(8); PG8_WAIT_L(0); PG8_BAR; PG8_MMA(1, 0, At, B0); PG8_MMA(1, 1, At, B1); PG8_BAR; PG8_SCHED;
        }
        if (wr == 0) PG8_BAR;
        E(acc, cur, wr, wc, fr, fq);
        if (!has_next) break;
#pragma unroll
        for (int a = 0; a < 2; ++a)
#pragma unroll
            for (int b = 0; b < 2; ++b)
#pragma unroll
                for (int m = 0; m < 4; ++m)
#pragma unroll
                    for (int n = 0; n < 2; ++n) acc[a][b][m][n] = (f32x4){0.f, 0.f, 0.f, 0.f};
        cur = nxt; cA = nA; cB = nB; ++ui;
        if (wr == 1) PG8_BAR;
    }
    PG8_WAIT_V(0);
    PG8_BAR;
    asm volatile("" ::: "memory"); PG8_SCHED;
#undef PG8_SA
#undef PG8_SB
#undef PG8_STAGE
#undef PG8_LDA
#undef PG8_LDB
#undef PG8_MMA
#undef PG8_WAIT_V
#undef PG8_WAIT_L
#undef PG8_BAR
#undef PG8_SCHED
}

#define EPI_ROWS_BEGIN _Pragma("unroll") for (int ai = 0; ai < 2; ++ai) _Pragma("unroll") for (int m = 0; m < 4; ++m) { const int row = u.pm * BM + ai * HALF + wr * 64 + m * 16 + fr;
#define EPI_ROWS_END if (m & 1) asm volatile("" ::: "memory"); }
#define EPI_COLS_BEGIN _Pragma("unroll") for (int bj = 0; bj < 2; ++bj) _Pragma("unroll") for (int n = 0; n < 2; ++n) { const int colt = bj * HALF + wc * 32 + n * 16 + 4 * fq;
#define EPI_COLS_END }
typedef f32x4 Acc[2][2][4][2];

__device__ __forceinline__ float rstd4(const float* ssq, int row, float inv_dim) { const f32x4 p = *(const f32x4*)(ssq + (size_t)row * 4); return __builtin_amdgcn_rsqf(((p[0] + p[1]) + (p[2] + p[3])) * inv_dim + NORM_EPS); }

struct Epi1 {
    static constexpr bool PERM = false;
    bf16_t *CQ, *CKV, *KPE, *QD, *KD, *QX; float *SSQq, *SSQkv; const float *COS, *SIN; float sc_d, sc_x;
    __device__ __forceinline__ void operator()(const Acc& acc, const Unit& u, int wr, int wc, int fr, int fq) const {
        const int pn = u.pn;
        EPI_ROWS_BEGIN
            const float r = 1.0f;
            if (pn == 0) {
                float ss = 0.f;
                EPI_COLS_BEGIN const f32x4 v = acc[ai][bj][m][n] * r; ss += (v[0] * v[0] + v[1] * v[1]) + (v[2] * v[2] + v[3] * v[3]); store4bf(CQ + (size_t)row * 256 + colt, v); EPI_COLS_END
                ss += __shfl_xor(ss, 16); ss += __shfl_xor(ss, 32);
                if (fq == 0) SSQq[(size_t)row * 4 + wc] = ss;
            } else if (pn == 1) {
                float ss = 0.f;
#pragma unroll
                for (int n = 0; n < 2; ++n) { const f32x4 v = acc[ai][0][m][n] * r; ss += (v[0] * v[0] + v[1] * v[1]) + (v[2] * v[2] + v[3] * v[3]); store4bf(CKV + (size_t)row * 128 + wc * 32 + n * 16 + 4 * fq, v); }
                ss += __shfl_xor(ss, 16); ss += __shfl_xor(ss, 32);
                if (fq == 0) SSQkv[(size_t)row * 4 + wc] = ss;
                if (wc == 0) {
                    const int s = row & (SEQ - 1); const f32x4 cs = *(const f32x4*)(COS + s * 16 + 4 * fq), sn = *(const f32x4*)(SIN + s * 16 + 4 * fq);
                    const f32x4 x1 = acc[ai][1][m][0] * r, x2 = acc[ai][1][m][1] * r;
                    store4bf(KPE + (size_t)row * 32 + 4 * fq, x1 * cs - x2 * sn); store4bf(KPE + (size_t)row * 32 + 16 + 4 * fq, x2 * cs + x1 * sn);
                }
            } else if (pn < 6) {
                bf16_t* dst = (pn < 4 ? QD : KD) + (size_t)row * 512 + (pn & 1) * 256 + wc * 32 + 4 * fq; const float sc = (pn < 4 ? sc_d : 1.0f) * r;
                const int s = row & (SEQ - 1); const f32x4 cs = *(const f32x4*)(COS + s * 16 + 4 * fq), sn = *(const f32x4*)(SIN + s * 16 + 4 * fq);
#pragma unroll
                for (int bj = 0; bj < 2; ++bj) { const f32x4 x1 = acc[ai][bj][m][0] * sc, x2 = acc[ai][bj][m][1] * sc;
                    store4bf(dst + bj * HALF, x1 * cs - x2 * sn); store4bf(dst + bj * HALF + 16, x2 * cs + x1 * sn); }
            } else {
                const float sc = sc_x * r;
                EPI_COLS_BEGIN store4bf(QX + (size_t)row * 512 + (pn - 6) * 256 + colt, acc[ai][bj][m][n] * sc); EPI_COLS_END
            }
        EPI_ROWS_END
    }
};
#define EPIP_BJ_BEGIN _Pragma("unroll") for (int bj = 0; bj < 2; ++bj) { const int colt = bj * HALF + wc * 32 + 8 * fq;
#define EPIP_BJ_END }
struct EpiT {
    static constexpr bool PERM = true;
    bf16_t* O; size_t ldc; size_t zO; const float* ssq; float inv_dim; const float* colscale;
    __device__ __forceinline__ void operator()(const Acc& acc, const Unit& u, int wr, int wc, int fr, int fq) const {
        f32x4 cs[2][2];
        EPIP_BJ_BEGIN
            const int col = u.pn * BM + colt;
#pragma unroll
            for (int n = 0; n < 2; ++n) {
                if (ssq) { for (int i = 0; i < 4; ++i) cs[bj][n][i] = rstd4(ssq, col + 4 * n + i, inv_dim); }
                else cs[bj][n] = (f32x4){1.f, 1.f, 1.f, 1.f}; }
        EPIP_BJ_END
        bf16_t* base = O + (size_t)u.z * zO;
        EPI_ROWS_BEGIN
            EPIP_BJ_BEGIN store8bf(base + (size_t)row * ldc + u.pn * BM + colt, acc[ai][bj][m][0] * cs[bj][0], acc[ai][bj][m][1] * cs[bj][1]); EPIP_BJ_END
        EPI_ROWS_END
    }
};
struct EpiRow {
    static constexpr bool PERM = true;
    bf16_t* O; size_t ldc; size_t zO; const float* ssq; float inv_dim;
    __device__ __forceinline__ void operator()(const Acc& acc, const Unit& u, int wr, int wc, int fr, int fq) const {
        bf16_t* base = O + (size_t)u.z * zO;
        EPI_ROWS_BEGIN
            const float sc = ssq ? rstd4(ssq, row, inv_dim) : 1.0f;
            EPIP_BJ_BEGIN store8bf(base + (size_t)row * ldc + u.pn * BM + colt, acc[ai][bj][m][0] * sc, acc[ai][bj][m][1] * sc); EPIP_BJ_END
        EPI_ROWS_END
    }
};
struct Epi2 {
    static constexpr bool PERM = false;
    bf16_t* QA; const float* SSQq; const float *COS, *SIN; float sc_a;
    __device__ __forceinline__ void operator()(const Acc& acc, const Unit& u, int wr, int wc, int fr, int fq) const {
        EPI_ROWS_BEGIN
            const float sc = rstd4(SSQq, row, 1.0f / 256.0f) * sc_a;
            if (u.pn < 2) {
                EPI_COLS_BEGIN const int nn = u.pn * BM + colt; store4bf(QA + (size_t)row * 768 + (nn >> 6) * 96 + (nn & 63), acc[ai][bj][m][n] * sc); EPI_COLS_END
            } else {
                const int s = row & (SEQ - 1); const f32x4 cs = *(const f32x4*)(COS + s * 16 + 4 * fq), sn = *(const f32x4*)(SIN + s * 16 + 4 * fq);
#pragma unroll
                for (int bj = 0; bj < 2; ++bj) { const f32x4 x1 = acc[ai][bj][m][0] * sc, x2 = acc[ai][bj][m][1] * sc; bf16_t* dst = QA + (size_t)row * 768 + (4 * bj + wc) * 96 + 64 + 4 * fq;
                    store4bf(dst, x1 * cs - x2 * sn); store4bf(dst + 16, x2 * cs + x1 * sn); }
            }
        EPI_ROWS_END
    }
};
struct EpiSG {
    static constexpr bool PERM = true;
    bf16_t* O;
    __device__ __forceinline__ void operator()(const Acc& acc, const Unit& u, int wr, int wc, int fr, int fq) const {
#pragma unroll
        for (int ai = 0; ai < 2; ++ai) {
            u32x4 ov[4][2];
#pragma unroll
            for (int m = 0; m < 4; ++m) { const int row = u.pm * BM + ai * HALF + wr * 64 + m * 16 + fr;
                EPIP_BJ_BEGIN ov[m][bj] = *(const u32x4*)(O + (size_t)row * 1536 + u.pn * BM + colt); EPIP_BJ_END }
#pragma unroll
            for (int m = 0; m < 4; ++m) { const int row = u.pm * BM + ai * HALF + wr * 64 + m * 16 + fr;
                EPIP_BJ_BEGIN u32x2 lo_, hi_; lo_.x = ov[m][bj].x; lo_.y = ov[m][bj].y; hi_.x = ov[m][bj].z; hi_.y = ov[m][bj].w;
                    const f32x4 o0 = unpack4bf(lo_), o1 = unpack4bf(hi_); const f32x4 g0 = acc[ai][bj][m][0], g1 = acc[ai][bj][m][1]; f32x4 v0, v1;
#pragma unroll
                    for (int i = 0; i < 4; ++i) { v0[i] = o0[i] * g0[i] * sigmoidf_(g0[i]); v1[i] = o1[i] * g1[i] * sigmoidf_(g1[i]); }
                    store8bf(O + (size_t)row * 1536 + u.pn * BM + colt, v0, v1); EPIP_BJ_END }
            asm volatile("" ::: "memory");
        }
    }
};
struct EpiGL {
    static constexpr bool PERM = true;
    bf16_t* S; const float* bias;
    __device__ __forceinline__ void operator()(const Acc& acc, const Unit& u, int wr, int wc, int fr, int fq) const {
        f32x4 bv[2][2];
        EPIP_BJ_BEGIN bv[bj][0] = *(const f32x4*)(bias + u.pn * BM + colt); bv[bj][1] = *(const f32x4*)(bias + u.pn * BM + colt + 4); EPIP_BJ_END
        EPI_ROWS_BEGIN
            EPIP_BJ_BEGIN const f32x4 g0 = acc[ai][bj][m][0] + bv[bj][0], g1 = acc[ai][bj][m][1] + bv[bj][1]; f32x4 v0, v1;
#pragma unroll
                for (int i = 0; i < 4; ++i) { v0[i] = sigmoidf_(g0[i]); v1[i] = sigmoidf_(g1[i]); }
                store8bf(S + (size_t)row * 3072 + u.pn * BM + colt, v0, v1); EPIP_BJ_END
        EPI_ROWS_END
    }
};
struct EpiBR {
    static constexpr bool PERM = true;
    const bf16_t* S; bf16_t* MG;
    __device__ __forceinline__ void operator()(const Acc& acc, const Unit& u, int wr, int wc, int fr, int fq) const {
#pragma unroll
        for (int ai = 0; ai < 2; ++ai) {
            u32x4 sv[4][2]; unsigned long long mv[4][2][2];
#pragma unroll
            for (int m = 0; m < 4; ++m) { const int row = u.pm * BM + ai * HALF + wr * 64 + m * 16 + fr;
                EPIP_BJ_BEGIN const int col = u.pn * BM + colt; sv[m][bj] = *(const u32x4*)(S + (size_t)row * 3072 + u.z * 1024 + col);
                    const unsigned long long* mp_ = (const unsigned long long*)(MG + (size_t)row * 1024 + col);
                    mv[m][bj][0] = (u.z > 0) ? __hip_atomic_load(mp_, __ATOMIC_RELAXED, __HIP_MEMORY_SCOPE_AGENT) : 0ull;
                    mv[m][bj][1] = (u.z > 0) ? __hip_atomic_load(mp_ + 1, __ATOMIC_RELAXED, __HIP_MEMORY_SCOPE_AGENT) : 0ull; EPIP_BJ_END }
#pragma unroll
            for (int m = 0; m < 4; ++m) { const int row = u.pm * BM + ai * HALF + wr * 64 + m * 16 + fr;
                EPIP_BJ_BEGIN const int col = u.pn * BM + colt; u32x2 lo_, hi_; lo_.x = sv[m][bj].x; lo_.y = sv[m][bj].y; hi_.x = sv[m][bj].z; hi_.y = sv[m][bj].w;
                    f32x4 v0 = unpack4bf(lo_) * acc[ai][bj][m][0], v1 = unpack4bf(hi_) * acc[ai][bj][m][1];
                    u32x2 w0, w1; w0.x = (unsigned)mv[m][bj][0]; w0.y = (unsigned)(mv[m][bj][0] >> 32); w1.x = (unsigned)mv[m][bj][1]; w1.y = (unsigned)(mv[m][bj][1] >> 32);
                    v0 += unpack4bf(w0); v1 += unpack4bf(w1);
                    store8bf(MG + (size_t)row * 1024 + col, v0, v1); EPIP_BJ_END }
            asm volatile("" ::: "memory");
        }
    }
};
struct EpiOut {
    static constexpr bool PERM = false;
    float* OUT;
    __device__ __forceinline__ void operator()(const Acc& acc, const Unit& u, int wr, int wc, int fr, int fq) const {
        EPI_ROWS_BEGIN
            EPI_COLS_BEGIN *(f32x4*)(OUT + (size_t)row * 1024 + u.pn * BM + colt) = acc[ai][bj][m][n]; EPI_COLS_END
        EPI_ROWS_END
    }
};
}

__device__ __forceinline__ float half_max(float v) { auto rr = __builtin_amdgcn_permlane32_swap(__float_as_uint(v), __float_as_uint(v), false, false); return fmaxf(__uint_as_float(rr[0]), __uint_as_float(rr[1])); }
__device__ __forceinline__ float half_sum(float v) { auto rr = __builtin_amdgcn_permlane32_swap(__float_as_uint(v), __float_as_uint(v), false, false); return __uint_as_float(rr[0]) + __uint_as_float(rr[1]); }
__device__ __forceinline__ int crow(int r, int hi) { return (r & 3) + 8 * (r >> 2) + 4 * hi; }

template <int NMAP, int DKM, int DV, bool CAUSAL, int W0, int W1>
__device__ __forceinline__ void attn_unit(LAS unsigned char* lds, const bf16_t* __restrict__ Q, int ldq, const bf16_t* __restrict__ K0, int ldk0, const bf16_t* __restrict__ K1, int ldk1,
                                          const bf16_t* __restrict__ Vt, size_t ldv, int q0, int NT, bf16_t* O, int ldo, float lam, const float* subln, float outscale) {
    constexpr int DKT = NMAP * DKM, KS = DKT * 2 + 16, VS = 136, KBUF = 64 * KS, VBUF = DV * VS;
    constexpr int NC = DKM / 16, NDB = DV / 32;
    constexpr int K0C = W0 / 8, K0N = (64 * K0C) / 512, K1C = W1 / 8, VN = (DV * 8) / 512;
    static_assert(W0 + W1 == DKT && K0N >= 1 && VN >= 1, "attention staging geometry");
    int tid = threadIdx.x; asm volatile("" : "+v"(tid));
    const int lane = tid & 63, wid = __builtin_amdgcn_readfirstlane(tid >> 6), r32 = lane & 31, hi = lane >> 5;
    LAS unsigned char* Kb = lds; LAS unsigned char* Vb = lds + 2 * KBUF;
    bf16x8 qf[NMAP][NC];
    { const bf16_t* qrow = Q + (size_t)(q0 + wid * 32 + r32) * ldq;
#pragma unroll
      for (int mp = 0; mp < NMAP; ++mp)
#pragma unroll
          for (int c = 0; c < NC; ++c) qf[mp][c] = *(const bf16x8*)(qrow + mp * DKM + 16 * c + 8 * hi); }
    f32x16 o[NMAP][NDB]; float mrow[NMAP], lrow[NMAP];
#pragma unroll
    for (int mp = 0; mp < NMAP; ++mp) { mrow[mp] = -INFINITY; lrow[mp] = 0.f;
#pragma unroll
        for (int db = 0; db < NDB; ++db)
#pragma unroll
            for (int r = 0; r < 16; ++r) o[mp][db][r] = 0.f; }
    u32x4 kreg[K0N], k1reg = {0u, 0u, 0u, 0u}, vreg[VN];
#define ATT_GLOAD(t) do { \
    _Pragma("unroll") for (int i = 0; i < K0N; ++i) { const int idx = tid + 512 * i, rr = idx / K0C, cc = idx % K0C; kreg[i] = *(const u32x4*)(K0 + (size_t)(64 * (t) + rr) * ldk0 + cc * 8); } \
    if (W1 > 0) { if (tid < 64 * K1C) { const int rr = tid / (K1C > 0 ? K1C : 1), cc = tid % (K1C > 0 ? K1C : 1); k1reg = *(const u32x4*)(K1 + (size_t)(64 * (t) + rr) * ldk1 + cc * 8); } } \
    _Pragma("unroll") for (int i = 0; i < VN; ++i) { const int idx = tid + 512 * i, dd = idx >> 3, cc = idx & 7; vreg[i] = *(const u32x4*)(Vt + (size_t)dd * ldv + 64 * (t) + cc * 8); } } while (0)
#define ATT_LWRITE(buf) do { \
    _Pragma("unroll") for (int i = 0; i < K0N; ++i) { const int idx = tid + 512 * i, rr = idx / K0C, cc = idx % K0C; *(LAS u32x4*)(Kb + (buf) * KBUF + rr * KS + cc * 16) = kreg[i]; } \
    if (W1 > 0) { if (tid < 64 * K1C) { const int rr = tid / (K1C > 0 ? K1C : 1), cc = tid % (K1C > 0 ? K1C : 1); *(LAS u32x4*)(Kb + (buf) * KBUF + rr * KS + W0 * 2 + cc * 16) = k1reg; } } \
    _Pragma("unroll") for (int i = 0; i < VN; ++i) { const int idx = tid + 512 * i, dd = idx >> 3, cc = idx & 7; LAS u32x2* vp = (LAS u32x2*)(Vb + (buf) * VBUF + dd * VS + cc * 16); \
        u32x2 lo_; lo_.x = vreg[i].x; lo_.y = vreg[i].y; u32x2 hi_; hi_.x = vreg[i].z; hi_.y = vreg[i].w; vp[0] = lo_; vp[1] = hi_; } } while (0)
    ATT_GLOAD(0);
    ATT_LWRITE(0);
    __syncthreads();
    const int qw0 = q0 + wid * 32;
    for (int t = 0; t < NT; ++t) {
        const int buf = t & 1;
        if (t + 1 < NT) ATT_GLOAD(t + 1);
#pragma unroll
        for (int kb = 0; kb < 2; ++kb) {
            const int kv0 = 64 * t + 32 * kb;
            if (CAUSAL && kv0 > qw0) continue;
            const bool diag = CAUSAL && (kv0 == qw0);
            bf16x8 vf[NDB][2];
#pragma unroll
            for (int db = 0; db < NDB; ++db)
#pragma unroll
                for (int j = 0; j < 2; ++j) { const LAS unsigned char* vp = Vb + buf * VBUF + (32 * db + r32) * VS + (32 * kb + 16 * j + 4 * hi) * 2;
                    const s16x4 lo = *(const LAS s16x4*)vp, hh = *(const LAS s16x4*)(vp + 16);
                    vf[db][j] = (bf16x8){lo[0], lo[1], lo[2], lo[3], hh[0], hh[1], hh[2], hh[3]}; }
#pragma unroll
            for (int mp = 0; mp < NMAP; ++mp) {
                f32x16 s;
#pragma unroll
                for (int r = 0; r < 16; ++r) s[r] = 0.f;
#pragma unroll
                for (int c = 0; c < NC; ++c) { const bf16x8 kf = *(const LAS bf16x8*)(Kb + buf * KBUF + (32 * kb + r32) * KS + (mp * DKM + 16 * c + 8 * hi) * 2);
                    s = __builtin_amdgcn_mfma_f32_32x32x16_bf16(kf, qf[mp][c], s, 0, 0, 0); }
                if (diag) {
#pragma unroll
                    for (int r = 0; r < 16; ++r) if (crow(r, hi) > r32) s[r] = -INFINITY;
                }
                float mx = s[0];
#pragma unroll
                for (int r = 1; r < 16; ++r) mx = fmaxf(mx, s[r]);
                mx = fmaxf(mx, __shfl_xor(mx, 32));
                if (__any(mx > mrow[mp])) {
                    const float mnew = fmaxf(mrow[mp], mx), alpha = fast_exp2(mrow[mp] - mnew);
                    mrow[mp] = mnew; lrow[mp] *= alpha;
#pragma unroll
                    for (int db = 0; db < NDB; ++db)
#pragma unroll
                        for (int r = 0; r < 16; ++r) o[mp][db][r] *= alpha;
                }
                const float mcur = mrow[mp]; float ls = 0.f;
#pragma unroll
                for (int r = 0; r < 16; ++r) { s[r] = fast_exp2(s[r] - mcur); ls += s[r]; }
                lrow[mp] += ls;
                bf16x8 pa[2];
#pragma unroll
                for (int j = 0; j < 2; ++j) { u32x4 w; w.x = cvtpk(s[8 * j + 0], s[8 * j + 1]); w.y = cvtpk(s[8 * j + 2], s[8 * j + 3]); w.z = cvtpk(s[8 * j + 4], s[8 * j + 5]); w.w = cvtpk(s[8 * j + 6], s[8 * j + 7]); pa[j] = __builtin_bit_cast(bf16x8, w); }
#pragma unroll
                for (int db = 0; db < NDB; ++db)
#pragma unroll
                    for (int j = 0; j < 2; ++j) o[mp][db] = __builtin_amdgcn_mfma_f32_32x32x16_bf16(vf[db][j], pa[j], o[mp][db], 0, 0, 0);
            }
        }
        if (t + 1 < NT) ATT_LWRITE(buf ^ 1);
        __syncthreads();
    }
#undef ATT_GLOAD
#undef ATT_LWRITE
    float inv[NMAP];
#pragma unroll
    for (int mp = 0; mp < NMAP; ++mp) { const float lt = lrow[mp] + __shfl_xor(lrow[mp], 32); inv[mp] = 1.0f / lt; }
    bf16_t* orow = O + (size_t)(q0 + wid * 32 + r32) * ldo;
    if constexpr (NMAP == 1) {
#pragma unroll
        for (int db = 0; db < NDB; ++db)
#pragma unroll
            for (int g = 0; g < 4; ++g) { f32x4 v; for (int i = 0; i < 4; ++i) v[i] = o[0][db][4 * g + i] * inv[0]; store4bf(orow + 32 * db + 8 * g + 4 * hi, v); }
    } else {
        float ss = 0.f;
#pragma unroll
        for (int db = 0; db < NDB; ++db)
#pragma unroll
            for (int r = 0; r < 16; ++r) { const float v = o[0][db][r] * inv[0] - lam * (o[1][db][r] * inv[1]); o[0][db][r] = v; ss += v * v; }
        ss += __shfl_xor(ss, 32);
        const float rstd = __builtin_amdgcn_rsqf(ss * (1.0f / DV) + NORM_EPS) * outscale;
#pragma unroll
        for (int db = 0; db < NDB; ++db)
#pragma unroll
            for (int g = 0; g < 4; ++g) { const f32x4 gn = *(const f32x4*)(subln + 32 * db + 8 * g + 4 * hi); f32x4 v; for (int i = 0; i < 4; ++i) v[i] = o[0][db][4 * g + i] * rstd * gn[i]; store4bf(orow + 32 * db + 8 * g + 4 * hi, v); }
    }
}

template <int NMAP, int DKM, int DV, int W0, int W1>
__device__ __forceinline__ void attn_unit2(LAS unsigned char* lds, const bf16_t* __restrict__ Q, int ldq, const bf16_t* __restrict__ K0, int ldk0, const bf16_t* __restrict__ K1, int ldk1,
                                           const bf16_t* __restrict__ Vt, size_t ldv, int q0, int NT, bf16_t* O, int ldo, float lam, const float* subln, float outscale) {
    constexpr int DKT = NMAP * DKM, KS = DKT * 2 + 16, VS = 136, KBUF = 64 * KS, VBUF = DV * VS;
    constexpr int NC = DKM / 16, NDB = DV / 32;
    constexpr int K0C = W0 / 8, K0N = (64 * K0C) / 512, K1C = W1 / 8, VN = (DV * 8) / 512;
    static_assert(W0 + W1 == DKT && K0N >= 1 && VN >= 1, "attention staging geometry");
    int tid = threadIdx.x; asm volatile("" : "+v"(tid));
    const int lane = tid & 63, wid = __builtin_amdgcn_readfirstlane(tid >> 6), r32 = lane & 31, hi = lane >> 5;
    LAS unsigned char* Kb = lds; LAS unsigned char* Vb = lds + 2 * KBUF;
    bf16x8 qf[NMAP][NC];
    { const bf16_t* qrow = Q + (size_t)(q0 + wid * 32 + r32) * ldq;
#pragma unroll
      for (int mp = 0; mp < NMAP; ++mp)
#pragma unroll
          for (int c = 0; c < NC; ++c) qf[mp][c] = *(const bf16x8*)(qrow + mp * DKM + 16 * c + 8 * hi); }
    f32x16 o[NMAP][NDB], negm[NMAP]; float lrow[NMAP];
#pragma unroll
    for (int mp = 0; mp < NMAP; ++mp) { lrow[mp] = 0.f;
#pragma unroll
        for (int r = 0; r < 16; ++r) negm[mp][r] = 0.f;
#pragma unroll
        for (int db = 0; db < NDB; ++db)
#pragma unroll
            for (int r = 0; r < 16; ++r) o[mp][db][r] = 0.f; }
    u32x4 kreg[K0N], k1reg = {0u, 0u, 0u, 0u}, vreg[VN];
#define ATT_GLOAD(t) do { \
    _Pragma("unroll") for (int i = 0; i < K0N; ++i) { const int idx = tid + 512 * i, rr = idx / K0C, cc = idx % K0C; kreg[i] = *(const u32x4*)(K0 + (size_t)(64 * (t) + rr) * ldk0 + cc * 8); } \
    if (W1 > 0) { if (tid < 64 * K1C) { const int rr = tid / (K1C > 0 ? K1C : 1), cc = tid % (K1C > 0 ? K1C : 1); k1reg = *(const u32x4*)(K1 + (size_t)(64 * (t) + rr) * ldk1 + cc * 8); } } \
    _Pragma("unroll") for (int i = 0; i < VN; ++i) { const int idx = tid + 512 * i, dd = idx >> 3, cc = idx & 7; vreg[i] = *(const u32x4*)(Vt + (size_t)dd * ldv + 64 * (t) + cc * 8); } } while (0)
#define ATT_LWRITE(buf) do { \
    _Pragma("unroll") for (int i = 0; i < K0N; ++i) { const int idx = tid + 512 * i, rr = idx / K0C, cc = idx % K0C; *(LAS u32x4*)(Kb + (buf) * KBUF + rr * KS + cc * 16) = kreg[i]; } \
    if (W1 > 0) { if (tid < 64 * K1C) { const int rr = tid / (K1C > 0 ? K1C : 1), cc = tid % (K1C > 0 ? K1C : 1); *(LAS u32x4*)(Kb + (buf) * KBUF + rr * KS + W0 * 2 + cc * 16) = k1reg; } } \
    _Pragma("unroll") for (int i = 0; i < VN; ++i) { const int idx = tid + 512 * i, dd = idx >> 3, cc = idx & 7; LAS u32x2* vp = (LAS u32x2*)(Vb + (buf) * VBUF + dd * VS + cc * 16); \
        u32x2 lo_; lo_.x = vreg[i].x; lo_.y = vreg[i].y; u32x2 hi_; hi_.x = vreg[i].z; hi_.y = vreg[i].w; vp[0] = lo_; vp[1] = hi_; } } while (0)
    ATT_GLOAD(0);
    ATT_LWRITE(0);
    __syncthreads();
    const int qw0 = q0 + wid * 32;
    for (int t = 0; t < NT; ++t) {
        const int buf = t & 1;
        if (t + 1 < NT) ATT_GLOAD(t + 1);
        const int kvt = 64 * t;
        if (kvt <= qw0) {
            const bool band = (kvt + 63 > qw0);
#pragma unroll
            for (int mp = 0; mp < NMAP; ++mp) {
                f32x16 s0, s1;
#pragma unroll
                for (int c = 0; c < NC; ++c) {
                    const bf16x8 kf0 = *(const LAS bf16x8*)(Kb + buf * KBUF + r32 * KS + (mp * DKM + 16 * c + 8 * hi) * 2);
                    const bf16x8 kf1 = *(const LAS bf16x8*)(Kb + buf * KBUF + (32 + r32) * KS + (mp * DKM + 16 * c + 8 * hi) * 2);
                    if (c == 0) { s0 = __builtin_amdgcn_mfma_f32_32x32x16_bf16(kf0, qf[mp][0], negm[mp], 0, 0, 0); s1 = __builtin_amdgcn_mfma_f32_32x32x16_bf16(kf1, qf[mp][0], negm[mp], 0, 0, 0); }
                    else { s0 = __builtin_amdgcn_mfma_f32_32x32x16_bf16(kf0, qf[mp][c], s0, 0, 0, 0); s1 = __builtin_amdgcn_mfma_f32_32x32x16_bf16(kf1, qf[mp][c], s1, 0, 0, 0); }
                }
                if (band) {
                    const int qd = qw0 + r32 - kvt;
#pragma unroll
                    for (int r = 0; r < 16; ++r) { const int kv = crow(r, hi); if (kv > qd) s0[r] = -INFINITY; if (kv + 32 > qd) s1[r] = -INFINITY; }
                }
                float mx = fmaxf(s0[0], s1[0]);
#pragma unroll
                for (int r = 1; r < 16; ++r) mx = fmaxf(mx, fmaxf(s0[r], s1[r]));
                mx = fmaxf(mx, __shfl_xor(mx, 32));
                if (__any(t == 0 || mx > 8.0f)) {
                    const float dl = (t == 0) ? mx : fmaxf(mx, 0.f), alpha = fast_exp2(-dl);
                    lrow[mp] *= alpha;
#pragma unroll
                    for (int r = 0; r < 16; ++r) { s0[r] -= dl; s1[r] -= dl; negm[mp][r] -= dl; }
#pragma unroll
                    for (int db = 0; db < NDB; ++db)
#pragma unroll
                        for (int r = 0; r < 16; ++r) o[mp][db][r] *= alpha;
                }
                float ls = 0.f;
#pragma unroll
                for (int kb = 0; kb < 2; ++kb) {
                    f32x16& s = kb ? s1 : s0;
                    bf16x8 vf[NDB][2];
#pragma unroll
                    for (int db = 0; db < NDB; ++db)
#pragma unroll
                        for (int j = 0; j < 2; ++j) { const LAS unsigned char* vp = Vb + buf * VBUF + (32 * db + r32) * VS + (32 * kb + 16 * j + 4 * hi) * 2;
                            const s16x4 lo = *(const LAS s16x4*)vp, hh = *(const LAS s16x4*)(vp + 16);
                            vf[db][j] = (bf16x8){lo[0], lo[1], lo[2], lo[3], hh[0], hh[1], hh[2], hh[3]}; }
#pragma unroll
                    for (int r = 0; r < 16; ++r) { s[r] = fast_exp2(s[r]); ls += s[r]; }
                    bf16x8 pa[2];
#pragma unroll
                    for (int j = 0; j < 2; ++j) { u32x4 w; w.x = cvtpk(s[8 * j + 0], s[8 * j + 1]); w.y = cvtpk(s[8 * j + 2], s[8 * j + 3]); w.z = cvtpk(s[8 * j + 4], s[8 * j + 5]); w.w = cvtpk(s[8 * j + 6], s[8 * j + 7]); pa[j] = __builtin_bit_cast(bf16x8, w); }
#pragma unroll
                    for (int db = 0; db < NDB; ++db)
#pragma unroll
                        for (int j = 0; j < 2; ++j) o[mp][db] = __builtin_amdgcn_mfma_f32_32x32x16_bf16(vf[db][j], pa[j], o[mp][db], 0, 0, 0);
                }
                lrow[mp] += ls;
                if (NMAP > 1) __builtin_amdgcn_sched_barrier(0);
            }
        }
        if (t + 1 < NT) ATT_LWRITE(buf ^ 1);
        __syncthreads();
    }
#undef ATT_GLOAD
#undef ATT_LWRITE
    float inv[NMAP];
#pragma unroll
    for (int mp = 0; mp < NMAP; ++mp) { const float lt = lrow[mp] + __shfl_xor(lrow[mp], 32); inv[mp] = 1.0f / lt; }
    bf16_t* orow = O + (size_t)(q0 + wid * 32 + r32) * ldo;
    if constexpr (NMAP == 1) {
#pragma unroll
        for (int db = 0; db < NDB; ++db)
#pragma unroll
            for (int g = 0; g < 4; ++g) { f32x4 v; for (int i = 0; i < 4; ++i) v[i] = o[0][db][4 * g + i] * inv[0]; store4bf(orow + 32 * db + 8 * g + 4 * hi, v); }
    } else {
        float ss = 0.f;
#pragma unroll
        for (int db = 0; db < NDB; ++db)
#pragma unroll
            for (int r = 0; r < 16; ++r) { const float v = o[0][db][r] * inv[0] - lam * (o[1][db][r] * inv[1]); o[0][db][r] = v; ss += v * v; }
        ss += __shfl_xor(ss, 32);
        const float rstd = __builtin_amdgcn_rsqf(ss * (1.0f / DV) + NORM_EPS) * outscale;
#pragma unroll
        for (int db = 0; db < NDB; ++db)
#pragma unroll
            for (int g = 0; g < 4; ++g) { const f32x4 gn = *(const f32x4*)(subln + 32 * db + 8 * g + 4 * hi); f32x4 v; for (int i = 0; i < 4; ++i) v[i] = o[0][db][4 * g + i] * rstd * gn[i]; store4bf(orow + 32 * db + 8 * g + 4 * hi, v); }
    }
}

template <int DKM, int DV, int W0, int W1>
__device__ __forceinline__ void attn_unit4(LAS unsigned char* lds, const bf16_t* __restrict__ Q, int ldq, const bf16_t* __restrict__ K0, int ldk0, const bf16_t* __restrict__ K1, int ldk1,
                                           const bf16_t* __restrict__ Vt, size_t ldv, int q0, int NT, bf16_t* O, int ldo) {
    constexpr int KS = DKM * 2 + 16, VS = 136, KBUF = 64 * KS, VBUF = DV * VS, QROW = DKM * 2 + 16;
    constexpr int NC = DKM / 16, NDB = DV / 32;
    constexpr int K0C = W0 / 8, K0N = (64 * K0C) / 512, K1C = W1 / 8, VN = (DV * 8) / 512;
    static_assert(W0 + W1 == DKM && K0N >= 1 && VN >= 1 && K1C >= 1, "attention staging geometry");
    static_assert(2 * KBUF + 2 * VBUF + 8 * 64 * QROW <= LDS_BYTES - 16, "attention LDS budget");
    int tid = threadIdx.x; asm volatile("" : "+v"(tid));
    const int lane = tid & 63, wid = __builtin_amdgcn_readfirstlane(tid >> 6), r32 = lane & 31, hi = lane >> 5;
    LAS unsigned char* Kb = lds; LAS unsigned char* Vb = lds + 2 * KBUF;
    LAS unsigned char* Qs = lds + 2 * KBUF + 2 * VBUF + wid * (64 * QROW) + r32 * QROW + 16 * hi;
#pragma unroll
    for (int rb = 0; rb < 2; ++rb) { const bf16_t* qrow = Q + (size_t)(q0 + wid * 64 + rb * 32 + r32) * ldq;
#pragma unroll
        for (int c = 0; c < NC; ++c) *(LAS bf16x8*)(Qs + rb * 32 * QROW + c * 32) = *(const bf16x8*)(qrow + 16 * c + 8 * hi); }
    f32x16 o[2][NDB], negm[2]; float lrow[2] = {0.f, 0.f};
#pragma unroll
    for (int rb = 0; rb < 2; ++rb) {
#pragma unroll
        for (int r = 0; r < 16; ++r) negm[rb][r] = 0.f;
#pragma unroll
        for (int db = 0; db < NDB; ++db)
#pragma unroll
            for (int r = 0; r < 16; ++r) o[rb][db][r] = 0.f; }
    u32x4 kreg[K0N], k1reg = {0u, 0u, 0u, 0u}, vreg[VN];
#define A4_GLOAD(t) do { \
    _Pragma("unroll") for (int i = 0; i < K0N; ++i) { const int idx = tid + 512 * i, rr = idx / K0C, cc = idx % K0C; kreg[i] = *(const u32x4*)(K0 + (size_t)(64 * (t) + rr) * ldk0 + cc * 8); } \
    if (tid < 64 * K1C) { const int rr = tid / K1C, cc = tid % K1C; k1reg = *(const u32x4*)(K1 + (size_t)(64 * (t) + rr) * ldk1 + cc * 8); } \
    _Pragma("unroll") for (int i = 0; i < VN; ++i) { const int idx = tid + 512 * i, dd = idx >> 3, cc = idx & 7; vreg[i] = *(const u32x4*)(Vt + (size_t)dd * ldv + 64 * (t) + cc * 8); } } while (0)
#define A4_LWRITE(buf) do { \
    _Pragma("unroll") for (int i = 0; i < K0N; ++i) { const int idx = tid + 512 * i, rr = idx / K0C, cc = idx % K0C; *(LAS u32x4*)(Kb + (buf) * KBUF + rr * KS + cc * 16) = kreg[i]; } \
    if (tid < 64 * K1C) { const int rr = tid / K1C, cc = tid % K1C; *(LAS u32x4*)(Kb + (buf) * KBUF + rr * KS + W0 * 2 + cc * 16) = k1reg; } \
    _Pragma("unroll") for (int i = 0; i < VN; ++i) { const int idx = tid + 512 * i, dd = idx >> 3, cc = idx & 7; LAS u32x2* vp = (LAS u32x2*)(Vb + (buf) * VBUF + dd * VS + cc * 16); \
        u32x2 lo_; lo_.x = vreg[i].x; lo_.y = vreg[i].y; u32x2 hi_; hi_.x = vreg[i].z; hi_.y = vreg[i].w; vp[0] = lo_; vp[1] = hi_; } } while (0)
    A4_GLOAD(0);
    A4_LWRITE(0);
    __syncthreads();
    const int qw0 = q0 + wid * 64;
    for (int t = 0; t < NT; ++t) {
        const int buf = t & 1;
        if (t + 1 < NT) A4_GLOAD(t + 1);
        const int kvt = 64 * t;
        if (kvt <= qw0) {
            const bool band = (kvt == qw0);
            f32x16 s[2][2];
#pragma unroll
            for (int c = 0; c < NC; ++c) {
                const bf16x8 kf0 = *(const LAS bf16x8*)(Kb + buf * KBUF + r32 * KS + (16 * c + 8 * hi) * 2);
                const bf16x8 kf1 = *(const LAS bf16x8*)(Kb + buf * KBUF + (32 + r32) * KS + (16 * c + 8 * hi) * 2);
#pragma unroll
                for (int rb = 0; rb < 2; ++rb) { const bf16x8 qv = *(const LAS bf16x8*)(Qs + rb * 32 * QROW + c * 32);
                    if (c == 0) { s[rb][0] = __builtin_amdgcn_mfma_f32_32x32x16_bf16(kf0, qv, negm[rb], 0, 0, 0); s[rb][1] = __builtin_amdgcn_mfma_f32_32x32x16_bf16(kf1, qv, negm[rb], 0, 0, 0); }
                    else { s[rb][0] = __builtin_amdgcn_mfma_f32_32x32x16_bf16(kf0, qv, s[rb][0], 0, 0, 0); s[rb][1] = __builtin_amdgcn_mfma_f32_32x32x16_bf16(kf1, qv, s[rb][1], 0, 0, 0); } }
            }
#pragma unroll
            for (int rb = 0; rb < 2; ++rb) {
                f32x16& s0 = s[rb][0]; f32x16& s1 = s[rb][1];
                if (band) {
                    const int qd = 32 * rb + r32;
#pragma unroll
                    for (int r = 0; r < 16; ++r) { const int kv = crow(r, hi); if (kv > qd) s0[r] = -INFINITY; if (kv + 32 > qd) s1[r] = -INFINITY; }
                }
                float mx = fmaxf(s0[0], s1[0]);
#pragma unroll
                for (int r = 1; r < 16; ++r) mx = fmaxf(mx, fmaxf(s0[r], s1[r]));
                mx = half_max(mx);
                if (__any(t == 0 || mx > 8.0f)) {
                    const float dl = (t == 0) ? mx : fmaxf(mx, 0.f), alpha = fast_exp2(-dl);
                    lrow[rb] *= alpha;
#pragma unroll
                    for (int r = 0; r < 16; ++r) { s0[r] -= dl; s1[r] -= dl; negm[rb][r] -= dl; }
#pragma unroll
                    for (int db = 0; db < NDB; ++db)
#pragma unroll
                        for (int r = 0; r < 16; ++r) o[rb][db][r] *= alpha;
                }
            }
#pragma unroll
            for (int kb = 0; kb < 2; ++kb) {
                bf16x8 vf[NDB][2];
#pragma unroll
                for (int db = 0; db < NDB; ++db)
#pragma unroll
                    for (int j = 0; j < 2; ++j) { const LAS unsigned char* vp = Vb + buf * VBUF + (32 * db + r32) * VS + (32 * kb + 16 * j + 4 * hi) * 2;
                        const s16x4 lo = *(const LAS s16x4*)vp, hh = *(const LAS s16x4*)(vp + 16);
                        vf[db][j] = (bf16x8){lo[0], lo[1], lo[2], lo[3], hh[0], hh[1], hh[2], hh[3]}; }
#pragma unroll
                for (int rb = 0; rb < 2; ++rb) {
                    f32x16& sv = s[rb][kb]; float ls = 0.f;
#pragma unroll
                    for (int r = 0; r < 16; ++r) { sv[r] = fast_exp2(sv[r]); ls += sv[r]; }
                    lrow[rb] += ls;
                    bf16x8 pa[2];
#pragma unroll
                    for (int j = 0; j < 2; ++j) { u32x4 w; w.x = cvtpk(sv[8 * j + 0], sv[8 * j + 1]); w.y = cvtpk(sv[8 * j + 2], sv[8 * j + 3]); w.z = cvtpk(sv[8 * j + 4], sv[8 * j + 5]); w.w = cvtpk(sv[8 * j + 6], sv[8 * j + 7]); pa[j] = __builtin_bit_cast(bf16x8, w); }
#pragma unroll
                    for (int db = 0; db < NDB; ++db)
#pragma unroll
                        for (int j = 0; j < 2; ++j) o[rb][db] = __builtin_amdgcn_mfma_f32_32x32x16_bf16(vf[db][j], pa[j], o[rb][db], 0, 0, 0);
                }
            }
        }
        if (t + 1 < NT) A4_LWRITE(buf ^ 1);
        __syncthreads();
    }
#undef A4_GLOAD
#undef A4_LWRITE
#pragma unroll
    for (int rb = 0; rb < 2; ++rb) {
        const float inv = 1.0f / half_sum(lrow[rb]);
        bf16_t* orow = O + (size_t)(q0 + wid * 64 + rb * 32 + r32) * ldo;
#pragma unroll
        for (int db = 0; db < NDB; ++db)
#pragma unroll
            for (int g = 0; g < 4; ++g) { f32x4 v; for (int i = 0; i < 4; ++i) v[i] = o[rb][db][4 * g + i] * inv; store4bf(orow + 32 * db + 8 * g + 4 * hi, v); }
    }
}

__device__ __forceinline__ float wave_sum(float v) {
#pragma unroll
    for (int o = 1; o < 64; o <<= 1) v += __shfl_xor(v, o);
    return v;
}
__device__ __forceinline__ void transpose_block(const float* __restrict__ W, int ldw, int src_col0, const float* __restrict__ gain, bf16_t* WT, int K, int dst_row0, int k0, LAS float* scr, int lane) {
#pragma unroll 8
    for (int i = 0; i < 32; ++i) { const int kk = 2 * i + (lane >> 5); float v = W[(size_t)(k0 + kk) * ldw + src_col0 + (lane & 31)]; if (gain) v *= gain[k0 + kk]; scr[kk * 33 + (lane & 31)] = v; }
    asm volatile("s_waitcnt lgkmcnt(0)" ::: "memory");
    const int c = lane & 7;
#pragma unroll
    for (int j = 0; j < 4; ++j) { const int n = (lane >> 3) + 8 * j; const LAS float* s = scr + (8 * c) * 33 + n;
        u32x4 ov; ov.x = cvtpk(s[0 * 33], s[1 * 33]); ov.y = cvtpk(s[2 * 33], s[3 * 33]); ov.z = cvtpk(s[4 * 33], s[5 * 33]); ov.w = cvtpk(s[6 * 33], s[7 * 33]);
        *(u32x4*)(WT + (size_t)(dst_row0 + n) * K + k0 + 8 * c) = ov; }
    asm volatile("s_waitcnt lgkmcnt(0)" ::: "memory");
}

#define XB_TMO      128
#define XB_XCNT(j)  (256  + 64 * (j))
#define XB_XSUB(j)  (1280 + 64 * (j))
#define XB_XGEN(j)  (2304 + 64 * (j))
#define XB_TOP      3328
#define XB_TOPGEN   3392
#define XCD_BAR_WORDS 3456
#define XB_SPIN_CAP (1u << 18)

__device__ __forceinline__ unsigned xb_ld(unsigned* p)              { return __hip_atomic_load(p, __ATOMIC_RELAXED, __HIP_MEMORY_SCOPE_AGENT); }
__device__ __forceinline__ unsigned xb_add(unsigned* p, unsigned v) { return __hip_atomic_fetch_add(p, v, __ATOMIC_RELAXED, __HIP_MEMORY_SCOPE_AGENT); }
__device__ __forceinline__ unsigned xb_xcc_id() { return (unsigned)__builtin_amdgcn_s_getreg((3 << 11) | 20) & 0xFu; }
#define XB_SPIN(cond, bar) do { unsigned _sp = 0; while (cond) { __builtin_amdgcn_s_sleep(1); \
    if ((++_sp & 255u) == 0u) { if (xb_ld(&(bar)[XB_TMO])) break; if (_sp > XB_SPIN_CAP) { atomicAdd(&(bar)[XB_TMO], 1u); break; } } } } while (0)

struct XcdBarrier {
    unsigned* bar; unsigned x;
    volatile LAS unsigned* st;
};

__device__ __forceinline__ XcdBarrier xcd_barrier_post(unsigned* bar, volatile LAS unsigned* st) {
    XcdBarrier b; b.bar = bar; b.x = xb_xcc_id(); b.st = st;
    if (threadIdx.x == 0) (void)xb_add(&bar[XB_XCNT(b.x)], 1u);
    return b;
}
__device__ __forceinline__ void xcd_barrier_complete(unsigned* bar, unsigned x, unsigned& nloc, unsigned& nx) {
    const unsigned G = gridDim.x * gridDim.y * gridDim.z;
    unsigned sum, cnt, mine, sp = 0u;
    for (;;) {
        sum = 0u; cnt = 0u; mine = 0u;
#pragma unroll
        for (unsigned j = 0; j < 16; ++j) { const unsigned c = xb_ld(&bar[XB_XCNT(j)]); sum += c; cnt += (c > 0u) ? 1u : 0u; mine = (j == x) ? c : mine; }
        if (sum == G) break;
        __builtin_amdgcn_s_sleep(1);
        if ((++sp & 255u) == 0u) { if (xb_ld(&bar[XB_TMO])) break; if (sp > XB_SPIN_CAP) { atomicAdd(&bar[XB_TMO], 1u); break; } }
    }
    nloc = mine > 0u ? mine : 1u; nx = cnt > 0u ? cnt : 1u;
}

__device__ __forceinline__ void xcd_barrier(const XcdBarrier& b) {
    asm volatile("s_waitcnt vmcnt(0)" ::: "memory");
    __syncthreads();
    if (threadIdx.x == 0) {
        unsigned* bar = b.bar;
        __builtin_amdgcn_s_waitcnt(0);
        unsigned nloc = b.st[0], nx = b.st[1];
        if (nloc == 0u) { xcd_barrier_complete(bar, b.x, nloc, nx); b.st[0] = nloc; b.st[1] = nx; }
        const unsigned old = xb_add(&bar[XB_XSUB(b.x)], 1u);
        const unsigned gen = old / nloc;
        if (old + 1u == (gen + 1u) * nloc) {
            __builtin_amdgcn_fence(__ATOMIC_RELEASE, "agent");
            asm volatile("s_waitcnt vmcnt(0)" ::: "memory");
            const unsigned og = xb_add(&bar[XB_TOP], 1u);
            const unsigned tg = og / nx;
            if (og + 1u == (tg + 1u) * nx) xb_add(&bar[XB_TOPGEN], 1u);
            else XB_SPIN(xb_ld(&bar[XB_TOPGEN]) == tg, bar);
            __builtin_amdgcn_fence(__ATOMIC_ACQUIRE, "agent");
            xb_add(&bar[XB_XGEN(b.x)], 1u);
            asm volatile("s_waitcnt vmcnt(0)" ::: "memory");
        } else {
            XB_SPIN(xb_ld(&bar[XB_XGEN(b.x)]) == gen, bar);
            __builtin_amdgcn_fence(__ATOMIC_ACQUIRE, "agent");
            asm volatile("s_waitcnt vmcnt(0)" ::: "memory");
        }
    }
    __syncthreads();
}


struct Args { const float* in[20]; float* out; unsigned char* ws; int ph_lo, ph_hi, coop, pad; float lam_init[4]; };

__global__ void __launch_bounds__(512, 2) hybrid_fwd(Args a) {
    extern __shared__ __attribute__((aligned(16))) unsigned char lds_raw[];
    LAS unsigned char* lds = (LAS unsigned char*)lds_raw;
    const float* x_in = a.in[0]; const float* mem = a.in[1]; const int* positions = (const int*)a.in[2];
    const float* norm_pre = a.in[3]; const float* norm_post = a.in[4]; const float* w_in = a.in[5]; const float* q_norm = a.in[6]; const float* w_uq = a.in[7];
    const float* kv_norm = a.in[8]; const float* w_ukv = a.in[9]; const float* lq1 = a.in[10]; const float* lk1 = a.in[11]; const float* lq2 = a.in[12]; const float* lk2 = a.in[13];
    const float* diff_subln = a.in[14]; const float* mem_norm = a.in[15]; const float* w_mem_kv = a.in[16]; const float* b_gate = a.in[17]; const float* w_branch = a.in[18]; const float* w_out = a.in[19];
#define P_WT ((bf16_t*)(ws + OFF_W))
#define P_COS ((float*)(ws + OFF_COS))
#define P_SIN ((float*)(ws + OFF_SIN))
#define P_SSQq ((float*)(ws + OFF_SSQQ))
#define P_SSQkv ((float*)(ws + OFF_SSQKV))
#define P_MN ((bf16_t*)(ws + OFF_MN))
#define P_KM ((bf16_t*)(ws + OFF_KM))
#define P_VMT ((bf16_t*)(ws + OFF_VMT))
#define P_XN ((bf16_t*)(ws + OFF_XN))
#define P_OB ((bf16_t*)(ws + OFF_O))
#define P_CQ ((bf16_t*)(ws + OFF_CQ))
#define P_CKV ((bf16_t*)(ws + OFF_CKV))
#define P_KPE ((bf16_t*)(ws + OFF_KPE))
#define P_QD ((bf16_t*)(ws + OFF_QD))
#define P_KD ((bf16_t*)(ws + OFF_KD))
#define P_VDT ((bf16_t*)(ws + OFF_VDT))
#define P_QX ((bf16_t*)(ws + OFF_QX))
#define P_QA ((bf16_t*)(ws + OFF_QA))
#define P_KN ((bf16_t*)(ws + OFF_KN))
#define P_VAT ((bf16_t*)(ws + OFF_VAT))
#define P_SB ((bf16_t*)(ws + OFF_S))
#define P_MG ((bf16_t*)(ws + OFF_MERGED))
#define P_OUTB ((float*)(ws + OFF_OUT))

    volatile LAS unsigned* bst = (volatile LAS unsigned*)(lds + LDS_BYTES - 16);
    if (threadIdx.x < 4) bst[threadIdx.x] = 0u;
    __syncthreads();
    XcdBarrier xbar; xbar.bar = (unsigned*)(a.ws + OFF_BAR); xbar.x = 0; xbar.st = bst;
    if (a.coop) xbar = xcd_barrier_post((unsigned*)(a.ws + OFF_BAR), bst);
    for (int ph = a.ph_lo; ph < a.ph_hi; ++ph) {
        __attribute__((address_space(1))) unsigned char* ws = (__attribute__((address_space(1))) unsigned char*)a.ws; asm volatile("" : "+s"(ws));
        int tid = threadIdx.x; asm volatile("" : "+v"(tid)); const int lane = tid & 63, wave = __builtin_amdgcn_readfirstlane(tid >> 6);
        int G = gridDim.x, bx = blockIdx.x; asm volatile("" : "+s"(G), "+s"(bx));
        const int vcu = (G % 8 == 0) ? (bx % 8) * (G / 8) + bx / 8 : bx;
        const int gw = vcu * 8 + wave, NGW = G * 8;
        if (ph == 0) {
#if PHSEL & 1
            LAS float* scr = (LAS float*)(lds + wave * 16384);
            constexpr int I_IN = 16 * 221, I_UQ = 4 * 24, I_UKV = 2 * 32, I_MEM = 16 * 32, I_BR = 3 * 256, I_OUT = 16 * 32;
            constexpr int I_L = I_IN + I_UQ + I_UKV + I_MEM + I_BR + I_OUT;
            for (int it = gw; it < DEPTH * I_L; it += NGW) {
                const int l = it / I_L; int r = it - l * I_L; bf16_t* wl = P_WT + (size_t)l * WL_TOTAL;
                if (r < I_IN) { const int kb = r / 221, nb = r - kb * 221, n = nb * 32; int dr;
                    if (n < 416) dr = n; else if (n < 1440) dr = n + 96; else if (n < 1952) dr = n - 1440 + 2048; else if (n < 2464) dr = n - 1952 + 1536; else dr = n + 96;
                    transpose_block(w_in + (size_t)l * 1024 * IN_WIDTH, IN_WIDTH, n, norm_pre + l * 1024, wl + WL_IN, 1024, dr, kb * 64, scr, lane); continue; }
                r -= I_IN;
                if (r < I_UQ) { const int kb = r / 24, nb = r - kb * 24, n = nb * 32, h = n / 96, w = n - h * 96; const int dr = (w < 64) ? h * 64 + w : 512 + h * 32 + (w - 64);
                    transpose_block(w_uq + (size_t)l * 256 * 768, 768, n, q_norm + l * 256, wl + WL_UQ, 256, dr, kb * 64, scr, lane); continue; }
                r -= I_UQ;
                if (r < I_UKV) { const int kb = r / 32, nb = r - kb * 32, n = nb * 32, h = n / 128, w = n - h * 128; const int dr = (w < 64) ? h * 64 + w : 512 + h * 64 + (w - 64);
                    transpose_block(w_ukv + (size_t)l * 128 * 1024, 1024, n, kv_norm + l * 128, wl + WL_UKV, 128, dr, kb * 64, scr, lane); continue; }
                r -= I_UKV;
                if (r < I_MEM) { const int kb = r / 32, nb = r - kb * 32;
                    transpose_block(w_mem_kv + (size_t)l * 1024 * 1024, 1024, nb * 32, mem_norm + l * 1024, wl + WL_MEM, 1024, nb * 32, kb * 64, scr, lane); continue; }
                r -= I_MEM;
                if (r < I_BR) { const int i = r / 256, rr = r - i * 256, kb = rr / 32, nb = rr - kb * 32;
                    transpose_block(w_branch + (size_t)(l * 3 + i) * 512 * 1024, 1024, nb * 32, nullptr, wl + WL_BR + (size_t)i * 1024 * 512, 512, nb * 32, kb * 64, scr, lane); continue; }
                r -= I_BR;
                { const int kb = r / 32, nb = r - kb * 32;
                    transpose_block(w_out + (size_t)l * 1024 * 1024, 1024, nb * 32, nullptr, wl + WL_OUT, 1024, nb * 32, kb * 64, scr, lane); }
            }
            for (int i = bx * 512 + tid; i < DEPTH * 96 * 1024 / 8; i += G * 512) { const int l = i / (96 * 1024 / 8), rr = i - l * (96 * 1024 / 8);
                *(u32x4*)(P_WT + (size_t)l * WL_TOTAL + WL_IN + (size_t)416 * 1024 + (size_t)rr * 8) = (u32x4){0u, 0u, 0u, 0u}; }
            for (int i = bx * 512 + tid; i < SEQ * 16; i += G * 512) { const int s = i >> 4, j = i & 15;
                const float invf = powf(10000.0f, -(float)j / 16.0f); const float ang = (float)positions[s] * invf;
                double rv = (double)ang * 0.15915494309189535; rv -= floor(rv); const float f = (float)rv;
                P_COS[i] = __builtin_amdgcn_cosf(f); P_SIN[i] = __builtin_amdgcn_sinf(f); }
            for (int m = gw; m < MMEM + MTOK; m += NGW) {
                const float* src = (m < MMEM) ? mem + (size_t)m * 1024 : x_in + (size_t)(m - MMEM) * 1024; bf16_t* dst = (m < MMEM) ? P_MN + (size_t)m * 1024 : P_XN + (size_t)(m - MMEM) * 1024;
                f32x4 v[4]; float s = 0.f;
#pragma unroll
                for (int j = 0; j < 4; ++j) { v[j] = ((const f32x4*)src)[64 * j + lane]; s += (v[j][0] * v[j][0] + v[j][1] * v[j][1]) + (v[j][2] * v[j][2] + v[j][3] * v[j][3]); }
                const float rstd = __builtin_amdgcn_rsqf(wave_sum(s) * (1.0f / 1024.0f) + NORM_EPS);
#pragma unroll
                for (int j = 0; j < 4; ++j) store4bf(dst + 4 * (64 * j + lane), v[j] * rstd);
            }
#endif
        } else {
            const int l = (ph - 1) / 7, sub = (ph - 1) % 7;
            const bf16_t* wl = P_WT + (size_t)l * WL_TOTAL;
            if (sub == 0) {
#if PHSEL & 2
#if GSEL & 1
                { pg8::Gemm g{P_XN, wl + WL_IN, MTOK, 2048, 1024, 1024, 1024, 0, 0}; pg8::StaticOrder S; S.init(MTOK, 2048, G, bx);
                  pg8::Epi1 E{P_CQ, P_CKV, P_KPE, P_QD, P_KD, P_QX, P_SSQq, P_SSQkv, P_COS, P_SIN, 0.17677669529663687f * LOG2E, 0.08838834764831845f * LOG2E};
                  pg8::gemm_phase(lds, g, S, E); }
#endif
#if GSEL & 2
                { pg8::Gemm g{wl + WL_IN + (size_t)2048 * 1024, P_XN, 512, MTOK, 1024, 1024, 1024, 0, 0}; pg8::StaticOrder S; S.init(512, MTOK, G, bx);
                  pg8::EpiT E{P_VDT, (size_t)MTOK, 0, nullptr, 0.f, nullptr};
                  pg8::gemm_phase(lds, g, S, E); }
#endif
                if (l == 0) {
#if GSEL & 4
                    { pg8::Gemm g{P_MN, P_WT + WL_MEM, MMEM, 512, 1024, 1024, 1024, 0, WL_TOTAL}; pg8::StaticOrder S; S.init(MMEM, 512, G, bx, DEPTH);
                      pg8::EpiRow E{P_KM, 512, (size_t)MMEM * 512, nullptr, 0.f};
                      pg8::gemm_phase(lds, g, S, E); }
#endif
#if GSEL & 8
                    { pg8::Gemm g{P_WT + WL_MEM + (size_t)512 * 1024, P_MN, 512, MMEM, 1024, 1024, 1024, WL_TOTAL, 0}; pg8::StaticOrder S; S.init(512, MMEM, G, bx, DEPTH);
                      pg8::EpiT E{P_VMT, (size_t)MMEM, (size_t)512 * MMEM, nullptr, 0.f, nullptr};
                      pg8::gemm_phase(lds, g, S, E); }
#endif
                }
#endif
            } else if (sub == 1) {
#if PHSEL & 4
#if GSEL & 16
                { pg8::Gemm g{P_CQ, wl + WL_UQ, MTOK, 768, 256, 256, 256, 0, 0}; pg8::StaticOrder S; S.init(MTOK, 768, G, bx);
                  pg8::Epi2 E{P_QA, P_SSQq, P_COS, P_SIN, 0.10206207261596575f * LOG2E};
                  pg8::gemm_phase(lds, g, S, E); }
#endif
#if GSEL & 32
                { pg8::Gemm g{P_CKV, wl + WL_UKV, MTOK, 512, 128, 128, 128, 0, 0}; pg8::StaticOrder S; S.init(MTOK, 512, G, bx);
                  pg8::EpiRow E{P_KN, 512, 0, P_SSQkv, 1.0f / 128.0f};
                  pg8::gemm_phase(lds, g, S, E); }
#endif
#if GSEL & 64
                { pg8::Gemm g{wl + WL_UKV + (size_t)512 * 128, P_CKV, 512, MTOK, 128, 128, 128, 0, 0}; pg8::StaticOrder S; S.init(512, MTOK, G, bx);
                  pg8::EpiT E{P_VAT, (size_t)MTOK, 0, P_SSQkv, 1.0f / 128.0f, nullptr};
                  pg8::gemm_phase(lds, g, S, E); }
#endif
#endif
            } else if (sub == 2) {
#if PHSEL & 8
                const float d1 = wave_sum(lane < 32 ? lq1[l * 32 + lane] * lk1[l * 32 + lane] : 0.f), d2 = wave_sum(lane < 32 ? lq2[l * 32 + lane] * lk2[l * 32 + lane] : 0.f);
                const float lam_init = a.lam_init[l]; const float lam = expf(d1) - expf(d2) + lam_init;
#if ATTSEL & 1
                for (int P = vcu; P < 512; P += G) { const int bh = P >> 2, s = P & 3, b = bh >> 3, h = bh & 7; const size_t rb = (size_t)b * SEQ;
                    for (int k = 0; k < 2; ++k) { const int qb = k ? s : 7 - s;
                        attn_unit4<96, 64, 64, 32>(lds, P_QA + rb * 768 + h * 96, 768, P_KN + rb * 512 + h * 64, 512, P_KPE + rb * 32, 32, P_VAT + (size_t)(h * 64) * MTOK + rb, (size_t)MTOK,
                                                   qb * 512, 8 * (qb + 1), P_OB + rb * 1536 + h * 64, 1536); } }
#endif
                asm volatile("" ::: "memory"); __builtin_amdgcn_sched_barrier(0);
#if ATTSEL & 2
                for (int P = vcu; P < 1024; P += G) { const int bh = P >> 3, s = P & 7, b = bh >> 3, h = bh & 7; const size_t rb = (size_t)b * SEQ;
                    for (int k = 0; k < 2; ++k) { const int qb = k ? s : 15 - s;
                        attn_unit2<2, 32, 64, 64, 0>(lds, P_QD + rb * 512 + h * 64, 512, P_KD + rb * 512 + h * 64, 512, nullptr, 0, P_VDT + (size_t)(h * 64) * MTOK + rb, (size_t)MTOK,
                                                           qb * 256, 4 * (qb + 1), P_OB + rb * 1536 + 512 + h * 64, 1536, lam, diff_subln + l * 64, 1.0f - lam_init); } }
#endif
                asm volatile("" ::: "memory"); __builtin_amdgcn_sched_barrier(0);
#if ATTSEL & 4
                for (int X = vcu; X < 1024; X += G) { const int bh = X >> 4, qb = X & 15, b = bh >> 2, h = bh & 3; const size_t rb = (size_t)b * SEQ;
                    attn_unit<1, 128, 128, false, 128, 0>(lds, P_QX + rb * 512 + h * 128, 512, P_KM + (size_t)l * MMEM * 512 + (size_t)b * MEMT * 512 + h * 128, 512, nullptr, 0,
                                                           P_VMT + (size_t)l * 512 * MMEM + (size_t)(h * 128) * MMEM + (size_t)b * MEMT, (size_t)MMEM,
                                                           qb * 256, 4, P_OB + rb * 1536 + 1024 + h * 128, 1536, 0.f, nullptr, 1.f); }
#endif
#endif
            } else if (sub == 3) {
#if PHSEL & 16
                { pg8::Gemm g{P_XN, wl + WL_IN + (size_t)2560 * 1024, MTOK, 1536, 1024, 1024, 1024, 0, 0}; pg8::StaticOrder S; S.init(MTOK, 1536, G, bx);
                  pg8::EpiSG E{P_OB};
                  pg8::gemm_phase(lds, g, S, E); }
                { pg8::Gemm g{P_XN, wl + WL_IN + (size_t)4096 * 1024, MTOK, 3072, 1024, 1024, 1024, 0, 0}; pg8::StaticOrder S; S.init(MTOK, 3072, G, bx);
                  pg8::EpiGL E{P_SB, b_gate + l * 3072};
                  pg8::gemm_phase(lds, g, S, E); }
#endif
            } else if (sub == 4) {
#if PHSEL & 32
                pg8::Gemm g{P_OB, wl + WL_BR, MTOK, 1024, 512, 1536, 512, 512, (size_t)1024 * 512}; pg8::StaticOrder S; S.init(MTOK, 1024, G, bx, 3);
                pg8::EpiBR E{P_SB, P_MG};
                pg8::gemm_phase(lds, g, S, E);
#endif
            } else if (sub == 5) {
#if PHSEL & 64
                pg8::Gemm g{P_MG, wl + WL_OUT, MTOK, 1024, 1024, 1024, 1024, 0, 0}; pg8::StaticOrder S; S.init(MTOK, 1024, G, bx);
                pg8::EpiRow E{(bf16_t*)P_OUTB, 1024, 0, nullptr, 0.f};
                pg8::gemm_phase(lds, g, S, E);
#endif
            } else {
#if PHSEL & 128
                const float* xo = (l == 0) ? x_in : a.out; const float* gp = norm_post + l * 1024;
                for (int m = gw; m < MTOK; m += NGW) {
                    f32x4 v[4]; float s = 0.f;
#pragma unroll
                    for (int j = 0; j < 4; ++j) { v[j] = unpack4bf(((const u32x2*)((const bf16_t*)P_OUTB + (size_t)m * 1024))[64 * j + lane]); s += (v[j][0] * v[j][0] + v[j][1] * v[j][1]) + (v[j][2] * v[j][2] + v[j][3] * v[j][3]); }
                    const float rstd = __builtin_amdgcn_rsqf(wave_sum(s) * (1.0f / 1024.0f) + NORM_EPS); float s2 = 0.f;
#pragma unroll
                    for (int j = 0; j < 4; ++j) { const f32x4 xv = ((const f32x4*)(xo + (size_t)m * 1024))[64 * j + lane]; const f32x4 gv = ((const f32x4*)gp)[64 * j + lane];
                        v[j] = xv + v[j] * rstd * gv; ((f32x4*)(a.out + (size_t)m * 1024))[64 * j + lane] = v[j];
                        s2 += (v[j][0] * v[j][0] + v[j][1] * v[j][1]) + (v[j][2] * v[j][2] + v[j][3] * v[j][3]); }
                    if (l + 1 < DEPTH) { const float rstd2 = __builtin_amdgcn_rsqf(wave_sum(s2) * (1.0f / 1024.0f) + NORM_EPS);
#pragma unroll
                        for (int j = 0; j < 4; ++j) store4bf(P_XN + (size_t)m * 1024 + 4 * (64 * j + lane), v[j] * rstd2); }
                }
#endif
            }
        }
        if (ph + 1 < a.ph_hi) { if (a.coop) { if (ph == 0) cg::this_grid().sync(); else xcd_barrier(xbar); } }
    }
#ifdef DBG_NPH
    if (a.pad) {
        if (a.coop) cg::this_grid().sync();
        const unsigned short* w16 = (const unsigned short*)(a.ws + OFF_MN);
        const size_t n16 = (WS_END - OFF_MN) / 2, nout = (size_t)MTOK * 1024;
        for (size_t i = (size_t)blockIdx.x * 512 + threadIdx.x; i < nout; i += (size_t)gridDim.x * 512) {
            unsigned x = 0; for (size_t k = i; k < n16; k += nout) x ^= w16[k];
            const unsigned short* w2 = (const unsigned short*)(a.ws + OFF_COS); if (i < (size_t)(4 * MiB) / 2) x ^= w2[i];
            a.out[i] = (float)x;
        }
    }
#endif
}

extern "C" void kernel_launch(void* const* d_in, const int* in_sizes, int n_in, void* d_out, int out_size, void* d_ws, size_t ws_size, hipStream_t stream) {
    static int grid = 0;
    if (grid == 0) {
        if (n_in != 20 || ws_size < WS_END) { fprintf(stderr, "kernel_launch: need 20 inputs and >= %zu bytes of workspace (got %d, %zu)\n", (size_t)WS_END, n_in, ws_size); grid = -1; return; }
        int dev = 0, cus = 0, per_cu = 0;
        hipGetDevice(&dev); hipDeviceGetAttribute(&cus, hipDeviceAttributeMultiprocessorCount, dev);
        if (hipFuncSetAttribute((const void*)hybrid_fwd, hipFuncAttributeMaxDynamicSharedMemorySize, LDS_BYTES) != hipSuccess) { fprintf(stderr, "kernel_launch: hipFuncSetAttribute failed\n"); grid = -1; return; }
        if (hipOccupancyMaxActiveBlocksPerMultiprocessor(&per_cu, (const void*)hybrid_fwd, 512, LDS_BYTES) != hipSuccess || per_cu < 1) per_cu = 1;
        (void)hipGetLastError();
        grid = cus * 1;
    }
    if (grid < 0) return;
    if (hipMemsetAsync((char*)d_ws + OFF_BAR, 0, 16384, stream) != hipSuccess) { fprintf(stderr, "kernel_launch: hipMemsetAsync failed\n"); return; }
    Args a{};
    for (int i = 0; i < 20; ++i) a.in[i] = (const float*)d_in[i];
    a.out = (float*)d_out; a.ws = (unsigned char*)d_ws; a.pad = 0;
    a.lam_init[0] = 0.2f; a.lam_init[1] = 0.35550906759096926f; a.lam_init[2] = 0.47071301834358424f; a.lam_init[3] = 0.55605820415654f;
#if MK_ONE_LAUNCH
#ifdef DBG_NPH
    a.ph_lo = 0; a.ph_hi = DBG_NPH; a.coop = 1; a.pad = 1;
#else
    a.ph_lo = 0; a.ph_hi = NPHASE; a.coop = 1;
#endif
    void* args[] = {&a};
    hipError_t e = hipLaunchCooperativeKernel((const void*)hybrid_fwd, dim3(grid), dim3(512), args, LDS_BYTES, stream);
    if (e != hipSuccess) fprintf(stderr, "cooperative launch failed: %s (grid %d)\n", hipGetErrorString(e), grid);
#else
    for (int ph = 0; ph < NPHASE; ++ph) { a.ph_lo = ph; a.ph_hi = ph + 1; a.coop = 0;
        hipLaunchKernelGGL(hybrid_fwd, dim3(grid), dim3(512), LDS_BYTES, stream, a); }
#endif
}
```

```cpp
#include <hip/hip_runtime.h>
#include <hip/hip_cooperative_groups.h>
#include <cstdio>
#include <cstdint>
namespace cg = cooperative_groups;

#ifndef ATTSEL
#define ATTSEL 7
#endif
#ifndef GSEL
#define GSEL 0xFFFF
#endif
#ifndef PHSEL
#define PHSEL 0xFFFF
#endif
#ifndef MK_ONE_LAUNCH
#define MK_ONE_LAUNCH 1
#endif

#define LAS __attribute__((address_space(3)))
typedef unsigned short bf16_t;
typedef short bf16x8 __attribute__((ext_vector_type(8)));
typedef short s16x4 __attribute__((ext_vector_type(4)));
typedef float f32x4 __attribute__((ext_vector_type(4)));
typedef float f32x16 __attribute__((ext_vector_type(16)));
typedef unsigned u32x4 __attribute__((ext_vector_type(4)));
typedef unsigned u32x2 __attribute__((ext_vector_type(2)));
typedef float f32x2_t __attribute__((ext_vector_type(2)));
typedef __bf16 bf16x2_t __attribute__((ext_vector_type(2)));

constexpr int D_MODEL = 1024, BATCH = 16, SEQ = 4096, DEPTH = 4, MEMT = 256;
constexpr int MTOK = BATCH * SEQ;
constexpr int MMEM = BATCH * MEMT;
constexpr int IN_WIDTH = 7072;
constexpr float NORM_EPS = 1e-6f;
constexpr float LOG2E = 1.4426950408889634f;

constexpr size_t WL_IN = 0;
constexpr size_t WL_UQ = WL_IN + (size_t)7168 * 1024;
constexpr size_t WL_UKV = WL_UQ + (size_t)768 * 256;
constexpr size_t WL_MEM = WL_UKV + (size_t)1024 * 128;
constexpr size_t WL_BR = WL_MEM + (size_t)1024 * 1024;
constexpr size_t WL_OUT = WL_BR + (size_t)3 * 1024 * 512;
constexpr size_t WL_TOTAL = WL_OUT + (size_t)1024 * 3072;

constexpr size_t MiB = 1u << 20;
constexpr size_t OFF_W = 0;
constexpr size_t OFF_COS = 104 * MiB, OFF_SIN = OFF_COS + 256 * 1024;
constexpr size_t OFF_SSQQ = 105 * MiB, OFF_SSQKV = 106 * MiB;
constexpr size_t OFF_BAR = 107 * MiB;
constexpr size_t OFF_MN = 108 * MiB;
constexpr size_t OFF_KM = 116 * MiB;
constexpr size_t OFF_VMT = 132 * MiB;
constexpr size_t OFF_XN = 148 * MiB;
constexpr size_t OFF_O = 276 * MiB;
constexpr size_t OFF_R = 468 * MiB;
constexpr size_t OFF_CQ = OFF_R;
constexpr size_t OFF_CKV = OFF_CQ + 32 * MiB;
constexpr size_t OFF_KPE = OFF_CKV + 16 * MiB;
constexpr size_t OFF_QD = OFF_KPE + 4 * MiB;
constexpr size_t OFF_KD = OFF_QD + 64 * MiB;
constexpr size_t OFF_VDT = OFF_KD + 64 * MiB;
constexpr size_t OFF_QX = OFF_VDT + 64 * MiB;
constexpr size_t OFF_QA = OFF_QX + 64 * MiB;
constexpr size_t OFF_KN = OFF_QA + 96 * MiB;
constexpr size_t OFF_VAT = OFF_KN + 64 * MiB;
constexpr size_t WS_END = OFF_VAT + 64 * MiB;
constexpr size_t OFF_S = OFF_R;
constexpr size_t OFF_MERGED = OFF_R + 384 * MiB;
constexpr size_t OFF_OUT = OFF_R;
static_assert(4 * WL_TOTAL * 2 <= OFF_COS && OFF_MERGED + 128 * MiB <= WS_END, "ws map");

constexpr int LDS_BYTES = 163840;
constexpr int NPHASE = 1 + 7 * DEPTH;

__device__ __forceinline__ unsigned cvtpk(float lo, float hi) { f32x2_t v = {lo, hi}; bf16x2_t b = __builtin_convertvector(v, bf16x2_t); return __builtin_bit_cast(unsigned, b); }
__device__ __forceinline__ void store4bf(bf16_t* p, f32x4 v) { u32x2 w; w.x = cvtpk(v[0], v[1]); w.y = cvtpk(v[2], v[3]); *(u32x2*)p = w; }
__device__ __forceinline__ f32x4 unpack4bf(u32x2 w) { f32x4 r; r[0] = __uint_as_float(w.x << 16); r[1] = __uint_as_float(w.x & 0xffff0000u); r[2] = __uint_as_float(w.y << 16); r[3] = __uint_as_float(w.y & 0xffff0000u); return r; }
__device__ __forceinline__ void store8bf(bf16_t* p, f32x4 a, f32x4 b) { u32x4 w; w.x = cvtpk(a[0], a[1]); w.y = cvtpk(a[2], a[3]); w.z = cvtpk(b[0], b[1]); w.w = cvtpk(b[2], b[3]); *(u32x4*)p = w; }
__device__ __forceinline__ float fast_rcp(float x) { return __builtin_amdgcn_rcpf(x); }
__device__ __forceinline__ float fast_exp2(float x) { return __builtin_amdgcn_exp2f(x); }
__device__ __forceinline__ float sigmoidf_(float v) { return fast_rcp(1.0f + fast_exp2(-v * LOG2E)); }

namespace pg8 {
constexpr int BM = 256, BK = 64, HALF = 128, HTB = HALF * BK * 2, STAGE_BYTES = 8 * HTB, NXCD = 8, WGM = 8;
__host__ __device__ __forceinline__ int lds_byte(int r, int c) { const int st = (r >> 4) * 2 + (c >> 5), rr = r & 15, cc = c & 31, ob = rr * 64 + cc * 2; return st * 1024 + (ob ^ (((ob >> 9) & 1) << 5)); }
__host__ __device__ __forceinline__ void stage_rc(int b, int& R, int& C) { const int st = b / 1024, sb = b % 1024, swz = sb ^ (((sb >> 9) & 1) << 5); R = (st >> 1) * 16 + swz / 64; C = (st & 1) * 32 + (swz % 64) / 2; }

__host__ __device__ __forceinline__ int perm32(int rho) { const int n = rho >> 4, i = rho & 15; return 8 * (i >> 2) + 4 * n + (i & 3); }
struct Unit { int pm, pn, z; };
struct Gemm { const bf16_t* A; const bf16_t* Bt; int M, N, K, lda, ldb; size_t zA, zB; };

struct StaticOrder {
    int nM, nN, nwg, G, c, nz;
    __device__ void init(int M, int N, int G_, int c_, int nz_ = 1) { nM = M / BM; nN = N / BM; nwg = nM * nN; G = G_; c = c_; nz = nz_; }
    __device__ bool next(int i, Unit& u) const {
        const int ib = i / nz; u.z = i - ib * nz;
        const long L = (long)ib * G + c; if (L >= nwg) return false;
        int wgid = (int)L; { const int q = nwg / NXCD, r = nwg % NXCD, xcd = wgid % NXCD, off = wgid / NXCD; wgid = (xcd < r ? xcd * (q + 1) : r * (q + 1) + (xcd - r) * q) + off; }
        const int nig = WGM * nN, gid = wgid / nig, fm = gid * WGM, gsz = (nM - fm) < WGM ? (nM - fm) : WGM;
        u.pm = fm + ((wgid % nig) % gsz); u.pn = (wgid % nig) / gsz; return true;
    }
};

template <class Epi>
__device__ __forceinline__ void gemm_phase(LAS unsigned char* lds, const Gemm g, const StaticOrder& S, const Epi& E) {
    int tid = threadIdx.x; asm volatile("" : "+v"(tid));
    const int wid = __builtin_amdgcn_readfirstlane(tid >> 6), lane = tid & 63, wr = wid >> 2, wc = wid & 3, fr = lane & 15, fq = lane >> 4;
    int K = g.K; asm volatile("" : "+s"(K)); const int nt = K / BK;
    unsigned voffA[2], voffB[2];
#pragma unroll
    for (int i = 0; i < 2; ++i) { int R, C; stage_rc(tid * 16 + i * 8192, R, C);
        const int Rb = Epi::PERM ? ((R & ~31) + perm32(R & 31)) : R;
        voffA[i] = (unsigned)(R * g.lda + C) * 2u; voffB[i] = (unsigned)(Rb * g.ldb + C) * 2u; }
    const size_t kstep = (size_t)(BK * 2);
    const size_t hstepA = (size_t)HALF * g.lda * 2, hstepB = (size_t)HALF * g.ldb * 2;
    const size_t tstepA = 2 * hstepA, tstepB = 2 * hstepB;
    const unsigned ldsw = (unsigned)wid * 1024u;
    const int aoff = lds_byte(wr * 64 + fr, fq * 8), boff = lds_byte(wc * 32 + fr, fq * 8);
#define PG8_SA(b, h) (((b) * 2 + (h)) * HTB)
#define PG8_SB(b, h) ((4 + (b) * 2 + (h)) * HTB)
#define PG8_STAGE(bufoff, gbase, voff) do { _Pragma("unroll") for (int _i = 0; _i < 2; ++_i) \
        __builtin_amdgcn_global_load_lds((const unsigned*)((const char*)(gbase) + (voff)[_i]), (LAS unsigned*)(lds + (bufoff) + ldsw + _i * 8192), 16, 0, 0); } while (0)
#define PG8_LDA(dst, b, h) do { _Pragma("unroll") for (int m = 0; m < 4; ++m) _Pragma("unroll") for (int k = 0; k < 2; ++k) dst[m][k] = *(const LAS bf16x8*)(lds + PG8_SA(b, h) + aoff + m * 2048 + k * 1024); } while (0)
#define PG8_LDB(dst, b, h) do { _Pragma("unroll") for (int n = 0; n < 2; ++n) _Pragma("unroll") for (int k = 0; k < 2; ++k) dst[n][k] = *(const LAS bf16x8*)(lds + PG8_SB(b, h) + boff + n * 2048 + k * 1024); } while (0)
#define PG8_MMA(ai, bj, At, Bt) do { __builtin_amdgcn_s_setprio(1); _Pragma("unroll") for (int m = 0; m < 4; ++m) _Pragma("unroll") for (int n = 0; n < 2; ++n) _Pragma("unroll") for (int k = 0; k < 2; ++k) \
        acc[ai][bj][m][n] = __builtin_amdgcn_mfma_f32_16x16x32_bf16(Bt[n][k], At[m][k], acc[ai][bj][m][n], 0, 0, 0); __builtin_amdgcn_s_setprio(0); } while (0)
#define PG8_WAIT_V(n) asm volatile("s_waitcnt vmcnt(" #n ")" ::: "memory")
#define PG8_WAIT_L(n) asm volatile("s_waitcnt lgkmcnt(" #n ")" ::: "memory")
#define PG8_BAR __builtin_amdgcn_s_barrier()
#define PG8_SCHED __builtin_amdgcn_sched_barrier(0)
    Unit cur, nxt; int ui = 0;
    if (!S.next(0, cur)) return;
    f32x4 acc[2][2][4][2];
#pragma unroll
    for (int a = 0; a < 2; ++a)
#pragma unroll
        for (int b = 0; b < 2; ++b)
#pragma unroll
            for (int m = 0; m < 4; ++m)
#pragma unroll
                for (int n = 0; n < 2; ++n) acc[a][b][m][n] = (f32x4){0.f, 0.f, 0.f, 0.f};
    bf16x8 At[4][2], B0[2][2], B1[2][2];
    const char* cA = (const char*)g.A + ((size_t)cur.z * g.zA) * 2 + (size_t)cur.pm * tstepA;
    const char* cB = (const char*)g.Bt + ((size_t)cur.z * g.zB) * 2 + (size_t)cur.pn * tstepB;
    PG8_STAGE(PG8_SB(0, 0), cB, voffB); PG8_STAGE(PG8_SB(0, 1), cB + hstepB, voffB); PG8_STAGE(PG8_SA(0, 0), cA, voffA); PG8_STAGE(PG8_SA(0, 1), cA + hstepA, voffA);
    if (wr == 1) PG8_BAR;
    PG8_WAIT_V(2); PG8_BAR;
    PG8_STAGE(PG8_SB(1, 0), cB + kstep, voffB); PG8_STAGE(PG8_SA(1, 0), cA + kstep, voffA); PG8_STAGE(PG8_SB(1, 1), cB + hstepB + kstep, voffB);
    PG8_WAIT_V(6); PG8_BAR;
    for (;;) {
        const bool has_next = S.next(ui + 1, nxt);
        const char* nA = has_next ? (const char*)g.A + ((size_t)nxt.z * g.zA) * 2 + (size_t)nxt.pm * tstepA : cA;
        const char* nB = has_next ? (const char*)g.Bt + ((size_t)nxt.z * g.zB) * 2 + (size_t)nxt.pn * tstepB : cB;
        for (int t = 0; t < nt; t += 2) {
            const bool last = (t == nt - 2);
            const char* a1 = cA + (size_t)(t + 1) * kstep;
            const char* a2 = last ? nA : cA + (size_t)(t + 2) * kstep; const char* b2 = last ? nB : cB + (size_t)(t + 2) * kstep;
            const char* a3 = a2 + kstep; const char* b3 = b2 + kstep;
            PG8_LDB(B0, 0, 0); PG8_LDB(B1, 0, 1); PG8_SCHED; PG8_LDA(At, 0, 0); PG8_STAGE(PG8_SA(1, 1), a1 + hstepA, voffA);
            PG8_WAIT_V(8); PG8_WAIT_L(0); PG8_BAR; PG8_MMA(0, 0, At, B0); PG8_MMA(0, 1, At, B1); PG8_BAR; PG8_SCHED;
            PG8_LDA(At, 0, 1); PG8_STAGE(PG8_SB(0, 0), b2, voffB); PG8_STAGE(PG8_SB(0, 1), b2 + hstepB, voffB); PG8_STAGE(PG8_SA(0, 0), a2, voffA);
            PG8_WAIT_V(8); PG8_WAIT_L(0); PG8_BAR; PG8_MMA(1, 0, At, B0); PG8_MMA(1, 1, At, B1); PG8_BAR; PG8_SCHED;
            PG8_LDB(B0, 1, 0); PG8_LDB(B1, 1, 1); PG8_SCHED; PG8_LDA(At, 1, 0); PG8_STAGE(PG8_SA(0, 1), a2 + hstepA, voffA);
            PG8_WAIT_V(8); PG8_WAIT_L(0); PG8_BAR; PG8_MMA(0, 0, At, B0); PG8_MMA(0, 1, At, B1); PG8_BAR; PG8_SCHED;
            PG8_LDA(At, 1, 1); PG8_STAGE(PG8_SB(1, 0), b3, voffB); PG8_STAGE(PG8_SB(1, 1), b3 + hstepB, voffB); PG8_STAGE(PG8_SA(1, 0), a3, voffA);
            PG8_WAIT_V(8); PG8_WAIT_L(0); PG8_BAR; PG8_MMA(1, 0, At, B0); PG8_MMA(1, 1, At, B1); PG8_BAR; PG8_SCHED;
        }
        if (wr == 0) PG8_BAR;
        E(acc, cur, wr, wc, fr, fq);
        if (!has_next) break;
#pragma unroll
        for (int a = 0; a < 2; ++a)
#pragma unroll
            for (int b = 0; b < 2; ++b)
#pragma unroll
                for (int m = 0; m < 4; ++m)
#pragma unroll
                    for (int n = 0; n < 2; ++n) acc[a][b][m][n] = (f32x4){0.f, 0.f, 0.f, 0.f};
        cur = nxt; cA = nA; cB = nB; ++ui;
        if (wr == 1) PG8_BAR;
    }
    PG8_WAIT_V(0);
    PG8_BAR;
    asm volatile("" ::: "memory"); PG8_SCHED;
#undef PG8_SA
#undef PG8_SB
#undef PG8_STAGE
#undef PG8_LDA
#undef PG8_LDB
#undef PG8_MMA
#undef PG8_WAIT_V
#undef PG8_WAIT_L
#undef PG8_BAR
#undef PG8_SCHED
}

#define EPI_ROWS_BEGIN _Pragma("unroll") for (int ai = 0; ai < 2; ++ai) _Pragma("unroll") for (int m = 0; m < 4; ++m) { const int row = u.pm * BM + ai * HALF + wr * 64 + m * 16 + fr;
#define EPI_ROWS_END if (m & 1) asm volatile("" ::: "memory"); }
#define EPI_COLS_BEGIN _Pragma("unroll") for (int bj = 0; bj < 2; ++bj) _Pragma("unroll") for (int n = 0; n < 2; ++n) { const int colt = bj * HALF + wc * 32 + n * 16 + 4 * fq;
#define EPI_COLS_END }
typedef f32x4 Acc[2][2][4][2];

__device__ __forceinline__ float rstd4(const float* ssq, int row, float inv_dim) { const f32x4 p = *(const f32x4*)(ssq + (size_t)row * 4); return __builtin_amdgcn_rsqf(((p[0] + p[1]) + (p[2] + p[3])) * inv_dim + NORM_EPS); }

struct Epi1 {
    static constexpr bool PERM = false;
    bf16_t *CQ, *CKV, *KPE, *QD, *KD, *QX; float *SSQq, *SSQkv; const float *COS, *SIN; float sc_d, sc_x;
    __device__ __forceinline__ void operator()(const Acc& acc, const Unit& u, int wr, int wc, int fr, int fq) const {
        const int pn = u.pn;
        EPI_ROWS_BEGIN
            const float r = 1.0f;
            if (pn == 0) {
                float ss = 0.f;
                EPI_COLS_BEGIN const f32x4 v = acc[ai][bj][m][n] * r; ss += (v[0] * v[0] + v[1] * v[1]) + (v[2] * v[2] + v[3] * v[3]); store4bf(CQ + (size_t)row * 256 + colt, v); EPI_COLS_END
                ss += __shfl_xor(ss, 16); ss += __shfl_xor(ss, 32);
                if (fq == 0) SSQq[(size_t)row * 4 + wc] = ss;
            } else if (pn == 1) {
                float ss = 0.f;
#pragma unroll
                for (int n = 0; n < 2; ++n) { const f32x4 v = acc[ai][0][m][n] * r; ss += (v[0] * v[0] + v[1] * v[1]) + (v[2] * v[2] + v[3] * v[3]); store4bf(CKV + (size_t)row * 128 + wc * 32 + n * 16 + 4 * fq, v); }
                ss += __shfl_xor(ss, 16); ss += __shfl_xor(ss, 32);
                if (fq == 0) SSQkv[(size_t)row * 4 + wc] = ss;
                if (wc == 0) {
                    const int s = row & (SEQ - 1); const f32x4 cs = *(const f32x4*)(COS + s * 16 + 4 * fq), sn = *(const f32x4*)(SIN + s * 16 + 4 * fq);
                    const f32x4 x1 = acc[ai][1][m][0] * r, x2 = acc[ai][1][m][1] * r;
                    store4bf(KPE + (size_t)row * 32 + 4 * fq, x1 * cs - x2 * sn); store4bf(KPE + (size_t)row * 32 + 16 + 4 * fq, x2 * cs + x1 * sn);
                }
            } else if (pn < 6) {
                bf16_t* dst = (pn < 4 ? QD : KD) + (size_t)row * 512 + (pn & 1) * 256 + wc * 32 + 4 * fq; const float sc = (pn < 4 ? sc_d : 1.0f) * r;
                const int s = row & (SEQ - 1); const f32x4 cs = *(const f32x4*)(COS + s * 16 + 4 * fq), sn = *(const f32x4*)(SIN + s * 16 + 4 * fq);
#pragma unroll
                for (int bj = 0; bj < 2; ++bj) { const f32x4 x1 = acc[ai][bj][m][0] * sc, x2 = acc[ai][bj][m][1] * sc;
                    store4bf(dst + bj * HALF, x1 * cs - x2 * sn); store4bf(dst + bj * HALF + 16, x2 * cs + x1 * sn); }
            } else {
                const float sc = sc_x * r;
                EPI_COLS_BEGIN store4bf(QX + (size_t)row * 512 + (pn - 6) * 256 + colt, acc[ai][bj][m][n] * sc); EPI_COLS_END
            }
        EPI_ROWS_END
    }
};
#define EPIP_BJ_BEGIN _Pragma("unroll") for (int bj = 0; bj < 2; ++bj) { const int colt = bj * HALF + wc * 32 + 8 * fq;
#define EPIP_BJ_END }
struct EpiT {
    static constexpr bool PERM = true;
    bf16_t* O; size_t ldc; size_t zO; const float* ssq; float inv_dim; const float* colscale;
    __device__ __forceinline__ void operator()(const Acc& acc, const Unit& u, int wr, int wc, int fr, int fq) const {
        f32x4 cs[2][2];
        EPIP_BJ_BEGIN
            const int col = u.pn * BM + colt;
#pragma unroll
            for (int n = 0; n < 2; ++n) {
                if (ssq) { for (int i = 0; i < 4; ++i) cs[bj][n][i] = rstd4(ssq, col + 4 * n + i, inv_dim); }
                else cs[bj][n] = (f32x4){1.f, 1.f, 1.f, 1.f}; }
        EPIP_BJ_END
        bf16_t* base = O + (size_t)u.z * zO;
        EPI_ROWS_BEGIN
            EPIP_BJ_BEGIN store8bf(base + (size_t)row * ldc + u.pn * BM + colt, acc[ai][bj][m][0] * cs[bj][0], acc[ai][bj][m][1] * cs[bj][1]); EPIP_BJ_END
        EPI_ROWS_END
    }
};
struct EpiRow {
    static constexpr bool PERM = true;
    bf16_t* O; size_t ldc; size_t zO; const float* ssq; float inv_dim;
    __device__ __forceinline__ void operator()(const Acc& acc, const Unit& u, int wr, int wc, int fr, int fq) const {
        bf16_t* base = O + (size_t)u.z * zO;
        EPI_ROWS_BEGIN
            const float sc = ssq ? rstd4(ssq, row, inv_dim) : 1.0f;
            EPIP_BJ_BEGIN store8bf(base + (size_t)row * ldc + u.pn * BM + colt, acc[ai][bj][m][0] * sc, acc[ai][bj][m][1] * sc); EPIP_BJ_END
        EPI_ROWS_END
    }
};
struct Epi2 {
    static constexpr bool PERM = false;
    bf16_t* QA; const float* SSQq; const float *COS, *SIN; float sc_a;
    __device__ __forceinline__ void operator()(const Acc& acc, const Unit& u, int wr, int wc, int fr, int fq) const {
        EPI_ROWS_BEGIN
            const float sc = rstd4(SSQq, row, 1.0f / 256.0f) * sc_a;
            if (u.pn < 2) {
                EPI_COLS_BEGIN const int nn = u.pn * BM + colt; store4bf(QA + (size_t)row * 768 + (nn >> 6) * 96 + (nn & 63), acc[ai][bj][m][n] * sc); EPI_COLS_END
            } else {
                const int s = row & (SEQ - 1); const f32x4 cs = *(const f32x4*)(COS + s * 16 + 4 * fq), sn = *(const f32x4*)(SIN + s * 16 + 4 * fq);
#pragma unroll
                for (int bj = 0; bj < 2; ++bj) { const f32x4 x1 = acc[ai][bj][m][0] * sc, x2 = acc[ai][bj][m][1] * sc; bf16_t* dst = QA + (size_t)row * 768 + (4 * bj + wc) * 96 + 64 + 4 * fq;
                    store4bf(dst, x1 * cs - x2 * sn); store4bf(dst + 16, x2 * cs + x1 * sn); }
            }
        EPI_ROWS_END
    }
};
struct EpiSG {
    static constexpr bool PERM = true;
    bf16_t* O;
    __device__ __forceinline__ void operator()(const Acc& acc, const Unit& u, int wr, int wc, int fr, int fq) const {
#pragma unroll
        for (int ai = 0; ai < 2; ++ai) {
            u32x4 ov[4][2];
#pragma unroll
            for (int m = 0; m < 4; ++m) { const int row = u.pm * BM + ai * HALF + wr * 64 + m * 16 + fr;
                EPIP_BJ_BEGIN ov[m][bj] = *(const u32x4*)(O + (size_t)row * 1536 + u.pn * BM + colt); EPIP_BJ_END }
#pragma unroll
            for (int m = 0; m < 4; ++m) { const int row = u.pm * BM + ai * HALF + wr * 64 + m * 16 + fr;
                EPIP_BJ_BEGIN u32x2 lo_, hi_; lo_.x = ov[m][bj].x; lo_.y = ov[m][bj].y; hi_.x = ov[m][bj].z; hi_.y = ov[m][bj].w;
                    const f32x4 o0 = unpack4bf(lo_), o1 = unpack4bf(hi_); const f32x4 g0 = acc[ai][bj][m][0], g1 = acc[ai][bj][m][1]; f32x4 v0, v1;
#pragma unroll
                    for (int i = 0; i < 4; ++i) { v0[i] = o0[i] * g0[i] * sigmoidf_(g0[i]); v1[i] = o1[i] * g1[i] * sigmoidf_(g1[i]); }
                    store8bf(O + (size_t)row * 1536 + u.pn * BM + colt, v0, v1); EPIP_BJ_END }
            asm volatile("" ::: "memory");
        }
    }
};
struct EpiGL {
    static constexpr bool PERM = true;
    bf16_t* S; const float* bias;
    __device__ __forceinline__ void operator()(const Acc& acc, const Unit& u, int wr, int wc, int fr, int fq) const {
        f32x4 bv[2][2];
        EPIP_BJ_BEGIN bv[bj][0] = *(const f32x4*)(bias + u.pn * BM + colt); bv[bj][1] = *(const f32x4*)(bias + u.pn * BM + colt + 4); EPIP_BJ_END
        EPI_ROWS_BEGIN
            EPIP_BJ_BEGIN const f32x4 g0 = acc[ai][bj][m][0] + bv[bj][0], g1 = acc[ai][bj][m][1] + bv[bj][1]; f32x4 v0, v1;
#pragma unroll
                for (int i = 0; i < 4; ++i) { v0[i] = sigmoidf_(g0[i]); v1[i] = sigmoidf_(g1[i]); }
                store8bf(S + (size_t)row * 3072 + u.pn * BM + colt, v0, v1); EPIP_BJ_END
        EPI_ROWS_END
    }
};
struct EpiBR {
    static constexpr bool PERM = true;
    const bf16_t* S; bf16_t* MG;
    __device__ __forceinline__ void operator()(const Acc& acc, const Unit& u, int wr, int wc, int fr, int fq) const {
#pragma unroll
        for (int ai = 0; ai < 2; ++ai) {
            u32x4 sv[4][2]; unsigned long long mv[4][2][2];
#pragma unroll
            for (int m = 0; m < 4; ++m) { const int row = u.pm * BM + ai * HALF + wr * 64 + m * 16 + fr;
                EPIP_BJ_BEGIN const int col = u.pn * BM + colt; sv[m][bj] = *(const u32x4*)(S + (size_t)row * 3072 + u.z * 1024 + col);
                    const unsigned long long* mp_ = (const unsigned long long*)(MG + (size_t)row * 1024 + col);
                    mv[m][bj][0] = (u.z > 0) ? __hip_atomic_load(mp_, __ATOMIC_RELAXED, __HIP_MEMORY_SCOPE_AGENT) : 0ull;
                    mv[m][bj][1] = (u.z > 0) ? __hip_atomic_load(mp_ + 1, __ATOMIC_RELAXED, __HIP_MEMORY_SCOPE_AGENT) : 0ull; EPIP_BJ_END }
#pragma unroll
            for (int m = 0; m < 4; ++m) { const int row = u.pm * BM + ai * HALF + wr * 64 + m * 16 + fr;
                EPIP_BJ_BEGIN const int col = u.pn * BM + colt; u32x2 lo_, hi_; lo_.x = sv[m][bj].x; lo_.y = sv[m][bj].y; hi_.x = sv[m][bj].z; hi_.y = sv[m][bj].w;
                    f32x4 v0 = unpack4bf(lo_) * acc[ai][bj][m][0], v1 = unpack4bf(hi_) * acc[ai][bj][m][1];
                    u32x2 w0, w1; w0.x = (unsigned)mv[m][bj][0]; w0.y = (unsigned)(mv[m][bj][0] >> 32); w1.x = (unsigned)mv[m][bj][1]; w1.y = (unsigned)(mv[m][bj][1] >> 32);
                    v0 += unpack4bf(w0); v1 += unpack4bf(w1);
                    store8bf(MG + (size_t)row * 1024 + col, v0, v1); EPIP_BJ_END }
            asm volatile("" ::: "memory");
        }
    }
};
struct EpiOut {
    static constexpr bool PERM = false;
    float* OUT;
    __device__ __forceinline__ void operator()(const Acc& acc, const Unit& u, int wr, int wc, int fr, int fq) const {
        EPI_ROWS_BEGIN
            EPI_COLS_BEGIN *(f32x4*)(OUT + (size_t)row * 1024 + u.pn * BM + colt) = acc[ai][bj][m][n]; EPI_COLS_END
        EPI_ROWS_END
    }
};
}

__device__ __forceinline__ float half_max(float v) { auto rr = __builtin_amdgcn_permlane32_swap(__float_as_uint(v), __float_as_uint(v), false, false); return fmaxf(__uint_as_float(rr[0]), __uint_as_float(rr[1])); }
__device__ __forceinline__ float half_sum(float v) { auto rr = __builtin_amdgcn_permlane32_swap(__float_as_uint(v), __float_as_uint(v), false, false); return __uint_as_float(rr[0]) + __uint_as_float(rr[1]); }
__device__ __forceinline__ int crow(int r, int hi) { return (r & 3) + 8 * (r >> 2) + 4 * hi; }

template <int NMAP, int DKM, int DV, bool CAUSAL, int W0, int W1>
__device__ __forceinline__ void attn_unit(LAS unsigned char* lds, const bf16_t* __restrict__ Q, int ldq, const bf16_t* __restrict__ K0, int ldk0, const bf16_t* __restrict__ K1, int ldk1,
                                          const bf16_t* __restrict__ Vt, size_t ldv, int q0, int NT, bf16_t* O, int ldo, float lam, const float* subln, float outscale) {
    constexpr int DKT = NMAP * DKM, KS = DKT * 2 + 16, VS = 136, KBUF = 64 * KS, VBUF = DV * VS;
    constexpr int NC = DKM / 16, NDB = DV / 32;
    constexpr int K0C = W0 / 8, K0N = (64 * K0C) / 512, K1C = W1 / 8, VN = (DV * 8) / 512;
    static_assert(W0 + W1 == DKT && K0N >= 1 && VN >= 1, "attention staging geometry");
    int tid = threadIdx.x; asm volatile("" : "+v"(tid));
    const int lane = tid & 63, wid = __builtin_amdgcn_readfirstlane(tid >> 6), r32 = lane & 31, hi = lane >> 5;
    LAS unsigned char* Kb = lds; LAS unsigned char* Vb = lds + 2 * KBUF;
    bf16x8 qf[NMAP][NC];
    { const bf16_t* qrow = Q + (size_t)(q0 + wid * 32 + r32) * ldq;
#pragma unroll
      for (int mp = 0; mp < NMAP; ++mp)
#pragma unroll
          for (int c = 0; c < NC; ++c) qf[mp][c] = *(const bf16x8*)(qrow + mp * DKM + 16 * c + 8 * hi); }
    f32x16 o[NMAP][NDB]; float mrow[NMAP], lrow[NMAP];
#pragma unroll
    for (int mp = 0; mp < NMAP; ++mp) { mrow[mp] = -INFINITY; lrow[mp] = 0.f;
#pragma unroll
        for (int db = 0; db < NDB; ++db)
#pragma unroll
            for (int r = 0; r < 16; ++r) o[mp][db][r] = 0.f; }
    u32x4 kreg[K0N], k1reg = {0u, 0u, 0u, 0u}, vreg[VN];
#define ATT_GLOAD(t) do { \
    _Pragma("unroll") for (int i = 0; i < K0N; ++i) { const int idx = tid + 512 * i, rr = idx / K0C, cc = idx % K0C; kreg[i] = *(const u32x4*)(K0 + (size_t)(64 * (t) + rr) * ldk0 + cc * 8); } \
    if (W1 > 0) { if (tid < 64 * K1C) { const int rr = tid / (K1C > 0 ? K1C : 1), cc = tid % (K1C > 0 ? K1C : 1); k1reg = *(const u32x4*)(K1 + (size_t)(64 * (t) + rr) * ldk1 + cc * 8); } } \
    _Pragma("unroll") for (int i = 0; i < VN; ++i) { const int idx = tid + 512 * i, dd = idx >> 3, cc = idx & 7; vreg[i] = *(const u32x4*)(Vt + (size_t)dd * ldv + 64 * (t) + cc * 8); } } while (0)
#define ATT_LWRITE(buf) do { \
    _Pragma("unroll") for (int i = 0; i < K0N; ++i) { const int idx = tid + 512 * i, rr = idx / K0C, cc = idx % K0C; *(LAS u32x4*)(Kb + (buf) * KBUF + rr * KS + cc * 16) = kreg[i]; } \
    if (W1 > 0) { if (tid < 64 * K1C) { const int rr = tid / (K1C > 0 ? K1C : 1), cc = tid % (K1C > 0 ? K1C : 1); *(LAS u32x4*)(Kb + (buf) * KBUF + rr * KS + W0 * 2 + cc * 16) = k1reg; } } \
    _Pragma("unroll") for (int i = 0; i < VN; ++i) { const int idx = tid + 512 * i, dd = idx >> 3, cc = idx & 7; LAS u32x2* vp = (LAS u32x2*)(Vb + (buf) * VBUF + dd * VS + cc * 16); \
        u32x2 lo_; lo_.x = vreg[i].x; lo_.y = vreg[i].y; u32x2 hi_; hi_.x = vreg[i].z; hi_.y = vreg[i].w; vp[0] = lo_; vp[1] = hi_; } } while (0)
    ATT_GLOAD(0);
    ATT_LWRITE(0);
    __syncthreads();
    const int qw0 = q0 + wid * 32;
    for (int t = 0; t < NT; ++t) {
        const int buf = t & 1;
        if (t + 1 < NT) ATT_GLOAD(t + 1);
#pragma unroll
        for (int kb = 0; kb < 2; ++kb) {
            const int kv0 = 64 * t + 32 * kb;
            if (CAUSAL && kv0 > qw0) continue;
            const bool diag = CAUSAL && (kv0 == qw0);
            bf16x8 vf[NDB][2];
#pragma unroll
            for (int db = 0; db < NDB; ++db)
#pragma unroll
                for (int j = 0; j < 2; ++j) { const LAS unsigned char* vp = Vb + buf * VBUF + (32 * db + r32) * VS + (32 * kb + 16 * j + 4 * hi) * 2;
                    const s16x4 lo = *(const LAS s16x4*)vp, hh = *(const LAS s16x4*)(vp + 16);
                    vf[db][j] = (bf16x8){lo[0], lo[1], lo[2], lo[3], hh[0], hh[1], hh[2], hh[3]}; }
#pragma unroll
            for (int mp = 0; mp < NMAP; ++mp) {
                f32x16 s;
#pragma unroll
                for (int r = 0; r < 16; ++r) s[r] = 0.f;
#pragma unroll
                for (int c = 0; c < NC; ++c) { const bf16x8 kf = *(const LAS bf16x8*)(Kb + buf * KBUF + (32 * kb + r32) * KS + (mp * DKM + 16 * c + 8 * hi) * 2);
                    s = __builtin_amdgcn_mfma_f32_32x32x16_bf16(kf, qf[mp][c], s, 0, 0, 0); }
                if (diag) {
#pragma unroll
                    for (int r = 0; r < 16; ++r) if (crow(r, hi) > r32) s[r] = -INFINITY;
                }
                float mx = s[0];
#pragma unroll
                for (int r = 1; r < 16; ++r) mx = fmaxf(mx, s[r]);
                mx = fmaxf(mx, __shfl_xor(mx, 32));
                if (__any(mx > mrow[mp])) {
                    const float mnew = fmaxf(mrow[mp], mx), alpha = fast_exp2(mrow[mp] - mnew);
                    mrow[mp] = mnew; lrow[mp] *= alpha;
#pragma unroll
                    for (int db = 0; db < NDB; ++db)
#pragma unroll
                        for (int r = 0; r < 16; ++r) o[mp][db][r] *= alpha;
                }
                const float mcur = mrow[mp]; float ls = 0.f;
#pragma unroll
                for (int r = 0; r < 16; ++r) { s[r] = fast_exp2(s[r] - mcur); ls += s[r]; }
                lrow[mp] += ls;
                bf16x8 pa[2];
#pragma unroll
                for (int j = 0; j < 2; ++j) { u32x4 w; w.x = cvtpk(s[8 * j + 0], s[8 * j + 1]); w.y = cvtpk(s[8 * j + 2], s[8 * j + 3]); w.z = cvtpk(s[8 * j + 4], s[8 * j + 5]); w.w = cvtpk(s[8 * j + 6], s[8 * j + 7]); pa[j] = __builtin_bit_cast(bf16x8, w); }
#pragma unroll
                for (int db = 0; db < NDB; ++db)
#pragma unroll
                    for (int j = 0; j < 2; ++j) o[mp][db] = __builtin_amdgcn_mfma_f32_32x32x16_bf16(vf[db][j], pa[j], o[mp][db], 0, 0, 0);
            }
        }
        if (t + 1 < NT) ATT_LWRITE(buf ^ 1);
        __syncthreads();
    }
#undef ATT_GLOAD
#undef ATT_LWRITE
    float inv[NMAP];
#pragma unroll
    for (int mp = 0; mp < NMAP; ++mp) { const float lt = lrow[mp] + __shfl_xor(lrow[mp], 32); inv[mp] = 1.0f / lt; }
    bf16_t* orow = O + (size_t)(q0 + wid * 32 + r32) * ldo;
    if constexpr (NMAP == 1) {
#pragma unroll
        for (int db = 0; db < NDB; ++db)
#pragma unroll
            for (int g = 0; g < 4; ++g) { f32x4 v; for (int i = 0; i < 4; ++i) v[i] = o[0][db][4 * g + i] * inv[0]; store4bf(orow + 32 * db + 8 * g + 4 * hi, v); }
    } else {
        float ss = 0.f;
#pragma unroll
        for (int db = 0; db < NDB; ++db)
#pragma unroll
            for (int r = 0; r < 16; ++r) { const float v = o[0][db][r] * inv[0] - lam * (o[1][db][r] * inv[1]); o[0][db][r] = v; ss += v * v; }
        ss += __shfl_xor(ss, 32);
        const float rstd = __builtin_amdgcn_rsqf(ss * (1.0f / DV) + NORM_EPS) * outscale;
#pragma unroll
        for (int db = 0; db < NDB; ++db)
#pragma unroll
            for (int g = 0; g < 4; ++g) { const f32x4 gn = *(const f32x4*)(subln + 32 * db + 8 * g + 4 * hi); f32x4 v; for (int i = 0; i < 4; ++i) v[i] = o[0][db][4 * g + i] * rstd * gn[i]; store4bf(orow + 32 * db + 8 * g + 4 * hi, v); }
    }
}

template <int NMAP, int DKM, int DV, int W0, int W1>
__device__ __forceinline__ void attn_unit2(LAS unsigned char* lds, const bf16_t* __restrict__ Q, int ldq, const bf16_t* __restrict__ K0, int ldk0, const bf16_t* __restrict__ K1, int ldk1,
                                           const bf16_t* __restrict__ Vt, size_t ldv, int q0, int NT, bf16_t* O, int ldo, float lam, const float* subln, float outscale) {
    constexpr int DKT = NMAP * DKM, KS = DKT * 2 + 16, VS = 136, KBUF = 64 * KS, VBUF = DV * VS;
    constexpr int NC = DKM / 16, NDB = DV / 32;
    constexpr int K0C = W0 / 8, K0N = (64 * K0C) / 512, K1C = W1 / 8, VN = (DV * 8) / 512;
    static_assert(W0 + W1 == DKT && K0N >= 1 && VN >= 1, "attention staging geometry");
    int tid = threadIdx.x; asm volatile("" : "+v"(tid));
    const int lane = tid & 63, wid = __builtin_amdgcn_readfirstlane(tid >> 6), r32 = lane & 31, hi = lane >> 5;
    LAS unsigned char* Kb = lds; LAS unsigned char* Vb = lds + 2 * KBUF;
    bf16x8 qf[NMAP][NC];
    { const bf16_t* qrow = Q + (size_t)(q0 + wid * 32 + r32) * ldq;
#pragma unroll
      for (int mp = 0; mp < NMAP; ++mp)
#pragma unroll
          for (int c = 0; c < NC; ++c) qf[mp][c] = *(const bf16x8*)(qrow + mp * DKM + 16 * c + 8 * hi); }
    f32x16 o[NMAP][NDB], negm[NMAP]; float lrow[NMAP];
#pragma unroll
    for (int mp = 0; mp < NMAP; ++mp) { lrow[mp] = 0.f;
#pragma unroll
        for (int r = 0; r < 16; ++r) negm[mp][r] = 0.f;
#pragma unroll
        for (int db = 0; db < NDB; ++db)
#pragma unroll
            for (int r = 0; r < 16; ++r) o[mp][db][r] = 0.f; }
    u32x4 kreg[K0N], k1reg = {0u, 0u, 0u, 0u}, vreg[VN];
#define ATT_GLOAD(t) do { \
    _Pragma("unroll") for (int i = 0; i < K0N; ++i) { const int idx = tid + 512 * i, rr = idx / K0C, cc = idx % K0C; kreg[i] = *(const u32x4*)(K0 + (size_t)(64 * (t) + rr) * ldk0 + cc * 8); } \
    if (W1 > 0) { if (tid < 64 * K1C) { const int rr = tid / (K1C > 0 ? K1C : 1), cc = tid % (K1C > 0 ? K1C : 1); k1reg = *(const u32x4*)(K1 + (size_t)(64 * (t) + rr) * ldk1 + cc * 8); } } \
    _Pragma("unroll") for (int i = 0; i < VN; ++i) { const int idx = tid + 512 * i, dd = idx >> 3, cc = idx & 7; vreg[i] = *(const u32x4*)(Vt + (size_t)dd * ldv + 64 * (t) + cc * 8); } } while (0)
#define ATT_LWRITE(buf) do { \
    _Pragma("unroll") for (int i = 0; i < K0N; ++i) { const int idx = tid + 512 * i, rr = idx / K0C, cc = idx % K0C; *(LAS u32x4*)(Kb + (buf) * KBUF + rr * KS + cc * 16) = kreg[i]; } \
    if (W1 > 0) { if (tid < 64 * K1C) { const int rr = tid / (K1C > 0 ? K1C : 1), cc = tid % (K1C > 0 ? K1C : 1); *(LAS u32x4*)(Kb + (buf) * KBUF + rr * KS + W0 * 2 + cc * 16) = k1reg; } } \
    _Pragma("unroll") for (int i = 0; i < VN; ++i) { const int idx = tid + 512 * i, dd = idx >> 3, cc = idx & 7; LAS u32x2* vp = (LAS u32x2*)(Vb + (buf) * VBUF + dd * VS + cc * 16); \
        u32x2 lo_; lo_.x = vreg[i].x; lo_.y = vreg[i].y; u32x2 hi_; hi_.x = vreg[i].z; hi_.y = vreg[i].w; vp[0] = lo_; vp[1] = hi_; } } while (0)
    ATT_GLOAD(0);
    ATT_LWRITE(0);
    __syncthreads();
    const int qw0 = q0 + wid * 32;
    for (int t = 0; t < NT; ++t) {
        const int buf = t & 1;
        if (t + 1 < NT) ATT_GLOAD(t + 1);
        const int kvt = 64 * t;
        if (kvt <= qw0) {
            const bool band = (kvt + 63 > qw0);
#pragma unroll
            for (int mp = 0; mp < NMAP; ++mp) {
                f32x16 s0, s1;
#pragma unroll
                for (int c = 0; c < NC; ++c) {
                    const bf16x8 kf0 = *(const LAS bf16x8*)(Kb + buf * KBUF + r32 * KS + (mp * DKM + 16 * c + 8 * hi) * 2);
                    const bf16x8 kf1 = *(const LAS bf16x8*)(Kb + buf * KBUF + (32 + r32) * KS + (mp * DKM + 16 * c + 8 * hi) * 2);
                    if (c == 0) { s0 = __builtin_amdgcn_mfma_f32_32x32x16_bf16(kf0, qf[mp][0], negm[mp], 0, 0, 0); s1 = __builtin_amdgcn_mfma_f32_32x32x16_bf16(kf1, qf[mp][0], negm[mp], 0, 0, 0); }
                    else { s0 = __builtin_amdgcn_mfma_f32_32x32x16_bf16(kf0, qf[mp][c], s0, 0, 0, 0); s1 = __builtin_amdgcn_mfma_f32_32x32x16_bf16(kf1, qf[mp][c], s1, 0, 0, 0); }
                }
                if (band) {
                    const int qd = qw0 + r32 - kvt;
#pragma unroll
                    for (int r = 0; r < 16; ++r) { const int kv = crow(r, hi); if (kv > qd) s0[r] = -INFINITY; if (kv + 32 > qd) s1[r] = -INFINITY; }
                }
                float mx = fmaxf(s0[0], s1[0]);
#pragma unroll
                for (int r = 1; r < 16; ++r) mx = fmaxf(mx, fmaxf(s0[r], s1[r]));
                mx = fmaxf(mx, __shfl_xor(mx, 32));
                if (__any(t == 0 || mx > 8.0f)) {
                    const float dl = (t == 0) ? mx : fmaxf(mx, 0.f), alpha = fast_exp2(-dl);
                    lrow[mp] *= alpha;
#pragma unroll
                    for (int r = 0; r < 16; ++r) { s0[r] -= dl; s1[r] -= dl; negm[mp][r] -= dl; }
#pragma unroll
                    for (int db = 0; db < NDB; ++db)
#pragma unroll
                        for (int r = 0; r < 16; ++r) o[mp][db][r] *= alpha;
                }
                float ls = 0.f;
#pragma unroll
                for (int kb = 0; kb < 2; ++kb) {
                    f32x16& s = kb ? s1 : s0;
                    bf16x8 vf[NDB][2];
#pragma unroll
                    for (int db = 0; db < NDB; ++db)
#pragma unroll
                        for (int j = 0; j < 2; ++j) { const LAS unsigned char* vp = Vb + buf * VBUF + (32 * db + r32) * VS + (32 * kb + 16 * j + 4 * hi) * 2;
                            const s16x4 lo = *(const LAS s16x4*)vp, hh = *(const LAS s16x4*)(vp + 16);
                            vf[db][j] = (bf16x8){lo[0], lo[1], lo[2], lo[3], hh[0], hh[1], hh[2], hh[3]}; }
#pragma unroll
                    for (int r = 0; r < 16; ++r) { s[r] = fast_exp2(s[r]); ls += s[r]; }
                    bf16x8 pa[2];
#pragma unroll
                    for (int j = 0; j < 2; ++j) { u32x4 w; w.x = cvtpk(s[8 * j + 0], s[8 * j + 1]); w.y = cvtpk(s[8 * j + 2], s[8 * j + 3]); w.z = cvtpk(s[8 * j + 4], s[8 * j + 5]); w.w = cvtpk(s[8 * j + 6], s[8 * j + 7]); pa[j] = __builtin_bit_cast(bf16x8, w); }
#pragma unroll
                    for (int db = 0; db < NDB; ++db)
#pragma unroll
                        for (int j = 0; j < 2; ++j) o[mp][db] = __builtin_amdgcn_mfma_f32_32x32x16_bf16(vf[db][j], pa[j], o[mp][db], 0, 0, 0);
                }
                lrow[mp] += ls;
                if (NMAP > 1) __builtin_amdgcn_sched_barrier(0);
            }
        }
        if (t + 1 < NT) ATT_LWRITE(buf ^ 1);
        __syncthreads();
    }
#undef ATT_GLOAD
#undef ATT_LWRITE
    float inv[NMAP];
#pragma unroll
    for (int mp = 0; mp < NMAP; ++mp) { const float lt = lrow[mp] + __shfl_xor(lrow[mp], 32); inv[mp] = 1.0f / lt; }
    bf16_t* orow = O + (size_t)(q0 + wid * 32 + r32) * ldo;
    if constexpr (NMAP == 1) {
#pragma unroll
        for (int db = 0; db < NDB; ++db)
#pragma unroll
            for (int g = 0; g < 4; ++g) { f32x4 v; for (int i = 0; i < 4; ++i) v[i] = o[0][db][4 * g + i] * inv[0]; store4bf(orow + 32 * db + 8 * g + 4 * hi, v); }
    } else {
        float ss = 0.f;
#pragma unroll
        for (int db = 0; db < NDB; ++db)
#pragma unroll
            for (int r = 0; r < 16; ++r) { const float v = o[0][db][r] * inv[0] - lam * (o[1][db][r] * inv[1]); o[0][db][r] = v; ss += v * v; }
        ss += __shfl_xor(ss, 32);
        const float rstd = __builtin_amdgcn_rsqf(ss * (1.0f / DV) + NORM_EPS) * outscale;
#pragma unroll
        for (int db = 0; db < NDB; ++db)
#pragma unroll
            for (int g = 0; g < 4; ++g) { const f32x4 gn = *(const f32x4*)(subln + 32 * db + 8 * g + 4 * hi); f32x4 v; for (int i = 0; i < 4; ++i) v[i] = o[0][db][4 * g + i] * rstd * gn[i]; store4bf(orow + 32 * db + 8 * g + 4 * hi, v); }
    }
}

template <int DKM, int DV, int W0, int W1>
__device__ __forceinline__ void attn_unit4(LAS unsigned char* lds, const bf16_t* __restrict__ Q, int ldq, const bf16_t* __restrict__ K0, int ldk0, const bf16_t* __restrict__ K1, int ldk1,
                                           const bf16_t* __restrict__ Vt, size_t ldv, int q0, int NT, bf16_t* O, int ldo) {
    constexpr int KS = DKM * 2 + 16, VS = 136, KBUF = 64 * KS, VBUF = DV * VS, QROW = DKM * 2 + 16;
    constexpr int NC = DKM / 16, NDB = DV / 32;
    constexpr int K0C = W0 / 8, K0N = (64 * K0C) / 512, K1C = W1 / 8, VN = (DV * 8) / 512;
    static_assert(W0 + W1 == DKM && K0N >= 1 && VN >= 1 && K1C >= 1, "attention staging geometry");
    static_assert(2 * KBUF + 2 * VBUF + 8 * 64 * QROW <= LDS_BYTES - 16, "attention LDS budget");
    int tid = threadIdx.x; asm volatile("" : "+v"(tid));
    const int lane = tid & 63, wid = __builtin_amdgcn_readfirstlane(tid >> 6), r32 = lane & 31, hi = lane >> 5;
    LAS unsigned char* Kb = lds; LAS unsigned char* Vb = lds + 2 * KBUF;
    LAS unsigned char* Qs = lds + 2 * KBUF + 2 * VBUF + wid * (64 * QROW) + r32 * QROW + 16 * hi;
#pragma unroll
    for (int rb = 0; rb < 2; ++rb) { const bf16_t* qrow = Q + (size_t)(q0 + wid * 64 + rb * 32 + r32) * ldq;
#pragma unroll
        for (int c = 0; c < NC; ++c) *(LAS bf16x8*)(Qs + rb * 32 * QROW + c * 32) = *(const bf16x8*)(qrow + 16 * c + 8 * hi); }
    f32x16 o[2][NDB], negm[2]; float lrow[2] = {0.f, 0.f};
#pragma unroll
    for (int rb = 0; rb < 2; ++rb) {
#pragma unroll
        for (int r = 0; r < 16; ++r) negm[rb][r] = 0.f;
#pragma unroll
        for (int db = 0; db < NDB; ++db)
#pragma unroll
            for (int r = 0; r < 16; ++r) o[rb][db][r] = 0.f; }
    u32x4 kreg[K0N], k1reg = {0u, 0u, 0u, 0u}, vreg[VN];
#define A4_GLOAD(t) do { \
    _Pragma("unroll") for (int i = 0; i < K0N; ++i) { const int idx = tid + 512 * i, rr = idx / K0C, cc = idx % K0C; kreg[i] = *(const u32x4*)(K0 + (size_t)(64 * (t) + rr) * ldk0 + cc * 8); } \
    if (tid < 64 * K1C) { const int rr = tid / K1C, cc = tid % K1C; k1reg = *(const u32x4*)(K1 + (size_t)(64 * (t) + rr) * ldk1 + cc * 8); } \
    _Pragma("unroll") for (int i = 0; i < VN; ++i) { const int idx = tid + 512 * i, dd = idx >> 3, cc = idx & 7; vreg[i] = *(const u32x4*)(Vt + (size_t)dd * ldv + 64 * (t) + cc * 8); } } while (0)
#define A4_LWRITE(buf) do { \
    _Pragma("unroll") for (int i = 0; i < K0N; ++i) { const int idx = tid + 512 * i, rr = idx / K0C, cc = idx % K0C; *(LAS u32x4*)(Kb + (buf) * KBUF + rr * KS + cc * 16) = kreg[i]; } \
    if (tid < 64 * K1C) { const int rr = tid / K1C, cc = tid % K1C; *(LAS u32x4*)(Kb + (buf) * KBUF + rr * KS + W0 * 2 + cc * 16) = k1reg; } \
    _Pragma("unroll") for (int i = 0; i < VN; ++i) { const int idx = tid + 512 * i, dd = idx >> 3, cc = idx & 7; LAS u32x2* vp = (LAS u32x2*)(Vb + (buf) * VBUF + dd * VS + cc * 16); \
        u32x2 lo_; lo_.x = vreg[i].x; lo_.y = vreg[i].y; u32x2 hi_; hi_.x = vreg[i].z; hi_.y = vreg[i].w; vp[0] = lo_; vp[1] = hi_; } } while (0)
    A4_GLOAD(0);
    A4_LWRITE(0);
    __syncthreads();
    const int qw0 = q0 + wid * 64;
    for (int t = 0; t < NT; ++t) {
        const int buf = t & 1;
        if (t + 1 < NT) A4_GLOAD(t + 1);
        const int kvt = 64 * t;
        if (kvt <= qw0) {
            const bool band = (kvt == qw0);
            f32x16 s[2][2];
#pragma unroll
            for (int c = 0; c < NC; ++c) {
                const bf16x8 kf0 = *(const LAS bf16x8*)(Kb + buf * KBUF + r32 * KS + (16 * c + 8 * hi) * 2);
                const bf16x8 kf1 = *(const LAS bf16x8*)(Kb + buf * KBUF + (32 + r32) * KS + (16 * c + 8 * hi) * 2);
#pragma unroll
                for (int rb = 0; rb < 2; ++rb) { const bf16x8 qv = *(const LAS bf16x8*)(Qs + rb * 32 * QROW + c * 32);
                    if (c == 0) { s[rb][0] = __builtin_amdgcn_mfma_f32_32x32x16_bf16(kf0, qv, negm[rb], 0, 0, 0); s[rb][1] = __builtin_amdgcn_mfma_f32_32x32x16_bf16(kf1, qv, negm[rb], 0, 0, 0); }
                    else { s[rb][0] = __builtin_amdgcn_mfma_f32_32x32x16_bf16(kf0, qv, s[rb][0], 0, 0, 0); s[rb][1] = __builtin_amdgcn_mfma_f32_32x32x16_bf16(kf1, qv, s[rb][1], 0, 0, 0); } }
            }
#pragma unroll
            for (int rb = 0; rb < 2; ++rb) {
                f32x16& s0 = s[rb][0]; f32x16& s1 = s[rb][1];
                if (band) {
                    const int qd = 32 * rb + r32;
#pragma unroll
                    for (int r = 0; r < 16; ++r) { const int kv = crow(r, hi); if (kv > qd) s0[r] = -INFINITY; if (kv + 32 > qd) s1[r] = -INFINITY; }
                }
                float mx = fmaxf(s0[0], s1[0]);
#pragma unroll
                for (int r = 1; r < 16; ++r) mx = fmaxf(mx, fmaxf(s0[r], s1[r]));
                mx = half_max(mx);
                if (__any(t == 0 || mx > 8.0f)) {
                    const float dl = (t == 0) ? mx : fmaxf(mx, 0.f), alpha = fast_exp2(-dl);
                    lrow[rb] *= alpha;
#pragma unroll
                    for (int r = 0; r < 16; ++r) { s0[r] -= dl; s1[r] -= dl; negm[rb][r] -= dl; }
#pragma unroll
                    for (int db = 0; db < NDB; ++db)
#pragma unroll
                        for (int r = 0; r < 16; ++r) o[rb][db][r] *= alpha;
                }
            }
#pragma unroll
            for (int kb = 0; kb < 2; ++kb) {
                bf16x8 vf[NDB][2];
#pragma unroll
                for (int db = 0; db < NDB; ++db)
#pragma unroll
                    for (int j = 0; j < 2; ++j) { const LAS unsigned char* vp = Vb + buf * VBUF + (32 * db + r32) * VS + (32 * kb + 16 * j + 4 * hi) * 2;
                        const s16x4 lo = *(const LAS s16x4*)vp, hh = *(const LAS s16x4*)(vp + 16);
                        vf[db][j] = (bf16x8){lo[0], lo[1], lo[2], lo[3], hh[0], hh[1], hh[2], hh[3]}; }
#pragma unroll
                for (int rb = 0; rb < 2; ++rb) {
                    f32x16& sv = s[rb][kb]; float ls = 0.f;
#pragma unroll
                    for (int r = 0; r < 16; ++r) { sv[r] = fast_exp2(sv[r]); ls += sv[r]; }
                    lrow[rb] += ls;
                    bf16x8 pa[2];
#pragma unroll
                    for (int j = 0; j < 2; ++j) { u32x4 w; w.x = cvtpk(sv[8 * j + 0], sv[8 * j + 1]); w.y = cvtpk(sv[8 * j + 2], sv[8 * j + 3]); w.z = cvtpk(sv[8 * j + 4], sv[8 * j + 5]); w.w = cvtpk(sv[8 * j + 6], sv[8 * j + 7]); pa[j] = __builtin_bit_cast(bf16x8, w); }
#pragma unroll
                    for (int db = 0; db < NDB; ++db)
#pragma unroll
                        for (int j = 0; j < 2; ++j) o[rb][db] = __builtin_amdgcn_mfma_f32_32x32x16_bf16(vf[db][j], pa[j], o[rb][db], 0, 0, 0);
                }
            }
        }
        if (t + 1 < NT) A4_LWRITE(buf ^ 1);
        __syncthreads();
    }
#undef A4_GLOAD
#undef A4_LWRITE
#pragma unroll
    for (int rb = 0; rb < 2; ++rb) {
        const float inv = 1.0f / half_sum(lrow[rb]);
        bf16_t* orow = O + (size_t)(q0 + wid * 64 + rb * 32 + r32) * ldo;
#pragma unroll
        for (int db = 0; db < NDB; ++db)
#pragma unroll
            for (int g = 0; g < 4; ++g) { f32x4 v; for (int i = 0; i < 4; ++i) v[i] = o[rb][db][4 * g + i] * inv; store4bf(orow + 32 * db + 8 * g + 4 * hi, v); }
    }
}

__device__ __forceinline__ float wave_sum(float v) {
#pragma unroll
    for (int o = 1; o < 64; o <<= 1) v += __shfl_xor(v, o);
    return v;
}
__device__ __forceinline__ void transpose_block(const float* __restrict__ W, int ldw, int src_col0, const float* __restrict__ gain, bf16_t* WT, int K, int dst_row0, int k0, LAS float* scr, int lane) {
#pragma unroll 8
    for (int i = 0; i < 32; ++i) { const int kk = 2 * i + (lane >> 5); float v = W[(size_t)(k0 + kk) * ldw + src_col0 + (lane & 31)]; if (gain) v *= gain[k0 + kk]; scr[kk * 33 + (lane & 31)] = v; }
    asm volatile("s_waitcnt lgkmcnt(0)" ::: "memory");
    const int c = lane & 7;
#pragma unroll
    for (int j = 0; j < 4; ++j) { const int n = (lane >> 3) + 8 * j; const LAS float* s = scr + (8 * c) * 33 + n;
        u32x4 ov; ov.x = cvtpk(s[0 * 33], s[1 * 33]); ov.y = cvtpk(s[2 * 33], s[3 * 33]); ov.z = cvtpk(s[4 * 33], s[5 * 33]); ov.w = cvtpk(s[6 * 33], s[7 * 33]);
        *(u32x4*)(WT + (size_t)(dst_row0 + n) * K + k0 + 8 * c) = ov; }
    asm volatile("s_waitcnt lgkmcnt(0)" ::: "memory");
}

#define XB_TMO      128
#define XB_XCNT(j)  (256  + 64 * (j))
#define XB_XSUB(j)  (1280 + 64 * (j))
#define XB_XGEN(j)  (2304 + 64 * (j))
#define XB_TOP      3328
#define XB_TOPGEN   3392
#define XCD_BAR_WORDS 3456
#define XB_SPIN_CAP (1u << 18)

__device__ __forceinline__ unsigned xb_ld(unsigned* p)              { return __hip_atomic_load(p, __ATOMIC_RELAXED, __HIP_MEMORY_SCOPE_AGENT); }
__device__ __forceinline__ unsigned xb_add(unsigned* p, unsigned v) { return __hip_atomic_fetch_add(p, v, __ATOMIC_RELAXED, __HIP_MEMORY_SCOPE_AGENT); }
__device__ __forceinline__ unsigned xb_xcc_id() { return (unsigned)__builtin_amdgcn_s_getreg((3 << 11) | 20) & 0xFu; }
#define XB_SPIN(cond, bar) do { unsigned _sp = 0; while (cond) { __builtin_amdgcn_s_sleep(1); \
    if ((++_sp & 255u) == 0u) { if (xb_ld(&(bar)[XB_TMO])) break; if (_sp > XB_SPIN_CAP) { atomicAdd(&(bar)[XB_TMO], 1u); break; } } } } while (0)

struct XcdBarrier {
    unsigned* bar; unsigned x;
    volatile LAS unsigned* st;
};

__device__ __forceinline__ XcdBarrier xcd_barrier_post(unsigned* bar, volatile LAS unsigned* st) {
    XcdBarrier b; b.bar = bar; b.x = xb_xcc_id(); b.st = st;
    if (threadIdx.x == 0) (void)xb_add(&bar[XB_XCNT(b.x)], 1u);
    return b;
}
__device__ __forceinline__ void xcd_barrier_complete(unsigned* bar, unsigned x, unsigned& nloc, unsigned& nx) {
    const unsigned G = gridDim.x * gridDim.y * gridDim.z;
    unsigned sum, cnt, mine, sp = 0u;
    for (;;) {
        sum = 0u; cnt = 0u; mine = 0u;
#pragma unroll
        for (unsigned j = 0; j < 16; ++j) { const unsigned c = xb_ld(&bar[XB_XCNT(j)]); sum += c; cnt += (c > 0u) ? 1u : 0u; mine = (j == x) ? c : mine; }
        if (sum == G) break;
        __builtin_amdgcn_s_sleep(1);
        if ((++sp & 255u) == 0u) { if (xb_ld(&bar[XB_TMO])) break; if (sp > XB_SPIN_CAP) { atomicAdd(&bar[XB_TMO], 1u); break; } }
    }
    nloc = mine > 0u ? mine : 1u; nx = cnt > 0u ? cnt : 1u;
}

__device__ __forceinline__ void xcd_barrier(const XcdBarrier& b) {
    asm volatile("s_waitcnt vmcnt(0)" ::: "memory");
    __syncthreads();
    if (threadIdx.x == 0) {
        unsigned* bar = b.bar;
        __builtin_amdgcn_s_waitcnt(0);
        unsigned nloc = b.st[0], nx = b.st[1];
        if (nloc == 0u) { xcd_barrier_complete(bar, b.x, nloc, nx); b.st[0] = nloc; b.st[1] = nx; }
        const unsigned old = xb_add(&bar[XB_XSUB(b.x)], 1u);
        const unsigned gen = old / nloc;
        if (old + 1u == (gen + 1u) * nloc) {
            __builtin_amdgcn_fence(__ATOMIC_RELEASE, "agent");
            asm volatile("s_waitcnt vmcnt(0)" ::: "memory");
            const unsigned og = xb_add(&bar[XB_TOP], 1u);
            const unsigned tg = og / nx;
            if (og + 1u == (tg + 1u) * nx) xb_add(&bar[XB_TOPGEN], 1u);
            else XB_SPIN(xb_ld(&bar[XB_TOPGEN]) == tg, bar);
            __builtin_amdgcn_fence(__ATOMIC_ACQUIRE, "agent");
            xb_add(&bar[XB_XGEN(b.x)], 1u);
            asm volatile("s_waitcnt vmcnt(0)" ::: "memory");
        } else {
            XB_SPIN(xb_ld(&bar[XB_XGEN(b.x)]) == gen, bar);
            __builtin_amdgcn_fence(__ATOMIC_ACQUIRE, "agent");
            asm volatile("s_waitcnt vmcnt(0)" ::: "memory");
        }
    }
    __syncthreads();
}


struct Args { const float* in[20]; float* out; unsigned char* ws; int ph_lo, ph_hi, coop, pad; float lam_init[4]; };

__global__ void __launch_bounds__(512, 2) hybrid_fwd(Args a) {
    extern __shared__ __attribute__((aligned(16))) unsigned char lds_raw[];
    LAS unsigned char* lds = (LAS unsigned char*)lds_raw;
    const float* x_in = a.in[0]; const float* mem = a.in[1]; const int* positions = (const int*)a.in[2];
    const float* norm_pre = a.in[3]; const float* norm_post = a.in[4]; const float* w_in = a.in[5]; const float* q_norm = a.in[6]; const float* w_uq = a.in[7];
    const float* kv_norm = a.in[8]; const float* w_ukv = a.in[9]; const float* lq1 = a.in[10]; const float* lk1 = a.in[11]; const float* lq2 = a.in[12]; const float* lk2 = a.in[13];
    const float* diff_subln = a.in[14]; const float* mem_norm = a.in[15]; const float* w_mem_kv = a.in[16]; const float* b_gate = a.in[17]; const float* w_branch = a.in[18]; const float* w_out = a.in[19];
#define P_WT ((bf16_t*)(ws + OFF_W))
#define P_COS ((float*)(ws + OFF_COS))
#define P_SIN ((float*)(ws + OFF_SIN))
#define P_SSQq ((float*)(ws + OFF_SSQQ))
#define P_SSQkv ((float*)(ws + OFF_SSQKV))
#define P_MN ((bf16_t*)(ws + OFF_MN))
#define P_KM ((bf16_t*)(ws + OFF_KM))
#define P_VMT ((bf16_t*)(ws + OFF_VMT))
#define P_XN ((bf16_t*)(ws + OFF_XN))
#define P_OB ((bf16_t*)(ws + OFF_O))
#define P_CQ ((bf16_t*)(ws + OFF_CQ))
#define P_CKV ((bf16_t*)(ws + OFF_CKV))
#define P_KPE ((bf16_t*)(ws + OFF_KPE))
#define P_QD ((bf16_t*)(ws + OFF_QD))
#define P_KD ((bf16_t*)(ws + OFF_KD))
#define P_VDT ((bf16_t*)(ws + OFF_VDT))
#define P_QX ((bf16_t*)(ws + OFF_QX))
#define P_QA ((bf16_t*)(ws + OFF_QA))
#define P_KN ((bf16_t*)(ws + OFF_KN))
#define P_VAT ((bf16_t*)(ws + OFF_VAT))
#define P_SB ((bf16_t*)(ws + OFF_S))
#define P_MG ((bf16_t*)(ws + OFF_MERGED))
#define P_OUTB ((float*)(ws + OFF_OUT))

    volatile LAS unsigned* bst = (volatile LAS unsigned*)(lds + LDS_BYTES - 16);
    if (threadIdx.x < 4) bst[threadIdx.x] = 0u;
    __syncthreads();
    XcdBarrier xbar; xbar.bar = (unsigned*)(a.ws + OFF_BAR); xbar.x = 0; xbar.st = bst;
    if (a.coop) xbar = xcd_barrier_post((unsigned*)(a.ws + OFF_BAR), bst);
    for (int ph = a.ph_lo; ph < a.ph_hi; ++ph) {
        __attribute__((address_space(1))) unsigned char* ws = (__attribute__((address_space(1))) unsigned char*)a.ws; asm volatile("" : "+s"(ws));
        int tid = threadIdx.x; asm volatile("" : "+v"(tid)); const int lane = tid & 63, wave = __builtin_amdgcn_readfirstlane(tid >> 6);
        int G = gridDim.x, bx = blockIdx.x; asm volatile("" : "+s"(G), "+s"(bx));
        const int vcu = (G % 8 == 0) ? (bx % 8) * (G / 8) + bx / 8 : bx;
        const int gw = vcu * 8 + wave, NGW = G * 8;
        if (ph == 0) {
#if PHSEL & 1
            LAS float* scr = (LAS float*)(lds + wave * 16384);
            constexpr int I_IN = 16 * 221, I_UQ = 4 * 24, I_UKV = 2 * 32, I_MEM = 16 * 32, I_BR = 3 * 256, I_OUT = 16 * 32;
            constexpr int I_L = I_IN + I_UQ + I_UKV + I_MEM + I_BR + I_OUT;
            for (int it = gw; it < DEPTH * I_L; it += NGW) {
                const int l = it / I_L; int r = it - l * I_L; bf16_t* wl = P_WT + (size_t)l * WL_TOTAL;
                if (r < I_IN) { const int kb = r / 221, nb = r - kb * 221, n = nb * 32; int dr;
                    if (n < 416) dr = n; else if (n < 1440) dr = n + 96; else if (n < 1952) dr = n - 1440 + 2048; else if (n < 2464) dr = n - 1952 + 1536; else dr = n + 96;
                    transpose_block(w_in + (size_t)l * 1024 * IN_WIDTH, IN_WIDTH, n, norm_pre + l * 1024, wl + WL_IN, 1024, dr, kb * 64, scr, lane); continue; }
                r -= I_IN;
                if (r < I_UQ) { const int kb = r / 24, nb = r - kb * 24, n = nb * 32, h = n / 96, w = n - h * 96; const int dr = (w < 64) ? h * 64 + w : 512 + h * 32 + (w - 64);
                    transpose_block(w_uq + (size_t)l * 256 * 768, 768, n, q_norm + l * 256, wl + WL_UQ, 256, dr, kb * 64, scr, lane); continue; }
                r -= I_UQ;
                if (r < I_UKV) { const int kb = r / 32, nb = r - kb * 32, n = nb * 32, h = n / 128, w = n - h * 128; const int dr = (w < 64) ? h * 64 + w : 512 + h * 64 + (w - 64);
                    transpose_block(w_ukv + (size_t)l * 128 * 1024, 1024, n, kv_norm + l * 128, wl + WL_UKV, 128, dr, kb * 64, scr, lane); continue; }
                r -= I_UKV;
                if (r < I_MEM) { const int kb = r / 32, nb = r - kb * 32;
                    transpose_block(w_mem_kv + (size_t)l * 1024 * 1024, 1024, nb * 32, mem_norm + l * 1024, wl + WL_MEM, 1024, nb * 32, kb * 64, scr, lane); continue; }
                r -= I_MEM;
                if (r < I_BR) { const int i = r / 256, rr = r - i * 256, kb = rr / 32, nb = rr - kb * 32;
                    transpose_block(w_branch + (size_t)(l * 3 + i) * 512 * 1024, 1024, nb * 32, nullptr, wl + WL_BR + (size_t)i * 1024 * 512, 512, nb * 32, kb * 64, scr, lane); continue; }
                r -= I_BR;
                { const int kb = r / 32, nb = r - kb * 32;
                    transpose_block(w_out + (size_t)l * 1024 * 1024, 1024, nb * 32, nullptr, wl + WL_OUT, 1024, nb * 32, kb * 64, scr, lane); }
            }
            for (int i = bx * 512 + tid; i < DEPTH * 96 * 1024 / 8; i += G * 512) { const int l = i / (96 * 1024 / 8), rr = i - l * (96 * 1024 / 8);
                *(u32x4*)(P_WT + (size_t)l * WL_TOTAL + WL_IN + (size_t)416 * 1024 + (size_t)rr * 8) = (u32x4){0u, 0u, 0u, 0u}; }
            for (int i = bx * 512 + tid; i < SEQ * 16; i += G * 512) { const int s = i >> 4, j = i & 15;
                const float invf = powf(10000.0f, -(float)j / 16.0f); const float ang = (float)positions[s] * invf;
                double rv = (double)ang * 0.15915494309189535; rv -= floor(rv); const float f = (float)rv;
                P_COS[i] = __builtin_amdgcn_cosf(f); P_SIN[i] = __builtin_amdgcn_sinf(f); }
            for (int m = gw; m < MMEM + MTOK; m += NGW) {
                const float* src = (m < MMEM) ? mem + (size_t)m * 1024 : x_in + (size_t)(m - MMEM) * 1024; bf16_t* dst = (m < MMEM) ? P_MN + (size_t)m * 1024 : P_XN + (size_t)(m - MMEM) * 1024;
                f32x4 v[4]; float s = 0.f;
#pragma unroll
                for (int j = 0; j < 4; ++j) { v[j] = ((const f32x4*)src)[64 * j + lane]; s += (v[j][0] * v[j][0] + v[j][1] * v[j][1]) + (v[j][2] * v[j][2] + v[j][3] * v[j][3]); }
                const float rstd = __builtin_amdgcn_rsqf(wave_sum(s) * (1.0f / 1024.0f) + NORM_EPS);
#pragma unroll
                for (int j = 0; j < 4; ++j) store4bf(dst + 4 * (64 * j + lane), v[j] * rstd);
            }
#endif
        } else {
            const int l = (ph - 1) / 7, sub = (ph - 1) % 7;
            const bf16_t* wl = P_WT + (size_t)l * WL_TOTAL;
            if (sub == 0) {
#if PHSEL & 2
#if GSEL & 1
                { pg8::Gemm g{P_XN, wl + WL_IN, MTOK, 2048, 1024, 1024, 1024, 0, 0}; pg8::StaticOrder S; S.init(MTOK, 2048, G, bx);
                  pg8::Epi1 E{P_CQ, P_CKV, P_KPE, P_QD, P_KD, P_QX, P_SSQq, P_SSQkv, P_COS, P_SIN, 0.17677669529663687f * LOG2E, 0.08838834764831845f * LOG2E};
                  pg8::gemm_phase(lds, g, S, E); }
#endif
#if GSEL & 2
                { pg8::Gemm g{wl + WL_IN + (size_t)2048 * 1024, P_XN, 512, MTOK, 1024, 1024, 1024, 0, 0}; pg8::StaticOrder S; S.init(512, MTOK, G, bx);
                  pg8::EpiT E{P_VDT, (size_t)MTOK, 0, nullptr, 0.f, nullptr};
                  pg8::gemm_phase(lds, g, S, E); }
#endif
                if (l == 0) {
#if GSEL & 4
                    { pg8::Gemm g{P_MN, P_WT + WL_MEM, MMEM, 512, 1024, 1024, 1024, 0, WL_TOTAL}; pg8::StaticOrder S; S.init(MMEM, 512, G, bx, DEPTH);
                      pg8::EpiRow E{P_KM, 512, (size_t)MMEM * 512, nullptr, 0.f};
                      pg8::gemm_phase(lds, g, S, E); }
#endif
#if GSEL & 8
                    { pg8::Gemm g{P_WT + WL_MEM + (size_t)512 * 1024, P_MN, 512, MMEM, 1024, 1024, 1024, WL_TOTAL, 0}; pg8::StaticOrder S; S.init(512, MMEM, G, bx, DEPTH);
                      pg8::EpiT E{P_VMT, (size_t)MMEM, (size_t)512 * MMEM, nullptr, 0.f, nullptr};
                      pg8::gemm_phase(lds, g, S, E); }
#endif
                }
#endif
            } else if (sub == 1) {
#if PHSEL & 4
#if GSEL & 16
                { pg8::Gemm g{P_CQ, wl + WL_UQ, MTOK, 768, 256, 256, 256, 0, 0}; pg8::StaticOrder S; S.init(MTOK, 768, G, bx);
                  pg8::Epi2 E{P_QA, P_SSQq, P_COS, P_SIN, 0.10206207261596575f * LOG2E};
                  pg8::gemm_phase(lds, g, S, E); }
#endif
#if GSEL & 32
                { pg8::Gemm g{P_CKV, wl + WL_UKV, MTOK, 512, 128, 128, 128, 0, 0}; pg8::StaticOrder S; S.init(MTOK, 512, G, bx);
                  pg8::EpiRow E{P_KN, 512, 0, P_SSQkv, 1.0f / 128.0f};
                  pg8::gemm_phase(lds, g, S, E); }
#endif
#if GSEL & 64
                { pg8::Gemm g{wl + WL_UKV + (size_t)512 * 128, P_CKV, 512, MTOK, 128, 128, 128, 0, 0}; pg8::StaticOrder S; S.init(512, MTOK, G, bx);
                  pg8::EpiT E{P_VAT, (size_t)MTOK, 0, P_SSQkv, 1.0f / 128.0f, nullptr};
                  pg8::gemm_phase(lds, g, S, E); }
#endif
#endif
            } else if (sub == 2) {
#if PHSEL & 8
                const float d1 = wave_sum(lane < 32 ? lq1[l * 32 + lane] * lk1[l * 32 + lane] : 0.f), d2 = wave_sum(lane < 32 ? lq2[l * 32 + lane] * lk2[l * 32 + lane] : 0.f);
                const float lam_init = a.lam_init[l]; const float lam = expf(d1) - expf(d2) + lam_init;
#if ATTSEL & 1
                for (int P = vcu; P < 512; P += G) { const int bh = P >> 2, s = P & 3, b = bh >> 3, h = bh & 7; const size_t rb = (size_t)b * SEQ;
                    for (int k = 0; k < 2; ++k) { const int qb = k ? s : 7 - s;
                        attn_unit4<96, 64, 64, 32>(lds, P_QA + rb * 768 + h * 96, 768, P_KN + rb * 512 + h * 64, 512, P_KPE + rb * 32, 32, P_VAT + (size_t)(h * 64) * MTOK + rb, (size_t)MTOK,
                                                   qb * 512, 8 * (qb + 1), P_OB + rb * 1536 + h * 64, 1536); } }
#endif
                asm volatile("" ::: "memory"); __builtin_amdgcn_sched_barrier(0);
#if ATTSEL & 2
                for (int P = vcu; P < 1024; P += G) { const int bh = P >> 3, s = P & 7, b = bh >> 3, h = bh & 7; const size_t rb = (size_t)b * SEQ;
                    for (int k = 0; k < 2; ++k) { const int qb = k ? s : 15 - s;
                        attn_unit2<2, 32, 64, 64, 0>(lds, P_QD + rb * 512 + h * 64, 512, P_KD + rb * 512 + h * 64, 512, nullptr, 0, P_VDT + (size_t)(h * 64) * MTOK + rb, (size_t)MTOK,
                                                           qb * 256, 4 * (qb + 1), P_OB + rb * 1536 + 512 + h * 64, 1536, lam, diff_subln + l * 64, 1.0f - lam_init); } }
#endif
                asm volatile("" ::: "memory"); __builtin_amdgcn_sched_barrier(0);
#if ATTSEL & 4
                for (int X = vcu; X < 1024; X += G) { const int bh = X >> 4, qb = X & 15, b = bh >> 2, h = bh & 3; const size_t rb = (size_t)b * SEQ;
                    attn_unit<1, 128, 128, false, 128, 0>(lds, P_QX + rb * 512 + h * 128, 512, P_KM + (size_t)l * MMEM * 512 + (size_t)b * MEMT * 512 + h * 128, 512, nullptr, 0,
                                                           P_VMT + (size_t)l * 512 * MMEM + (size_t)(h * 128) * MMEM + (size_t)b * MEMT, (size_t)MMEM,
                                                           qb * 256, 4, P_OB + rb * 1536 + 1024 + h * 128, 1536, 0.f, nullptr, 1.f); }
#endif
#endif
            } else if (sub == 3) {
#if PHSEL & 16
                { pg8::Gemm g{P_XN, wl + WL_IN + (size_t)2560 * 1024, MTOK, 1536, 1024, 1024, 1024, 0, 0}; pg8::StaticOrder S; S.init(MTOK, 1536, G, bx);
                  pg8::EpiSG E{P_OB};
                  pg8::gemm_phase(lds, g, S, E); }
                { pg8::Gemm g{P_XN, wl + WL_IN + (size_t)4096 * 1024, MTOK, 3072, 1024, 1024, 1024, 0, 0}; pg8::StaticOrder S; S.init(MTOK, 3072, G, bx);
                  pg8::EpiGL E{P_SB, b_gate + l * 3072};
                  pg8::gemm_phase(lds, g, S, E); }
#endif
            } else if (sub == 4) {
#if PHSEL & 32
                pg8::Gemm g{P_OB, wl + WL_BR, MTOK, 1024, 512, 1536, 512, 512, (size_t)1024 * 512}; pg8::StaticOrder S; S.init(MTOK, 1024, G, bx, 3);
                pg8::EpiBR E{P_SB, P_MG};
                pg8::gemm_phase(lds, g, S, E);
#endif
            } else if (sub == 5) {
#if PHSEL & 64
                pg8::Gemm g{P_MG, wl + WL_OUT, MTOK, 1024, 1024, 1024, 1024, 0, 0}; pg8::StaticOrder S; S.init(MTOK, 1024, G, bx);
                pg8::EpiRow E{(bf16_t*)P_OUTB, 1024, 0, nullptr, 0.f};
                pg8::gemm_phase(lds, g, S, E);
#endif
            } else {
#if PHSEL & 128
                const float* xo = (l == 0) ? x_in : a.out; const float* gp = norm_post + l * 1024;
                for (int m0 = gw; m0 < MTOK; m0 += 2 * NGW) {
                    const int m1 = (m0 + NGW < MTOK) ? m0 + NGW : m0;
                    f32x4 v[2][4], xv[2][4]; float s[2] = {0.f, 0.f};
#pragma unroll
                    for (int q = 0; q < 2; ++q) { const int m = q ? m1 : m0;
#pragma unroll
                        for (int j = 0; j < 4; ++j) { v[q][j] = unpack4bf(((const u32x2*)((const bf16_t*)P_OUTB + (size_t)m * 1024))[64 * j + lane]); xv[q][j] = ((const f32x4*)(xo + (size_t)m * 1024))[64 * j + lane]; } }
#pragma unroll
                    for (int q = 0; q < 2; ++q)
#pragma unroll
                        for (int j = 0; j < 4; ++j) s[q] += (v[q][j][0] * v[q][j][0] + v[q][j][1] * v[q][j][1]) + (v[q][j][2] * v[q][j][2] + v[q][j][3] * v[q][j][3]);
#pragma unroll
                    for (int q = 0; q < 2; ++q) { const int m = q ? m1 : m0;
                        const float rstd = __builtin_amdgcn_rsqf(wave_sum(s[q]) * (1.0f / 1024.0f) + NORM_EPS); float s2 = 0.f;
#pragma unroll
                        for (int j = 0; j < 4; ++j) { const f32x4 gv = ((const f32x4*)gp)[64 * j + lane];
                            v[q][j] = xv[q][j] + v[q][j] * rstd * gv; ((f32x4*)(a.out + (size_t)m * 1024))[64 * j + lane] = v[q][j];
                            s2 += (v[q][j][0] * v[q][j][0] + v[q][j][1] * v[q][j][1]) + (v[q][j][2] * v[q][j][2] + v[q][j][3] * v[q][j][3]); }
                        if (l + 1 < DEPTH) { const float rstd2 = __builtin_amdgcn_rsqf(wave_sum(s2) * (1.0f / 1024.0f) + NORM_EPS);
#pragma unroll
                            for (int j = 0; j < 4; ++j) store4bf(P_XN + (size_t)m * 1024 + 4 * (64 * j + lane), v[q][j] * rstd2); } }
                }
#endif
            }
        }
        if (ph + 1 < a.ph_hi) { if (a.coop) { if (ph == 0) cg::this_grid().sync(); else xcd_barrier(xbar); } }
    }
#ifdef DBG_NPH
    if (a.pad) {
        if (a.coop) cg::this_grid().sync();
        const unsigned short* w16 = (const unsigned short*)(a.ws + OFF_MN);
        const size_t n16 = (WS_END - OFF_MN) / 2, nout = (size_t)MTOK * 1024;
        for (size_t i = (size_t)blockIdx.x * 512 + threadIdx.x; i < nout; i += (size_t)gridDim.x * 512) {
            unsigned x = 0; for (size_t k = i; k < n16; k += nout) x ^= w16[k];
            const unsigned short* w2 = (const unsigned short*)(a.ws + OFF_COS); if (i < (size_t)(4 * MiB) / 2) x ^= w2[i];
            a.out[i] = (float)x;
        }
    }
#endif
}

extern "C" void kernel_launch(void* const* d_in, const int* in_sizes, int n_in, void* d_out, int out_size, void* d_ws, size_t ws_size, hipStream_t stream) {
    static int grid = 0;
    if (grid == 0) {
        if (n_in != 20 || ws_size < WS_END) { fprintf(stderr, "kernel_launch: need 20 inputs and >= %zu bytes of workspace (got %d, %zu)\n", (size_t)WS_END, n_in, ws_size); grid = -1; return; }
        int dev = 0, cus = 0, per_cu = 0;
        hipGetDevice(&dev); hipDeviceGetAttribute(&cus, hipDeviceAttributeMultiprocessorCount, dev);
        if (hipFuncSetAttribute((const void*)hybrid_fwd, hipFuncAttributeMaxDynamicSharedMemorySize, LDS_BYTES) != hipSuccess) { fprintf(stderr, "kernel_launch: hipFuncSetAttribute failed\n"); grid = -1; return; }
        if (hipOccupancyMaxActiveBlocksPerMultiprocessor(&per_cu, (const void*)hybrid_fwd, 512, LDS_BYTES) != hipSuccess || per_cu < 1) per_cu = 1;
        (void)hipGetLastError();
        grid = cus * 1;
    }
    if (grid < 0) return;
    if (hipMemsetAsync((char*)d_ws + OFF_BAR, 0, 16384, stream) != hipSuccess) { fprintf(stderr, "kernel_launch: hipMemsetAsync failed\n"); return; }
    Args a{};
    for (int i = 0; i < 20; ++i) a.in[i] = (const float*)d_in[i];
    a.out = (float*)d_out; a.ws = (unsigned char*)d_ws; a.pad = 0;
    a.lam_init[0] = 0.2f; a.lam_init[1] = 0.35550906759096926f; a.lam_init[2] = 0.47071301834358424f; a.lam_init[3] = 0.55605820415654f;
#if MK_ONE_LAUNCH
#ifdef DBG_NPH
    a.ph_lo = 0; a.ph_hi = DBG_NPH; a.coop = 1; a.pad = 1;
#else
    a.ph_lo = 0; a.ph_hi = NPHASE; a.coop = 1;
#endif
    void* args[] = {&a};
    hipError_t e = hipLaunchCooperativeKernel((const void*)hybrid_fwd, dim3(grid), dim3(512), args, LDS_BYTES, stream);
    if (e != hipSuccess) fprintf(stderr, "cooperative launch failed: %s (grid %d)\n", hipGetErrorString(e), grid);
#else
    for (int ph = 0; ph < NPHASE; ++ph) { a.ph_lo = ph; a.ph_hi = ph + 1; a.coop = 0;
        hipLaunchKernelGGL(hybrid_fwd, dim3(grid), dim3(512), LDS_BYTES, stream, a); }
#endif
}
```

```cpp
#include <hip/hip_runtime.h>
#include <hip/hip_cooperative_groups.h>
#include <cstdio>
#include <cstdint>
namespace cg = cooperative_groups;

#ifndef ATTSEL
#define ATTSEL 7
#endif
#ifndef GSEL
#define GSEL 0xFFFF
#endif
#ifndef PHSEL
#define PHSEL 0xFFFF
#endif
#ifndef MK_ONE_LAUNCH
#define MK_ONE_LAUNCH 1
#endif

#define LAS __attribute__((address_space(3)))
typedef unsigned short bf16_t;
typedef short bf16x8 __attribute__((ext_vector_type(8)));
typedef short s16x4 __attribute__((ext_vector_type(4)));
typedef float f32x4 __attribute__((ext_vector_type(4)));
typedef float f32x16 __attribute__((ext_vector_type(16)));
typedef unsigned u32x4 __attribute__((ext_vector_type(4)));
typedef unsigned u32x2 __attribute__((ext_vector_type(2)));
typedef float f32x2_t __attribute__((ext_vector_type(2)));
typedef __bf16 bf16x2_t __attribute__((ext_vector_type(2)));

constexpr int D_MODEL = 1024, BATCH = 16, SEQ = 4096, DEPTH = 4, MEMT = 256;
constexpr int MTOK = BATCH * SEQ;
constexpr int MMEM = BATCH * MEMT;
constexpr int IN_WIDTH = 7072;
constexpr float NORM_EPS = 1e-6f;
constexpr float LOG2E = 1.4426950408889634f;

constexpr size_t WL_IN = 0;
constexpr size_t WL_UQ = WL_IN + (size_t)7168 * 1024;
constexpr size_t WL_UKV = WL_UQ + (size_t)768 * 256;
constexpr size_t WL_MEM = WL_UKV + (size_t)1024 * 128;
constexpr size_t WL_BR = WL_MEM + (size_t)1024 * 1024;
constexpr size_t WL_OUT = WL_BR + (size_t)3 * 1024 * 512;
constexpr size_t WL_TOTAL = WL_OUT + (size_t)1024 * 3072;

constexpr size_t MiB = 1u << 20;
constexpr size_t OFF_W = 0;
constexpr size_t OFF_COS = 104 * MiB, OFF_SIN = OFF_COS + 256 * 1024;
constexpr size_t OFF_SSQQ = 105 * MiB, OFF_SSQKV = 106 * MiB;
constexpr size_t OFF_BAR = 107 * MiB;
constexpr size_t OFF_MN = 108 * MiB;
constexpr size_t OFF_KM = 116 * MiB;
constexpr size_t OFF_VMT = 132 * MiB;
constexpr size_t OFF_XN = 148 * MiB;
constexpr size_t OFF_O = 276 * MiB;
constexpr size_t OFF_R = 468 * MiB;
constexpr size_t OFF_CQ = OFF_R;
constexpr size_t OFF_CKV = OFF_CQ + 32 * MiB;
constexpr size_t OFF_KPE = OFF_CKV + 16 * MiB;
constexpr size_t OFF_QD = OFF_KPE + 4 * MiB;
constexpr size_t OFF_KD = OFF_QD + 64 * MiB;
constexpr size_t OFF_VDT = OFF_KD + 64 * MiB;
constexpr size_t OFF_QX = OFF_VDT + 64 * MiB;
constexpr size_t OFF_QA = OFF_QX + 64 * MiB;
constexpr size_t OFF_KN = OFF_QA + 96 * MiB;
constexpr size_t OFF_VAT = OFF_KN + 64 * MiB;
constexpr size_t WS_END = OFF_VAT + 64 * MiB;
constexpr size_t OFF_S = OFF_R;
constexpr size_t OFF_MERGED = OFF_R + 384 * MiB;
constexpr size_t OFF_OUT = OFF_R;
static_assert(4 * WL_TOTAL * 2 <= OFF_COS && OFF_MERGED + 128 * MiB <= WS_END, "ws map");

constexpr int LDS_BYTES = 163840;
constexpr int NPHASE = 1 + 7 * DEPTH;

__device__ __forceinline__ unsigned cvtpk(float lo, float hi) { f32x2_t v = {lo, hi}; bf16x2_t b = __builtin_convertvector(v, bf16x2_t); return __builtin_bit_cast(unsigned, b); }
__device__ __forceinline__ void store4bf(bf16_t* p, f32x4 v) { u32x2 w; w.x = cvtpk(v[0], v[1]); w.y = cvtpk(v[2], v[3]); *(u32x2*)p = w; }
__device__ __forceinline__ f32x4 unpack4bf(u32x2 w) { f32x4 r; r[0] = __uint_as_float(w.x << 16); r[1] = __uint_as_float(w.x & 0xffff0000u); r[2] = __uint_as_float(w.y << 16); r[3] = __uint_as_float(w.y & 0xffff0000u); return r; }
__device__ __forceinline__ void store8bf(bf16_t* p, f32x4 a, f32x4 b) { u32x4 w; w.x = cvtpk(a[0], a[1]); w.y = cvtpk(a[2], a[3]); w.z = cvtpk(b[0], b[1]); w.w = cvtpk(b[2], b[3]); *(u32x4*)p = w; }
__device__ __forceinline__ float fast_rcp(float x) { return __builtin_amdgcn_rcpf(x); }
__device__ __forceinline__ float fast_exp2(float x) { return __builtin_amdgcn_exp2f(x); }
__device__ __forceinline__ float sigmoidf_(float v) { return fast_rcp(1.0f + fast_exp2(-v * LOG2E)); }

namespace pg8 {
constexpr int BM = 256, BK = 64, HALF = 128, HTB = HALF * BK * 2, STAGE_BYTES = 8 * HTB, NXCD = 8, WGM = 8;
__host__ __device__ __forceinline__ int lds_byte(int r, int c) { const int st = (r >> 4) * 2 + (c >> 5), rr = r & 15, cc = c & 31, ob = rr * 64 + cc * 2; return st * 1024 + (ob ^ (((ob >> 9) & 1) << 5)); }
__host__ __device__ __forceinline__ void stage_rc(int b, int& R, int& C) { const int st = b / 1024, sb = b % 1024, swz = sb ^ (((sb >> 9) & 1) << 5); R = (st >> 1) * 16 + swz / 64; C = (st & 1) * 32 + (swz % 64) / 2; }

__host__ __device__ __forceinline__ int perm32(int rho) { const int n = rho >> 4, i = rho & 15; return 8 * (i >> 2) + 4 * n + (i & 3); }
struct Unit { int pm, pn, z; };
struct Gemm { const bf16_t* A; const bf16_t* Bt; int M, N, K, lda, ldb; size_t zA, zB; };

struct StaticOrder {
    int nM, nN, nwg, G, c, nz;
    __device__ void init(int M, int N, int G_, int c_, int nz_ = 1) { nM = M / BM; nN = N / BM; nwg = nM * nN; G = G_; c = c_; nz = nz_; }
    __device__ bool next(int i, Unit& u) const {
        const int ib = i / nz; u.z = i - ib * nz;
        const long L = (long)ib * G + c; if (L >= nwg) return false;
        int wgid = (int)L; { const int q = nwg / NXCD, r = nwg % NXCD, xcd = wgid % NXCD, off = wgid / NXCD; wgid = (xcd < r ? xcd * (q + 1) : r * (q + 1) + (xcd - r) * q) + off; }
        const int nig = WGM * nN, gid = wgid / nig, fm = gid * WGM, gsz = (nM - fm) < WGM ? (nM - fm) : WGM;
        u.pm = fm + ((wgid % nig) % gsz); u.pn = (wgid % nig) / gsz; return true;
    }
};

template <class Epi>
__device__ __forceinline__ void gemm_phase(LAS unsigned char* lds, const Gemm g, const StaticOrder& S, const Epi& E) {
    int tid = threadIdx.x; asm volatile("" : "+v"(tid));
    const int wid = __builtin_amdgcn_readfirstlane(tid >> 6), lane = tid & 63, wr = wid >> 2, wc = wid & 3, fr = lane & 15, fq = lane >> 4;
    int K = g.K; asm volatile("" : "+s"(K)); const int nt = K / BK;
    unsigned voffA[2], voffB[2];
#pragma unroll
    for (int i = 0; i < 2; ++i) { int R, C; stage_rc(tid * 16 + i * 8192, R, C);
        const int Rb = Epi::PERM ? ((R & ~31) + perm32(R & 31)) : R;
        voffA[i] = (unsigned)(R * g.lda + C) * 2u; voffB[i] = (unsigned)(Rb * g.ldb + C) * 2u; }
    const size_t kstep = (size_t)(BK * 2);
    const size_t hstepA = (size_t)HALF * g.lda * 2, hstepB = (size_t)HALF * g.ldb * 2;
    const size_t tstepA = 2 * hstepA, tstepB = 2 * hstepB;
    const unsigned ldsw = (unsigned)wid * 1024u;
    const int aoff = lds_byte(wr * 64 + fr, fq * 8), boff = lds_byte(wc * 32 + fr, fq * 8);
#define PG8_SA(b, h) (((b) * 2 + (h)) * HTB)
#define PG8_SB(b, h) ((4 + (b) * 2 + (h)) * HTB)
#define PG8_STAGE(bufoff, gbase, voff) do { _Pragma("unroll") for (int _i = 0; _i < 2; ++_i) \
        __builtin_amdgcn_global_load_lds((const unsigned*)((const char*)(gbase) + (voff)[_i]), (LAS unsigned*)(lds + (bufoff) + ldsw + _i * 8192), 16, 0, 0); } while (0)
#define PG8_LDA(dst, b, h) do { _Pragma("unroll") for (int m = 0; m < 4; ++m) _Pragma("unroll") for (int k = 0; k < 2; ++k) dst[m][k] = *(const LAS bf16x8*)(lds + PG8_SA(b, h) + aoff + m * 2048 + k * 1024); } while (0)
#define PG8_LDB(dst, b, h) do { _Pragma("unroll") for (int n = 0; n < 2; ++n) _Pragma("unroll") for (int k = 0; k < 2; ++k) dst[n][k] = *(const LAS bf16x8*)(lds + PG8_SB(b, h) + boff + n * 2048 + k * 1024); } while (0)
#define PG8_MMA(ai, bj, At, Bt) do { __builtin_amdgcn_s_setprio(1); _Pragma("unroll") for (int m = 0; m < 4; ++m) _Pragma("unroll") for (int n = 0; n < 2; ++n) _Pragma("unroll") for (int k = 0; k < 2; ++k) \
        acc[ai][bj][m][n] = __builtin_amdgcn_mfma_f32_16x16x32_bf16(Bt[n][k], At[m][k], acc[ai][bj][m][n], 0, 0, 0); __builtin_amdgcn_s_setprio(0); } while (0)
#define PG8_WAIT_V(n) asm volatile("s_waitcnt vmcnt(" #n ")" ::: "memory")
#define PG8_WAIT_L(n) asm volatile("s_waitcnt lgkmcnt(" #n ")" ::: "memory")
#define PG8_BAR __builtin_amdgcn_s_barrier()
#define PG8_SCHED __builtin_amdgcn_sched_barrier(0)
    Unit cur, nxt; int ui = 0;
    if (!S.next(0, cur)) return;
    f32x4 acc[2][2][4][2];
#pragma unroll
    for (int a = 0; a < 2; ++a)
#pragma unroll
        for (int b = 0; b < 2; ++b)
#pragma unroll
            for (int m = 0; m < 4; ++m)
#pragma unroll
                for (int n = 0; n < 2; ++n) acc[a][b][m][n] = (f32x4){0.f, 0.f, 0.f, 0.f};
    bf16x8 At[4][2], B0[2][2], B1[2][2];
    const char* cA = (const char*)g.A + ((size_t)cur.z * g.zA) * 2 + (size_t)cur.pm * tstepA;
    const char* cB = (const char*)g.Bt + ((size_t)cur.z * g.zB) * 2 + (size_t)cur.pn * tstepB;
    PG8_STAGE(PG8_SB(0, 0), cB, voffB); PG8_STAGE(PG8_SB(0, 1), cB + hstepB, voffB); PG8_STAGE(PG8_SA(0, 0), cA, voffA); PG8_STAGE(PG8_SA(0, 1), cA + hstepA, voffA);
    if (wr == 1) PG8_BAR;
    PG8_WAIT_V(2); PG8_BAR;
    PG8_STAGE(PG8_SB(1, 0), cB + kstep, voffB); PG8_STAGE(PG8_SA(1, 0), cA + kstep, voffA); PG8_STAGE(PG8_SB(1, 1), cB + hstepB + kstep, voffB);
    PG8_WAIT_V(6); PG8_BAR;
    for (;;) {
        const bool has_next = S.next(ui + 1, nxt);
        const char* nA = has_next ? (const char*)g.A + ((size_t)nxt.z * g.zA) * 2 + (size_t)nxt.pm * tstepA : cA;
        const char* nB = has_next ? (const char*)g.Bt + ((size_t)nxt.z * g.zB) * 2 + (size_t)nxt.pn * tstepB : cB;
        for (int t = 0; t < nt; t += 2) {
            const bool last = (t == nt - 2);
            const char* a1 = cA + (size_t)(t + 1) * kstep;
            const char* a2 = last ? nA : cA + (size_t)(t + 2) * kstep; const char* b2 = last ? nB : cB + (size_t)(t + 2) * kstep;
            const char* a3 = a2 + kstep; const char* b3 = b2 + kstep;
            PG8_LDB(B0, 0, 0); PG8_LDB(B1, 0, 1); PG8_SCHED; PG8_LDA(At, 0, 0); PG8_STAGE(PG8_SA(1, 1), a1 + hstepA, voffA);
            PG8_WAIT_V(8); PG8_WAIT_L(0); PG8_BAR; PG8_MMA(0, 0, At, B0); PG8_MMA(0, 1, At, B1); PG8_BAR; PG8_SCHED;
            PG8_LDA(At, 0, 1); PG8_STAGE(PG8_SB(0, 0), b2, voffB); PG8_STAGE(PG8_SB(0, 1), b2 + hstepB, voffB); PG8_STAGE(PG8_SA(0, 0), a2, voffA);
            PG8_WAIT_V(8); PG8_WAIT_L(0); PG8_BAR; PG8_MMA(1, 0, At, B0); PG8_MMA(1, 1, At, B1); PG8_BAR; PG8_SCHED;
            PG8_LDB(B0, 1, 0); PG8_LDB(B1, 1, 1); PG8_SCHED; PG8_LDA(At, 1, 0); PG8_STAGE(PG8_SA(0, 1), a2 + hstepA, voffA);
            PG8_WAIT_V(8); PG8_WAIT_L(0); PG8_BAR; PG8_MMA(0, 0, At, B0); PG8_MMA(0, 1, At, B1); PG8_BAR; PG8_SCHED;
            PG8_LDA(At, 1, 1); PG8_STAGE(PG8_SB(1, 0), b3, voffB); PG8_STAGE(PG8_SB(1, 1), b3 + hstepB, voffB); PG8_STAGE(PG8_SA(1, 0), a3, voffA);
            PG8_WAIT_V(8); PG8_WAIT_L(0); PG8_BAR; PG8_MMA(1, 0, At, B0); PG8_MMA(1, 1, At, B1); PG8_BAR; PG8_SCHED;
        }
        if (wr == 0) PG8_BAR;
        E(acc, cur, wr, wc, fr, fq);
        if (!has_next) break;
#pragma unroll
        for (int a = 0; a < 2; ++a)
#pragma unroll
            for (int b = 0; b < 2; ++b)
#pragma unroll
                for (int m = 0; m < 4; ++m)
#pragma unroll
                    for (int n = 0; n < 2; ++n) acc[a][b][m][n] = (f32x4){0.f, 0.f, 0.f, 0.f};
        cur = nxt; cA = nA; cB = nB; ++ui;
        if (wr == 1) PG8_BAR;
    }
    PG8_WAIT_V(0);
    PG8_BAR;
    asm volatile("" ::: "memory"); PG8_SCHED;
#undef PG8_SA
#undef PG8_SB
#undef PG8_STAGE
#undef PG8_LDA
#undef PG8_LDB
#undef PG8_MMA
#undef PG8_WAIT_V
#undef PG8_WAIT_L
#undef PG8_BAR
#undef PG8_SCHED
}

#define EPI_ROWS_BEGIN _Pragma("unroll") for (int ai = 0; ai < 2; ++ai) _Pragma("unroll") for (int m = 0; m < 4; ++m) { const int row = u.pm * BM + ai * HALF + wr * 64 + m * 16 + fr;
#define EPI_ROWS_END if (m & 1) asm volatile("" ::: "memory"); }
#define EPI_COLS_BEGIN _Pragma("unroll") for (int bj = 0; bj < 2; ++bj) _Pragma("unroll") for (int n = 0; n < 2; ++n) { const int colt = bj * HALF + wc * 32 + n * 16 + 4 * fq;
#define EPI_COLS_END }
typedef f32x4 Acc[2][2][4][2];

__device__ __forceinline__ float rstd4(const float* ssq, int row, float inv_dim) { const f32x4 p = *(const f32x4*)(ssq + (size_t)row * 4); return __builtin_amdgcn_rsqf(((p[0] + p[1]) + (p[2] + p[3])) * inv_dim + NORM_EPS); }

struct Epi1 {
    static constexpr bool PERM = false;
    bf16_t *CQ, *CKV, *KPE, *QD, *KD, *QX; float *SSQq, *SSQkv; const float *COS, *SIN; float sc_d, sc_x;
    __device__ __forceinline__ void operator()(const Acc& acc, const Unit& u, int wr, int wc, int fr, int fq) const {
        const int pn = u.pn;
        EPI_ROWS_BEGIN
            const float r = 1.0f;
            if (pn == 0) {
                float ss = 0.f;
                EPI_COLS_BEGIN const f32x4 v = acc[ai][bj][m][n] * r; ss += (v[0] * v[0] + v[1] * v[1]) + (v[2] * v[2] + v[3] * v[3]); store4bf(CQ + (size_t)row * 256 + colt, v); EPI_COLS_END
                ss += __shfl_xor(ss, 16); ss += __shfl_xor(ss, 32);
                if (fq == 0) SSQq[(size_t)row * 4 + wc] = ss;
            } else if (pn == 1) {
                float ss = 0.f;
#pragma unroll
                for (int n = 0; n < 2; ++n) { const f32x4 v = acc[ai][0][m][n] * r; ss += (v[0] * v[0] + v[1] * v[1]) + (v[2] * v[2] + v[3] * v[3]); store4bf(CKV + (size_t)row * 128 + wc * 32 + n * 16 + 4 * fq, v); }
                ss += __shfl_xor(ss, 16); ss += __shfl_xor(ss, 32);
                if (fq == 0) SSQkv[(size_t)row * 4 + wc] = ss;
                if (wc == 0) {
                    const int s = row & (SEQ - 1); const f32x4 cs = *(const f32x4*)(COS + s * 16 + 4 * fq), sn = *(const f32x4*)(SIN + s * 16 + 4 * fq);
                    const f32x4 x1 = acc[ai][1][m][0] * r, x2 = acc[ai][1][m][1] * r;
                    store4bf(KPE + (size_t)row * 32 + 4 * fq, x1 * cs - x2 * sn); store4bf(KPE + (size_t)row * 32 + 16 + 4 * fq, x2 * cs + x1 * sn);
                }
            } else if (pn < 6) {
                bf16_t* dst = (pn < 4 ? QD : KD) + (size_t)row * 512 + (pn & 1) * 256 + wc * 32 + 4 * fq; const float sc = (pn < 4 ? sc_d : 1.0f) * r;
                const int s = row & (SEQ - 1); const f32x4 cs = *(const f32x4*)(COS + s * 16 + 4 * fq), sn = *(const f32x4*)(SIN + s * 16 + 4 * fq);
#pragma unroll
                for (int bj = 0; bj < 2; ++bj) { const f32x4 x1 = acc[ai][bj][m][0] * sc, x2 = acc[ai][bj][m][1] * sc;
                    store4bf(dst + bj * HALF, x1 * cs - x2 * sn); store4bf(dst + bj * HALF + 16, x2 * cs + x1 * sn); }
            } else {
                const float sc = sc_x * r;
                EPI_COLS_BEGIN store4bf(QX + (size_t)row * 512 + (pn - 6) * 256 + colt, acc[ai][bj][m][n] * sc); EPI_COLS_END
            }
        EPI_ROWS_END
    }
};
#define EPIP_BJ_BEGIN _Pragma("unroll") for (int bj = 0; bj < 2; ++bj) { const int colt = bj * HALF + wc * 32 + 8 * fq;
#define EPIP_BJ_END }
struct EpiT {
    static constexpr bool PERM = true;
    bf16_t* O; size_t ldc; size_t zO; const float* ssq; float inv_dim; const float* colscale;
    __device__ __forceinline__ void operator()(const Acc& acc, const Unit& u, int wr, int wc, int fr, int fq) const {
        f32x4 cs[2][2];
        EPIP_BJ_BEGIN
            const int col = u.pn * BM + colt;
#pragma unroll
            for (int n = 0; n < 2; ++n) {
                if (ssq) { for (int i = 0; i < 4; ++i) cs[bj][n][i] = rstd4(ssq, col + 4 * n + i, inv_dim); }
                else cs[bj][n] = (f32x4){1.f, 1.f, 1.f, 1.f}; }
        EPIP_BJ_END
        bf16_t* base = O + (size_t)u.z * zO;
        EPI_ROWS_BEGIN
            EPIP_BJ_BEGIN store8bf(base + (size_t)row * ldc + u.pn * BM + colt, acc[ai][bj][m][0] * cs[bj][0], acc[ai][bj][m][1] * cs[bj][1]); EPIP_BJ_END
        EPI_ROWS_END
    }
};
struct EpiRow {
    static constexpr bool PERM = true;
    bf16_t* O; size_t ldc; size_t zO; const float* ssq; float inv_dim;
    __device__ __forceinline__ void operator()(const Acc& acc, const Unit& u, int wr, int wc, int fr, int fq) const {
        bf16_t* base = O + (size_t)u.z * zO;
        EPI_ROWS_BEGIN
            const float sc = ssq ? rstd4(ssq, row, inv_dim) : 1.0f;
            EPIP_BJ_BEGIN store8bf(base + (size_t)row * ldc + u.pn * BM + colt, acc[ai][bj][m][0] * sc, acc[ai][bj][m][1] * sc); EPIP_BJ_END
        EPI_ROWS_END
    }
};
struct Epi2 {
    static constexpr bool PERM = false;
    bf16_t* QA; const float* SSQq; const float *COS, *SIN; float sc_a;
    __device__ __forceinline__ void operator()(const Acc& acc, const Unit& u, int wr, int wc, int fr, int fq) const {
        EPI_ROWS_BEGIN
            const float sc = rstd4(SSQq, row, 1.0f / 256.0f) * sc_a;
            if (u.pn < 2) {
                EPI_COLS_BEGIN const int nn = u.pn * BM + colt; store4bf(QA + (size_t)row * 768 + (nn >> 6) * 96 + (nn & 63), acc[ai][bj][m][n] * sc); EPI_COLS_END
            } else {
                const int s = row & (SEQ - 1); const f32x4 cs = *(const f32x4*)(COS + s * 16 + 4 * fq), sn = *(const f32x4*)(SIN + s * 16 + 4 * fq);
#pragma unroll
                for (int bj = 0; bj < 2; ++bj) { const f32x4 x1 = acc[ai][bj][m][0] * sc, x2 = acc[ai][bj][m][1] * sc; bf16_t* dst = QA + (size_t)row * 768 + (4 * bj + wc) * 96 + 64 + 4 * fq;
                    store4bf(dst, x1 * cs - x2 * sn); store4bf(dst + 16, x2 * cs + x1 * sn); }
            }
        EPI_ROWS_END
    }
};
struct EpiSG {
    static constexpr bool PERM = true;
    bf16_t* O;
    __device__ __forceinline__ void operator()(const Acc& acc, const Unit& u, int wr, int wc, int fr, int fq) const {
#pragma unroll
        for (int ai = 0; ai < 2; ++ai) {
            u32x4 ov[4][2];
#pragma unroll
            for (int m = 0; m < 4; ++m) { const int row = u.pm * BM + ai * HALF + wr * 64 + m * 16 + fr;
                EPIP_BJ_BEGIN ov[m][bj] = *(const u32x4*)(O + (size_t)row * 1536 + u.pn * BM + colt); EPIP_BJ_END }
#pragma unroll
            for (int m = 0; m < 4; ++m) { const int row = u.pm * BM + ai * HALF + wr * 64 + m * 16 + fr;
                EPIP_BJ_BEGIN u32x2 lo_, hi_; lo_.x = ov[m][bj].x; lo_.y = ov[m][bj].y; hi_.x = ov[m][bj].z; hi_.y = ov[m][bj].w;
                    const f32x4 o0 = unpack4bf(lo_), o1 = unpack4bf(hi_); const f32x4 g0 = acc[ai][bj][m][0], g1 = acc[ai][bj][m][1]; f32x4 v0, v1;
#pragma unroll
                    for (int i = 0; i < 4; ++i) { v0[i] = o0[i] * g0[i] * sigmoidf_(g0[i]); v1[i] = o1[i] * g1[i] * sigmoidf_(g1[i]); }
                    store8bf(O + (size_t)row * 1536 + u.pn * BM + colt, v0, v1); EPIP_BJ_END }
            asm volatile("" ::: "memory");
        }
    }
};
struct EpiGL {
    static constexpr bool PERM = true;
    bf16_t* S; const float* bias;
    __device__ __forceinline__ void operator()(const Acc& acc, const Unit& u, int wr, int wc, int fr, int fq) const {
        f32x4 bv[2][2];
        EPIP_BJ_BEGIN bv[bj][0] = *(const f32x4*)(bias + u.pn * BM + colt); bv[bj][1] = *(const f32x4*)(bias + u.pn * BM + colt + 4); EPIP_BJ_END
        EPI_ROWS_BEGIN
            EPIP_BJ_BEGIN const f32x4 g0 = acc[ai][bj][m][0] + bv[bj][0], g1 = acc[ai][bj][m][1] + bv[bj][1]; f32x4 v0, v1;
#pragma unroll
                for (int i = 0; i < 4; ++i) { v0[i] = sigmoidf_(g0[i]); v1[i] = sigmoidf_(g1[i]); }
                store8bf(S + (size_t)row * 3072 + u.pn * BM + colt, v0, v1); EPIP_BJ_END
        EPI_ROWS_END
    }
};
struct EpiBR {
    static constexpr bool PERM = true;
    const bf16_t* S; bf16_t* MG;
    __device__ __forceinline__ void operator()(const Acc& acc, const Unit& u, int wr, int wc, int fr, int fq) const {
#pragma unroll
        for (int ai = 0; ai < 2; ++ai) {
            u32x4 sv[4][2]; unsigned long long mv[4][2][2];
#pragma unroll
            for (int m = 0; m < 4; ++m) { const int row = u.pm * BM + ai * HALF + wr * 64 + m * 16 + fr;
                EPIP_BJ_BEGIN const int col = u.pn * BM + colt; sv[m][bj] = *(const u32x4*)(S + (size_t)row * 3072 + u.z * 1024 + col);
                    const unsigned long long* mp_ = (const unsigned long long*)(MG + (size_t)row * 1024 + col);
                    mv[m][bj][0] = (u.z > 0) ? __hip_atomic_load(mp_, __ATOMIC_RELAXED, __HIP_MEMORY_SCOPE_AGENT) : 0ull;
                    mv[m][bj][1] = (u.z > 0) ? __hip_atomic_load(mp_ + 1, __ATOMIC_RELAXED, __HIP_MEMORY_SCOPE_AGENT) : 0ull; EPIP_BJ_END }
#pragma unroll
            for (int m = 0; m < 4; ++m) { const int row = u.pm * BM + ai * HALF + wr * 64 + m * 16 + fr;
                EPIP_BJ_BEGIN const int col = u.pn * BM + colt; u32x2 lo_, hi_; lo_.x = sv[m][bj].x; lo_.y = sv[m][bj].y; hi_.x = sv[m][bj].z; hi_.y = sv[m][bj].w;
                    f32x4 v0 = unpack4bf(lo_) * acc[ai][bj][m][0], v1 = unpack4bf(hi_) * acc[ai][bj][m][1];
                    u32x2 w0, w1; w0.x = (unsigned)mv[m][bj][0]; w0.y = (unsigned)(mv[m][bj][0] >> 32); w1.x = (unsigned)mv[m][bj][1]; w1.y = (unsigned)(mv[m][bj][1] >> 32);
                    v0 += unpack4bf(w0); v1 += unpack4bf(w1);
                    store8bf(MG + (size_t)row * 1024 + col, v0, v1); EPIP_BJ_END }
            asm volatile("" ::: "memory");
        }
    }
};
struct EpiOut {
    static constexpr bool PERM = false;
    float* OUT;
    __device__ __forceinline__ void operator()(const Acc& acc, const Unit& u, int wr, int wc, int fr, int fq) const {
        EPI_ROWS_BEGIN
            EPI_COLS_BEGIN *(f32x4*)(OUT + (size_t)row * 1024 + u.pn * BM + colt) = acc[ai][bj][m][n]; EPI_COLS_END
        EPI_ROWS_END
    }
};
}

__device__ __forceinline__ float half_max(float v) { auto rr = __builtin_amdgcn_permlane32_swap(__float_as_uint(v), __float_as_uint(v), false, false); return fmaxf(__uint_as_float(rr[0]), __uint_as_float(rr[1])); }
__device__ __forceinline__ float half_sum(float v) { auto rr = __builtin_amdgcn_permlane32_swap(__float_as_uint(v), __float_as_uint(v), false, false); return __uint_as_float(rr[0]) + __uint_as_float(rr[1]); }
__device__ __forceinline__ int crow(int r, int hi) { return (r & 3) + 8 * (r >> 2) + 4 * hi; }

template <int NMAP, int DKM, int DV, bool CAUSAL, int W0, int W1>
__device__ __forceinline__ void attn_unit(LAS unsigned char* lds, const bf16_t* __restrict__ Q, int ldq, const bf16_t* __restrict__ K0, int ldk0, const bf16_t* __restrict__ K1, int ldk1,
                                          const bf16_t* __restrict__ Vt, size_t ldv, int q0, int NT, bf16_t* O, int ldo, float lam, const float* subln, float outscale) {
    constexpr int DKT = NMAP * DKM, KS = DKT * 2 + 16, VS = 136, KBUF = 64 * KS, VBUF = DV * VS;
    constexpr int NC = DKM / 16, NDB = DV / 32;
    constexpr int K0C = W0 / 8, K0N = (64 * K0C) / 512, K1C = W1 / 8, VN = (DV * 8) / 512;
    static_assert(W0 + W1 == DKT && K0N >= 1 && VN >= 1, "attention staging geometry");
    int tid = threadIdx.x; asm volatile("" : "+v"(tid));
    const int lane = tid & 63, wid = __builtin_amdgcn_readfirstlane(tid >> 6), r32 = lane & 31, hi = lane >> 5;
    LAS unsigned char* Kb = lds; LAS unsigned char* Vb = lds + 2 * KBUF;
    bf16x8 qf[NMAP][NC];
    { const bf16_t* qrow = Q + (size_t)(q0 + wid * 32 + r32) * ldq;
#pragma unroll
      for (int mp = 0; mp < NMAP; ++mp)
#pragma unroll
          for (int c = 0; c < NC; ++c) qf[mp][c] = *(const bf16x8*)(qrow + mp * DKM + 16 * c + 8 * hi); }
    f32x16 o[NMAP][NDB]; float mrow[NMAP], lrow[NMAP];
#pragma unroll
    for (int mp = 0; mp < NMAP; ++mp) { mrow[mp] = -INFINITY; lrow[mp] = 0.f;
#pragma unroll
        for (int db = 0; db < NDB; ++db)
#pragma unroll
            for (int r = 0; r < 16; ++r) o[mp][db][r] = 0.f; }
    u32x4 kreg[K0N], k1reg = {0u, 0u, 0u, 0u}, vreg[VN];
#define ATT_GLOAD(t) do { \
    _Pragma("unroll") for (int i = 0; i < K0N; ++i) { const int idx = tid + 512 * i, rr = idx / K0C, cc = idx % K0C; kreg[i] = *(const u32x4*)(K0 + (size_t)(64 * (t) + rr) * ldk0 + cc * 8); } \
    if (W1 > 0) { if (tid < 64 * K1C) { const int rr = tid / (K1C > 0 ? K1C : 1), cc = tid % (K1C > 0 ? K1C : 1); k1reg = *(const u32x4*)(K1 + (size_t)(64 * (t) + rr) * ldk1 + cc * 8); } } \
    _Pragma("unroll") for (int i = 0; i < VN; ++i) { const int idx = tid + 512 * i, dd = idx >> 3, cc = idx & 7; vreg[i] = *(const u32x4*)(Vt + (size_t)dd * ldv + 64 * (t) + cc * 8); } } while (0)
#define ATT_LWRITE(buf) do { \
    _Pragma("unroll") for (int i = 0; i < K0N; ++i) { const int idx = tid + 512 * i, rr = idx / K0C, cc = idx % K0C; *(LAS u32x4*)(Kb + (buf) * KBUF + rr * KS + cc * 16) = kreg[i]; } \
    if (W1 > 0) { if (tid < 64 * K1C) { const int rr = tid / (K1C > 0 ? K1C : 1), cc = tid % (K1C > 0 ? K1C : 1); *(LAS u32x4*)(Kb + (buf) * KBUF + rr * KS + W0 * 2 + cc * 16) = k1reg; } } \
    _Pragma("unroll") for (int i = 0; i < VN; ++i) { const int idx = tid + 512 * i, dd = idx >> 3, cc = idx & 7; LAS u32x2* vp = (LAS u32x2*)(Vb + (buf) * VBUF + dd * VS + cc * 16); \
        u32x2 lo_; lo_.x = vreg[i].x; lo_.y = vreg[i].y; u32x2 hi_; hi_.x = vreg[i].z; hi_.y = vreg[i].w; vp[0] = lo_; vp[1] = hi_; } } while (0)
    ATT_GLOAD(0);
    ATT_LWRITE(0);
    __syncthreads();
    const int qw0 = q0 + wid * 32;
    for (int t = 0; t < NT; ++t) {
        const int buf = t & 1;
        if (t + 1 < NT) ATT_GLOAD(t + 1);
#pragma unroll
        for (int kb = 0; kb < 2; ++kb) {
            const int kv0 = 64 * t + 32 * kb;
            if (CAUSAL && kv0 > qw0) continue;
            const bool diag = CAUSAL && (kv0 == qw0);
            bf16x8 vf[NDB][2];
#pragma unroll
            for (int db = 0; db < NDB; ++db)
#pragma unroll
                for (int j = 0; j < 2; ++j) { const LAS unsigned char* vp = Vb + buf * VBUF + (32 * db + r32) * VS + (32 * kb + 16 * j + 4 * hi) * 2;
                    const s16x4 lo = *(const LAS s16x4*)vp, hh = *(const LAS s16x4*)(vp + 16);
                    vf[db][j] = (bf16x8){lo[0], lo[1], lo[2], lo[3], hh[0], hh[1], hh[2], hh[3]}; }
#pragma unroll
            for (int mp = 0; mp < NMAP; ++mp) {
                f32x16 s;
#pragma unroll
                for (int r = 0; r < 16; ++r) s[r] = 0.f;
#pragma unroll
                for (int c = 0; c < NC; ++c) { const bf16x8 kf = *(const LAS bf16x8*)(Kb + buf * KBUF + (32 * kb + r32) * KS + (mp * DKM + 16 * c + 8 * hi) * 2);
                    s = __builtin_amdgcn_mfma_f32_32x32x16_bf16(kf, qf[mp][c], s, 0, 0, 0); }
                if (diag) {
#pragma unroll
                    for (int r = 0; r < 16; ++r) if (crow(r, hi) > r32) s[r] = -INFINITY;
                }
                float mx = s[0];
#pragma unroll
                for (int r = 1; r < 16; ++r) mx = fmaxf(mx, s[r]);
                mx = fmaxf(mx, __shfl_xor(mx, 32));
                if (__any(mx > mrow[mp])) {
                    const float mnew = fmaxf(mrow[mp], mx), alpha = fast_exp2(mrow[mp] - mnew);
                    mrow[mp] = mnew; lrow[mp] *= alpha;
#pragma unroll
                    for (int db = 0; db < NDB; ++db)
#pragma unroll
                        for (int r = 0; r < 16; ++r) o[mp][db][r] *= alpha;
                }
                const float mcur = mrow[mp]; float ls = 0.f;
#pragma unroll
                for (int r = 0; r < 16; ++r) { s[r] = fast_exp2(s[r] - mcur); ls += s[r]; }
                lrow[mp] += ls;
                bf16x8 pa[2];
#pragma unroll
                for (int j = 0; j < 2; ++j) { u32x4 w; w.x = cvtpk(s[8 * j + 0], s[8 * j + 1]); w.y = cvtpk(s[8 * j + 2], s[8 * j + 3]); w.z = cvtpk(s[8 * j + 4], s[8 * j + 5]); w.w = cvtpk(s[8 * j + 6], s[8 * j + 7]); pa[j] = __builtin_bit_cast(bf16x8, w); }
#pragma unroll
                for (int db = 0; db < NDB; ++db)
#pragma unroll
                    for (int j = 0; j < 2; ++j) o[mp][db] = __builtin_amdgcn_mfma_f32_32x32x16_bf16(vf[db][j], pa[j], o[mp][db], 0, 0, 0);
            }
        }
        if (t + 1 < NT) ATT_LWRITE(buf ^ 1);
        __syncthreads();
    }
#undef ATT_GLOAD
#undef ATT_LWRITE
    float inv[NMAP];
#pragma unroll
    for (int mp = 0; mp < NMAP; ++mp) { const float lt = lrow[mp] + __shfl_xor(lrow[mp], 32); inv[mp] = 1.0f / lt; }
    bf16_t* orow = O + (size_t)(q0 + wid * 32 + r32) * ldo;
    if constexpr (NMAP == 1) {
#pragma unroll
        for (int db = 0; db < NDB; ++db)
#pragma unroll
            for (int g = 0; g < 4; ++g) { f32x4 v; for (int i = 0; i < 4; ++i) v[i] = o[0][db][4 * g + i] * inv[0]; store4bf(orow + 32 * db + 8 * g + 4 * hi, v); }
    } else {
        float ss = 0.f;
#pragma unroll
        for (int db = 0; db < NDB; ++db)
#pragma unroll
            for (int r = 0; r < 16; ++r) { const float v = o[0][db][r] * inv[0] - lam * (o[1][db][r] * inv[1]); o[0][db][r] = v; ss += v * v; }
        ss += __shfl_xor(ss, 32);
        const float rstd = __builtin_amdgcn_rsqf(ss * (1.0f / DV) + NORM_EPS) * outscale;
#pragma unroll
        for (int db = 0; db < NDB; ++db)
#pragma unroll
            for (int g = 0; g < 4; ++g) { const f32x4 gn = *(const f32x4*)(subln + 32 * db + 8 * g + 4 * hi); f32x4 v; for (int i = 0; i < 4; ++i) v[i] = o[0][db][4 * g + i] * rstd * gn[i]; store4bf(orow + 32 * db + 8 * g + 4 * hi, v); }
    }
}

template <int NMAP, int DKM, int DV, int W0, int W1>
__device__ __forceinline__ void attn_unit2(LAS unsigned char* lds, const bf16_t* __restrict__ Q, int ldq, const bf16_t* __restrict__ K0, int ldk0, const bf16_t* __restrict__ K1, int ldk1,
                                           const bf16_t* __restrict__ Vt, size_t ldv, int q0, int NT, bf16_t* O, int ldo, float lam, const float* subln, float outscale) {
    constexpr int DKT = NMAP * DKM, KS = DKT * 2 + 16, VS = 136, KBUF = 64 * KS, VBUF = DV * VS;
    constexpr int NC = DKM / 16, NDB = DV / 32;
    constexpr int K0C = W0 / 8, K0N = (64 * K0C) / 512, K1C = W1 / 8, VN = (DV * 8) / 512;
    static_assert(W0 + W1 == DKT && K0N >= 1 && VN >= 1, "attention staging geometry");
    int tid = threadIdx.x; asm volatile("" : "+v"(tid));
    const int lane = tid & 63, wid = __builtin_amdgcn_readfirstlane(tid >> 6), r32 = lane & 31, hi = lane >> 5;
    LAS unsigned char* Kb = lds; LAS unsigned char* Vb = lds + 2 * KBUF;
    bf16x8 qf[NMAP][NC];
    { const bf16_t* qrow = Q + (size_t)(q0 + wid * 32 + r32) * ldq;
#pragma unroll
      for (int mp = 0; mp < NMAP; ++mp)
#pragma unroll
          for (int c = 0; c < NC; ++c) qf[mp][c] = *(const bf16x8*)(qrow + mp * DKM + 16 * c + 8 * hi); }
    f32x16 o[NMAP][NDB], negm[NMAP]; float lrow[NMAP];
#pragma unroll
    for (int mp = 0; mp < NMAP; ++mp) { lrow[mp] = 0.f;
#pragma unroll
        for (int r = 0; r < 16; ++r) negm[mp][r] = 0.f;
#pragma unroll
        for (int db = 0; db < NDB; ++db)
#pragma unroll
            for (int r = 0; r < 16; ++r) o[mp][db][r] = 0.f; }
    u32x4 kreg[K0N], k1reg = {0u, 0u, 0u, 0u}, vreg[VN];
#define ATT_GLOAD(t) do { \
    _Pragma("unroll") for (int i = 0; i < K0N; ++i) { const int idx = tid + 512 * i, rr = idx / K0C, cc = idx % K0C; kreg[i] = *(const u32x4*)(K0 + (size_t)(64 * (t) + rr) * ldk0 + cc * 8); } \
    if (W1 > 0) { if (tid < 64 * K1C) { const int rr = tid / (K1C > 0 ? K1C : 1), cc = tid % (K1C > 0 ? K1C : 1); k1reg = *(const u32x4*)(K1 + (size_t)(64 * (t) + rr) * ldk1 + cc * 8); } } \
    _Pragma("unroll") for (int i = 0; i < VN; ++i) { const int idx = tid + 512 * i, dd = idx >> 3, cc = idx & 7; vreg[i] = *(const u32x4*)(Vt + (size_t)dd * ldv + 64 * (t) + cc * 8); } } while (0)
#define ATT_LWRITE(buf) do { \
    _Pragma("unroll") for (int i = 0; i < K0N; ++i) { const int idx = tid + 512 * i, rr = idx / K0C, cc = idx % K0C; *(LAS u32x4*)(Kb + (buf) * KBUF + rr * KS + cc * 16) = kreg[i]; } \
    if (W1 > 0) { if (tid < 64 * K1C) { const int rr = tid / (K1C > 0 ? K1C : 1), cc = tid % (K1C > 0 ? K1C : 1); *(LAS u32x4*)(Kb + (buf) * KBUF + rr * KS + W0 * 2 + cc * 16) = k1reg; } } \
    _Pragma("unroll") for (int i = 0; i < VN; ++i) { const int idx = tid + 512 * i, dd = idx >> 3, cc = idx & 7; LAS u32x2* vp = (LAS u32x2*)(Vb + (buf) * VBUF + dd * VS + cc * 16); \
        u32x2 lo_; lo_.x = vreg[i].x; lo_.y = vreg[i].y; u32x2 hi_; hi_.x = vreg[i].z; hi_.y = vreg[i].w; vp[0] = lo_; vp[1] = hi_; } } while (0)
    ATT_GLOAD(0);
    ATT_LWRITE(0);
    __syncthreads();
    const int qw0 = q0 + wid * 32;
    for (int t = 0; t < NT; ++t) {
        const int buf = t & 1;
        if (t + 1 < NT) ATT_GLOAD(t + 1);
        const int kvt = 64 * t;
        if (kvt <= qw0) {
            const bool band = (kvt + 63 > qw0);
#pragma unroll
            for (int mp = 0; mp < NMAP; ++mp) {
                f32x16 s0, s1;
#pragma unroll
                for (int c = 0; c < NC; ++c) {
                    const bf16x8 kf0 = *(const LAS bf16x8*)(Kb + buf * KBUF + r32 * KS + (mp * DKM + 16 * c + 8 * hi) * 2);
                    const bf16x8 kf1 = *(const LAS bf16x8*)(Kb + buf * KBUF + (32 + r32) * KS + (mp * DKM + 16 * c + 8 * hi) * 2);
                    if (c == 0) { s0 = __builtin_amdgcn_mfma_f32_32x32x16_bf16(kf0, qf[mp][0], negm[mp], 0, 0, 0); s1 = __builtin_amdgcn_mfma_f32_32x32x16_bf16(kf1, qf[mp][0], negm[mp], 0, 0, 0); }
                    else { s0 = __builtin_amdgcn_mfma_f32_32x32x16_bf16(kf0, qf[mp][c], s0, 0, 0, 0); s1 = __builtin_amdgcn_mfma_f32_32x32x16_bf16(kf1, qf[mp][c], s1, 0, 0, 0); }
                }
                if (band) {
                    const int qd = qw0 + r32 - kvt;
#pragma unroll
                    for (int r = 0; r < 16; ++r) { const int kv = crow(r, hi); if (kv > qd) s0[r] = -INFINITY; if (kv + 32 > qd) s1[r] = -INFINITY; }
                }
                float mx = fmaxf(s0[0], s1[0]);
#pragma unroll
                for (int r = 1; r < 16; ++r) mx = fmaxf(mx, fmaxf(s0[r], s1[r]));
                mx = fmaxf(mx, __shfl_xor(mx, 32));
                if (__any(t == 0 || mx > 8.0f)) {
                    const float dl = (t == 0) ? mx : fmaxf(mx, 0.f), alpha = fast_exp2(-dl);
                    lrow[mp] *= alpha;
#pragma unroll
                    for (int r = 0; r < 16; ++r) { s0[r] -= dl; s1[r] -= dl; negm[mp][r] -= dl; }
#pragma unroll
                    for (int db = 0; db < NDB; ++db)
#pragma unroll
                        for (int r = 0; r < 16; ++r) o[mp][db][r] *= alpha;
                }
                float ls = 0.f;
#pragma unroll
                for (int kb = 0; kb < 2; ++kb) {
                    f32x16& s = kb ? s1 : s0;
                    bf16x8 vf[NDB][2];
#pragma unroll
                    for (int db = 0; db < NDB; ++db)
#pragma unroll
                        for (int j = 0; j < 2; ++j) { const LAS unsigned char* vp = Vb + buf * VBUF + (32 * db + r32) * VS + (32 * kb + 16 * j + 4 * hi) * 2;
                            const s16x4 lo = *(const LAS s16x4*)vp, hh = *(const LAS s16x4*)(vp + 16);
                            vf[db][j] = (bf16x8){lo[0], lo[1], lo[2], lo[3], hh[0], hh[1], hh[2], hh[3]}; }
#pragma unroll
                    for (int r = 0; r < 16; ++r) { s[r] = fast_exp2(s[r]); ls += s[r]; }
                    bf16x8 pa[2];
#pragma unroll
                    for (int j = 0; j < 2; ++j) { u32x4 w; w.x = cvtpk(s[8 * j + 0], s[8 * j + 1]); w.y = cvtpk(s[8 * j + 2], s[8 * j + 3]); w.z = cvtpk(s[8 * j + 4], s[8 * j + 5]); w.w = cvtpk(s[8 * j + 6], s[8 * j + 7]); pa[j] = __builtin_bit_cast(bf16x8, w); }
#pragma unroll
                    for (int db = 0; db < NDB; ++db)
#pragma unroll
                        for (int j = 0; j < 2; ++j) o[mp][db] = __builtin_amdgcn_mfma_f32_32x32x16_bf16(vf[db][j], pa[j], o[mp][db], 0, 0, 0);
                }
                lrow[mp] += ls;
                if (NMAP > 1) __builtin_amdgcn_sched_barrier(0);
            }
        }
        if (t + 1 < NT) ATT_LWRITE(buf ^ 1);
        __syncthreads();
    }
#undef ATT_GLOAD
#undef ATT_LWRITE
    float inv[NMAP];
#pragma unroll
    for (int mp = 0; mp < NMAP; ++mp) { const float lt = lrow[mp] + __shfl_xor(lrow[mp], 32); inv[mp] = 1.0f / lt; }
    bf16_t* orow = O + (size_t)(q0 + wid * 32 + r32) * ldo;
    if constexpr (NMAP == 1) {
#pragma unroll
        for (int db = 0; db < NDB; ++db)
#pragma unroll
            for (int g = 0; g < 4; ++g) { f32x4 v; for (int i = 0; i < 4; ++i) v[i] = o[0][db][4 * g + i] * inv[0]; store4bf(orow + 32 * db + 8 * g + 4 * hi, v); }
    } else {
        float ss = 0.f;
#pragma unroll
        for (int db = 0; db < NDB; ++db)
#pragma unroll
            for (int r = 0; r < 16; ++r) { const float v = o[0][db][r] * inv[0] - lam * (o[1][db][r] * inv[1]); o[0][db][r] = v; ss += v * v; }
        ss += __shfl_xor(ss, 32);
        const float rstd = __builtin_amdgcn_rsqf(ss * (1.0f / DV) + NORM_EPS) * outscale;
#pragma unroll
        for (int db = 0; db < NDB; ++db)
#pragma unroll
            for (int g = 0; g < 4; ++g) { const f32x4 gn = *(const f32x4*)(subln + 32 * db + 8 * g + 4 * hi); f32x4 v; for (int i = 0; i < 4; ++i) v[i] = o[0][db][4 * g + i] * rstd * gn[i]; store4bf(orow + 32 * db + 8 * g + 4 * hi, v); }
    }
}

template <int DKM, int DV, int W0, int W1>
__device__ __forceinline__ void attn_unit4(LAS unsigned char* lds, const bf16_t* __restrict__ Q, int ldq, const bf16_t* __restrict__ K0, int ldk0, const bf16_t* __restrict__ K1, int ldk1,
                                           const bf16_t* __restrict__ Vt, size_t ldv, int q0, int NT, bf16_t* O, int ldo) {
    constexpr int KS = DKM * 2 + 16, VS = 136, KBUF = 64 * KS, VBUF = DV * VS, QROW = DKM * 2 + 16;
    constexpr int NC = DKM / 16, NDB = DV / 32;
    constexpr int K0C = W0 / 8, K0N = (64 * K0C) / 512, K1C = W1 / 8, VN = (DV * 8) / 512;
    static_assert(W0 + W1 == DKM && K0N >= 1 && VN >= 1 && K1C >= 1, "attention staging geometry");
    static_assert(2 * KBUF + 2 * VBUF + 8 * 64 * QROW <= LDS_BYTES - 16, "attention LDS budget");
    int tid = threadIdx.x; asm volatile("" : "+v"(tid));
    const int lane = tid & 63, wid = __builtin_amdgcn_readfirstlane(tid >> 6), r32 = lane & 31, hi = lane >> 5;
    LAS unsigned char* Kb = lds; LAS unsigned char* Vb = lds + 2 * KBUF;
    LAS unsigned char* Qs = lds + 2 * KBUF + 2 * VBUF + wid * (64 * QROW) + r32 * QROW + 16 * hi;
#pragma unroll
    for (int rb = 0; rb < 2; ++rb) { const bf16_t* qrow = Q + (size_t)(q0 + wid * 64 + rb * 32 + r32) * ldq;
#pragma unroll
        for (int c = 0; c < NC; ++c) *(LAS bf16x8*)(Qs + rb * 32 * QROW + c * 32) = *(const bf16x8*)(qrow + 16 * c + 8 * hi); }
    f32x16 o[2][NDB], negm[2]; float lrow[2] = {0.f, 0.f};
#pragma unroll
    for (int rb = 0; rb < 2; ++rb) {
#pragma unroll
        for (int r = 0; r < 16; ++r) negm[rb][r] = 0.f;
#pragma unroll
        for (int db = 0; db < NDB; ++db)
#pragma unroll
            for (int r = 0; r < 16; ++r) o[rb][db][r] = 0.f; }
    u32x4 kreg[K0N], k1reg = {0u, 0u, 0u, 0u}, vreg[VN];
#define A4_GLOAD(t) do { \
    _Pragma("unroll") for (int i = 0; i < K0N; ++i) { const int idx = tid + 512 * i, rr = idx / K0C, cc = idx % K0C; kreg[i] = *(const u32x4*)(K0 + (size_t)(64 * (t) + rr) * ldk0 + cc * 8); } \
    if (tid < 64 * K1C) { const int rr = tid / K1C, cc = tid % K1C; k1reg = *(const u32x4*)(K1 + (size_t)(64 * (t) + rr) * ldk1 + cc * 8); } \
    _Pragma("unroll") for (int i = 0; i < VN; ++i) { const int idx = tid + 512 * i, dd = idx >> 3, cc = idx & 7; vreg[i] = *(const u32x4*)(Vt + (size_t)dd * ldv + 64 * (t) + cc * 8); } } while (0)
#define A4_LWRITE(buf) do { \
    _Pragma("unroll") for (int i = 0; i < K0N; ++i) { const int idx = tid + 512 * i, rr = idx / K0C, cc = idx % K0C; *(LAS u32x4*)(Kb + (buf) * KBUF + rr * KS + cc * 16) = kreg[i]; } \
    if (tid < 64 * K1C) { const int rr = tid / K1C, cc = tid % K1C; *(LAS u32x4*)(Kb + (buf) * KBUF + rr * KS + W0 * 2 + cc * 16) = k1reg; } \
    _Pragma("unroll") for (int i = 0; i < VN; ++i) { const int idx = tid + 512 * i, dd = idx >> 3, cc = idx & 7; LAS u32x2* vp = (LAS u32x2*)(Vb + (buf) * VBUF + dd * VS + cc * 16); \
        u32x2 lo_; lo_.x = vreg[i].x; lo_.y = vreg[i].y; u32x2 hi_; hi_.x = vreg[i].z; hi_.y = vreg[i].w; vp[0] = lo_; vp[1] = hi_; } } while (0)
    A4_GLOAD(0);
    A4_LWRITE(0);
    __syncthreads();
    const int qw0 = q0 + wid * 64;
    for (int t = 0; t < NT; ++t) {
        const int buf = t & 1;
        if (t + 1 < NT) A4_GLOAD(t + 1);
        const int kvt = 64 * t;
        if (kvt <= qw0) {
            const bool band = (kvt == qw0);
            f32x16 s[2][2];
#pragma unroll
            for (int c = 0; c < NC; ++c) {
                const bf16x8 kf0 = *(const LAS bf16x8*)(Kb + buf * KBUF + r32 * KS + (16 * c + 8 * hi) * 2);
                const bf16x8 kf1 = *(const LAS bf16x8*)(Kb + buf * KBUF + (32 + r32) * KS + (16 * c + 8 * hi) * 2);
#pragma unroll
                for (int rb = 0; rb < 2; ++rb) { const bf16x8 qv = *(const LAS bf16x8*)(Qs + rb * 32 * QROW + c * 32);
                    if (c == 0) { s[rb][0] = __builtin_amdgcn_mfma_f32_32x32x16_bf16(kf0, qv, negm[rb], 0, 0, 0); s[rb][1] = __builtin_amdgcn_mfma_f32_32x32x16_bf16(kf1, qv, negm[rb], 0, 0, 0); }
                    else { s[rb][0] = __builtin_amdgcn_mfma_f32_32x32x16_bf16(kf0, qv, s[rb][0], 0, 0, 0); s[rb][1] = __builtin_amdgcn_mfma_f32_32x32x16_bf16(kf1, qv, s[rb][1], 0, 0, 0); } }
            }
#pragma unroll
            for (int rb = 0; rb < 2; ++rb) {
                f32x16& s0 = s[rb][0]; f32x16& s1 = s[rb][1];
                if (band) {
                    const int qd = 32 * rb + r32;
#pragma unroll
                    for (int r = 0; r < 16; ++r) { const int kv = crow(r, hi); if (kv > qd) s0[r] = -INFINITY; if (kv + 32 > qd) s1[r] = -INFINITY; }
                }
                float mx = fmaxf(s0[0], s1[0]);
#pragma unroll
                for (int r = 1; r < 16; ++r) mx = fmaxf(mx, fmaxf(s0[r], s1[r]));
                mx = half_max(mx);
                if (__any(t == 0 || mx > 8.0f)) {
                    const float dl = (t == 0) ? mx : fmaxf(mx, 0.f), alpha = fast_exp2(-dl);
                    lrow[rb] *= alpha;
#pragma unroll
                    for (int r = 0; r < 16; ++r) { s0[r] -= dl; s1[r] -= dl; negm[rb][r] -= dl; }
#pragma unroll
                    for (int db = 0; db < NDB; ++db)
#pragma unroll
                        for (int r = 0; r < 16; ++r) o[rb][db][r] *= alpha;
                }
            }
#pragma unroll
            for (int kb = 0; kb < 2; ++kb) {
                bf16x8 vf[NDB][2];
#pragma unroll
                for (int db = 0; db < NDB; ++db)
#pragma unroll
                    for (int j = 0; j < 2; ++j) { const LAS unsigned char* vp = Vb + buf * VBUF + (32 * db + r32) * VS + (32 * kb + 16 * j + 4 * hi) * 2;
                        const s16x4 lo = *(const LAS s16x4*)vp, hh = *(const LAS s16x4*)(vp + 16);
                        vf[db][j] = (bf16x8){lo[0], lo[1], lo[2], lo[3], hh[0], hh[1], hh[2], hh[3]}; }
#pragma unroll
                for (int rb = 0; rb < 2; ++rb) {
                    f32x16& sv = s[rb][kb]; float ls = 0.f;
#pragma unroll
                    for (int r = 0; r < 16; ++r) { sv[r] = fast_exp2(sv[r]); ls += sv[r]; }
                    lrow[rb] += ls;
                    bf16x8 pa[2];
#pragma unroll
                    for (int j = 0; j < 2; ++j) { u32x4 w; w.x = cvtpk(sv[8 * j + 0], sv[8 * j + 1]); w.y = cvtpk(sv[8 * j + 2], sv[8 * j + 3]); w.z = cvtpk(sv[8 * j + 4], sv[8 * j + 5]); w.w = cvtpk(sv[8 * j + 6], sv[8 * j + 7]); pa[j] = __builtin_bit_cast(bf16x8, w); }
#pragma unroll
                    for (int db = 0; db < NDB; ++db)
#pragma unroll
                        for (int j = 0; j < 2; ++j) o[rb][db] = __builtin_amdgcn_mfma_f32_32x32x16_bf16(vf[db][j], pa[j], o[rb][db], 0, 0, 0);
                }
            }
        }
        if (t + 1 < NT) A4_LWRITE(buf ^ 1);
        __syncthreads();
    }
#undef A4_GLOAD
#undef A4_LWRITE
#pragma unroll
    for (int rb = 0; rb < 2; ++rb) {
        const float inv = 1.0f / half_sum(lrow[rb]);
        bf16_t* orow = O + (size_t)(q0 + wid * 64 + rb * 32 + r32) * ldo;
#pragma unroll
        for (int db = 0; db < NDB; ++db)
#pragma unroll
            for (int g = 0; g < 4; ++g) { f32x4 v; for (int i = 0; i < 4; ++i) v[i] = o[rb][db][4 * g + i] * inv; store4bf(orow + 32 * db + 8 * g + 4 * hi, v); }
    }
}

__device__ __forceinline__ float wave_sum(float v) {
#pragma unroll
    for (int o = 1; o < 64; o <<= 1) v += __shfl_xor(v, o);
    return v;
}
__device__ __forceinline__ void transpose_block(const float* __restrict__ W, int ldw, int src_col0, const float* __restrict__ gain, bf16_t* WT, int K, int dst_row0, int k0, LAS float* scr, int lane) {
#pragma unroll 8
    for (int i = 0; i < 32; ++i) { const int kk = 2 * i + (lane >> 5); float v = W[(size_t)(k0 + kk) * ldw + src_col0 + (lane & 31)]; if (gain) v *= gain[k0 + kk]; scr[kk * 33 + (lane & 31)] = v; }
    asm volatile("s_waitcnt lgkmcnt(0)" ::: "memory");
    const int c = lane & 7;
#pragma unroll
    for (int j = 0; j < 4; ++j) { const int n = (lane >> 3) + 8 * j; const LAS float* s = scr + (8 * c) * 33 + n;
        u32x4 ov; ov.x = cvtpk(s[0 * 33], s[1 * 33]); ov.y = cvtpk(s[2 * 33], s[3 * 33]); ov.z = cvtpk(s[4 * 33], s[5 * 33]); ov.w = cvtpk(s[6 * 33], s[7 * 33]);
        *(u32x4*)(WT + (size_t)(dst_row0 + n) * K + k0 + 8 * c) = ov; }
    asm volatile("s_waitcnt lgkmcnt(0)" ::: "memory");
}

#define XB_TMO      128
#define XB_XCNT(j)  (256  + 64 * (j))
#define XB_XSUB(j)  (1280 + 64 * (j))
#define XB_XGEN(j)  (2304 + 64 * (j))
#define XB_TOP      3328
#define XB_TOPGEN   3392
#define XCD_BAR_WORDS 3456
#define XB_SPIN_CAP (1u << 18)

__device__ __forceinline__ unsigned xb_ld(unsigned* p)              { return __hip_atomic_load(p, __ATOMIC_RELAXED, __HIP_MEMORY_SCOPE_AGENT); }
__device__ __forceinline__ unsigned xb_add(unsigned* p, unsigned v) { return __hip_atomic_fetch_add(p, v, __ATOMIC_RELAXED, __HIP_MEMORY_SCOPE_AGENT); }
__device__ __forceinline__ unsigned xb_xcc_id() { return (unsigned)__builtin_amdgcn_s_getreg((3 << 11) | 20) & 0xFu; }
#define XB_SPIN(cond, bar) do { unsigned _sp = 0; while (cond) { __builtin_amdgcn_s_sleep(1); \
    if ((++_sp & 255u) == 0u) { if (xb_ld(&(bar)[XB_TMO])) break; if (_sp > XB_SPIN_CAP) { atomicAdd(&(bar)[XB_TMO], 1u); break; } } } } while (0)

struct XcdBarrier {
    unsigned* bar; unsigned x;
    volatile LAS unsigned* st;
};

__device__ __forceinline__ XcdBarrier xcd_barrier_post(unsigned* bar, volatile LAS unsigned* st) {
    XcdBarrier b; b.bar = bar; b.x = xb_xcc_id(); b.st = st;
    if (threadIdx.x == 0) (void)xb_add(&bar[XB_XCNT(b.x)], 1u);
    return b;
}
__device__ __forceinline__ void xcd_barrier_complete(unsigned* bar, unsigned x, unsigned& nloc, unsigned& nx) {
    const unsigned G = gridDim.x * gridDim.y * gridDim.z;
    unsigned sum, cnt, mine, sp = 0u;
    for (;;) {
        sum = 0u; cnt = 0u; mine = 0u;
#pragma unroll
        for (unsigned j = 0; j < 16; ++j) { const unsigned c = xb_ld(&bar[XB_XCNT(j)]); sum += c; cnt += (c > 0u) ? 1u : 0u; mine = (j == x) ? c : mine; }
        if (sum == G) break;
        __builtin_amdgcn_s_sleep(1);
        if ((++sp & 255u) == 0u) { if (xb_ld(&bar[XB_TMO])) break; if (sp > XB_SPIN_CAP) { atomicAdd(&bar[XB_TMO], 1u); break; } }
    }
    nloc = mine > 0u ? mine : 1u; nx = cnt > 0u ? cnt : 1u;
}

__device__ __forceinline__ void xcd_barrier(const XcdBarrier& b) {
    asm volatile("s_waitcnt vmcnt(0)" ::: "memory");
    __syncthreads();
    if (threadIdx.x == 0) {
        unsigned* bar = b.bar;
        __builtin_amdgcn_s_waitcnt(0);
        unsigned nloc = b.st[0], nx = b.st[1];
        if (nloc == 0u) { xcd_barrier_complete(bar, b.x, nloc, nx); b.st[0] = nloc; b.st[1] = nx; }
        const unsigned old = xb_add(&bar[XB_XSUB(b.x)], 1u);
        const unsigned gen = old / nloc;
        if (old + 1u == (gen + 1u) * nloc) {
            __builtin_amdgcn_fence(__ATOMIC_RELEASE, "agent");
            asm volatile("s_waitcnt vmcnt(0)" ::: "memory");
            const unsigned og = xb_add(&bar[XB_TOP], 1u);
            const unsigned tg = og / nx;
            if (og + 1u == (tg + 1u) * nx) xb_add(&bar[XB_TOPGEN], 1u);
            else XB_SPIN(xb_ld(&bar[XB_TOPGEN]) == tg, bar);
            __builtin_amdgcn_fence(__ATOMIC_ACQUIRE, "agent");
            xb_add(&bar[XB_XGEN(b.x)], 1u);
            asm volatile("s_waitcnt vmcnt(0)" ::: "memory");
        } else {
            XB_SPIN(xb_ld(&bar[XB_XGEN(b.x)]) == gen, bar);
            __builtin_amdgcn_fence(__ATOMIC_ACQUIRE, "agent");
            asm volatile("s_waitcnt vmcnt(0)" ::: "memory");
        }
    }
    __syncthreads();
}


struct Args { const float* in[20]; float* out; unsigned char* ws; int ph_lo, ph_hi, coop, pad; float lam_init[4]; };

__global__ void __launch_bounds__(512, 2) hybrid_fwd(Args a) {
    extern __shared__ __attribute__((aligned(16))) unsigned char lds_raw[];
    LAS unsigned char* lds = (LAS unsigned char*)lds_raw;
    const float* x_in = a.in[0]; const float* mem = a.in[1]; const int* positions = (const int*)a.in[2];
    const float* norm_pre = a.in[3]; const float* norm_post = a.in[4]; const float* w_in = a.in[5]; const float* q_norm = a.in[6]; const float* w_uq = a.in[7];
    const float* kv_norm = a.in[8]; const float* w_ukv = a.in[9]; const float* lq1 = a.in[10]; const float* lk1 = a.in[11]; const float* lq2 = a.in[12]; const float* lk2 = a.in[13];
    const float* diff_subln = a.in[14]; const float* mem_norm = a.in[15]; const float* w_mem_kv = a.in[16]; const float* b_gate = a.in[17]; const float* w_branch = a.in[18]; const float* w_out = a.in[19];
#define P_WT ((bf16_t*)(ws + OFF_W))
#define P_COS ((float*)(ws + OFF_COS))
#define P_SIN ((float*)(ws + OFF_SIN))
#define P_SSQq ((float*)(ws + OFF_SSQQ))
#define P_SSQkv ((float*)(ws + OFF_SSQKV))
#define P_MN ((bf16_t*)(ws + OFF_MN))
#define P_KM ((bf16_t*)(ws + OFF_KM))
#define P_VMT ((bf16_t*)(ws + OFF_VMT))
#define P_XN ((bf16_t*)(ws + OFF_XN))
#define P_OB ((bf16_t*)(ws + OFF_O))
#define P_CQ ((bf16_t*)(ws + OFF_CQ))
#define P_CKV ((bf16_t*)(ws + OFF_CKV))
#define P_KPE ((bf16_t*)(ws + OFF_KPE))
#define P_QD ((bf16_t*)(ws + OFF_QD))
#define P_KD ((bf16_t*)(ws + OFF_KD))
#define P_VDT ((bf16_t*)(ws + OFF_VDT))
#define P_QX ((bf16_t*)(ws + OFF_QX))
#define P_QA ((bf16_t*)(ws + OFF_QA))
#define P_KN ((bf16_t*)(ws + OFF_KN))
#define P_VAT ((bf16_t*)(ws + OFF_VAT))
#define P_SB ((bf16_t*)(ws + OFF_S))
#define P_MG ((bf16_t*)(ws + OFF_MERGED))
#define P_OUTB ((float*)(ws + OFF_OUT))

    volatile LAS unsigned* bst = (volatile LAS unsigned*)(lds + LDS_BYTES - 16);
    if (threadIdx.x < 4) bst[threadIdx.x] = 0u;
    __syncthreads();
    XcdBarrier xbar; xbar.bar = (unsigned*)(a.ws + OFF_BAR); xbar.x = 0; xbar.st = bst;
    if (a.coop) xbar = xcd_barrier_post((unsigned*)(a.ws + OFF_BAR), bst);
    for (int ph = a.ph_lo; ph < a.ph_hi; ++ph) {
        __attribute__((address_space(1))) unsigned char* ws = (__attribute__((address_space(1))) unsigned char*)a.ws; asm volatile("" : "+s"(ws));
        int tid = threadIdx.x; asm volatile("" : "+v"(tid)); const int lane = tid & 63, wave = __builtin_amdgcn_readfirstlane(tid >> 6);
        int G = gridDim.x, bx = blockIdx.x; asm volatile("" : "+s"(G), "+s"(bx));
        const int vcu = (G % 8 == 0) ? (bx % 8) * (G / 8) + bx / 8 : bx;
        const int gw = vcu * 8 + wave, NGW = G * 8;
        if (ph == 0) {
#if PHSEL & 1
            LAS float* scr = (LAS float*)(lds + wave * 16384);
            constexpr int I_IN = 16 * 221, I_UQ = 4 * 24, I_UKV = 2 * 32, I_MEM = 16 * 32, I_BR = 3 * 256, I_OUT = 16 * 32;
            constexpr int I_L = I_IN + I_UQ + I_UKV + I_MEM + I_BR + I_OUT;
            for (int it = gw; it < DEPTH * I_L; it += NGW) {
                const int l = it / I_L; int r = it - l * I_L; bf16_t* wl = P_WT + (size_t)l * WL_TOTAL;
                if (r < I_IN) { const int kb = r / 221, nb = r - kb * 221, n = nb * 32; int dr;
                    if (n < 416) dr = n; else if (n < 1440) dr = n + 96; else if (n < 1952) dr = n - 1440 + 2048; else if (n < 2464) dr = n - 1952 + 1536; else dr = n + 96;
                    transpose_block(w_in + (size_t)l * 1024 * IN_WIDTH, IN_WIDTH, n, norm_pre + l * 1024, wl + WL_IN, 1024, dr, kb * 64, scr, lane); continue; }
                r -= I_IN;
                if (r < I_UQ) { const int kb = r / 24, nb = r - kb * 24, n = nb * 32, h = n / 96, w = n - h * 96; const int dr = (w < 64) ? h * 64 + w : 512 + h * 32 + (w - 64);
                    transpose_block(w_uq + (size_t)l * 256 * 768, 768, n, q_norm + l * 256, wl + WL_UQ, 256, dr, kb * 64, scr, lane); continue; }
                r -= I_UQ;
                if (r < I_UKV) { const int kb = r / 32, nb = r - kb * 32, n = nb * 32, h = n / 128, w = n - h * 128; const int dr = (w < 64) ? h * 64 + w : 512 + h * 64 + (w - 64);
                    transpose_block(w_ukv + (size_t)l * 128 * 1024, 1024, n, kv_norm + l * 128, wl + WL_UKV, 128, dr, kb * 64, scr, lane); continue; }
                r -= I_UKV;
                if (r < I_MEM) { const int kb = r / 32, nb = r - kb * 32;
                    transpose_block(w_mem_kv + (size_t)l * 1024 * 1024, 1024, nb * 32, mem_norm + l * 1024, wl + WL_MEM, 1024, nb * 32, kb * 64, scr, lane); continue; }
                r -= I_MEM;
                if (r < I_BR) { const int i = r / 256, rr = r - i * 256, kb = rr / 32, nb = rr - kb * 32;
                    transpose_block(w_branch + (size_t)(l * 3 + i) * 512 * 1024, 1024, nb * 32, nullptr, wl + WL_BR + (size_t)i * 1024 * 512, 512, nb * 32, kb * 64, scr, lane); continue; }
                r -= I_BR;
                { const int kb = r / 32, nb = r - kb * 32;
                    transpose_block(w_out + (size_t)l * 1024 * 1024, 1024, nb * 32, nullptr, wl + WL_OUT, 1024, nb * 32, kb * 64, scr, lane); }
            }
            for (int i = bx * 512 + tid; i < DEPTH * 96 * 1024 / 8; i += G * 512) { const int l = i / (96 * 1024 / 8), rr = i - l * (96 * 1024 / 8);
                *(u32x4*)(P_WT + (size_t)l * WL_TOTAL + WL_IN + (size_t)416 * 1024 + (size_t)rr * 8) = (u32x4){0u, 0u, 0u, 0u}; }
            for (int i = bx * 512 + tid; i < SEQ * 16; i += G * 512) { const int s = i >> 4, j = i & 15;
                const float invf = powf(10000.0f, -(float)j / 16.0f); const float ang = (float)positions[s] * invf;
                double rv = (double)ang * 0.15915494309189535; rv -= floor(rv); const float f = (float)rv;
                P_COS[i] = __builtin_amdgcn_cosf(f); P_SIN[i] = __builtin_amdgcn_sinf(f); }
            for (int m0 = gw; m0 < MMEM + MTOK; m0 += 2 * NGW) {
                const int m1 = (m0 + NGW < MMEM + MTOK) ? m0 + NGW : m0;
                f32x4 v[2][4]; float ss[2] = {0.f, 0.f};
#pragma unroll
                for (int q = 0; q < 2; ++q) { const int m = q ? m1 : m0; const float* src = (m < MMEM) ? mem + (size_t)m * 1024 : x_in + (size_t)(m - MMEM) * 1024;
#pragma unroll
                    for (int j = 0; j < 4; ++j) v[q][j] = ((const f32x4*)src)[64 * j + lane]; }
#pragma unroll
                for (int q = 0; q < 2; ++q)
#pragma unroll
                    for (int j = 0; j < 4; ++j) ss[q] += (v[q][j][0] * v[q][j][0] + v[q][j][1] * v[q][j][1]) + (v[q][j][2] * v[q][j][2] + v[q][j][3] * v[q][j][3]);
#pragma unroll
                for (int q = 0; q < 2; ++q) { const int m = q ? m1 : m0; bf16_t* dst = (m < MMEM) ? P_MN + (size_t)m * 1024 : P_XN + (size_t)(m - MMEM) * 1024;
                    const float rstd = __builtin_amdgcn_rsqf(wave_sum(ss[q]) * (1.0f / 1024.0f) + NORM_EPS);
#pragma unroll
                    for (int j = 0; j < 4; ++j) store4bf(dst + 4 * (64 * j + lane), v[q][j] * rstd); }
            }
#endif
        } else {
            const int l = (ph - 1) / 7, sub = (ph - 1) % 7;
            const bf16_t* wl = P_WT + (size_t)l * WL_TOTAL;
            if (sub == 0) {
#if PHSEL & 2
#if GSEL & 1
                { pg8::Gemm g{P_XN, wl + WL_IN, MTOK, 2048, 1024, 1024, 1024, 0, 0}; pg8::StaticOrder S; S.init(MTOK, 2048, G, bx);
                  pg8::Epi1 E{P_CQ, P_CKV, P_KPE, P_QD, P_KD, P_QX, P_SSQq, P_SSQkv, P_COS, P_SIN, 0.17677669529663687f * LOG2E, 0.08838834764831845f * LOG2E};
                  pg8::gemm_phase(lds, g, S, E); }
#endif
#if GSEL & 2
                { pg8::Gemm g{wl + WL_IN + (size_t)2048 * 1024, P_XN, 512, MTOK, 1024, 1024, 1024, 0, 0}; pg8::StaticOrder S; S.init(512, MTOK, G, bx);
                  pg8::EpiT E{P_VDT, (size_t)MTOK, 0, nullptr, 0.f, nullptr};
                  pg8::gemm_phase(lds, g, S, E); }
#endif
                if (l == 0) {
#if GSEL & 4
                    { pg8::Gemm g{P_MN, P_WT + WL_MEM, MMEM, 512, 1024, 1024, 1024, 0, WL_TOTAL}; pg8::StaticOrder S; S.init(MMEM, 512, G, bx, DEPTH);
                      pg8::EpiRow E{P_KM, 512, (size_t)MMEM * 512, nullptr, 0.f};
                      pg8::gemm_phase(lds, g, S, E); }
#endif
#if GSEL & 8
                    { pg8::Gemm g{P_WT + WL_MEM + (size_t)512 * 1024, P_MN, 512, MMEM, 1024, 1024, 1024, WL_TOTAL, 0}; pg8::StaticOrder S; S.init(512, MMEM, G, bx, DEPTH);
                      pg8::EpiT E{P_VMT, (size_t)MMEM, (size_t)512 * MMEM, nullptr, 0.f, nullptr};
                      pg8::gemm_phase(lds, g, S, E); }
#endif
                }
#endif
            } else if (sub == 1) {
#if PHSEL & 4
#if GSEL & 16
                { pg8::Gemm g{P_CQ, wl + WL_UQ, MTOK, 768, 256, 256, 256, 0, 0}; pg8::StaticOrder S; S.init(MTOK, 768, G, bx);
                  pg8::Epi2 E{P_QA, P_SSQq, P_COS, P_SIN, 0.10206207261596575f * LOG2E};
                  pg8::gemm_phase(lds, g, S, E); }
#endif
#if GSEL & 32
                { pg8::Gemm g{P_CKV, wl + WL_UKV, MTOK, 512, 128, 128, 128, 0, 0}; pg8::StaticOrder S; S.init(MTOK, 512, G, bx);
                  pg8::EpiRow E{P_KN, 512, 0, P_SSQkv, 1.0f / 128.0f};
                  pg8::gemm_phase(lds, g, S, E); }
#endif
#if GSEL & 64
                { pg8::Gemm g{wl + WL_UKV + (size_t)512 * 128, P_CKV, 512, MTOK, 128, 128, 128, 0, 0}; pg8::StaticOrder S; S.init(512, MTOK, G, bx);
                  pg8::EpiT E{P_VAT, (size_t)MTOK, 0, P_SSQkv, 1.0f / 128.0f, nullptr};
                  pg8::gemm_phase(lds, g, S, E); }
#endif
#endif
            } else if (sub == 2) {
#if PHSEL & 8
                const float d1 = wave_sum(lane < 32 ? lq1[l * 32 + lane] * lk1[l * 32 + lane] : 0.f), d2 = wave_sum(lane < 32 ? lq2[l * 32 + lane] * lk2[l * 32 + lane] : 0.f);
                const float lam_init = a.lam_init[l]; const float lam = expf(d1) - expf(d2) + lam_init;
#if ATTSEL & 1
                for (int P = vcu; P < 512; P += G) { const int bh = P >> 2, s = P & 3, b = bh >> 3, h = bh & 7; const size_t rb = (size_t)b * SEQ;
                    for (int k = 0; k < 2; ++k) { const int qb = k ? s : 7 - s;
                        attn_unit4<96, 64, 64, 32>(lds, P_QA + rb * 768 + h * 96, 768, P_KN + rb * 512 + h * 64, 512, P_KPE + rb * 32, 32, P_VAT + (size_t)(h * 64) * MTOK + rb, (size_t)MTOK,
                                                   qb * 512, 8 * (qb + 1), P_OB + rb * 1536 + h * 64, 1536); } }
#endif
                asm volatile("" ::: "memory"); __builtin_amdgcn_sched_barrier(0);
#if ATTSEL & 2
                for (int P = vcu; P < 1024; P += G) { const int bh = P >> 3, s = P & 7, b = bh >> 3, h = bh & 7; const size_t rb = (size_t)b * SEQ;
                    for (int k = 0; k < 2; ++k) { const int qb = k ? s : 15 - s;
                        attn_unit2<2, 32, 64, 64, 0>(lds, P_QD + rb * 512 + h * 64, 512, P_KD + rb * 512 + h * 64, 512, nullptr, 0, P_VDT + (size_t)(h * 64) * MTOK + rb, (size_t)MTOK,
                                                           qb * 256, 4 * (qb + 1), P_OB + rb * 1536 + 512 + h * 64, 1536, lam, diff_subln + l * 64, 1.0f - lam_init); } }
#endif
                asm volatile("" ::: "memory"); __builtin_amdgcn_sched_barrier(0);
#if ATTSEL & 4
                for (int X = vcu; X < 1024; X += G) { const int bh = X >> 4, qb = X & 15, b = bh >> 2, h = bh & 3; const size_t rb = (size_t)b * SEQ;
                    attn_unit<1, 128, 128, false, 128, 0>(lds, P_QX + rb * 512 + h * 128, 512, P_KM + (size_t)l * MMEM * 512 + (size_t)b * MEMT * 512 + h * 128, 512, nullptr, 0,
                                                           P_VMT + (size_t)l * 512 * MMEM + (size_t)(h * 128) * MMEM + (size_t)b * MEMT, (size_t)MMEM,
                                                           qb * 256, 4, P_OB + rb * 1536 + 1024 + h * 128, 1536, 0.f, nullptr, 1.f); }
#endif
#endif
            } else if (sub == 3) {
#if PHSEL & 16
                { pg8::Gemm g{P_XN, wl + WL_IN + (size_t)2560 * 1024, MTOK, 1536, 1024, 1024, 1024, 0, 0}; pg8::StaticOrder S; S.init(MTOK, 1536, G, bx);
                  pg8::EpiSG E{P_OB};
                  pg8::gemm_phase(lds, g, S, E); }
                { pg8::Gemm g{P_XN, wl + WL_IN + (size_t)4096 * 1024, MTOK, 3072, 1024, 1024, 1024, 0, 0}; pg8::StaticOrder S; S.init(MTOK, 3072, G, bx);
                  pg8::EpiGL E{P_SB, b_gate + l * 3072};
                  pg8::gemm_phase(lds, g, S, E); }
#endif
            } else if (sub == 4) {
#if PHSEL & 32
                pg8::Gemm g{P_OB, wl + WL_BR, MTOK, 1024, 512, 1536, 512, 512, (size_t)1024 * 512}; pg8::StaticOrder S; S.init(MTOK, 1024, G, bx, 3);
                pg8::EpiBR E{P_SB, P_MG};
                pg8::gemm_phase(lds, g, S, E);
#endif
            } else if (sub == 5) {
#if PHSEL & 64
                pg8::Gemm g{P_MG, wl + WL_OUT, MTOK, 1024, 1024, 1024, 1024, 0, 0}; pg8::StaticOrder S; S.init(MTOK, 1024, G, bx);
                pg8::EpiRow E{(bf16_t*)P_OUTB, 1024, 0, nullptr, 0.f};
                pg8::gemm_phase(lds, g, S, E);
#endif
            } else {
#if PHSEL & 128
                const float* xo = (l == 0) ? x_in : a.out; const float* gp = norm_post + l * 1024;
                for (int m0 = gw; m0 < MTOK; m0 += 2 * NGW) {
                    const int m1 = (m0 + NGW < MTOK) ? m0 + NGW : m0;
                    f32x4 v[2][4], xv[2][4]; float s[2] = {0.f, 0.f};
#pragma unroll
                    for (int q = 0; q < 2; ++q) { const int m = q ? m1 : m0;
#pragma unroll
                        for (int j = 0; j < 4; ++j) { v[q][j] = unpack4bf(((const u32x2*)((const bf16_t*)P_OUTB + (size_t)m * 1024))[64 * j + lane]); xv[q][j] = ((const f32x4*)(xo + (size_t)m * 1024))[64 * j + lane]; } }
#pragma unroll
                    for (int q = 0; q < 2; ++q)
#pragma unroll
                        for (int j = 0; j < 4; ++j) s[q] += (v[q][j][0] * v[q][j][0] + v[q][j][1] * v[q][j][1]) + (v[q][j][2] * v[q][j][2] + v[q][j][3] * v[q][j][3]);
#pragma unroll
                    for (int q = 0; q < 2; ++q) { const int m = q ? m1 : m0;
                        const float rstd = __builtin_amdgcn_rsqf(wave_sum(s[q]) * (1.0f / 1024.0f) + NORM_EPS); float s2 = 0.f;
#pragma unroll
                        for (int j = 0; j < 4; ++j) { const f32x4 gv = ((const f32x4*)gp)[64 * j + lane];
                            v[q][j] = xv[q][j] + v[q][j] * rstd * gv; ((f32x4*)(a.out + (size_t)m * 1024))[64 * j + lane] = v[q][j];
                            s2 += (v[q][j][0] * v[q][j][0] + v[q][j][1] * v[q][j][1]) + (v[q][j][2] * v[q][j][2] + v[q][j][3] * v[q][j][3]); }
                        if (l + 1 < DEPTH) { const float rstd2 = __builtin_amdgcn_rsqf(wave_sum(s2) * (1.0f / 1024.0f) + NORM_EPS);
#pragma unroll
                            for (int j = 0; j < 4; ++j) store4bf(P_XN + (size_t)m * 1024 + 4 * (64 * j + lane), v[q][j] * rstd2); } }
                }
#endif
            }
        }
        if (ph + 1 < a.ph_hi) { if (a.coop) { if (ph == 0) cg::this_grid().sync(); else xcd_barrier(xbar); } }
    }
#ifdef DBG_NPH
    if (a.pad) {
        if (a.coop) cg::this_grid().sync();
        const unsigned short* w16 = (const unsigned short*)(a.ws + OFF_MN);
        const size_t n16 = (WS_END - OFF_MN) / 2, nout = (size_t)MTOK * 1024;
        for (size_t i = (size_t)blockIdx.x * 512 + threadIdx.x; i < nout; i += (size_t)gridDim.x * 512) {
            unsigned x = 0; for (size_t k = i; k < n16; k += nout) x ^= w16[k];
            const unsigned short* w2 = (const unsigned short*)(a.ws + OFF_COS); if (i < (size_t)(4 * MiB) / 2) x ^= w2[i];
            a.out[i] = (float)x;
        }
    }
#endif
}

extern "C" void kernel_launch(void* const* d_in, const int* in_sizes, int n_in, void* d_out, int out_size, void* d_ws, size_t ws_size, hipStream_t stream) {
    static int grid = 0;
    if (grid == 0) {
        if (n_in != 20 || ws_size < WS_END) { fprintf(stderr, "kernel_launch: need 20 inputs and >= %zu bytes of workspace (got %d, %zu)\n", (size_t)WS_END, n_in, ws_size); grid = -1; return; }
        int dev = 0, cus = 0, per_cu = 0;
        hipGetDevice(&dev); hipDeviceGetAttribute(&cus, hipDeviceAttributeMultiprocessorCount, dev);
        if (hipFuncSetAttribute((const void*)hybrid_fwd, hipFuncAttributeMaxDynamicSharedMemorySize, LDS_BYTES) != hipSuccess) { fprintf(stderr, "kernel_launch: hipFuncSetAttribute failed\n"); grid = -1; return; }
        if (hipOccupancyMaxActiveBlocksPerMultiprocessor(&per_cu, (const void*)hybrid_fwd, 512, LDS_BYTES) != hipSuccess || per_cu < 1) per_cu = 1;
        (void)hipGetLastError();
        grid = cus * 1;
    }
    if (grid < 0) return;
    if (hipMemsetAsync((char*)d_ws + OFF_BAR, 0, 16384, stream) != hipSuccess) { fprintf(stderr, "kernel_launch: hipMemsetAsync failed\n"); return; }
    Args a{};
    for (int i = 0; i < 20; ++i) a.in[i] = (const float*)d_in[i];
    a.out = (float*)d_out; a.ws = (unsigned char*)d_ws; a.pad = 0;
    a.lam_init[0] = 0.2f; a.lam_init[1] = 0.35550906759096926f; a.lam_init[2] = 0.47071301834358424f; a.lam_init[3] = 0.55605820415654f;
#if MK_ONE_LAUNCH
#ifdef DBG_NPH
    a.ph_lo = 0; a.ph_hi = DBG_NPH; a.coop = 1; a.pad = 1;
#else
    a.ph_lo = 0; a.ph_hi = NPHASE; a.coop = 1;
#endif
    void* args[] = {&a};
    hipError_t e = hipLaunchCooperativeKernel((const void*)hybrid_fwd, dim3(grid), dim3(512), args, LDS_BYTES, stream);
    if (e != hipSuccess) fprintf(stderr, "cooperative launch failed: %s (grid %d)\n", hipGetErrorString(e), grid);
#else
    for (int ph = 0; ph < NPHASE; ++ph) { a.ph_lo = ph; a.ph_hi = ph + 1; a.coop = 0;
        hipLaunchKernelGGL(hybrid_fwd, dim3(grid), dim3(512), LDS_BYTES, stream, a); }
#endif
}
```

```cpp
#include <hip/hip_runtime.h>
#include <hip/hip_cooperative_groups.h>
#include <cstdio>
#include <cstdint>
namespace cg = cooperative_groups;

#ifndef ATTSEL
#define ATTSEL 7
#endif
#ifndef GSEL
#define GSEL 0xFFFF
#endif
#ifndef PHSEL
#define PHSEL 0xFFFF
#endif
#ifndef MK_ONE_LAUNCH
#define MK_ONE_LAUNCH 1
#endif

#define LAS __attribute__((address_space(3)))
typedef unsigned short bf16_t;
typedef short bf16x8 __attribute__((ext_vector_type(8)));
typedef short s16x4 __attribute__((ext_vector_type(4)));
typedef float f32x4 __attribute__((ext_vector_type(4)));
typedef float f32x16 __attribute__((ext_vector_type(16)));
typedef unsigned u32x4 __attribute__((ext_vector_type(4)));
typedef unsigned u32x2 __attribute__((ext_vector_type(2)));
typedef float f32x2_t __attribute__((ext_vector_type(2)));
typedef __bf16 bf16x2_t __attribute__((ext_vector_type(2)));

constexpr int D_MODEL = 1024, BATCH = 16, SEQ = 4096, DEPTH = 4, MEMT = 256;
constexpr int MTOK = BATCH * SEQ;
constexpr int MMEM = BATCH * MEMT;
constexpr int IN_WIDTH = 7072;
constexpr float NORM_EPS = 1e-6f;
constexpr float LOG2E = 1.4426950408889634f;

constexpr size_t WL_IN = 0;
constexpr size_t WL_UQ = WL_IN + (size_t)7168 * 1024;
constexpr size_t WL_UKV = WL_UQ + (size_t)768 * 256;
constexpr size_t WL_MEM = WL_UKV + (size_t)1024 * 128;
constexpr size_t WL_BR = WL_MEM + (size_t)1024 * 1024;
constexpr size_t WL_OUT = WL_BR + (size_t)3 * 1024 * 512;
constexpr size_t WL_TOTAL = WL_OUT + (size_t)1024 * 3072;

constexpr size_t MiB = 1u << 20;
constexpr size_t OFF_W = 0;
constexpr size_t OFF_COS = 104 * MiB, OFF_SIN = OFF_COS + 256 * 1024;
constexpr size_t OFF_SSQQ = 105 * MiB, OFF_SSQKV = 106 * MiB;
constexpr size_t OFF_BAR = 107 * MiB;
constexpr size_t OFF_MN = 108 * MiB;
constexpr size_t OFF_KM = 116 * MiB;
constexpr size_t OFF_VMT = 132 * MiB;
constexpr size_t OFF_XN = 148 * MiB;
constexpr size_t OFF_O = 276 * MiB;
constexpr size_t OFF_R = 468 * MiB;
constexpr size_t OFF_CQ = OFF_R;
constexpr size_t OFF_CKV = OFF_CQ + 32 * MiB;
constexpr size_t OFF_KPE = OFF_CKV + 16 * MiB;
constexpr size_t OFF_QD = OFF_KPE + 4 * MiB;
constexpr size_t OFF_KD = OFF_QD + 64 * MiB;
constexpr size_t OFF_VDT = OFF_KD + 64 * MiB;
constexpr size_t OFF_QX = OFF_VDT + 64 * MiB;
constexpr size_t OFF_QA = OFF_QX + 64 * MiB;
constexpr size_t OFF_KN = OFF_QA + 96 * MiB;
constexpr size_t OFF_VAT = OFF_KN + 64 * MiB;
constexpr size_t WS_END = OFF_VAT + 64 * MiB;
constexpr size_t OFF_S = OFF_R;
constexpr size_t OFF_MERGED = OFF_R + 384 * MiB;
constexpr size_t OFF_OUT = OFF_R;
static_assert(4 * WL_TOTAL * 2 <= OFF_COS && OFF_MERGED + 128 * MiB <= WS_END, "ws map");

constexpr int LDS_BYTES = 163840;
constexpr int NPHASE = 1 + 7 * DEPTH;

__device__ __forceinline__ unsigned cvtpk(float lo, float hi) { f32x2_t v = {lo, hi}; bf16x2_t b = __builtin_convertvector(v, bf16x2_t); return __builtin_bit_cast(unsigned, b); }
__device__ __forceinline__ void store4bf(bf16_t* p, f32x4 v) { u32x2 w; w.x = cvtpk(v[0], v[1]); w.y = cvtpk(v[2], v[3]); *(u32x2*)p = w; }
__device__ __forceinline__ f32x4 unpack4bf(u32x2 w) { f32x4 r; r[0] = __uint_as_float(w.x << 16); r[1] = __uint_as_float(w.x & 0xffff0000u); r[2] = __uint_as_float(w.y << 16); r[3] = __uint_as_float(w.y & 0xffff0000u); return r; }
__device__ __forceinline__ void store8bf(bf16_t* p, f32x4 a, f32x4 b) { u32x4 w; w.x = cvtpk(a[0], a[1]); w.y = cvtpk(a[2], a[3]); w.z = cvtpk(b[0], b[1]); w.w = cvtpk(b[2], b[3]); *(u32x4*)p = w; }
__device__ __forceinline__ float fast_rcp(float x) { return __builtin_amdgcn_rcpf(x); }
__device__ __forceinline__ float fast_exp2(float x) { return __builtin_amdgcn_exp2f(x); }
__device__ __forceinline__ float sigmoidf_(float v) { return fast_rcp(1.0f + fast_exp2(-v * LOG2E)); }

namespace pg8 {
constexpr int BM = 256, BK = 64, HALF = 128, HTB = HALF * BK * 2, STAGE_BYTES = 8 * HTB, NXCD = 8, WGM = 8;
__host__ __device__ __forceinline__ int lds_byte(int r, int c) { const int st = (r >> 4) * 2 + (c >> 5), rr = r & 15, cc = c & 31, ob = rr * 64 + cc * 2; return st * 1024 + (ob ^ (((ob >> 9) & 1) << 5)); }
__host__ __device__ __forceinline__ void stage_rc(int b, int& R, int& C) { const int st = b / 1024, sb = b % 1024, swz = sb ^ (((sb >> 9) & 1) << 5); R = (st >> 1) * 16 + swz / 64; C = (st & 1) * 32 + (swz % 64) / 2; }

__host__ __device__ __forceinline__ int perm32(int rho) { const int n = rho >> 4, i = rho & 15; return 8 * (i >> 2) + 4 * n + (i & 3); }
struct Unit { int pm, pn, z; };
struct Gemm { const bf16_t* A; const bf16_t* Bt; int M, N, K, lda, ldb; size_t zA, zB; };

struct StaticOrder {
    int nM, nN, nwg, G, c, nz;
    __device__ void init(int M, int N, int G_, int c_, int nz_ = 1) { nM = M / BM; nN = N / BM; nwg = nM * nN; G = G_; c = c_; nz = nz_; }
    __device__ bool next(int i, Unit& u) const {
        const int ib = i / nz; u.z = i - ib * nz;
        const long L = (long)ib * G + c; if (L >= nwg) return false;
        int wgid = (int)L; { const int q = nwg / NXCD, r = nwg % NXCD, xcd = wgid % NXCD, off = wgid / NXCD; wgid = (xcd < r ? xcd * (q + 1) : r * (q + 1) + (xcd - r) * q) + off; }
        const int nig = WGM * nN, gid = wgid / nig, fm = gid * WGM, gsz = (nM - fm) < WGM ? (nM - fm) : WGM;
        u.pm = fm + ((wgid % nig) % gsz); u.pn = (wgid % nig) / gsz; return true;
    }
};

template <class Epi>
__device__ __forceinline__ void gemm_phase(LAS unsigned char* lds, const Gemm g, const StaticOrder& S, const Epi& E) {
    int tid = threadIdx.x; asm volatile("" : "+v"(tid));
    const int wid = __builtin_amdgcn_readfirstlane(tid >> 6), lane = tid & 63, wr = wid >> 2, wc = wid & 3, fr = lane & 15, fq = lane >> 4;
    int K = g.K; asm volatile("" : "+s"(K)); const int nt = K / BK;
    unsigned voffA[2], voffB[2];
#pragma unroll
    for (int i = 0; i < 2; ++i) { int R, C; stage_rc(tid * 16 + i * 8192, R, C);
        const int Rb = Epi::PERM ? ((R & ~31) + perm32(R & 31)) : R;
        voffA[i] = (unsigned)(R * g.lda + C) * 2u; voffB[i] = (unsigned)(Rb * g.ldb + C) * 2u; }
    const size_t kstep = (size_t)(BK * 2);
    const size_t hstepA = (size_t)HALF * g.lda * 2, hstepB = (size_t)HALF * g.ldb * 2;
    const size_t tstepA = 2 * hstepA, tstepB = 2 * hstepB;
    const unsigned ldsw = (unsigned)wid * 1024u;
    const int aoff = lds_byte(wr * 64 + fr, fq * 8), boff = lds_byte(wc * 32 + fr, fq * 8);
#define PG8_SA(b, h) (((b) * 2 + (h)) * HTB)
#define PG8_SB(b, h) ((4 + (b) * 2 + (h)) * HTB)
#define PG8_STAGE(bufoff, gbase, voff) do { _Pragma("unroll") for (int _i = 0; _i < 2; ++_i) \
        __builtin_amdgcn_global_load_lds((const unsigned*)((const char*)(gbase) + (voff)[_i]), (LAS unsigned*)(lds + (bufoff) + ldsw + _i * 8192), 16, 0, 0); } while (0)
#define PG8_LDA(dst, b, h) do { _Pragma("unroll") for (int m = 0; m < 4; ++m) _Pragma("unroll") for (int k = 0; k < 2; ++k) dst[m][k] = *(const LAS bf16x8*)(lds + PG8_SA(b, h) + aoff + m * 2048 + k * 1024); } while (0)
#define PG8_LDB(dst, b, h) do { _Pragma("unroll") for (int n = 0; n < 2; ++n) _Pragma("unroll") for (int k = 0; k < 2; ++k) dst[n][k] = *(const LAS bf16x8*)(lds + PG8_SB(b, h) + boff + n * 2048 + k * 1024); } while (0)
#define PG8_MMA(ai, bj, At, Bt) do { __builtin_amdgcn_s_setprio(1); _Pragma("unroll") for (int m = 0; m < 4; ++m) _Pragma("unroll") for (int n = 0; n < 2; ++n) _Pragma("unroll") for (int k = 0; k < 2; ++k) \
        acc[ai][bj][m][n] = __builtin_amdgcn_mfma_f32_16x16x32_bf16(Bt[n][k], At[m][k], acc[ai][bj][m][n], 0, 0, 0); __builtin_amdgcn_s_setprio(0); } while (0)
#define PG8_WAIT_V(n) asm volatile("s_waitcnt vmcnt(" #n ")" ::: "memory")
#define PG8_WAIT_L(n) asm volatile("s_waitcnt lgkmcnt(" #n ")" ::: "memory")
#define PG8_BAR __builtin_amdgcn_s_barrier()
#define PG8_SCHED __builtin_amdgcn_sched_barrier(0)
    Unit cur, nxt; int ui = 0;
    if (!S.next(0, cur)) return;
    f32x4 acc[2][2][4][2];
#pragma unroll
    for (int a = 0; a < 2; ++a)
#pragma unroll
        for (int b = 0; b < 2; ++b)
#pragma unroll
            for (int m = 0; m < 4; ++m)
#pragma unroll
                for (int n = 0; n < 2; ++n) acc[a][b][m][n] = (f32x4){0.f, 0.f, 0.f, 0.f};
    bf16x8 At[4][2], B0[2][2], B1[2][2];
    const char* cA = (const char*)g.A + ((size_t)cur.z * g.zA) * 2 + (size_t)cur.pm * tstepA;
    const char* cB = (const char*)g.Bt + ((size_t)cur.z * g.zB) * 2 + (size_t)cur.pn * tstepB;
    PG8_STAGE(PG8_SB(0, 0), cB, voffB); PG8_STAGE(PG8_SB(0, 1), cB + hstepB, voffB); PG8_STAGE(PG8_SA(0, 0), cA, voffA); PG8_STAGE(PG8_SA(0, 1), cA + hstepA, voffA);
    if (wr == 1) PG8_BAR;
    PG8_WAIT_V(2); PG8_BAR;
    PG8_STAGE(PG8_SB(1, 0), cB + kstep, voffB); PG8_STAGE(PG8_SA(1, 0), cA + kstep, voffA); PG8_STAGE(PG8_SB(1, 1), cB + hstepB + kstep, voffB);
    PG8_WAIT_V(6); PG8_BAR;
    for (;;) {
        const bool has_next = S.next(ui + 1, nxt);
        const char* nA = has_next ? (const char*)g.A + ((size_t)nxt.z * g.zA) * 2 + (size_t)nxt.pm * tstepA : cA;
        const char* nB = has_next ? (const char*)g.Bt + ((size_t)nxt.z * g.zB) * 2 + (size_t)nxt.pn * tstepB : cB;
        for (int t = 0; t < nt; t += 2) {
            const bool last = (t == nt - 2);
            const char* a1 = cA + (size_t)(t + 1) * kstep;
            const char* a2 = last ? nA : cA + (size_t)(t + 2) * kstep; const char* b2 = last ? nB : cB + (size_t)(t + 2) * kstep;
            const char* a3 = a2 + kstep; const char* b3 = b2 + kstep;
            PG8_LDB(B0, 0, 0); PG8_LDB(B1, 0, 1); PG8_SCHED; PG8_LDA(At, 0, 0); PG8_STAGE(PG8_SA(1, 1), a1 + hstepA, voffA);
            PG8_WAIT_V(8); PG8_WAIT_L(0); PG8_BAR; PG8_MMA(0, 0, At, B0); PG8_MMA(0, 1, At, B1); PG8_BAR; PG8_SCHED;
            PG8_LDA(At, 0, 1); PG8_STAGE(PG8_SB(0, 0), b2, voffB); PG8_STAGE(PG8_SB(0, 1), b2 + hstepB, voffB); PG8_STAGE(PG8_SA(0, 0), a2, voffA);
            PG8_WAIT_V(8); PG8_WAIT_L(0); PG8_BAR; PG8_MMA(1, 0, At, B0); PG8_MMA(1, 1, At, B1); PG8_BAR; PG8_SCHED;
            PG8_LDB(B0, 1, 0); PG8_LDB(B1, 1, 1); PG8_SCHED; PG8_LDA(At, 1, 0); PG8_STAGE(PG8_SA(0, 1), a2 + hstepA, voffA);
            PG8_WAIT_V(8); PG8_WAIT_L(0); PG8_BAR; PG8_MMA(0, 0, At, B0); PG8_MMA(0, 1, At, B1); PG8_BAR; PG8_SCHED;
            PG8_LDA(At, 1, 1); PG8_STAGE(PG8_SB(1, 0), b3, voffB); PG8_STAGE(PG8_SB(1, 1), b3 + hstepB, voffB); PG8_STAGE(PG8_SA(1, 0), a3, voffA);
            PG8_WAIT_V(8); PG8_WAIT_L(0); PG8_BAR; PG8_MMA(1, 0, At, B0); PG8_MMA(1, 1, At, B1); PG8_BAR; PG8_SCHED;
        }
        if (wr == 0) PG8_BAR;
        E(acc, cur, wr, wc, fr, fq);
        if (!has_next) break;
#pragma unroll
        for (int a = 0; a < 2; ++a)
#pragma unroll
            for (int b = 0; b < 2; ++b)
#pragma unroll
                for (int m = 0; m < 4; ++m)
#pragma unroll
                    for (int n = 0; n < 2; ++n) acc[a][b][m][n] = (f32x4){0.f, 0.f, 0.f, 0.f};
        cur = nxt; cA = nA; cB = nB; ++ui;
        if (wr == 1) PG8_BAR;
    }
    PG8_WAIT_V(0);
    PG8_BAR;
    asm volatile("" ::: "memory"); PG8_SCHED;
#undef PG8_SA
#undef PG8_SB
#undef PG8_STAGE
#undef PG8_LDA
#undef PG8_LDB
#undef PG8_MMA
#undef PG8_WAIT_V
#undef PG8_WAIT_L
#undef PG8_BAR
#undef PG8_SCHED
}

#define EPI_ROWS_BEGIN _Pragma("unroll") for (int ai = 0; ai < 2; ++ai) _Pragma("unroll") for (int m = 0; m < 4; ++m) { const int row = u.pm * BM + ai * HALF + wr * 64 + m * 16 + fr;
#define EPI_ROWS_END if (m & 1) asm volatile("" ::: "memory"); }
#define EPI_COLS_BEGIN _Pragma("unroll") for (int bj = 0; bj < 2; ++bj) _Pragma("unroll") for (int n = 0; n < 2; ++n) { const int colt = bj * HALF + wc * 32 + n * 16 + 4 * fq;
#define EPI_COLS_END }
typedef f32x4 Acc[2][2][4][2];

__device__ __forceinline__ float rstd4(const float* ssq, int row, float inv_dim) { const f32x4 p = *(const f32x4*)(ssq + (size_t)row * 4); return __builtin_amdgcn_rsqf(((p[0] + p[1]) + (p[2] + p[3])) * inv_dim + NORM_EPS); }

struct Epi1 {
    static constexpr bool PERM = false;
    bf16_t *CQ, *CKV, *KPE, *QD, *KD, *QX; float *SSQq, *SSQkv; const float *COS, *SIN; float sc_d, sc_x;
    __device__ __forceinline__ void operator()(const Acc& acc, const Unit& u, int wr, int wc, int fr, int fq) const {
        const int pn = u.pn;
        EPI_ROWS_BEGIN
            const float r = 1.0f;
            if (pn == 0) {
                float ss = 0.f;
                EPI_COLS_BEGIN const f32x4 v = acc[ai][bj][m][n] * r; ss += (v[0] * v[0] + v[1] * v[1]) + (v[2] * v[2] + v[3] * v[3]); store4bf(CQ + (size_t)row * 256 + colt, v); EPI_COLS_END
                ss += __shfl_xor(ss, 16); ss += __shfl_xor(ss, 32);
                if (fq == 0) SSQq[(size_t)row * 4 + wc] = ss;
            } else if (pn == 1) {
                float ss = 0.f;
#pragma unroll
                for (int n = 0; n < 2; ++n) { const f32x4 v = acc[ai][0][m][n] * r; ss += (v[0] * v[0] + v[1] * v[1]) + (v[2] * v[2] + v[3] * v[3]); store4bf(CKV + (size_t)row * 128 + wc * 32 + n * 16 + 4 * fq, v); }
                ss += __shfl_xor(ss, 16); ss += __shfl_xor(ss, 32);
                if (fq == 0) SSQkv[(size_t)row * 4 + wc] = ss;
                if (wc == 0) {
                    const int s = row & (SEQ - 1); const f32x4 cs = *(const f32x4*)(COS + s * 16 + 4 * fq), sn = *(const f32x4*)(SIN + s * 16 + 4 * fq);
                    const f32x4 x1 = acc[ai][1][m][0] * r, x2 = acc[ai][1][m][1] * r;
                    store4bf(KPE + (size_t)row * 32 + 4 * fq, x1 * cs - x2 * sn); store4bf(KPE + (size_t)row * 32 + 16 + 4 * fq, x2 * cs + x1 * sn);
                }
            } else if (pn < 6) {
                bf16_t* dst = (pn < 4 ? QD : KD) + (size_t)row * 512 + (pn & 1) * 256 + wc * 32 + 4 * fq; const float sc = (pn < 4 ? sc_d : 1.0f) * r;
                const int s = row & (SEQ - 1); const f32x4 cs = *(const f32x4*)(COS + s * 16 + 4 * fq), sn = *(const f32x4*)(SIN + s * 16 + 4 * fq);
#pragma unroll
                for (int bj = 0; bj < 2; ++bj) { const f32x4 x1 = acc[ai][bj][m][0] * sc, x2 = acc[ai][bj][m][1] * sc;
                    store4bf(dst + bj * HALF, x1 * cs - x2 * sn); store4bf(dst + bj * HALF + 16, x2 * cs + x1 * sn); }
            } else {
                const float sc = sc_x * r;
                EPI_COLS_BEGIN store4bf(QX + (size_t)row * 512 + (pn - 6) * 256 + colt, acc[ai][bj][m][n] * sc); EPI_COLS_END
            }
        EPI_ROWS_END
    }
};
#define EPIP_BJ_BEGIN _Pragma("unroll") for (int bj = 0; bj < 2; ++bj) { const int colt = bj * HALF + wc * 32 + 8 * fq;
#define EPIP_BJ_END }
struct EpiT {
    static constexpr bool PERM = true;
    bf16_t* O; size_t ldc; size_t zO; const float* ssq; float inv_dim; const float* colscale;
    __device__ __forceinline__ void operator()(const Acc& acc, const Unit& u, int wr, int wc, int fr, int fq) const {
        f32x4 cs[2][2];
        EPIP_BJ_BEGIN
            const int col = u.pn * BM + colt;
#pragma unroll
            for (int n = 0; n < 2; ++n) {
                if (ssq) { for (int i = 0; i < 4; ++i) cs[bj][n][i] = rstd4(ssq, col + 4 * n + i, inv_dim); }
                else cs[bj][n] = (f32x4){1.f, 1.f, 1.f, 1.f}; }
        EPIP_BJ_END
        bf16_t* base = O + (size_t)u.z * zO;
        EPI_ROWS_BEGIN
            EPIP_BJ_BEGIN store8bf(base + (size_t)row * ldc + u.pn * BM + colt, acc[ai][bj][m][0] * cs[bj][0], acc[ai][bj][m][1] * cs[bj][1]); EPIP_BJ_END
        EPI_ROWS_END
    }
};
struct EpiRow {
    static constexpr bool PERM = true;
    bf16_t* O; size_t ldc; size_t zO; const float* ssq; float inv_dim;
    __device__ __forceinline__ void operator()(const Acc& acc, const Unit& u, int wr, int wc, int fr, int fq) const {
        bf16_t* base = O + (size_t)u.z * zO;
        EPI_ROWS_BEGIN
            const float sc = ssq ? rstd4(ssq, row, inv_dim) : 1.0f;
            EPIP_BJ_BEGIN store8bf(base + (size_t)row * ldc + u.pn * BM + colt, acc[ai][bj][m][0] * sc, acc[ai][bj][m][1] * sc); EPIP_BJ_END
        EPI_ROWS_END
    }
};
struct Epi2 {
    static constexpr bool PERM = false;
    bf16_t* QA; const float* SSQq; const float *COS, *SIN; float sc_a;
    __device__ __forceinline__ void operator()(const Acc& acc, const Unit& u, int wr, int wc, int fr, int fq) const {
        EPI_ROWS_BEGIN
            const float sc = rstd4(SSQq, row, 1.0f / 256.0f) * sc_a;
            if (u.pn < 2) {
                EPI_COLS_BEGIN const int nn = u.pn * BM + colt; store4bf(QA + (size_t)row * 768 + (nn >> 6) * 96 + (nn & 63), acc[ai][bj][m][n] * sc); EPI_COLS_END
            } else {
                const int s = row & (SEQ - 1); const f32x4 cs = *(const f32x4*)(COS + s * 16 + 4 * fq), sn = *(const f32x4*)(SIN + s * 16 + 4 * fq);
#pragma unroll
                for (int bj = 0; bj < 2; ++bj) { const f32x4 x1 = acc[ai][bj][m][0] * sc, x2 = acc[ai][bj][m][1] * sc; bf16_t* dst = QA + (size_t)row * 768 + (4 * bj + wc) * 96 + 64 + 4 * fq;
                    store4bf(dst, x1 * cs - x2 * sn); store4bf(dst + 16, x2 * cs + x1 * sn); }
            }
        EPI_ROWS_END
    }
};
struct EpiSG {
    static constexpr bool PERM = true;
    bf16_t* O;
    __device__ __forceinline__ void operator()(const Acc& acc, const Unit& u, int wr, int wc, int fr, int fq) const {
#pragma unroll
        for (int ai = 0; ai < 2; ++ai) {
            u32x4 ov[4][2];
#pragma unroll
            for (int m = 0; m < 4; ++m) { const int row = u.pm * BM + ai * HALF + wr * 64 + m * 16 + fr;
                EPIP_BJ_BEGIN ov[m][bj] = *(const u32x4*)(O + (size_t)row * 1536 + u.pn * BM + colt); EPIP_BJ_END }
#pragma unroll
            for (int m = 0; m < 4; ++m) { const int row = u.pm * BM + ai * HALF + wr * 64 + m * 16 + fr;
                EPIP_BJ_BEGIN u32x2 lo_, hi_; lo_.x = ov[m][bj].x; lo_.y = ov[m][bj].y; hi_.x = ov[m][bj].z; hi_.y = ov[m][bj].w;
                    const f32x4 o0 = unpack4bf(lo_), o1 = unpack4bf(hi_); const f32x4 g0 = acc[ai][bj][m][0], g1 = acc[ai][bj][m][1]; f32x4 v0, v1;
#pragma unroll
                    for (int i = 0; i < 4; ++i) { v0[i] = o0[i] * g0[i] * sigmoidf_(g0[i]); v1[i] = o1[i] * g1[i] * sigmoidf_(g1[i]); }
                    store8bf(O + (size_t)row * 1536 + u.pn * BM + colt, v0, v1); EPIP_BJ_END }
            asm volatile("" ::: "memory");
        }
    }
};
struct EpiGL {
    static constexpr bool PERM = true;
    bf16_t* S; const float* bias;
    __device__ __forceinline__ void operator()(const Acc& acc, const Unit& u, int wr, int wc, int fr, int fq) const {
        f32x4 bv[2][2];
        EPIP_BJ_BEGIN bv[bj][0] = *(const f32x4*)(bias + u.pn * BM + colt); bv[bj][1] = *(const f32x4*)(bias + u.pn * BM + colt + 4); EPIP_BJ_END
        EPI_ROWS_BEGIN
            EPIP_BJ_BEGIN const f32x4 g0 = acc[ai][bj][m][0] + bv[bj][0], g1 = acc[ai][bj][m][1] + bv[bj][1]; f32x4 v0, v1;
#pragma unroll
                for (int i = 0; i < 4; ++i) { v0[i] = sigmoidf_(g0[i]); v1[i] = sigmoidf_(g1[i]); }
                store8bf(S + (size_t)row * 3072 + u.pn * BM + colt, v0, v1); EPIP_BJ_END
        EPI_ROWS_END
    }
};
struct EpiBR {
    static constexpr bool PERM = true;
    const bf16_t* S; bf16_t* MG;
    __device__ __forceinline__ void operator()(const Acc& acc, const Unit& u, int wr, int wc, int fr, int fq) const {
#pragma unroll
        for (int ai = 0; ai < 2; ++ai) {
            u32x4 sv[4][2]; unsigned long long mv[4][2][2];
#pragma unroll
            for (int m = 0; m < 4; ++m) { const int row = u.pm * BM + ai * HALF + wr * 64 + m * 16 + fr;
                EPIP_BJ_BEGIN const int col = u.pn * BM + colt; sv[m][bj] = *(const u32x4*)(S + (size_t)row * 3072 + u.z * 1024 + col);
                    const unsigned long long* mp_ = (const unsigned long long*)(MG + (size_t)row * 1024 + col);
                    mv[m][bj][0] = (u.z > 0) ? __hip_atomic_load(mp_, __ATOMIC_RELAXED, __HIP_MEMORY_SCOPE_AGENT) : 0ull;
                    mv[m][bj][1] = (u.z > 0) ? __hip_atomic_load(mp_ + 1, __ATOMIC_RELAXED, __HIP_MEMORY_SCOPE_AGENT) : 0ull; EPIP_BJ_END }
#pragma unroll
            for (int m = 0; m < 4; ++m) { const int row = u.pm * BM + ai * HALF + wr * 64 + m * 16 + fr;
                EPIP_BJ_BEGIN const int col = u.pn * BM + colt; u32x2 lo_, hi_; lo_.x = sv[m][bj].x; lo_.y = sv[m][bj].y; hi_.x = sv[m][bj].z; hi_.y = sv[m][bj].w;
                    f32x4 v0 = unpack4bf(lo_) * acc[ai][bj][m][0], v1 = unpack4bf(hi_) * acc[ai][bj][m][1];
                    u32x2 w0, w1; w0.x = (unsigned)mv[m][bj][0]; w0.y = (unsigned)(mv[m][bj][0] >> 32); w1.x = (unsigned)mv[m][bj][1]; w1.y = (unsigned)(mv[m][bj][1] >> 32);
                    v0 += unpack4bf(w0); v1 += unpack4bf(w1);
                    store8bf(MG + (size_t)row * 1024 + col, v0, v1); EPIP_BJ_END }
            asm volatile("" ::: "memory");
        }
    }
};
struct EpiOut {
    static constexpr bool PERM = false;
    float* OUT;
    __device__ __forceinline__ void operator()(const Acc& acc, const Unit& u, int wr, int wc, int fr, int fq) const {
        EPI_ROWS_BEGIN
            EPI_COLS_BEGIN *(f32x4*)(OUT + (size_t)row * 1024 + u.pn * BM + colt) = acc[ai][bj][m][n]; EPI_COLS_END
        EPI_ROWS_END
    }
};
}

__device__ __forceinline__ float max3f(float a, float b, float c) { float r; asm("v_max3_f32 %0, %1, %2, %3" : "=v"(r) : "v"(a), "v"(b), "v"(c)); return r; }
__device__ __forceinline__ float max2f(float a, float b) { float r; asm("v_max_f32_e32 %0, %1, %2" : "=v"(r) : "v"(a), "v"(b)); return r; }
__device__ __forceinline__ float fadd_s(float a, float b) { float r; asm("v_add_f32_e32 %0, %1, %2" : "=v"(r) : "v"(a), "v"(b)); return r; }
__device__ __forceinline__ float rowmax32(const f32x16& p0, const f32x16& p1) {
    float a = max3f(p0[0], p0[1], p1[0]), b = max3f(p0[2], p0[3], p1[1]); a = max3f(a, p1[2], p1[3]);
#pragma unroll
    for (int r = 4; r < 16; r += 4) { a = max3f(a, p0[r], p0[r + 1]); b = max3f(b, p0[r + 2], p0[r + 3]); a = max3f(a, p1[r], p1[r + 1]); b = max3f(b, p1[r + 2], p1[r + 3]); }
    return max2f(a, b);
}
__device__ __forceinline__ float half_max(float v) { auto rr = __builtin_amdgcn_permlane32_swap(__float_as_uint(v), __float_as_uint(v), false, false); return fmaxf(__uint_as_float(rr[0]), __uint_as_float(rr[1])); }
__device__ __forceinline__ float half_sum(float v) { auto rr = __builtin_amdgcn_permlane32_swap(__float_as_uint(v), __float_as_uint(v), false, false); return __uint_as_float(rr[0]) + __uint_as_float(rr[1]); }
__device__ __forceinline__ int crow(int r, int hi) { return (r & 3) + 8 * (r >> 2) + 4 * hi; }

template <int NMAP, int DKM, int DV, bool CAUSAL, int W0, int W1>
__device__ __forceinline__ void attn_unit(LAS unsigned char* lds, const bf16_t* __restrict__ Q, int ldq, const bf16_t* __restrict__ K0, int ldk0, const bf16_t* __restrict__ K1, int ldk1,
                                          const bf16_t* __restrict__ Vt, size_t ldv, int q0, int NT, bf16_t* O, int ldo, float lam, const float* subln, float outscale) {
    constexpr int DKT = NMAP * DKM, KS = DKT * 2 + 16, VS = 136, KBUF = 64 * KS, VBUF = DV * VS;
    constexpr int NC = DKM / 16, NDB = DV / 32;
    constexpr int K0C = W0 / 8, K0N = (64 * K0C) / 512, K1C = W1 / 8, VN = (DV * 8) / 512;
    static_assert(W0 + W1 == DKT && K0N >= 1 && VN >= 1, "attention staging geometry");
    int tid = threadIdx.x; asm volatile("" : "+v"(tid));
    const int lane = tid & 63, wid = __builtin_amdgcn_readfirstlane(tid >> 6), r32 = lane & 31, hi = lane >> 5;
    LAS unsigned char* Kb = lds; LAS unsigned char* Vb = lds + 2 * KBUF;
    bf16x8 qf[NMAP][NC];
    { const bf16_t* qrow = Q + (size_t)(q0 + wid * 32 + r32) * ldq;
#pragma unroll
      for (int mp = 0; mp < NMAP; ++mp)
#pragma unroll
          for (int c = 0; c < NC; ++c) qf[mp][c] = *(const bf16x8*)(qrow + mp * DKM + 16 * c + 8 * hi); }
    f32x16 o[NMAP][NDB]; float mrow[NMAP], lrow[NMAP];
#pragma unroll
    for (int mp = 0; mp < NMAP; ++mp) { mrow[mp] = -INFINITY; lrow[mp] = 0.f;
#pragma unroll
        for (int db = 0; db < NDB; ++db)
#pragma unroll
            for (int r = 0; r < 16; ++r) o[mp][db][r] = 0.f; }
    u32x4 kreg[K0N], k1reg = {0u, 0u, 0u, 0u}, vreg[VN];
#define ATT_GLOAD(t) do { \
    _Pragma("unroll") for (int i = 0; i < K0N; ++i) { const int idx = tid + 512 * i, rr = idx / K0C, cc = idx % K0C; kreg[i] = *(const u32x4*)(K0 + (size_t)(64 * (t) + rr) * ldk0 + cc * 8); } \
    if (W1 > 0) { if (tid < 64 * K1C) { const int rr = tid / (K1C > 0 ? K1C : 1), cc = tid % (K1C > 0 ? K1C : 1); k1reg = *(const u32x4*)(K1 + (size_t)(64 * (t) + rr) * ldk1 + cc * 8); } } \
    _Pragma("unroll") for (int i = 0; i < VN; ++i) { const int idx = tid + 512 * i, dd = idx >> 3, cc = idx & 7; vreg[i] = *(const u32x4*)(Vt + (size_t)dd * ldv + 64 * (t) + cc * 8); } } while (0)
#define ATT_LWRITE(buf) do { \
    _Pragma("unroll") for (int i = 0; i < K0N; ++i) { const int idx = tid + 512 * i, rr = idx / K0C, cc = idx % K0C; *(LAS u32x4*)(Kb + (buf) * KBUF + rr * KS + cc * 16) = kreg[i]; } \
    if (W1 > 0) { if (tid < 64 * K1C) { const int rr = tid / (K1C > 0 ? K1C : 1), cc = tid % (K1C > 0 ? K1C : 1); *(LAS u32x4*)(Kb + (buf) * KBUF + rr * KS + W0 * 2 + cc * 16) = k1reg; } } \
    _Pragma("unroll") for (int i = 0; i < VN; ++i) { const int idx = tid + 512 * i, dd = idx >> 3, cc = idx & 7; LAS u32x2* vp = (LAS u32x2*)(Vb + (buf) * VBUF + dd * VS + cc * 16); \
        u32x2 lo_; lo_.x = vreg[i].x; lo_.y = vreg[i].y; u32x2 hi_; hi_.x = vreg[i].z; hi_.y = vreg[i].w; vp[0] = lo_; vp[1] = hi_; } } while (0)
    ATT_GLOAD(0);
    ATT_LWRITE(0);
    __syncthreads();
    const int qw0 = q0 + wid * 32;
    for (int t = 0; t < NT; ++t) {
        const int buf = t & 1;
        if (t + 1 < NT) ATT_GLOAD(t + 1);
#pragma unroll
        for (int kb = 0; kb < 2; ++kb) {
            const int kv0 = 64 * t + 32 * kb;
            if (CAUSAL && kv0 > qw0) continue;
            const bool diag = CAUSAL && (kv0 == qw0);
            bf16x8 vf[NDB][2];
#pragma unroll
            for (int db = 0; db < NDB; ++db)
#pragma unroll
                for (int j = 0; j < 2; ++j) { const LAS unsigned char* vp = Vb + buf * VBUF + (32 * db + r32) * VS + (32 * kb + 16 * j + 4 * hi) * 2;
                    const s16x4 lo = *(const LAS s16x4*)vp, hh = *(const LAS s16x4*)(vp + 16);
                    vf[db][j] = (bf16x8){lo[0], lo[1], lo[2], lo[3], hh[0], hh[1], hh[2], hh[3]}; }
#pragma unroll
            for (int mp = 0; mp < NMAP; ++mp) {
                f32x16 s;
#pragma unroll
                for (int r = 0; r < 16; ++r) s[r] = 0.f;
#pragma unroll
                for (int c = 0; c < NC; ++c) { const bf16x8 kf = *(const LAS bf16x8*)(Kb + buf * KBUF + (32 * kb + r32) * KS + (mp * DKM + 16 * c + 8 * hi) * 2);
                    s = __builtin_amdgcn_mfma_f32_32x32x16_bf16(kf, qf[mp][c], s, 0, 0, 0); }
                if (diag) {
#pragma unroll
                    for (int r = 0; r < 16; ++r) if (crow(r, hi) > r32) s[r] = -INFINITY;
                }
                float mx = s[0];
#pragma unroll
                for (int r = 1; r < 16; ++r) mx = fmaxf(mx, s[r]);
                mx = fmaxf(mx, __shfl_xor(mx, 32));
                if (__any(mx > mrow[mp])) {
                    const float mnew = fmaxf(mrow[mp], mx), alpha = fast_exp2(mrow[mp] - mnew);
                    mrow[mp] = mnew; lrow[mp] *= alpha;
#pragma unroll
                    for (int db = 0; db < NDB; ++db)
#pragma unroll
                        for (int r = 0; r < 16; ++r) o[mp][db][r] *= alpha;
                }
                const float mcur = mrow[mp]; float ls = 0.f;
#pragma unroll
                for (int r = 0; r < 16; ++r) { s[r] = fast_exp2(s[r] - mcur); ls += s[r]; }
                lrow[mp] += ls;
                bf16x8 pa[2];
#pragma unroll
                for (int j = 0; j < 2; ++j) { u32x4 w; w.x = cvtpk(s[8 * j + 0], s[8 * j + 1]); w.y = cvtpk(s[8 * j + 2], s[8 * j + 3]); w.z = cvtpk(s[8 * j + 4], s[8 * j + 5]); w.w = cvtpk(s[8 * j + 6], s[8 * j + 7]); pa[j] = __builtin_bit_cast(bf16x8, w); }
#pragma unroll
                for (int db = 0; db < NDB; ++db)
#pragma unroll
                    for (int j = 0; j < 2; ++j) o[mp][db] = __builtin_amdgcn_mfma_f32_32x32x16_bf16(vf[db][j], pa[j], o[mp][db], 0, 0, 0);
            }
        }
        if (t + 1 < NT) ATT_LWRITE(buf ^ 1);
        __syncthreads();
    }
#undef ATT_GLOAD
#undef ATT_LWRITE
    float inv[NMAP];
#pragma unroll
    for (int mp = 0; mp < NMAP; ++mp) { const float lt = lrow[mp] + __shfl_xor(lrow[mp], 32); inv[mp] = 1.0f / lt; }
    bf16_t* orow = O + (size_t)(q0 + wid * 32 + r32) * ldo;
    if constexpr (NMAP == 1) {
#pragma unroll
        for (int db = 0; db < NDB; ++db)
#pragma unroll
            for (int g = 0; g < 4; ++g) { f32x4 v; for (int i = 0; i < 4; ++i) v[i] = o[0][db][4 * g + i] * inv[0]; store4bf(orow + 32 * db + 8 * g + 4 * hi, v); }
    } else {
        float ss = 0.f;
#pragma unroll
        for (int db = 0; db < NDB; ++db)
#pragma unroll
            for (int r = 0; r < 16; ++r) { const float v = o[0][db][r] * inv[0] - lam * (o[1][db][r] * inv[1]); o[0][db][r] = v; ss += v * v; }
        ss += __shfl_xor(ss, 32);
        const float rstd = __builtin_amdgcn_rsqf(ss * (1.0f / DV) + NORM_EPS) * outscale;
#pragma unroll
        for (int db = 0; db < NDB; ++db)
#pragma unroll
            for (int g = 0; g < 4; ++g) { const f32x4 gn = *(const f32x4*)(subln + 32 * db + 8 * g + 4 * hi); f32x4 v; for (int i = 0; i < 4; ++i) v[i] = o[0][db][4 * g + i] * rstd * gn[i]; store4bf(orow + 32 * db + 8 * g + 4 * hi, v); }
    }
}

template <int NMAP, int DKM, int DV, int W0, int W1>
__device__ __forceinline__ void attn_unit2(LAS unsigned char* lds, const bf16_t* __restrict__ Q, int ldq, const bf16_t* __restrict__ K0, int ldk0, const bf16_t* __restrict__ K1, int ldk1,
                                           const bf16_t* __restrict__ Vt, size_t ldv, int q0, int NT, bf16_t* O, int ldo, float lam, const float* subln, float outscale) {
    constexpr int DKT = NMAP * DKM, KS = DKT * 2 + 16, VS = 136, KBUF = 64 * KS, VBUF = DV * VS;
    constexpr int NC = DKM / 16, NDB = DV / 32;
    constexpr int K0C = W0 / 8, K0N = (64 * K0C) / 512, K1C = W1 / 8, VN = (DV * 8) / 512;
    static_assert(W0 + W1 == DKT && K0N >= 1 && VN >= 1, "attention staging geometry");
    int tid = threadIdx.x; asm volatile("" : "+v"(tid));
    const int lane = tid & 63, wid = __builtin_amdgcn_readfirstlane(tid >> 6), r32 = lane & 31, hi = lane >> 5;
    LAS unsigned char* Kb = lds; LAS unsigned char* Vb = lds + 2 * KBUF;
    bf16x8 qf[NMAP][NC];
    { const bf16_t* qrow = Q + (size_t)(q0 + wid * 32 + r32) * ldq;
#pragma unroll
      for (int mp = 0; mp < NMAP; ++mp)
#pragma unroll
          for (int c = 0; c < NC; ++c) qf[mp][c] = *(const bf16x8*)(qrow + mp * DKM + 16 * c + 8 * hi); }
    f32x16 o[NMAP][NDB], negm[NMAP]; float lrow[NMAP];
#pragma unroll
    for (int mp = 0; mp < NMAP; ++mp) { lrow[mp] = 0.f;
#pragma unroll
        for (int r = 0; r < 16; ++r) negm[mp][r] = 0.f;
#pragma unroll
        for (int db = 0; db < NDB; ++db)
#pragma unroll
            for (int r = 0; r < 16; ++r) o[mp][db][r] = 0.f; }
    u32x4 kreg[K0N], k1reg = {0u, 0u, 0u, 0u}, vreg[VN];
#define ATT_GLOAD(t) do { \
    _Pragma("unroll") for (int i = 0; i < K0N; ++i) { const int idx = tid + 512 * i, rr = idx / K0C, cc = idx % K0C; kreg[i] = *(const u32x4*)(K0 + (size_t)(64 * (t) + rr) * ldk0 + cc * 8); } \
    if (W1 > 0) { if (tid < 64 * K1C) { const int rr = tid / (K1C > 0 ? K1C : 1), cc = tid % (K1C > 0 ? K1C : 1); k1reg = *(const u32x4*)(K1 + (size_t)(64 * (t) + rr) * ldk1 + cc * 8); } } \
    _Pragma("unroll") for (int i = 0; i < VN; ++i) { const int idx = tid + 512 * i, dd = idx >> 3, cc = idx & 7; vreg[i] = *(const u32x4*)(Vt + (size_t)dd * ldv + 64 * (t) + cc * 8); } } while (0)
#define ATT_LWRITE(buf) do { \
    _Pragma("unroll") for (int i = 0; i < K0N; ++i) { const int idx = tid + 512 * i, rr = idx / K0C, cc = idx % K0C; *(LAS u32x4*)(Kb + (buf) * KBUF + rr * KS + cc * 16) = kreg[i]; } \
    if (W1 > 0) { if (tid < 64 * K1C) { const int rr = tid / (K1C > 0 ? K1C : 1), cc = tid % (K1C > 0 ? K1C : 1); *(LAS u32x4*)(Kb + (buf) * KBUF + rr * KS + W0 * 2 + cc * 16) = k1reg; } } \
    _Pragma("unroll") for (int i = 0; i < VN; ++i) { const int idx = tid + 512 * i, dd = idx >> 3, cc = idx & 7; LAS u32x2* vp = (LAS u32x2*)(Vb + (buf) * VBUF + dd * VS + cc * 16); \
        u32x2 lo_; lo_.x = vreg[i].x; lo_.y = vreg[i].y; u32x2 hi_; hi_.x = vreg[i].z; hi_.y = vreg[i].w; vp[0] = lo_; vp[1] = hi_; } } while (0)
    ATT_GLOAD(0);
    ATT_LWRITE(0);
    __syncthreads();
    const int qw0 = q0 + wid * 32;
    for (int t = 0; t < NT; ++t) {
        const int buf = t & 1;
        if (t + 1 < NT) ATT_GLOAD(t + 1);
        const int kvt = 64 * t;
        if (kvt <= qw0) {
            const bool band = (kvt + 63 > qw0);
#pragma unroll
            for (int mp = 0; mp < NMAP; ++mp) {
                f32x16 s0, s1;
#pragma unroll
                for (int c = 0; c < NC; ++c) {
                    const bf16x8 kf0 = *(const LAS bf16x8*)(Kb + buf * KBUF + r32 * KS + (mp * DKM + 16 * c + 8 * hi) * 2);
                    const bf16x8 kf1 = *(const LAS bf16x8*)(Kb + buf * KBUF + (32 + r32) * KS + (mp * DKM + 16 * c + 8 * hi) * 2);
                    if (c == 0) { s0 = __builtin_amdgcn_mfma_f32_32x32x16_bf16(kf0, qf[mp][0], negm[mp], 0, 0, 0); s1 = __builtin_amdgcn_mfma_f32_32x32x16_bf16(kf1, qf[mp][0], negm[mp], 0, 0, 0); }
                    else { s0 = __builtin_amdgcn_mfma_f32_32x32x16_bf16(kf0, qf[mp][c], s0, 0, 0, 0); s1 = __builtin_amdgcn_mfma_f32_32x32x16_bf16(kf1, qf[mp][c], s1, 0, 0, 0); }
                }
                asm volatile("s_nop 15\n\ts_nop 7" : "+v"(s0), "+v"(s1));
                if (band) {
                    const int qd = qw0 + r32 - kvt;
#pragma unroll
                    for (int r = 0; r < 16; ++r) { const int kv = crow(r, hi); if (kv > qd) s0[r] = -INFINITY; if (kv + 32 > qd) s1[r] = -INFINITY; }
                }
                float mx = rowmax32(s0, s1);
                mx = fmaxf(mx, __shfl_xor(mx, 32));
                if (__any(t == 0 || mx > 8.0f)) {
                    const float dl = (t == 0) ? mx : fmaxf(mx, 0.f), alpha = fast_exp2(-dl);
                    lrow[mp] *= alpha;
#pragma unroll
                    for (int r = 0; r < 16; ++r) { s0[r] -= dl; s1[r] -= dl; negm[mp][r] -= dl; }
#pragma unroll
                    for (int db = 0; db < NDB; ++db)
#pragma unroll
                        for (int r = 0; r < 16; ++r) o[mp][db][r] *= alpha;
                }
                float ls = 0.f;
#pragma unroll
                for (int kb = 0; kb < 2; ++kb) {
                    f32x16& s = kb ? s1 : s0;
                    bf16x8 vf[NDB][2];
#pragma unroll
                    for (int db = 0; db < NDB; ++db)
#pragma unroll
                        for (int j = 0; j < 2; ++j) { const LAS unsigned char* vp = Vb + buf * VBUF + (32 * db + r32) * VS + (32 * kb + 16 * j + 4 * hi) * 2;
                            const s16x4 lo = *(const LAS s16x4*)vp, hh = *(const LAS s16x4*)(vp + 16);
                            vf[db][j] = (bf16x8){lo[0], lo[1], lo[2], lo[3], hh[0], hh[1], hh[2], hh[3]}; }
#pragma unroll
                    for (int r = 0; r < 16; ++r) s[r] = fast_exp2(s[r]);
                    asm volatile("s_nop 1" : "+v"(s));
#pragma unroll
                    for (int r = 0; r < 16; ++r) ls = fadd_s(ls, s[r]);
                    bf16x8 pa[2];
#pragma unroll
                    for (int j = 0; j < 2; ++j) { u32x4 w; w.x = cvtpk(s[8 * j + 0], s[8 * j + 1]); w.y = cvtpk(s[8 * j + 2], s[8 * j + 3]); w.z = cvtpk(s[8 * j + 4], s[8 * j + 5]); w.w = cvtpk(s[8 * j + 6], s[8 * j + 7]); pa[j] = __builtin_bit_cast(bf16x8, w); }
#pragma unroll
                    for (int db = 0; db < NDB; ++db)
#pragma unroll
                        for (int j = 0; j < 2; ++j) o[mp][db] = __builtin_amdgcn_mfma_f32_32x32x16_bf16(vf[db][j], pa[j], o[mp][db], 0, 0, 0);
                }
                lrow[mp] += ls;
                if (NMAP > 1) __builtin_amdgcn_sched_barrier(0);
            }
        }
        if (t + 1 < NT) ATT_LWRITE(buf ^ 1);
        __syncthreads();
    }
#undef ATT_GLOAD
#undef ATT_LWRITE
    float inv[NMAP];
#pragma unroll
    for (int mp = 0; mp < NMAP; ++mp) { const float lt = lrow[mp] + __shfl_xor(lrow[mp], 32); inv[mp] = 1.0f / lt; }
    bf16_t* orow = O + (size_t)(q0 + wid * 32 + r32) * ldo;
    if constexpr (NMAP == 1) {
#pragma unroll
        for (int db = 0; db < NDB; ++db)
#pragma unroll
            for (int g = 0; g < 4; ++g) { f32x4 v; for (int i = 0; i < 4; ++i) v[i] = o[0][db][4 * g + i] * inv[0]; store4bf(orow + 32 * db + 8 * g + 4 * hi, v); }
    } else {
        float ss = 0.f;
#pragma unroll
        for (int db = 0; db < NDB; ++db)
#pragma unroll
            for (int r = 0; r < 16; ++r) { const float v = o[0][db][r] * inv[0] - lam * (o[1][db][r] * inv[1]); o[0][db][r] = v; ss += v * v; }
        ss += __shfl_xor(ss, 32);
        const float rstd = __builtin_amdgcn_rsqf(ss * (1.0f / DV) + NORM_EPS) * outscale;
#pragma unroll
        for (int db = 0; db < NDB; ++db)
#pragma unroll
            for (int g = 0; g < 4; ++g) { const f32x4 gn = *(const f32x4*)(subln + 32 * db + 8 * g + 4 * hi); f32x4 v; for (int i = 0; i < 4; ++i) v[i] = o[0][db][4 * g + i] * rstd * gn[i]; store4bf(orow + 32 * db + 8 * g + 4 * hi, v); }
    }
}

template <int DKM, int DV, int W0, int W1>
__device__ __forceinline__ void attn_unit4(LAS unsigned char* lds, const bf16_t* __restrict__ Q, int ldq, const bf16_t* __restrict__ K0, int ldk0, const bf16_t* __restrict__ K1, int ldk1,
                                           const bf16_t* __restrict__ Vt, size_t ldv, int q0, int NT, bf16_t* O, int ldo) {
    constexpr int KS = DKM * 2 + 16, VS = 136, KBUF = 64 * KS, VBUF = DV * VS, QROW = DKM * 2 + 16;
    constexpr int NC = DKM / 16, NDB = DV / 32;
    constexpr int K0C = W0 / 8, K0N = (64 * K0C) / 512, K1C = W1 / 8, VN = (DV * 8) / 512;
    static_assert(W0 + W1 == DKM && K0N >= 1 && VN >= 1 && K1C >= 1, "attention staging geometry");
    static_assert(2 * KBUF + 2 * VBUF + 8 * 64 * QROW <= LDS_BYTES - 16, "attention LDS budget");
    int tid = threadIdx.x; asm volatile("" : "+v"(tid));
    const int lane = tid & 63, wid = __builtin_amdgcn_readfirstlane(tid >> 6), r32 = lane & 31, hi = lane >> 5;
    LAS unsigned char* Kb = lds; LAS unsigned char* Vb = lds + 2 * KBUF;
    LAS unsigned char* Qs = lds + 2 * KBUF + 2 * VBUF + wid * (64 * QROW) + r32 * QROW + 16 * hi;
#pragma unroll
    for (int rb = 0; rb < 2; ++rb) { const bf16_t* qrow = Q + (size_t)(q0 + wid * 64 + rb * 32 + r32) * ldq;
#pragma unroll
        for (int c = 0; c < NC; ++c) *(LAS bf16x8*)(Qs + rb * 32 * QROW + c * 32) = *(const bf16x8*)(qrow + 16 * c + 8 * hi); }
    f32x16 o[2][NDB], negm[2]; float lrow[2] = {0.f, 0.f};
#pragma unroll
    for (int rb = 0; rb < 2; ++rb) {
#pragma unroll
        for (int r = 0; r < 16; ++r) negm[rb][r] = 0.f;
#pragma unroll
        for (int db = 0; db < NDB; ++db)
#pragma unroll
            for (int r = 0; r < 16; ++r) o[rb][db][r] = 0.f; }
    u32x4 kreg[K0N], k1reg = {0u, 0u, 0u, 0u}, vreg[VN];
#define A4_GLOAD(t) do { \
    _Pragma("unroll") for (int i = 0; i < K0N; ++i) { const int idx = tid + 512 * i, rr = idx / K0C, cc = idx % K0C; kreg[i] = *(const u32x4*)(K0 + (size_t)(64 * (t) + rr) * ldk0 + cc * 8); } \
    if (tid < 64 * K1C) { const int rr = tid / K1C, cc = tid % K1C; k1reg = *(const u32x4*)(K1 + (size_t)(64 * (t) + rr) * ldk1 + cc * 8); } \
    _Pragma("unroll") for (int i = 0; i < VN; ++i) { const int idx = tid + 512 * i, dd = idx >> 3, cc = idx & 7; vreg[i] = *(const u32x4*)(Vt + (size_t)dd * ldv + 64 * (t) + cc * 8); } } while (0)
#define A4_LWRITE(buf) do { \
    _Pragma("unroll") for (int i = 0; i < K0N; ++i) { const int idx = tid + 512 * i, rr = idx / K0C, cc = idx % K0C; *(LAS u32x4*)(Kb + (buf) * KBUF + rr * KS + cc * 16) = kreg[i]; } \
    if (tid < 64 * K1C) { const int rr = tid / K1C, cc = tid % K1C; *(LAS u32x4*)(Kb + (buf) * KBUF + rr * KS + W0 * 2 + cc * 16) = k1reg; } \
    _Pragma("unroll") for (int i = 0; i < VN; ++i) { const int idx = tid + 512 * i, dd = idx >> 3, cc = idx & 7; LAS u32x2* vp = (LAS u32x2*)(Vb + (buf) * VBUF + dd * VS + cc * 16); \
        u32x2 lo_; lo_.x = vreg[i].x; lo_.y = vreg[i].y; u32x2 hi_; hi_.x = vreg[i].z; hi_.y = vreg[i].w; vp[0] = lo_; vp[1] = hi_; } } while (0)
    A4_GLOAD(0);
    A4_LWRITE(0);
    __syncthreads();
    const int qw0 = q0 + wid * 64;
    for (int t = 0; t < NT; ++t) {
        const int buf = t & 1;
        if (t + 1 < NT) A4_GLOAD(t + 1);
        const int kvt = 64 * t;
        if (kvt <= qw0) {
            const bool band = (kvt == qw0);
            f32x16 s[2][2];
#pragma unroll
            for (int c = 0; c < NC; ++c) {
                const bf16x8 kf0 = *(const LAS bf16x8*)(Kb + buf * KBUF + r32 * KS + (16 * c + 8 * hi) * 2);
                const bf16x8 kf1 = *(const LAS bf16x8*)(Kb + buf * KBUF + (32 + r32) * KS + (16 * c + 8 * hi) * 2);
#pragma unroll
                for (int rb = 0; rb < 2; ++rb) { const bf16x8 qv = *(const LAS bf16x8*)(Qs + rb * 32 * QROW + c * 32);
                    if (c == 0) { s[rb][0] = __builtin_amdgcn_mfma_f32_32x32x16_bf16(kf0, qv, negm[rb], 0, 0, 0); s[rb][1] = __builtin_amdgcn_mfma_f32_32x32x16_bf16(kf1, qv, negm[rb], 0, 0, 0); }
                    else { s[rb][0] = __builtin_amdgcn_mfma_f32_32x32x16_bf16(kf0, qv, s[rb][0], 0, 0, 0); s[rb][1] = __builtin_amdgcn_mfma_f32_32x32x16_bf16(kf1, qv, s[rb][1], 0, 0, 0); } }
            }
            asm volatile("s_nop 15\n\ts_nop 7" : "+v"(s[0][0]), "+v"(s[0][1]), "+v"(s[1][0]), "+v"(s[1][1]));
#pragma unroll
            for (int rb = 0; rb < 2; ++rb) {
                f32x16& s0 = s[rb][0]; f32x16& s1 = s[rb][1];
                if (band) {
                    const int qd = 32 * rb + r32;
#pragma unroll
                    for (int r = 0; r < 16; ++r) { const int kv = crow(r, hi); if (kv > qd) s0[r] = -INFINITY; if (kv + 32 > qd) s1[r] = -INFINITY; }
                }
                float mx = rowmax32(s0, s1);
                mx = half_max(mx);
                if (__any(t == 0 || mx > 8.0f)) {
                    const float dl = (t == 0) ? mx : fmaxf(mx, 0.f), alpha = fast_exp2(-dl);
                    lrow[rb] *= alpha;
#pragma unroll
                    for (int r = 0; r < 16; ++r) { s0[r] -= dl; s1[r] -= dl; negm[rb][r] -= dl; }
#pragma unroll
                    for (int db = 0; db < NDB; ++db)
#pragma unroll
                        for (int r = 0; r < 16; ++r) o[rb][db][r] *= alpha;
                }
            }
#pragma unroll
            for (int kb = 0; kb < 2; ++kb) {
                bf16x8 vf[NDB][2];
#pragma unroll
                for (int db = 0; db < NDB; ++db)
#pragma unroll
                    for (int j = 0; j < 2; ++j) { const LAS unsigned char* vp = Vb + buf * VBUF + (32 * db + r32) * VS + (32 * kb + 16 * j + 4 * hi) * 2;
                        const s16x4 lo = *(const LAS s16x4*)vp, hh = *(const LAS s16x4*)(vp + 16);
                        vf[db][j] = (bf16x8){lo[0], lo[1], lo[2], lo[3], hh[0], hh[1], hh[2], hh[3]}; }
#pragma unroll
                for (int rb = 0; rb < 2; ++rb) {
                    f32x16& sv = s[rb][kb]; float ls = 0.f;
#pragma unroll
                    for (int r = 0; r < 16; ++r) sv[r] = fast_exp2(sv[r]);
                    asm volatile("s_nop 1" : "+v"(sv));
#pragma unroll
                    for (int r = 0; r < 16; ++r) ls = fadd_s(ls, sv[r]);
                    lrow[rb] += ls;
                    bf16x8 pa[2];
#pragma unroll
                    for (int j = 0; j < 2; ++j) { u32x4 w; w.x = cvtpk(sv[8 * j + 0], sv[8 * j + 1]); w.y = cvtpk(sv[8 * j + 2], sv[8 * j + 3]); w.z = cvtpk(sv[8 * j + 4], sv[8 * j + 5]); w.w = cvtpk(sv[8 * j + 6], sv[8 * j + 7]); pa[j] = __builtin_bit_cast(bf16x8, w); }
#pragma unroll
                    for (int db = 0; db < NDB; ++db)
#pragma unroll
                        for (int j = 0; j < 2; ++j) o[rb][db] = __builtin_amdgcn_mfma_f32_32x32x16_bf16(vf[db][j], pa[j], o[rb][db], 0, 0, 0);
                }
            }
        }
        if (t + 1 < NT) A4_LWRITE(buf ^ 1);
        __syncthreads();
    }
#undef A4_GLOAD
#undef A4_LWRITE
#pragma unroll
    for (int rb = 0; rb < 2; ++rb) {
        const float inv = 1.0f / half_sum(lrow[rb]);
        bf16_t* orow = O + (size_t)(q0 + wid * 64 + rb * 32 + r32) * ldo;
#pragma unroll
        for (int db = 0; db < NDB; ++db)
#pragma unroll
            for (int g = 0; g < 4; ++g) { f32x4 v; for (int i = 0; i < 4; ++i) v[i] = o[rb][db][4 * g + i] * inv; store4bf(orow + 32 * db + 8 * g + 4 * hi, v); }
    }
}

__device__ __forceinline__ float wave_sum(float v) {
#pragma unroll
    for (int o = 1; o < 64; o <<= 1) v += __shfl_xor(v, o);
    return v;
}
__device__ __forceinline__ void transpose_block(const float* __restrict__ W, int ldw, int src_col0, const float* __restrict__ gain, bf16_t* WT, int K, int dst_row0, int k0, LAS float* scr, int lane) {
#pragma unroll 8
    for (int i = 0; i < 32; ++i) { const int kk = 2 * i + (lane >> 5); float v = W[(size_t)(k0 + kk) * ldw + src_col0 + (lane & 31)]; if (gain) v *= gain[k0 + kk]; scr[kk * 33 + (lane & 31)] = v; }
    asm volatile("s_waitcnt lgkmcnt(0)" ::: "memory");
    const int c = lane & 7;
#pragma unroll
    for (int j = 0; j < 4; ++j) { const int n = (lane >> 3) + 8 * j; const LAS float* s = scr + (8 * c) * 33 + n;
        u32x4 ov; ov.x = cvtpk(s[0 * 33], s[1 * 33]); ov.y = cvtpk(s[2 * 33], s[3 * 33]); ov.z = cvtpk(s[4 * 33], s[5 * 33]); ov.w = cvtpk(s[6 * 33], s[7 * 33]);
        *(u32x4*)(WT + (size_t)(dst_row0 + n) * K + k0 + 8 * c) = ov; }
    asm volatile("s_waitcnt lgkmcnt(0)" ::: "memory");
}

#define XB_TMO      128
#define XB_XCNT(j)  (256  + 64 * (j))
#define XB_XSUB(j)  (1280 + 64 * (j))
#define XB_XGEN(j)  (2304 + 64 * (j))
#define XB_TOP      3328
#define XB_TOPGEN   3392
#define XCD_BAR_WORDS 3456
#define XB_SPIN_CAP (1u << 18)

__device__ __forceinline__ unsigned xb_ld(unsigned* p)              { return __hip_atomic_load(p, __ATOMIC_RELAXED, __HIP_MEMORY_SCOPE_AGENT); }
__device__ __forceinline__ unsigned xb_add(unsigned* p, unsigned v) { return __hip_atomic_fetch_add(p, v, __ATOMIC_RELAXED, __HIP_MEMORY_SCOPE_AGENT); }
__device__ __forceinline__ unsigned xb_xcc_id() { return (unsigned)__builtin_amdgcn_s_getreg((3 << 11) | 20) & 0xFu; }
#define XB_SPIN(cond, bar) do { unsigned _sp = 0; while (cond) { __builtin_amdgcn_s_sleep(1); \
    if ((++_sp & 255u) == 0u) { if (xb_ld(&(bar)[XB_TMO])) break; if (_sp > XB_SPIN_CAP) { atomicAdd(&(bar)[XB_TMO], 1u); break; } } } } while (0)

struct XcdBarrier {
    unsigned* bar; unsigned x;
    volatile LAS unsigned* st;
};

__device__ __forceinline__ XcdBarrier xcd_barrier_post(unsigned* bar, volatile LAS unsigned* st) {
    XcdBarrier b; b.bar = bar; b.x = xb_xcc_id(); b.st = st;
    if (threadIdx.x == 0) (void)xb_add(&bar[XB_XCNT(b.x)], 1u);
    return b;
}
__device__ __forceinline__ void xcd_barrier_complete(unsigned* bar, unsigned x, unsigned& nloc, unsigned& nx) {
    const unsigned G = gridDim.x * gridDim.y * gridDim.z;
    unsigned sum, cnt, mine, sp = 0u;
    for (;;) {
        sum = 0u; cnt = 0u; mine = 0u;
#pragma unroll
        for (unsigned j = 0; j < 16; ++j) { const unsigned c = xb_ld(&bar[XB_XCNT(j)]); sum += c; cnt += (c > 0u) ? 1u : 0u; mine = (j == x) ? c : mine; }
        if (sum == G) break;
        __builtin_amdgcn_s_sleep(1);
        if ((++sp & 255u) == 0u) { if (xb_ld(&bar[XB_TMO])) break; if (sp > XB_SPIN_CAP) { atomicAdd(&bar[XB_TMO], 1u); break; } }
    }
    nloc = mine > 0u ? mine : 1u; nx = cnt > 0u ? cnt : 1u;
}

__device__ __forceinline__ void xcd_barrier(const XcdBarrier& b) {
    asm volatile("s_waitcnt vmcnt(0)" ::: "memory");
    __syncthreads();
    if (threadIdx.x == 0) {
        unsigned* bar = b.bar;
        __builtin_amdgcn_s_waitcnt(0);
        unsigned nloc = b.st[0], nx = b.st[1];
        if (nloc == 0u) { xcd_barrier_complete(bar, b.x, nloc, nx); b.st[0] = nloc; b.st[1] = nx; }
        const unsigned old = xb_add(&bar[XB_XSUB(b.x)], 1u);
        const unsigned gen = old / nloc;
        if (old + 1u == (gen + 1u) * nloc) {
            __builtin_amdgcn_fence(__ATOMIC_RELEASE, "agent");
            asm volatile("s_waitcnt vmcnt(0)" ::: "memory");
            const unsigned og = xb_add(&bar[XB_TOP], 1u);
            const unsigned tg = og / nx;
            if (og + 1u == (tg + 1u) * nx) xb_add(&bar[XB_TOPGEN], 1u);
            else XB_SPIN(xb_ld(&bar[XB_TOPGEN]) == tg, bar);
            __builtin_amdgcn_fence(__ATOMIC_ACQUIRE, "agent");
            xb_add(&bar[XB_XGEN(b.x)], 1u);
            asm volatile("s_waitcnt vmcnt(0)" ::: "memory");
        } else {
            XB_SPIN(xb_ld(&bar[XB_XGEN(b.x)]) == gen, bar);
            __builtin_amdgcn_fence(__ATOMIC_ACQUIRE, "agent");
            asm volatile("s_waitcnt vmcnt(0)" ::: "memory");
        }
    }
    __syncthreads();
}


struct Args { const float* in[20]; float* out; unsigned char* ws; int ph_lo, ph_hi, coop, pad; float lam_init[4]; };

__global__ void __launch_bounds__(512, 2) hybrid_fwd(Args a) {
    extern __shared__ __attribute__((aligned(16))) unsigned char lds_raw[];
    LAS unsigned char* lds = (LAS unsigned char*)lds_raw;
    const float* x_in = a.in[0]; const float* mem = a.in[1]; const int* positions = (const int*)a.in[2];
    const float* norm_pre = a.in[3]; const float* norm_post = a.in[4]; const float* w_in = a.in[5]; const float* q_norm = a.in[6]; const float* w_uq = a.in[7];
    const float* kv_norm = a.in[8]; const float* w_ukv = a.in[9]; const float* lq1 = a.in[10]; const float* lk1 = a.in[11]; const float* lq2 = a.in[12]; const float* lk2 = a.in[13];
    const float* diff_subln = a.in[14]; const float* mem_norm = a.in[15]; const float* w_mem_kv = a.in[16]; const float* b_gate = a.in[17]; const float* w_branch = a.in[18]; const float* w_out = a.in[19];
#define P_WT ((bf16_t*)(ws + OFF_W))
#define P_COS ((float*)(ws + OFF_COS))
#define P_SIN ((float*)(ws + OFF_SIN))
#define P_SSQq ((float*)(ws + OFF_SSQQ))
#define P_SSQkv ((float*)(ws + OFF_SSQKV))
#define P_MN ((bf16_t*)(ws + OFF_MN))
#define P_KM ((bf16_t*)(ws + OFF_KM))
#define P_VMT ((bf16_t*)(ws + OFF_VMT))
#define P_XN ((bf16_t*)(ws + OFF_XN))
#define P_OB ((bf16_t*)(ws + OFF_O))
#define P_CQ ((bf16_t*)(ws + OFF_CQ))
#define P_CKV ((bf16_t*)(ws + OFF_CKV))
#define P_KPE ((bf16_t*)(ws + OFF_KPE))
#define P_QD ((bf16_t*)(ws + OFF_QD))
#define P_KD ((bf16_t*)(ws + OFF_KD))
#define P_VDT ((bf16_t*)(ws + OFF_VDT))
#define P_QX ((bf16_t*)(ws + OFF_QX))
#define P_QA ((bf16_t*)(ws + OFF_QA))
#define P_KN ((bf16_t*)(ws + OFF_KN))
#define P_VAT ((bf16_t*)(ws + OFF_VAT))
#define P_SB ((bf16_t*)(ws + OFF_S))
#define P_MG ((bf16_t*)(ws + OFF_MERGED))
#define P_OUTB ((float*)(ws + OFF_OUT))

    volatile LAS unsigned* bst = (volatile LAS unsigned*)(lds + LDS_BYTES - 16);
    if (threadIdx.x < 4) bst[threadIdx.x] = 0u;
    __syncthreads();
    XcdBarrier xbar; xbar.bar = (unsigned*)(a.ws + OFF_BAR); xbar.x = 0; xbar.st = bst;
    if (a.coop) xbar = xcd_barrier_post((unsigned*)(a.ws + OFF_BAR), bst);
    for (int ph = a.ph_lo; ph < a.ph_hi; ++ph) {
        __attribute__((address_space(1))) unsigned char* ws = (__attribute__((address_space(1))) unsigned char*)a.ws; asm volatile("" : "+s"(ws));
        int tid = threadIdx.x; asm volatile("" : "+v"(tid)); const int lane = tid & 63, wave = __builtin_amdgcn_readfirstlane(tid >> 6);
        int G = gridDim.x, bx = blockIdx.x; asm volatile("" : "+s"(G), "+s"(bx));
        const int vcu = (G % 8 == 0) ? (bx % 8) * (G / 8) + bx / 8 : bx;
        const int gw = vcu * 8 + wave, NGW = G * 8;
        if (ph == 0) {
#if PHSEL & 1
            LAS float* scr = (LAS float*)(lds + wave * 16384);
            constexpr int I_IN = 16 * 221, I_UQ = 4 * 24, I_UKV = 2 * 32, I_MEM = 16 * 32, I_BR = 3 * 256, I_OUT = 16 * 32;
            constexpr int I_L = I_IN + I_UQ + I_UKV + I_MEM + I_BR + I_OUT;
            for (int it = gw; it < DEPTH * I_L; it += NGW) {
                const int l = it / I_L; int r = it - l * I_L; bf16_t* wl = P_WT + (size_t)l * WL_TOTAL;
                if (r < I_IN) { const int kb = r / 221, nb = r - kb * 221, n = nb * 32; int dr;
                    if (n < 416) dr = n; else if (n < 1440) dr = n + 96; else if (n < 1952) dr = n - 1440 + 2048; else if (n < 2464) dr = n - 1952 + 1536; else dr = n + 96;
                    transpose_block(w_in + (size_t)l * 1024 * IN_WIDTH, IN_WIDTH, n, norm_pre + l * 1024, wl + WL_IN, 1024, dr, kb * 64, scr, lane); continue; }
                r -= I_IN;
                if (r < I_UQ) { const int kb = r / 24, nb = r - kb * 24, n = nb * 32, h = n / 96, w = n - h * 96; const int dr = (w < 64) ? h * 64 + w : 512 + h * 32 + (w - 64);
                    transpose_block(w_uq + (size_t)l * 256 * 768, 768, n, q_norm + l * 256, wl + WL_UQ, 256, dr, kb * 64, scr, lane); continue; }
                r -= I_UQ;
                if (r < I_UKV) { const int kb = r / 32, nb = r - kb * 32, n = nb * 32, h = n / 128, w = n - h * 128; const int dr = (w < 64) ? h * 64 + w : 512 + h * 64 + (w - 64);
                    transpose_block(w_ukv + (size_t)l * 128 * 1024, 1024, n, kv_norm + l * 128, wl + WL_UKV, 128, dr, kb * 64, scr, lane); continue; }
                r -= I_UKV;
                if (r < I_MEM) { const int kb = r / 32, nb = r - kb * 32;
                    transpose_block(w_mem_kv + (size_t)l * 1024 * 1024, 1024, nb * 32, mem_norm + l * 1024, wl + WL_MEM, 1024, nb * 32, kb * 64, scr, lane); continue; }
                r -= I_MEM;
                if (r < I_BR) { const int i = r / 256, rr = r - i * 256, kb = rr / 32, nb = rr - kb * 32;
                    transpose_block(w_branch + (size_t)(l * 3 + i) * 512 * 1024, 1024, nb * 32, nullptr, wl + WL_BR + (size_t)i * 1024 * 512, 512, nb * 32, kb * 64, scr, lane); continue; }
                r -= I_BR;
                { const int kb = r / 32, nb = r - kb * 32;
                    transpose_block(w_out + (size_t)l * 1024 * 1024, 1024, nb * 32, nullptr, wl + WL_OUT, 1024, nb * 32, kb * 64, scr, lane); }
            }
            for (int i = bx * 512 + tid; i < DEPTH * 96 * 1024 / 8; i += G * 512) { const int l = i / (96 * 1024 / 8), rr = i - l * (96 * 1024 / 8);
                *(u32x4*)(P_WT + (size_t)l * WL_TOTAL + WL_IN + (size_t)416 * 1024 + (size_t)rr * 8) = (u32x4){0u, 0u, 0u, 0u}; }
            for (int i = bx * 512 + tid; i < SEQ * 16; i += G * 512) { const int s = i >> 4, j = i & 15;
                const float invf = powf(10000.0f, -(float)j / 16.0f); const float ang = (float)positions[s] * invf;
                double rv = (double)ang * 0.15915494309189535; rv -= floor(rv); const float f = (float)rv;
                P_COS[i] = __builtin_amdgcn_cosf(f); P_SIN[i] = __builtin_amdgcn_sinf(f); }
            for (int m0 = gw; m0 < MMEM + MTOK; m0 += 2 * NGW) {
                const int m1 = (m0 + NGW < MMEM + MTOK) ? m0 + NGW : m0;
                f32x4 v[2][4]; float ss[2] = {0.f, 0.f};
#pragma unroll
                for (int q = 0; q < 2; ++q) { const int m = q ? m1 : m0; const float* src = (m < MMEM) ? mem + (size_t)m * 1024 : x_in + (size_t)(m - MMEM) * 1024;
#pragma unroll
                    for (int j = 0; j < 4; ++j) v[q][j] = ((const f32x4*)src)[64 * j + lane]; }
#pragma unroll
                for (int q = 0; q < 2; ++q)
#pragma unroll
                    for (int j = 0; j < 4; ++j) ss[q] += (v[q][j][0] * v[q][j][0] + v[q][j][1] * v[q][j][1]) + (v[q][j][2] * v[q][j][2] + v[q][j][3] * v[q][j][3]);
#pragma unroll
                for (int q = 0; q < 2; ++q) { const int m = q ? m1 : m0; bf16_t* dst = (m < MMEM) ? P_MN + (size_t)m * 1024 : P_XN + (size_t)(m - MMEM) * 1024;
                    const float rstd = __builtin_amdgcn_rsqf(wave_sum(ss[q]) * (1.0f / 1024.0f) + NORM_EPS);
#pragma unroll
                    for (int j = 0; j < 4; ++j) store4bf(dst + 4 * (64 * j + lane), v[q][j] * rstd); }
            }
#endif
        } else {
            const int l = (ph - 1) / 7, sub = (ph - 1) % 7;
            const bf16_t* wl = P_WT + (size_t)l * WL_TOTAL;
            if (sub == 0) {
#if PHSEL & 2
#if GSEL & 1
                { pg8::Gemm g{P_XN, wl + WL_IN, MTOK, 2048, 1024, 1024, 1024, 0, 0}; pg8::StaticOrder S; S.init(MTOK, 2048, G, bx);
                  pg8::Epi1 E{P_CQ, P_CKV, P_KPE, P_QD, P_KD, P_QX, P_SSQq, P_SSQkv, P_COS, P_SIN, 0.17677669529663687f * LOG2E, 0.08838834764831845f * LOG2E};
                  pg8::gemm_phase(lds, g, S, E); }
#endif
#if GSEL & 2
                { pg8::Gemm g{wl + WL_IN + (size_t)2048 * 1024, P_XN, 512, MTOK, 1024, 1024, 1024, 0, 0}; pg8::StaticOrder S; S.init(512, MTOK, G, bx);
                  pg8::EpiT E{P_VDT, (size_t)MTOK, 0, nullptr, 0.f, nullptr};
                  pg8::gemm_phase(lds, g, S, E); }
#endif
                if (l == 0) {
#if GSEL & 4
                    { pg8::Gemm g{P_MN, P_WT + WL_MEM, MMEM, 512, 1024, 1024, 1024, 0, WL_TOTAL}; pg8::StaticOrder S; S.init(MMEM, 512, G, bx, DEPTH);
                      pg8::EpiRow E{P_KM, 512, (size_t)MMEM * 512, nullptr, 0.f};
                      pg8::gemm_phase(lds, g, S, E); }
#endif
#if GSEL & 8
                    { pg8::Gemm g{P_WT + WL_MEM + (size_t)512 * 1024, P_MN, 512, MMEM, 1024, 1024, 1024, WL_TOTAL, 0}; pg8::StaticOrder S; S.init(512, MMEM, G, bx, DEPTH);
                      pg8::EpiT E{P_VMT, (size_t)MMEM, (size_t)512 * MMEM, nullptr, 0.f, nullptr};
                      pg8::gemm_phase(lds, g, S, E); }
#endif
                }
#endif
            } else if (sub == 1) {
#if PHSEL & 4
#if GSEL & 16
                { pg8::Gemm g{P_CQ, wl + WL_UQ, MTOK, 768, 256, 256, 256, 0, 0}; pg8::StaticOrder S; S.init(MTOK, 768, G, bx);
                  pg8::Epi2 E{P_QA, P_SSQq, P_COS, P_SIN, 0.10206207261596575f * LOG2E};
                  pg8::gemm_phase(lds, g, S, E); }
#endif
#if GSEL & 32
                { pg8::Gemm g{P_CKV, wl + WL_UKV, MTOK, 512, 128, 128, 128, 0, 0}; pg8::StaticOrder S; S.init(MTOK, 512, G, bx);
                  pg8::EpiRow E{P_KN, 512, 0, P_SSQkv, 1.0f / 128.0f};
                  pg8::gemm_phase(lds, g, S, E); }
#endif
#if GSEL & 64
                { pg8::Gemm g{wl + WL_UKV + (size_t)512 * 128, P_CKV, 512, MTOK, 128, 128, 128, 0, 0}; pg8::StaticOrder S; S.init(512, MTOK, G, bx);
                  pg8::EpiT E{P_VAT, (size_t)MTOK, 0, P_SSQkv, 1.0f / 128.0f, nullptr};
                  pg8::gemm_phase(lds, g, S, E); }
#endif
#endif
            } else if (sub == 2) {
#if PHSEL & 8
                const float d1 = wave_sum(lane < 32 ? lq1[l * 32 + lane] * lk1[l * 32 + lane] : 0.f), d2 = wave_sum(lane < 32 ? lq2[l * 32 + lane] * lk2[l * 32 + lane] : 0.f);
                const float lam_init = a.lam_init[l]; const float lam = expf(d1) - expf(d2) + lam_init;
#if ATTSEL & 1
                for (int P = vcu; P < 512; P += G) { const int bh = P >> 2, s = P & 3, b = bh >> 3, h = bh & 7; const size_t rb = (size_t)b * SEQ;
                    for (int k = 0; k < 2; ++k) { const int qb = k ? s : 7 - s;
                        attn_unit4<96, 64, 64, 32>(lds, P_QA + rb * 768 + h * 96, 768, P_KN + rb * 512 + h * 64, 512, P_KPE + rb * 32, 32, P_VAT + (size_t)(h * 64) * MTOK + rb, (size_t)MTOK,
                                                   qb * 512, 8 * (qb + 1), P_OB + rb * 1536 + h * 64, 1536); } }
#endif
                asm volatile("" ::: "memory"); __builtin_amdgcn_sched_barrier(0);
#if ATTSEL & 2
                for (int P = vcu; P < 1024; P += G) { const int bh = P >> 3, s = P & 7, b = bh >> 3, h = bh & 7; const size_t rb = (size_t)b * SEQ;
                    for (int k = 0; k < 2; ++k) { const int qb = k ? s : 15 - s;
                        attn_unit2<2, 32, 64, 64, 0>(lds, P_QD + rb * 512 + h * 64, 512, P_KD + rb * 512 + h * 64, 512, nullptr, 0, P_VDT + (size_t)(h * 64) * MTOK + rb, (size_t)MTOK,
                                                           qb * 256, 4 * (qb + 1), P_OB + rb * 1536 + 512 + h * 64, 1536, lam, diff_subln + l * 64, 1.0f - lam_init); } }
#endif
                asm volatile("" ::: "memory"); __builtin_amdgcn_sched_barrier(0);
#if ATTSEL & 4
                for (int X = vcu; X < 1024; X += G) { const int bh = X >> 4, qb = X & 15, b = bh >> 2, h = bh & 3; const size_t rb = (size_t)b * SEQ;
                    attn_unit<1, 128, 128, false, 128, 0>(lds, P_QX + rb * 512 + h * 128, 512, P_KM + (size_t)l * MMEM * 512 + (size_t)b * MEMT * 512 + h * 128, 512, nullptr, 0,
                                                           P_VMT + (size_t)l * 512 * MMEM + (size_t)(h * 128) * MMEM + (size_t)b * MEMT, (size_t)MMEM,
                                                           qb * 256, 4, P_OB + rb * 1536 + 1024 + h * 128, 1536, 0.f, nullptr, 1.f); }
#endif
#endif
            } else if (sub == 3) {
#if PHSEL & 16
                { pg8::Gemm g{P_XN, wl + WL_IN + (size_t)2560 * 1024, MTOK, 1536, 1024, 1024, 1024, 0, 0}; pg8::StaticOrder S; S.init(MTOK, 1536, G, bx);
                  pg8::EpiSG E{P_OB};
                  pg8::gemm_phase(lds, g, S, E); }
                { pg8::Gemm g{P_XN, wl + WL_IN + (size_t)4096 * 1024, MTOK, 3072, 1024, 1024, 1024, 0, 0}; pg8::StaticOrder S; S.init(MTOK, 3072, G, bx);
                  pg8::EpiGL E{P_SB, b_gate + l * 3072};
                  pg8::gemm_phase(lds, g, S, E); }
#endif
            } else if (sub == 4) {
#if PHSEL & 32
                pg8::Gemm g{P_OB, wl + WL_BR, MTOK, 1024, 512, 1536, 512, 512, (size_t)1024 * 512}; pg8::StaticOrder S; S.init(MTOK, 1024, G, bx, 3);
                pg8::EpiBR E{P_SB, P_MG};
                pg8::gemm_phase(lds, g, S, E);
#endif
            } else if (sub == 5) {
#if PHSEL & 64
                pg8::Gemm g{P_MG, wl + WL_OUT, MTOK, 1024, 1024, 1024, 1024, 0, 0}; pg8::StaticOrder S; S.init(MTOK, 1024, G, bx);
                pg8::EpiRow E{(bf16_t*)P_OUTB, 1024, 0, nullptr, 0.f};
                pg8::gemm_phase(lds, g, S, E);
#endif
            } else {
#if PHSEL & 128
                const float* xo = (l == 0) ? x_in : a.out; const float* gp = norm_post + l * 1024;
                for (int m0 = gw; m0 < MTOK; m0 += 2 * NGW) {
                    const int m1 = (m0 + NGW < MTOK) ? m0 + NGW : m0;
                    f32x4 v[2][4], xv[2][4]; float s[2] = {0.f, 0.f};
#pragma unroll
                    for (int q = 0; q < 2; ++q) { const int m = q ? m1 : m0;
#pragma unroll
                        for (int j = 0; j < 4; ++j) { v[q][j] = unpack4bf(((const u32x2*)((const bf16_t*)P_OUTB + (size_t)m * 1024))[64 * j + lane]); xv[q][j] = ((const f32x4*)(xo + (size_t)m * 1024))[64 * j + lane]; } }
#pragma unroll
                    for (int q = 0; q < 2; ++q)
#pragma unroll
                        for (int j = 0; j < 4; ++j) s[q] += (v[q][j][0] * v[q][j][0] + v[q][j][1] * v[q][j][1]) + (v[q][j][2] * v[q][j][2] + v[q][j][3] * v[q][j][3]);
#pragma unroll
                    for (int q = 0; q < 2; ++q) { const int m = q ? m1 : m0;
                        const float rstd = __builtin_amdgcn_rsqf(wave_sum(s[q]) * (1.0f / 1024.0f) + NORM_EPS); float s2 = 0.f;
#pragma unroll
                        for (int j = 0; j < 4; ++j) { const f32x4 gv = ((const f32x4*)gp)[64 * j + lane];
                            v[q][j] = xv[q][j] + v[q][j] * rstd * gv; ((f32x4*)(a.out + (size_t)m * 1024))[64 * j + lane] = v[q][j];
                            s2 += (v[q][j][0] * v[q][j][0] + v[q][j][1] * v[q][j][1]) + (v[q][j][2] * v[q][j][2] + v[q][j][3] * v[q][j][3]); }
                        if (l + 1 < DEPTH) { const float rstd2 = __builtin_amdgcn_rsqf(wave_sum(s2) * (1.0f / 1024.0f) + NORM_EPS);
#pragma unroll
                            for (int j = 0; j < 4; ++j) store4bf(P_XN + (size_t)m * 1024 + 4 * (64 * j + lane), v[q][j] * rstd2); } }
                }
#endif
            }
        }
        if (ph + 1 < a.ph_hi) { if (a.coop) { if (ph == 0) cg::this_grid().sync(); else xcd_barrier(xbar); } }
    }
#ifdef DBG_NPH
    if (a.pad) {
        if (a.coop) cg::this_grid().sync();
        const unsigned short* w16 = (const unsigned short*)(a.ws + OFF_MN);
        const size_t n16 = (WS_END - OFF_MN) / 2, nout = (size_t)MTOK * 1024;
        for (size_t i = (size_t)blockIdx.x * 512 + threadIdx.x; i < nout; i += (size_t)gridDim.x * 512) {
            unsigned x = 0; for (size_t k = i; k < n16; k += nout) x ^= w16[k];
            const unsigned short* w2 = (const unsigned short*)(a.ws + OFF_COS); if (i < (size_t)(4 * MiB) / 2) x ^= w2[i];
            a.out[i] = (float)x;
        }
    }
#endif
}

extern "C" void kernel_launch(void* const* d_in, const int* in_sizes, int n_in, void* d_out, int out_size, void* d_ws, size_t ws_size, hipStream_t stream) {
    static int grid = 0;
    if (grid == 0) {
        if (n_in != 20 || ws_size < WS_END) { fprintf(stderr, "kernel_launch: need 20 inputs and >= %zu bytes of workspace (got %d, %zu)\n", (size_t)WS_END, n_in, ws_size); grid = -1; return; }
        int dev = 0, cus = 0, per_cu = 0;
        hipGetDevice(&dev); hipDeviceGetAttribute(&cus, hipDeviceAttributeMultiprocessorCount, dev);
        if (hipFuncSetAttribute((const void*)hybrid_fwd, hipFuncAttributeMaxDynamicSharedMemorySize, LDS_BYTES) != hipSuccess) { fprintf(stderr, "kernel_launch: hipFuncSetAttribute failed\n"); grid = -1; return; }
        if (hipOccupancyMaxActiveBlocksPerMultiprocessor(&per_cu, (const void*)hybrid_fwd, 512, LDS_BYTES) != hipSuccess || per_cu < 1) per_cu = 1;
        (void)hipGetLastError();
        grid = cus * 1;
    }
    if (grid < 0) return;
    if (hipMemsetAsync((char*)d_ws + OFF_BAR, 0, 16384, stream) != hipSuccess) { fprintf(stderr, "kernel_launch: hipMemsetAsync failed\n"); return; }
    Args a{};
    for (int i = 0; i < 20; ++i) a.in[i] = (const float*)d_in[i];
    a.out = (float*)d_out; a.ws = (unsigned char*)d_ws; a.pad = 0;
    a.lam_init[0] = 0.2f; a.lam_init[1] = 0.35550906759096926f; a.lam_init[2] = 0.47071301834358424f; a.lam_init[3] = 0.55605820415654f;
#if MK_ONE_LAUNCH
#ifdef DBG_NPH
    a.ph_lo = 0; a.ph_hi = DBG_NPH; a.coop = 1; a.pad = 1;
#else
    a.ph_lo = 0; a.ph_hi = NPHASE; a.coop = 1;
#endif
    void* args[] = {&a};
    hipError_t e = hipLaunchCooperativeKernel((const void*)hybrid_fwd, dim3(grid), dim3(512), args, LDS_BYTES, stream);
    if (e != hipSuccess) fprintf(stderr, "cooperative launch failed: %s (grid %d)\n", hipGetErrorString(e), grid);
#else
    for (int ph = 0; ph < NPHASE; ++ph) { a.ph_lo = ph; a.ph_hi = ph + 1; a.coop = 0;
        hipLaunchKernelGGL(hybrid_fwd, dim3(grid), dim3(512), LDS_BYTES, stream, a); }
#endif
}
```

```cpp
#include <hip/hip_runtime.h>
#include <hip/hip_cooperative_groups.h>
#include <cstdio>
#include <cstdint>
namespace cg = cooperative_groups;

#ifndef ATTSEL
#define ATTSEL 7
#endif
#ifndef GSEL
#define GSEL 0xFFFF
#endif
#ifndef PHSEL
#define PHSEL 0xFFFF
#endif
#ifndef MK_ONE_LAUNCH
#define MK_ONE_LAUNCH 1
#endif

#define LAS __attribute__((address_space(3)))
typedef unsigned short bf16_t;
typedef short bf16x8 __attribute__((ext_vector_type(8)));
typedef short s16x4 __attribute__((ext_vector_type(4)));
typedef float f32x4 __attribute__((ext_vector_type(4)));
typedef float f32x16 __attribute__((ext_vector_type(16)));
typedef unsigned u32x4 __attribute__((ext_vector_type(4)));
typedef unsigned u32x2 __attribute__((ext_vector_type(2)));
typedef float f32x2_t __attribute__((ext_vector_type(2)));
typedef __bf16 bf16x2_t __attribute__((ext_vector_type(2)));

constexpr int D_MODEL = 1024, BATCH = 16, SEQ = 4096, DEPTH = 4, MEMT = 256;
constexpr int MTOK = BATCH * SEQ;
constexpr int MMEM = BATCH * MEMT;
constexpr int IN_WIDTH = 7072;
constexpr float NORM_EPS = 1e-6f;
constexpr float LOG2E = 1.4426950408889634f;

constexpr size_t WL_IN = 0;
constexpr size_t WL_UQ = WL_IN + (size_t)7168 * 1024;
constexpr size_t WL_UKV = WL_UQ + (size_t)768 * 256;
constexpr size_t WL_MEM = WL_UKV + (size_t)1024 * 128;
constexpr size_t WL_BR = WL_MEM + (size_t)1024 * 1024;
constexpr size_t WL_OUT = WL_BR + (size_t)3 * 1024 * 512;
constexpr size_t WL_TOTAL = WL_OUT + (size_t)1024 * 3072;

constexpr size_t MiB = 1u << 20;
constexpr size_t OFF_W = 0;
constexpr size_t OFF_COS = 104 * MiB, OFF_SIN = OFF_COS + 256 * 1024;
constexpr size_t OFF_SSQQ = 105 * MiB, OFF_SSQKV = 106 * MiB;
constexpr size_t OFF_BAR = 107 * MiB;
constexpr size_t OFF_MN = 108 * MiB;
constexpr size_t OFF_KM = 116 * MiB;
constexpr size_t OFF_VMT = 132 * MiB;
constexpr size_t OFF_XN = 148 * MiB;
constexpr size_t OFF_O = 276 * MiB;
constexpr size_t OFF_R = 468 * MiB;
constexpr size_t OFF_CQ = OFF_R;
constexpr size_t OFF_CKV = OFF_CQ + 32 * MiB;
constexpr size_t OFF_KPE = OFF_CKV + 16 * MiB;
constexpr size_t OFF_QD = OFF_KPE + 4 * MiB;
constexpr size_t OFF_KD = OFF_QD + 64 * MiB;
constexpr size_t OFF_VDT = OFF_KD + 64 * MiB;
constexpr size_t OFF_QX = OFF_VDT + 64 * MiB;
constexpr size_t OFF_QA = OFF_QX + 64 * MiB;
constexpr size_t OFF_KN = OFF_QA + 96 * MiB;
constexpr size_t OFF_VAT = OFF_KN + 64 * MiB;
constexpr size_t WS_END = OFF_VAT + 64 * MiB;
constexpr size_t OFF_S = OFF_R;
constexpr size_t OFF_MERGED = OFF_R + 384 * MiB;
constexpr size_t OFF_OUT = OFF_R;
static_assert(4 * WL_TOTAL * 2 <= OFF_COS && OFF_MERGED + 128 * MiB <= WS_END, "ws map");

constexpr int LDS_BYTES = 163840;
constexpr int NPHASE = 1 + 7 * DEPTH;

__device__ __forceinline__ unsigned cvtpk(float lo, float hi) { f32x2_t v = {lo, hi}; bf16x2_t b = __builtin_convertvector(v, bf16x2_t); return __builtin_bit_cast(unsigned, b); }
__device__ __forceinline__ void store4bf(bf16_t* p, f32x4 v) { u32x2 w; w.x = cvtpk(v[0], v[1]); w.y = cvtpk(v[2], v[3]); *(u32x2*)p = w; }
__device__ __forceinline__ f32x4 unpack4bf(u32x2 w) { f32x4 r; r[0] = __uint_as_float(w.x << 16); r[1] = __uint_as_float(w.x & 0xffff0000u); r[2] = __uint_as_float(w.y << 16); r[3] = __uint_as_float(w.y & 0xffff0000u); return r; }
__device__ __forceinline__ void store8bf(bf16_t* p, f32x4 a, f32x4 b) { u32x4 w; w.x = cvtpk(a[0], a[1]); w.y = cvtpk(a[2], a[3]); w.z = cvtpk(b[0], b[1]); w.w = cvtpk(b[2], b[3]); *(u32x4*)p = w; }
__device__ __forceinline__ float fast_rcp(float x) { return __builtin_amdgcn_rcpf(x); }
__device__ __forceinline__ float fast_exp2(float x) { return __builtin_amdgcn_exp2f(x); }
__device__ __forceinline__ float sigmoidf_(float v) { return fast_rcp(1.0f + fast_exp2(-v * LOG2E)); }

namespace pg8 {
constexpr int BM = 256, BK = 64, HALF = 128, HTB = HALF * BK * 2, STAGE_BYTES = 8 * HTB, NXCD = 8, WGM = 8;
__host__ __device__ __forceinline__ int lds_byte(int r, int c) { const int st = (r >> 4) * 2 + (c >> 5), rr = r & 15, cc = c & 31, ob = rr * 64 + cc * 2; return st * 1024 + (ob ^ (((ob >> 9) & 1) << 5)); }
__host__ __device__ __forceinline__ void stage_rc(int b, int& R, int& C) { const int st = b / 1024, sb = b % 1024, swz = sb ^ (((sb >> 9) & 1) << 5); R = (st >> 1) * 16 + swz / 64; C = (st & 1) * 32 + (swz % 64) / 2; }

__host__ __device__ __forceinline__ int perm32(int rho) { const int n = rho >> 4, i = rho & 15; return 8 * (i >> 2) + 4 * n + (i & 3); }
struct Unit { int pm, pn, z; };
struct Gemm { const bf16_t* A; const bf16_t* Bt; int M, N, K, lda, ldb; size_t zA, zB; };

struct StaticOrder {
    int nM, nN, nwg, G, c, nz;
    __device__ void init(int M, int N, int G_, int c_, int nz_ = 1) { nM = M / BM; nN = N / BM; nwg = nM * nN; G = G_; c = c_; nz = nz_; }
    __device__ bool next(int i, Unit& u) const {
        const int ib = i / nz; u.z = i - ib * nz;
        const long L = (long)ib * G + c; if (L >= nwg) return false;
        int wgid = (int)L; { const int q = nwg / NXCD, r = nwg % NXCD, xcd = wgid % NXCD, off = wgid / NXCD; wgid = (xcd < r ? xcd * (q + 1) : r * (q + 1) + (xcd - r) * q) + off; }
        const int nig = WGM * nN, gid = wgid / nig, fm = gid * WGM, gsz = (nM - fm) < WGM ? (nM - fm) : WGM;
        u.pm = fm + ((wgid % nig) % gsz); u.pn = (wgid % nig) / gsz; return true;
    }
};

template <class Epi>
__device__ __forceinline__ void gemm_phase(LAS unsigned char* lds, const Gemm g, const StaticOrder& S, const Epi& E) {
    int tid = threadIdx.x; asm volatile("" : "+v"(tid));
    const int wid = __builtin_amdgcn_readfirstlane(tid >> 6), lane = tid & 63, wr = wid >> 2, wc = wid & 3, fr = lane & 15, fq = lane >> 4;
    int K = g.K; asm volatile("" : "+s"(K)); const int nt = K / BK;
    unsigned voffA[2], voffB[2];
#pragma unroll
    for (int i = 0; i < 2; ++i) { int R, C; stage_rc(tid * 16 + i * 8192, R, C);
        const int Rb = Epi::PERM ? ((R & ~31) + perm32(R & 31)) : R;
        voffA[i] = (unsigned)(R * g.lda + C) * 2u; voffB[i] = (unsigned)(Rb * g.ldb + C) * 2u; }
    const size_t kstep = (size_t)(BK * 2);
    const size_t hstepA = (size_t)HALF * g.lda * 2, hstepB = (size_t)HALF * g.ldb * 2;
    const size_t tstepA = 2 * hstepA, tstepB = 2 * hstepB;
    const unsigned ldsw = (unsigned)wid * 1024u;
    const int aoff = lds_byte(wr * 64 + fr, fq * 8), boff = lds_byte(wc * 32 + fr, fq * 8);
#define PG8_SA(b, h) (((b) * 2 + (h)) * HTB)
#define PG8_SB(b, h) ((4 + (b) * 2 + (h)) * HTB)
#define PG8_STAGE(bufoff, gbase, voff) do { _Pragma("unroll") for (int _i = 0; _i < 2; ++_i) \
        __builtin_amdgcn_global_load_lds((const unsigned*)((const char*)(gbase) + (voff)[_i]), (LAS unsigned*)(lds + (bufoff) + ldsw + _i * 8192), 16, 0, 0); } while (0)
#define PG8_LDA(dst, b, h) do { _Pragma("unroll") for (int m = 0; m < 4; ++m) _Pragma("unroll") for (int k = 0; k < 2; ++k) dst[m][k] = *(const LAS bf16x8*)(lds + PG8_SA(b, h) + aoff + m * 2048 + k * 1024); } while (0)
#define PG8_LDB(dst, b, h) do { _Pragma("unroll") for (int n = 0; n < 2; ++n) _Pragma("unroll") for (int k = 0; k < 2; ++k) dst[n][k] = *(const LAS bf16x8*)(lds + PG8_SB(b, h) + boff + n * 2048 + k * 1024); } while (0)
#define PG8_MMA(ai, bj, At, Bt) do { __builtin_amdgcn_s_setprio(1); _Pragma("unroll") for (int m = 0; m < 4; ++m) _Pragma("unroll") for (int n = 0; n < 2; ++n) _Pragma("unroll") for (int k = 0; k < 2; ++k) \
        acc[ai][bj][m][n] = __builtin_amdgcn_mfma_f32_16x16x32_bf16(Bt[n][k], At[m][k], acc[ai][bj][m][n], 0, 0, 0); __builtin_amdgcn_s_setprio(0); } while (0)
#define PG8_WAIT_V(n) asm volatile("s_waitcnt vmcnt(" #n ")" ::: "memory")
#define PG8_WAIT_L(n) asm volatile("s_waitcnt lgkmcnt(" #n ")" ::: "memory")
#define PG8_BAR __builtin_amdgcn_s_barrier()
#define PG8_SCHED __builtin_amdgcn_sched_barrier(0)
    Unit cur, nxt; int ui = 0;
    if (!S.next(0, cur)) return;
    f32x4 acc[2][2][4][2];
#pragma unroll
    for (int a = 0; a < 2; ++a)
#pragma unroll
        for (int b = 0; b < 2; ++b)
#pragma unroll
            for (int m = 0; m < 4; ++m)
#pragma unroll
                for (int n = 0; n < 2; ++n) acc[a][b][m][n] = (f32x4){0.f, 0.f, 0.f, 0.f};
    bf16x8 At[4][2], B0[2][2], B1[2][2];
    const char* cA = (const char*)g.A + ((size_t)cur.z * g.zA) * 2 + (size_t)cur.pm * tstepA;
    const char* cB = (const char*)g.Bt + ((size_t)cur.z * g.zB) * 2 + (size_t)cur.pn * tstepB;
    PG8_STAGE(PG8_SB(0, 0), cB, voffB); PG8_STAGE(PG8_SB(0, 1), cB + hstepB, voffB); PG8_STAGE(PG8_SA(0, 0), cA, voffA); PG8_STAGE(PG8_SA(0, 1), cA + hstepA, voffA);
    if (wr == 1) PG8_BAR;
    PG8_WAIT_V(2); PG8_BAR;
    PG8_STAGE(PG8_SB(1, 0), cB + kstep, voffB); PG8_STAGE(PG8_SA(1, 0), cA + kstep, voffA); PG8_STAGE(PG8_SB(1, 1), cB + hstepB + kstep, voffB);
    PG8_WAIT_V(6); PG8_BAR;
    for (;;) {
        const bool has_next = S.next(ui + 1, nxt);
        const char* nA = has_next ? (const char*)g.A + ((size_t)nxt.z * g.zA) * 2 + (size_t)nxt.pm * tstepA : cA;
        const char* nB = has_next ? (const char*)g.Bt + ((size_t)nxt.z * g.zB) * 2 + (size_t)nxt.pn * tstepB : cB;
        for (int t = 0; t < nt; t += 2) {
            const bool last = (t == nt - 2);
            const char* a1 = cA + (size_t)(t + 1) * kstep;
            const char* a2 = last ? nA : cA + (size_t)(t + 2) * kstep; const char* b2 = last ? nB : cB + (size_t)(t + 2) * kstep;
            const char* a3 = a2 + kstep; const char* b3 = b2 + kstep;
            PG8_LDB(B0, 0, 0); PG8_LDB(B1, 0, 1); PG8_SCHED; PG8_LDA(At, 0, 0); PG8_STAGE(PG8_SA(1, 1), a1 + hstepA, voffA);
            PG8_WAIT_V(8); PG8_WAIT_L(0); PG8_BAR; PG8_MMA(0, 0, At, B0); PG8_MMA(0, 1, At, B1); PG8_BAR; PG8_SCHED;
            PG8_LDA(At, 0, 1); PG8_STAGE(PG8_SB(0, 0), b2, voffB); PG8_STAGE(PG8_SB(0, 1), b2 + hstepB, voffB); PG8_STAGE(PG8_SA(0, 0), a2, voffA);
            PG8_WAIT_V(8); PG8_WAIT_L(0); PG8_BAR; PG8_MMA(1, 0, At, B0); PG8_MMA(1, 1, At, B1); PG8_BAR; PG8_SCHED;
            PG8_LDB(B0, 1, 0); PG8_LDB(B1, 1, 1); PG8_SCHED; PG8_LDA(At, 1, 0); PG8_STAGE(PG8_SA(0, 1), a2 + hstepA, voffA);
            PG8_WAIT_V(8); PG8_WAIT_L(0); PG8_BAR; PG8_MMA(0, 0, At, B0); PG8_MMA(0, 1, At, B1); PG8_BAR; PG8_SCHED;
            PG8_LDA(At, 1, 1); PG8_STAGE(PG8_SB(1, 0), b3, voffB); PG8_STAGE(PG8_SB(1, 1), b3 + hstepB, voffB); PG8_STAGE(PG8_SA(1, 0), a3, voffA);
            PG8_WAIT_V(8); PG8_WAIT_L(0); PG8_BAR; PG8_MMA(1, 0, At, B0); PG8_MMA(1, 1, At, B1); PG8_BAR; PG8_SCHED;
        }
        if (wr == 0) PG8_BAR;
        E(acc, cur, wr, wc, fr, fq);
        if (!has_next) break;
#pragma unroll
        for (int a = 0; a < 2; ++a)
#pragma unroll
            for (int b = 0; b < 2; ++b)
#pragma unroll
                for (int m = 0; m < 4; ++m)
#pragma unroll
                    for (int n = 0; n < 2; ++n) acc[a][b][m][n] = (f32x4){0.f, 0.f, 0.f, 0.f};
        cur = nxt; cA = nA; cB = nB; ++ui;
        if (wr == 1) PG8_BAR;
    }
    PG8_WAIT_V(0);
    PG8_BAR;
    asm volatile("" ::: "memory"); PG8_SCHED;
#undef PG8_SA
#undef PG8_SB
#undef PG8_STAGE
#undef PG8_LDA
#undef PG8_LDB
#undef PG8_MMA
#undef PG8_WAIT_V
#undef PG8_WAIT_L
#undef PG8_BAR
#undef PG8_SCHED
}

#define EPI_ROWS_BEGIN _Pragma("unroll") for (int ai = 0; ai < 2; ++ai) _Pragma("unroll") for (int m = 0; m < 4; ++m) { const int row = u.pm * BM + ai * HALF + wr * 64 + m * 16 + fr;
#define EPI_ROWS_END if (m & 1) asm volatile("" ::: "memory"); }
#define EPI_COLS_BEGIN _Pragma("unroll") for (int bj = 0; bj < 2; ++bj) _Pragma("unroll") for (int n = 0; n < 2; ++n) { const int colt = bj * HALF + wc * 32 + n * 16 + 4 * fq;
#define EPI_COLS_END }
typedef f32x4 Acc[2][2][4][2];

__device__ __forceinline__ float rstd4(const float* ssq, int row, float inv_dim) { const f32x4 p = *(const f32x4*)(ssq + (size_t)row * 4); return __builtin_amdgcn_rsqf(((p[0] + p[1]) + (p[2] + p[3])) * inv_dim + NORM_EPS); }

struct Epi1 {
    static constexpr bool PERM = false;
    bf16_t *CQ, *CKV, *KPE, *QD, *KD, *QX; float *SSQq, *SSQkv; const float *COS, *SIN; float sc_d, sc_x;
    __device__ __forceinline__ void operator()(const Acc& acc, const Unit& u, int wr, int wc, int fr, int fq) const {
        const int pn = u.pn;
        EPI_ROWS_BEGIN
            const float r = 1.0f;
            if (pn == 0) {
                float ss = 0.f;
                EPI_COLS_BEGIN const f32x4 v = acc[ai][bj][m][n] * r; ss += (v[0] * v[0] + v[1] * v[1]) + (v[2] * v[2] + v[3] * v[3]); store4bf(CQ + (size_t)row * 256 + colt, v); EPI_COLS_END
                ss += __shfl_xor(ss, 16); ss += __shfl_xor(ss, 32);
                if (fq == 0) SSQq[(size_t)row * 4 + wc] = ss;
            } else if (pn == 1) {
                float ss = 0.f;
#pragma unroll
                for (int n = 0; n < 2; ++n) { const f32x4 v = acc[ai][0][m][n] * r; ss += (v[0] * v[0] + v[1] * v[1]) + (v[2] * v[2] + v[3] * v[3]); store4bf(CKV + (size_t)row * 128 + wc * 32 + n * 16 + 4 * fq, v); }
                ss += __shfl_xor(ss, 16); ss += __shfl_xor(ss, 32);
                if (fq == 0) SSQkv[(size_t)row * 4 + wc] = ss;
                if (wc == 0) {
                    const int s = row & (SEQ - 1); const f32x4 cs = *(const f32x4*)(COS + s * 16 + 4 * fq), sn = *(const f32x4*)(SIN + s * 16 + 4 * fq);
                    const f32x4 x1 = acc[ai][1][m][0] * r, x2 = acc[ai][1][m][1] * r;
                    store4bf(KPE + (size_t)row * 32 + 4 * fq, x1 * cs - x2 * sn); store4bf(KPE + (size_t)row * 32 + 16 + 4 * fq, x2 * cs + x1 * sn);
                }
            } else if (pn < 6) {
                bf16_t* dst = (pn < 4 ? QD : KD) + (size_t)row * 512 + (pn & 1) * 256 + wc * 32 + 4 * fq; const float sc = (pn < 4 ? sc_d : 1.0f) * r;
                const int s = row & (SEQ - 1); const f32x4 cs = *(const f32x4*)(COS + s * 16 + 4 * fq), sn = *(const f32x4*)(SIN + s * 16 + 4 * fq);
#pragma unroll
                for (int bj = 0; bj < 2; ++bj) { const f32x4 x1 = acc[ai][bj][m][0] * sc, x2 = acc[ai][bj][m][1] * sc;
                    store4bf(dst + bj * HALF, x1 * cs - x2 * sn); store4bf(dst + bj * HALF + 16, x2 * cs + x1 * sn); }
            } else {
                const float sc = sc_x * r;
                EPI_COLS_BEGIN store4bf(QX + (size_t)row * 512 + (pn - 6) * 256 + colt, acc[ai][bj][m][n] * sc); EPI_COLS_END
            }
        EPI_ROWS_END
    }
};
#define EPIP_BJ_BEGIN _Pragma("unroll") for (int bj = 0; bj < 2; ++bj) { const int colt = bj * HALF + wc * 32 + 8 * fq;
#define EPIP_BJ_END }
struct EpiT {
    static constexpr bool PERM = true;
    bf16_t* O; size_t ldc; size_t zO; const float* ssq; float inv_dim; const float* colscale;
    __device__ __forceinline__ void operator()(const Acc& acc, const Unit& u, int wr, int wc, int fr, int fq) const {
        f32x4 cs[2][2];
        EPIP_BJ_BEGIN
            const int col = u.pn * BM + colt;
#pragma unroll
            for (int n = 0; n < 2; ++n) {
                if (ssq) { for (int i = 0; i < 4; ++i) cs[bj][n][i] = rstd4(ssq, col + 4 * n + i, inv_dim); }
                else cs[bj][n] = (f32x4){1.f, 1.f, 1.f, 1.f}; }
        EPIP_BJ_END
        bf16_t* base = O + (size_t)u.z * zO;
        EPI_ROWS_BEGIN
            EPIP_BJ_BEGIN store8bf(base + (size_t)row * ldc + u.pn * BM + colt, acc[ai][bj][m][0] * cs[bj][0], acc[ai][bj][m][1] * cs[bj][1]); EPIP_BJ_END
        EPI_ROWS_END
    }
};
struct EpiRow {
    static constexpr bool PERM = true;
    bf16_t* O; size_t ldc; size_t zO; const float* ssq; float inv_dim;
    __device__ __forceinline__ void operator()(const Acc& acc, const Unit& u, int wr, int wc, int fr, int fq) const {
        bf16_t* base = O + (size_t)u.z * zO;
        EPI_ROWS_BEGIN
            const float sc = ssq ? rstd4(ssq, row, inv_dim) : 1.0f;
            EPIP_BJ_BEGIN store8bf(base + (size_t)row * ldc + u.pn * BM + colt, acc[ai][bj][m][0] * sc, acc[ai][bj][m][1] * sc); EPIP_BJ_END
        EPI_ROWS_END
    }
};
struct Epi2 {
    static constexpr bool PERM = false;
    bf16_t* QA; const float* SSQq; const float *COS, *SIN; float sc_a;
    __device__ __forceinline__ void operator()(const Acc& acc, const Unit& u, int wr, int wc, int fr, int fq) const {
        EPI_ROWS_BEGIN
            const float sc = rstd4(SSQq, row, 1.0f / 256.0f) * sc_a;
            if (u.pn < 2) {
                EPI_COLS_BEGIN const int nn = u.pn * BM + colt; store4bf(QA + (size_t)row * 768 + (nn >> 6) * 96 + (nn & 63), acc[ai][bj][m][n] * sc); EPI_COLS_END
            } else {
                const int s = row & (SEQ - 1); const f32x4 cs = *(const f32x4*)(COS + s * 16 + 4 * fq), sn = *(const f32x4*)(SIN + s * 16 + 4 * fq);
#pragma unroll
                for (int bj = 0; bj < 2; ++bj) { const f32x4 x1 = acc[ai][bj][m][0] * sc, x2 = acc[ai][bj][m][1] * sc; bf16_t* dst = QA + (size_t)row * 768 + (4 * bj + wc) * 96 + 64 + 4 * fq;
                    store4bf(dst, x1 * cs - x2 * sn); store4bf(dst + 16, x2 * cs + x1 * sn); }
            }
        EPI_ROWS_END
    }
};
struct EpiSG {
    static constexpr bool PERM = true;
    bf16_t* O;
    __device__ __forceinline__ void operator()(const Acc& acc, const Unit& u, int wr, int wc, int fr, int fq) const {
#pragma unroll
        for (int ai = 0; ai < 2; ++ai) {
            u32x4 ov[4][2];
#pragma unroll
            for (int m = 0; m < 4; ++m) { const int row = u.pm * BM + ai * HALF + wr * 64 + m * 16 + fr;
                EPIP_BJ_BEGIN ov[m][bj] = *(const u32x4*)(O + (size_t)row * 1536 + u.pn * BM + colt); EPIP_BJ_END }
#pragma unroll
            for (int m = 0; m < 4; ++m) { const int row = u.pm * BM + ai * HALF + wr * 64 + m * 16 + fr;
                EPIP_BJ_BEGIN u32x2 lo_, hi_; lo_.x = ov[m][bj].x; lo_.y = ov[m][bj].y; hi_.x = ov[m][bj].z; hi_.y = ov[m][bj].w;
                    const f32x4 o0 = unpack4bf(lo_), o1 = unpack4bf(hi_); const f32x4 g0 = acc[ai][bj][m][0], g1 = acc[ai][bj][m][1]; f32x4 v0, v1;
#pragma unroll
                    for (int i = 0; i < 4; ++i) { v0[i] = o0[i] * g0[i] * sigmoidf_(g0[i]); v1[i] = o1[i] * g1[i] * sigmoidf_(g1[i]); }
                    store8bf(O + (size_t)row * 1536 + u.pn * BM + colt, v0, v1); EPIP_BJ_END }
            asm volatile("" ::: "memory");
        }
    }
};
struct EpiGL {
    static constexpr bool PERM = true;
    unsigned char* S; const float* bias;
    __device__ __forceinline__ void operator()(const Acc& acc, const Unit& u, int wr, int wc, int fr, int fq) const {
        f32x4 bv[2][2];
        EPIP_BJ_BEGIN bv[bj][0] = *(const f32x4*)(bias + u.pn * BM + colt); bv[bj][1] = *(const f32x4*)(bias + u.pn * BM + colt + 4); EPIP_BJ_END
        EPI_ROWS_BEGIN
            EPIP_BJ_BEGIN const f32x4 g0 = acc[ai][bj][m][0] + bv[bj][0], g1 = acc[ai][bj][m][1] + bv[bj][1]; u32x2 w; w.x = 0u; w.y = 0u;
#pragma unroll
                for (int i = 0; i < 4; ++i) { w.x = __builtin_amdgcn_cvt_pk_u8_f32(sigmoidf_(g0[i]) * 255.0f, i, w.x); w.y = __builtin_amdgcn_cvt_pk_u8_f32(sigmoidf_(g1[i]) * 255.0f, i, w.y); }
                *(u32x2*)(S + (size_t)row * 3072 + u.pn * BM + colt) = w; EPIP_BJ_END
        EPI_ROWS_END
    }
};
struct EpiBR {
    static constexpr bool PERM = true;
    const unsigned char* S; bf16_t* MG;
    __device__ __forceinline__ void operator()(const Acc& acc, const Unit& u, int wr, int wc, int fr, int fq) const {
#pragma unroll
        for (int ai = 0; ai < 2; ++ai) {
            u32x2 sv[4][2]; unsigned long long mv[4][2][2];
#pragma unroll
            for (int m = 0; m < 4; ++m) { const int row = u.pm * BM + ai * HALF + wr * 64 + m * 16 + fr;
                EPIP_BJ_BEGIN const int col = u.pn * BM + colt; sv[m][bj] = *(const u32x2*)(S + (size_t)row * 3072 + u.z * 1024 + col);
                    const unsigned long long* mp_ = (const unsigned long long*)(MG + (size_t)row * 1024 + col);
                    mv[m][bj][0] = (u.z > 0) ? __hip_atomic_load(mp_, __ATOMIC_RELAXED, __HIP_MEMORY_SCOPE_AGENT) : 0ull;
                    mv[m][bj][1] = (u.z > 0) ? __hip_atomic_load(mp_ + 1, __ATOMIC_RELAXED, __HIP_MEMORY_SCOPE_AGENT) : 0ull; EPIP_BJ_END }
#pragma unroll
            for (int m = 0; m < 4; ++m) { const int row = u.pm * BM + ai * HALF + wr * 64 + m * 16 + fr;
                EPIP_BJ_BEGIN const int col = u.pn * BM + colt; const unsigned wa = sv[m][bj].x, wb = sv[m][bj].y;
                    const f32x4 g0 = {(float)(wa & 0xffu), (float)((wa >> 8) & 0xffu), (float)((wa >> 16) & 0xffu), (float)(wa >> 24)};
                    const f32x4 g1 = {(float)(wb & 0xffu), (float)((wb >> 8) & 0xffu), (float)((wb >> 16) & 0xffu), (float)(wb >> 24)};
                    f32x4 v0 = g0 * (acc[ai][bj][m][0] * (1.0f / 255.0f)), v1 = g1 * (acc[ai][bj][m][1] * (1.0f / 255.0f));
                    u32x2 w0, w1; w0.x = (unsigned)mv[m][bj][0]; w0.y = (unsigned)(mv[m][bj][0] >> 32); w1.x = (unsigned)mv[m][bj][1]; w1.y = (unsigned)(mv[m][bj][1] >> 32);
                    v0 += unpack4bf(w0); v1 += unpack4bf(w1);
                    store8bf(MG + (size_t)row * 1024 + col, v0, v1); EPIP_BJ_END }
            asm volatile("" ::: "memory");
        }
    }
};
struct EpiOut {
    static constexpr bool PERM = false;
    float* OUT;
    __device__ __forceinline__ void operator()(const Acc& acc, const Unit& u, int wr, int wc, int fr, int fq) const {
        EPI_ROWS_BEGIN
            EPI_COLS_BEGIN *(f32x4*)(OUT + (size_t)row * 1024 + u.pn * BM + colt) = acc[ai][bj][m][n]; EPI_COLS_END
        EPI_ROWS_END
    }
};
}

__device__ __forceinline__ float max3f(float a, float b, float c) { float r; asm("v_max3_f32 %0, %1, %2, %3" : "=v"(r) : "v"(a), "v"(b), "v"(c)); return r; }
__device__ __forceinline__ float max2f(float a, float b) { float r; asm("v_max_f32_e32 %0, %1, %2" : "=v"(r) : "v"(a), "v"(b)); return r; }
__device__ __forceinline__ float fadd_s(float a, float b) { float r; asm("v_add_f32_e32 %0, %1, %2" : "=v"(r) : "v"(a), "v"(b)); return r; }
__device__ __forceinline__ float rowmax32(const f32x16& p0, const f32x16& p1) {
    float a = max3f(p0[0], p0[1], p1[0]), b = max3f(p0[2], p0[3], p1[1]); a = max3f(a, p1[2], p1[3]);
#pragma unroll
    for (int r = 4; r < 16; r += 4) { a = max3f(a, p0[r], p0[r + 1]); b = max3f(b, p0[r + 2], p0[r + 3]); a = max3f(a, p1[r], p1[r + 1]); b = max3f(b, p1[r + 2], p1[r + 3]); }
    return max2f(a, b);
}
__device__ __forceinline__ float half_max(float v) { auto rr = __builtin_amdgcn_permlane32_swap(__float_as_uint(v), __float_as_uint(v), false, false); return fmaxf(__uint_as_float(rr[0]), __uint_as_float(rr[1])); }
__device__ __forceinline__ float half_sum(float v) { auto rr = __builtin_amdgcn_permlane32_swap(__float_as_uint(v), __float_as_uint(v), false, false); return __uint_as_float(rr[0]) + __uint_as_float(rr[1]); }
__device__ __forceinline__ int crow(int r, int hi) { return (r & 3) + 8 * (r >> 2) + 4 * hi; }

template <int NMAP, int DKM, int DV, bool CAUSAL, int W0, int W1>
__device__ __forceinline__ void attn_unit(LAS unsigned char* lds, const bf16_t* __restrict__ Q, int ldq, const bf16_t* __restrict__ K0, int ldk0, const bf16_t* __restrict__ K1, int ldk1,
                                          const bf16_t* __restrict__ Vt, size_t ldv, int q0, int NT, bf16_t* O, int ldo, float lam, const float* subln, float outscale) {
    constexpr int DKT = NMAP * DKM, KS = DKT * 2 + 16, VS = 136, KBUF = 64 * KS, VBUF = DV * VS;
    constexpr int NC = DKM / 16, NDB = DV / 32;
    constexpr int K0C = W0 / 8, K0N = (64 * K0C) / 512, K1C = W1 / 8, VN = (DV * 8) / 512;
    static_assert(W0 + W1 == DKT && K0N >= 1 && VN >= 1, "attention staging geometry");
    int tid = threadIdx.x; asm volatile("" : "+v"(tid));
    const int lane = tid & 63, wid = __builtin_amdgcn_readfirstlane(tid >> 6), r32 = lane & 31, hi = lane >> 5;
    LAS unsigned char* Kb = lds; LAS unsigned char* Vb = lds + 2 * KBUF;
    bf16x8 qf[NMAP][NC];
    { const bf16_t* qrow = Q + (size_t)(q0 + wid * 32 + r32) * ldq;
#pragma unroll
      for (int mp = 0; mp < NMAP; ++mp)
#pragma unroll
          for (int c = 0; c < NC; ++c) qf[mp][c] = *(const bf16x8*)(qrow + mp * DKM + 16 * c + 8 * hi); }
    f32x16 o[NMAP][NDB]; float mrow[NMAP], lrow[NMAP];
#pragma unroll
    for (int mp = 0; mp < NMAP; ++mp) { mrow[mp] = -INFINITY; lrow[mp] = 0.f;
#pragma unroll
        for (int db = 0; db < NDB; ++db)
#pragma unroll
            for (int r = 0; r < 16; ++r) o[mp][db][r] = 0.f; }
    u32x4 kreg[K0N], k1reg = {0u, 0u, 0u, 0u}, vreg[VN];
#define ATT_GLOAD(t) do { \
    _Pragma("unroll") for (int i = 0; i < K0N; ++i) { const int idx = tid + 512 * i, rr = idx / K0C, cc = idx % K0C; kreg[i] = *(const u32x4*)(K0 + (size_t)(64 * (t) + rr) * ldk0 + cc * 8); } \
    if (W1 > 0) { if (tid < 64 * K1C) { const int rr = tid / (K1C > 0 ? K1C : 1), cc = tid % (K1C > 0 ? K1C : 1); k1reg = *(const u32x4*)(K1 + (size_t)(64 * (t) + rr) * ldk1 + cc * 8); } } \
    _Pragma("unroll") for (int i = 0; i < VN; ++i) { const int idx = tid + 512 * i, dd = idx >> 3, cc = idx & 7; vreg[i] = *(const u32x4*)(Vt + (size_t)dd * ldv + 64 * (t) + cc * 8); } } while (0)
#define ATT_LWRITE(buf) do { \
    _Pragma("unroll") for (int i = 0; i < K0N; ++i) { const int idx = tid + 512 * i, rr = idx / K0C, cc = idx % K0C; *(LAS u32x4*)(Kb + (buf) * KBUF + rr * KS + cc * 16) = kreg[i]; } \
    if (W1 > 0) { if (tid < 64 * K1C) { const int rr = tid / (K1C > 0 ? K1C : 1), cc = tid % (K1C > 0 ? K1C : 1); *(LAS u32x4*)(Kb + (buf) * KBUF + rr * KS + W0 * 2 + cc * 16) = k1reg; } } \
    _Pragma("unroll") for (int i = 0; i < VN; ++i) { const int idx = tid + 512 * i, dd = idx >> 3, cc = idx & 7; LAS u32x2* vp = (LAS u32x2*)(Vb + (buf) * VBUF + dd * VS + cc * 16); \
        u32x2 lo_; lo_.x = vreg[i].x; lo_.y = vreg[i].y; u32x2 hi_; hi_.x = vreg[i].z; hi_.y = vreg[i].w; vp[0] = lo_; vp[1] = hi_; } } while (0)
    ATT_GLOAD(0);
    ATT_LWRITE(0);
    __syncthreads();
    const int qw0 = q0 + wid * 32;
    for (int t = 0; t < NT; ++t) {
        const int buf = t & 1;
        if (t + 1 < NT) ATT_GLOAD(t + 1);
#pragma unroll
        for (int kb = 0; kb < 2; ++kb) {
            const int kv0 = 64 * t + 32 * kb;
            if (CAUSAL && kv0 > qw0) continue;
            const bool diag = CAUSAL && (kv0 == qw0);
            bf16x8 vf[NDB][2];
#pragma unroll
            for (int db = 0; db < NDB; ++db)
#pragma unroll
                for (int j = 0; j < 2; ++j) { const LAS unsigned char* vp = Vb + buf * VBUF + (32 * db + r32) * VS + (32 * kb + 16 * j + 4 * hi) * 2;
                    const s16x4 lo = *(const LAS s16x4*)vp, hh = *(const LAS s16x4*)(vp + 16);
                    vf[db][j] = (bf16x8){lo[0], lo[1], lo[2], lo[3], hh[0], hh[1], hh[2], hh[3]}; }
#pragma unroll
            for (int mp = 0; mp < NMAP; ++mp) {
                f32x16 s;
#pragma unroll
                for (int r = 0; r < 16; ++r) s[r] = 0.f;
#pragma unroll
                for (int c = 0; c < NC; ++c) { const bf16x8 kf = *(const LAS bf16x8*)(Kb + buf * KBUF + (32 * kb + r32) * KS + (mp * DKM + 16 * c + 8 * hi) * 2);
                    s = __builtin_amdgcn_mfma_f32_32x32x16_bf16(kf, qf[mp][c], s, 0, 0, 0); }
                if (diag) {
#pragma unroll
                    for (int r = 0; r < 16; ++r) if (crow(r, hi) > r32) s[r] = -INFINITY;
                }
                float mx = s[0];
#pragma unroll
                for (int r = 1; r < 16; ++r) mx = fmaxf(mx, s[r]);
                mx = fmaxf(mx, __shfl_xor(mx, 32));
                if (__any(mx > mrow[mp])) {
                    const float mnew = fmaxf(mrow[mp], mx), alpha = fast_exp2(mrow[mp] - mnew);
                    mrow[mp] = mnew; lrow[mp] *= alpha;
#pragma unroll
                    for (int db = 0; db < NDB; ++db)
#pragma unroll
                        for (int r = 0; r < 16; ++r) o[mp][db][r] *= alpha;
                }
                const float mcur = mrow[mp]; float ls = 0.f;
#pragma unroll
                for (int r = 0; r < 16; ++r) { s[r] = fast_exp2(s[r] - mcur); ls += s[r]; }
                lrow[mp] += ls;
                bf16x8 pa[2];
#pragma unroll
                for (int j = 0; j < 2; ++j) { u32x4 w; w.x = cvtpk(s[8 * j + 0], s[8 * j + 1]); w.y = cvtpk(s[8 * j + 2], s[8 * j + 3]); w.z = cvtpk(s[8 * j + 4], s[8 * j + 5]); w.w = cvtpk(s[8 * j + 6], s[8 * j + 7]); pa[j] = __builtin_bit_cast(bf16x8, w); }
#pragma unroll
                for (int db = 0; db < NDB; ++db)
#pragma unroll
                    for (int j = 0; j < 2; ++j) o[mp][db] = __builtin_amdgcn_mfma_f32_32x32x16_bf16(vf[db][j], pa[j], o[mp][db], 0, 0, 0);
            }
        }
        if (t + 1 < NT) ATT_LWRITE(buf ^ 1);
        __syncthreads();
    }
#undef ATT_GLOAD
#undef ATT_LWRITE
    float inv[NMAP];
#pragma unroll
    for (int mp = 0; mp < NMAP; ++mp) { const float lt = lrow[mp] + __shfl_xor(lrow[mp], 32); inv[mp] = 1.0f / lt; }
    bf16_t* orow = O + (size_t)(q0 + wid * 32 + r32) * ldo;
    if constexpr (NMAP == 1) {
#pragma unroll
        for (int db = 0; db < NDB; ++db)
#pragma unroll
            for (int g = 0; g < 4; ++g) { f32x4 v; for (int i = 0; i < 4; ++i) v[i] = o[0][db][4 * g + i] * inv[0]; store4bf(orow + 32 * db + 8 * g + 4 * hi, v); }
    } else {
        float ss = 0.f;
#pragma unroll
        for (int db = 0; db < NDB; ++db)
#pragma unroll
            for (int r = 0; r < 16; ++r) { const float v = o[0][db][r] * inv[0] - lam * (o[1][db][r] * inv[1]); o[0][db][r] = v; ss += v * v; }
        ss += __shfl_xor(ss, 32);
        const float rstd = __builtin_amdgcn_rsqf(ss * (1.0f / DV) + NORM_EPS) * outscale;
#pragma unroll
        for (int db = 0; db < NDB; ++db)
#pragma unroll
            for (int g = 0; g < 4; ++g) { const f32x4 gn = *(const f32x4*)(subln + 32 * db + 8 * g + 4 * hi); f32x4 v; for (int i = 0; i < 4; ++i) v[i] = o[0][db][4 * g + i] * rstd * gn[i]; store4bf(orow + 32 * db + 8 * g + 4 * hi, v); }
    }
}

template <int NMAP, int DKM, int DV, int W0, int W1>
__device__ __forceinline__ void attn_unit2(LAS unsigned char* lds, const bf16_t* __restrict__ Q, int ldq, const bf16_t* __restrict__ K0, int ldk0, const bf16_t* __restrict__ K1, int ldk1,
                                           const bf16_t* __restrict__ Vt, size_t ldv, int q0, int NT, bf16_t* O, int ldo, float lam, const float* subln, float outscale) {
    constexpr int DKT = NMAP * DKM, KS = DKT * 2 + 16, VS = 136, KBUF = 64 * KS, VBUF = DV * VS;
    constexpr int NC = DKM / 16, NDB = DV / 32;
    constexpr int K0C = W0 / 8, K0N = (64 * K0C) / 512, K1C = W1 / 8, VN = (DV * 8) / 512;
    static_assert(W0 + W1 == DKT && K0N >= 1 && VN >= 1, "attention staging geometry");
    int tid = threadIdx.x; asm volatile("" : "+v"(tid));
    const int lane = tid & 63, wid = __builtin_amdgcn_readfirstlane(tid >> 6), r32 = lane & 31, hi = lane >> 5;
    LAS unsigned char* Kb = lds; LAS unsigned char* Vb = lds + 2 * KBUF;
    bf16x8 qf[NMAP][NC];
    { const bf16_t* qrow = Q + (size_t)(q0 + wid * 32 + r32) * ldq;
#pragma unroll
      for (int mp = 0; mp < NMAP; ++mp)
#pragma unroll
          for (int c = 0; c < NC; ++c) qf[mp][c] = *(const bf16x8*)(qrow + mp * DKM + 16 * c + 8 * hi); }
    f32x16 o[NMAP][NDB], negm[NMAP]; float lrow[NMAP];
#pragma unroll
    for (int mp = 0; mp < NMAP; ++mp) { lrow[mp] = 0.f;
#pragma unroll
        for (int r = 0; r < 16; ++r) negm[mp][r] = 0.f;
#pragma unroll
        for (int db = 0; db < NDB; ++db)
#pragma unroll
            for (int r = 0; r < 16; ++r) o[mp][db][r] = 0.f; }
    u32x4 kreg[K0N], k1reg = {0u, 0u, 0u, 0u}, vreg[VN];
#define ATT_GLOAD(t) do { \
    _Pragma("unroll") for (int i = 0; i < K0N; ++i) { const int idx = tid + 512 * i, rr = idx / K0C, cc = idx % K0C; kreg[i] = *(const u32x4*)(K0 + (size_t)(64 * (t) + rr) * ldk0 + cc * 8); } \
    if (W1 > 0) { if (tid < 64 * K1C) { const int rr = tid / (K1C > 0 ? K1C : 1), cc = tid % (K1C > 0 ? K1C : 1); k1reg = *(const u32x4*)(K1 + (size_t)(64 * (t) + rr) * ldk1 + cc * 8); } } \
    _Pragma("unroll") for (int i = 0; i < VN; ++i) { const int idx = tid + 512 * i, dd = idx >> 3, cc = idx & 7; vreg[i] = *(const u32x4*)(Vt + (size_t)dd * ldv + 64 * (t) + cc * 8); } } while (0)
#define ATT_LWRITE(buf) do { \
    _Pragma("unroll") for (int i = 0; i < K0N; ++i) { const int idx = tid + 512 * i, rr = idx / K0C, cc = idx % K0C; *(LAS u32x4*)(Kb + (buf) * KBUF + rr * KS + cc * 16) = kreg[i]; } \
    if (W1 > 0) { if (tid < 64 * K1C) { const int rr = tid / (K1C > 0 ? K1C : 1), cc = tid % (K1C > 0 ? K1C : 1); *(LAS u32x4*)(Kb + (buf) * KBUF + rr * KS + W0 * 2 + cc * 16) = k1reg; } } \
    _Pragma("unroll") for (int i = 0; i < VN; ++i) { const int idx = tid + 512 * i, dd = idx >> 3, cc = idx & 7; LAS u32x2* vp = (LAS u32x2*)(Vb + (buf) * VBUF + dd * VS + cc * 16); \
        u32x2 lo_; lo_.x = vreg[i].x; lo_.y = vreg[i].y; u32x2 hi_; hi_.x = vreg[i].z; hi_.y = vreg[i].w; vp[0] = lo_; vp[1] = hi_; } } while (0)
    ATT_GLOAD(0);
    ATT_LWRITE(0);
    __syncthreads();
    const int qw0 = q0 + wid * 32;
    for (int t = 0; t < NT; ++t) {
        const int buf = t & 1;
        if (t + 1 < NT) ATT_GLOAD(t + 1);
        const int kvt = 64 * t;
        if (kvt <= qw0) {
            const bool band = (kvt + 63 > qw0);
#pragma unroll
            for (int mp = 0; mp < NMAP; ++mp) {
                f32x16 s0, s1;
#pragma unroll
                for (int c = 0; c < NC; ++c) {
                    const bf16x8 kf0 = *(const LAS bf16x8*)(Kb + buf * KBUF + r32 * KS + (mp * DKM + 16 * c + 8 * hi) * 2);
                    const bf16x8 kf1 = *(const LAS bf16x8*)(Kb + buf * KBUF + (32 + r32) * KS + (mp * DKM + 16 * c + 8 * hi) * 2);
                    if (c == 0) { s0 = __builtin_amdgcn_mfma_f32_32x32x16_bf16(kf0, qf[mp][0], negm[mp], 0, 0, 0); s1 = __builtin_amdgcn_mfma_f32_32x32x16_bf16(kf1, qf[mp][0], negm[mp], 0, 0, 0); }
                    else { s0 = __builtin_amdgcn_mfma_f32_32x32x16_bf16(kf0, qf[mp][c], s0, 0, 0, 0); s1 = __builtin_amdgcn_mfma_f32_32x32x16_bf16(kf1, qf[mp][c], s1, 0, 0, 0); }
                }
                asm volatile("s_nop 15\n\ts_nop 7" : "+v"(s0), "+v"(s1));
                if (band) {
                    const int qd = qw0 + r32 - kvt;
#pragma unroll
                    for (int r = 0; r < 16; ++r) { const int kv = crow(r, hi); if (kv > qd) s0[r] = -INFINITY; if (kv + 32 > qd) s1[r] = -INFINITY; }
                }
                float mx = rowmax32(s0, s1);
                mx = fmaxf(mx, __shfl_xor(mx, 32));
                if (__any(t == 0 || mx > 8.0f)) {
                    const float dl = (t == 0) ? mx : fmaxf(mx, 0.f), alpha = fast_exp2(-dl);
                    lrow[mp] *= alpha;
#pragma unroll
                    for (int r = 0; r < 16; ++r) { s0[r] -= dl; s1[r] -= dl; negm[mp][r] -= dl; }
#pragma unroll
                    for (int db = 0; db < NDB; ++db)
#pragma unroll
                        for (int r = 0; r < 16; ++r) o[mp][db][r] *= alpha;
                }
                float ls = 0.f;
#pragma unroll
                for (int kb = 0; kb < 2; ++kb) {
                    f32x16& s = kb ? s1 : s0;
                    bf16x8 vf[NDB][2];
#pragma unroll
                    for (int db = 0; db < NDB; ++db)
#pragma unroll
                        for (int j = 0; j < 2; ++j) { const LAS unsigned char* vp = Vb + buf * VBUF + (32 * db + r32) * VS + (32 * kb + 16 * j + 4 * hi) * 2;
                            const s16x4 lo = *(const LAS s16x4*)vp, hh = *(const LAS s16x4*)(vp + 16);
                            vf[db][j] = (bf16x8){lo[0], lo[1], lo[2], lo[3], hh[0], hh[1], hh[2], hh[3]}; }
#pragma unroll
                    for (int r = 0; r < 16; ++r) s[r] = fast_exp2(s[r]);
                    asm volatile("s_nop 1" : "+v"(s));
#pragma unroll
                    for (int r = 0; r < 16; ++r) ls = fadd_s(ls, s[r]);
                    bf16x8 pa[2];
#pragma unroll
                    for (int j = 0; j < 2; ++j) { u32x4 w; w.x = cvtpk(s[8 * j + 0], s[8 * j + 1]); w.y = cvtpk(s[8 * j + 2], s[8 * j + 3]); w.z = cvtpk(s[8 * j + 4], s[8 * j + 5]); w.w = cvtpk(s[8 * j + 6], s[8 * j + 7]); pa[j] = __builtin_bit_cast(bf16x8, w); }
#pragma unroll
                    for (int db = 0; db < NDB; ++db)
#pragma unroll
                        for (int j = 0; j < 2; ++j) o[mp][db] = __builtin_amdgcn_mfma_f32_32x32x16_bf16(vf[db][j], pa[j], o[mp][db], 0, 0, 0);
                }
                lrow[mp] += ls;
                if (NMAP > 1) __builtin_amdgcn_sched_barrier(0);
            }
        }
        if (t + 1 < NT) ATT_LWRITE(buf ^ 1);
        __syncthreads();
    }
#undef ATT_GLOAD
#undef ATT_LWRITE
    float inv[NMAP];
#pragma unroll
    for (int mp = 0; mp < NMAP; ++mp) { const float lt = lrow[mp] + __shfl_xor(lrow[mp], 32); inv[mp] = 1.0f / lt; }
    bf16_t* orow = O + (size_t)(q0 + wid * 32 + r32) * ldo;
    if constexpr (NMAP == 1) {
#pragma unroll
        for (int db = 0; db < NDB; ++db)
#pragma unroll
            for (int g = 0; g < 4; ++g) { f32x4 v; for (int i = 0; i < 4; ++i) v[i] = o[0][db][4 * g + i] * inv[0]; store4bf(orow + 32 * db + 8 * g + 4 * hi, v); }
    } else {
        float ss = 0.f;
#pragma unroll
        for (int db = 0; db < NDB; ++db)
#pragma unroll
            for (int r = 0; r < 16; ++r) { const float v = o[0][db][r] * inv[0] - lam * (o[1][db][r] * inv[1]); o[0][db][r] = v; ss += v * v; }
        ss += __shfl_xor(ss, 32);
        const float rstd = __builtin_amdgcn_rsqf(ss * (1.0f / DV) + NORM_EPS) * outscale;
#pragma unroll
        for (int db = 0; db < NDB; ++db)
#pragma unroll
            for (int g = 0; g < 4; ++g) { const f32x4 gn = *(const f32x4*)(subln + 32 * db + 8 * g + 4 * hi); f32x4 v; for (int i = 0; i < 4; ++i) v[i] = o[0][db][4 * g + i] * rstd * gn[i]; store4bf(orow + 32 * db + 8 * g + 4 * hi, v); }
    }
}

template <int DKM, int DV, int W0, int W1>
__device__ __forceinline__ void attn_unit4(LAS unsigned char* lds, const bf16_t* __restrict__ Q, int ldq, const bf16_t* __restrict__ K0, int ldk0, const bf16_t* __restrict__ K1, int ldk1,
                                           const bf16_t* __restrict__ Vt, size_t ldv, int q0, int NT, bf16_t* O, int ldo) {
    constexpr int KS = DKM * 2 + 16, VS = 136, KBUF = 64 * KS, VBUF = DV * VS, QROW = DKM * 2 + 16;
    constexpr int NC = DKM / 16, NDB = DV / 32;
    constexpr int K0C = W0 / 8, K0N = (64 * K0C) / 512, K1C = W1 / 8, VN = (DV * 8) / 512;
    static_assert(W0 + W1 == DKM && K0N >= 1 && VN >= 1 && K1C >= 1, "attention staging geometry");
    static_assert(2 * KBUF + 2 * VBUF + 8 * 64 * QROW <= LDS_BYTES - 16, "attention LDS budget");
    int tid = threadIdx.x; asm volatile("" : "+v"(tid));
    const int lane = tid & 63, wid = __builtin_amdgcn_readfirstlane(tid >> 6), r32 = lane & 31, hi = lane >> 5;
    LAS unsigned char* Kb = lds; LAS unsigned char* Vb = lds + 2 * KBUF;
    LAS unsigned char* Qs = lds + 2 * KBUF + 2 * VBUF + wid * (64 * QROW) + r32 * QROW + 16 * hi;
#pragma unroll
    for (int rb = 0; rb < 2; ++rb) { const bf16_t* qrow = Q + (size_t)(q0 + wid * 64 + rb * 32 + r32) * ldq;
#pragma unroll
        for (int c = 0; c < NC; ++c) *(LAS bf16x8*)(Qs + rb * 32 * QROW + c * 32) = *(const bf16x8*)(qrow + 16 * c + 8 * hi); }
    f32x16 o[2][NDB], negm[2]; float lrow[2] = {0.f, 0.f};
#pragma unroll
    for (int rb = 0; rb < 2; ++rb) {
#pragma unroll
        for (int r = 0; r < 16; ++r) negm[rb][r] = 0.f;
#pragma unroll
        for (int db = 0; db < NDB; ++db)
#pragma unroll
            for (int r = 0; r < 16; ++r) o[rb][db][r] = 0.f; }
    u32x4 kreg[K0N], k1reg = {0u, 0u, 0u, 0u}, vreg[VN];
#define A4_GLOAD(t) do { \
    _Pragma("unroll") for (int i = 0; i < K0N; ++i) { const int idx = tid + 512 * i, rr = idx / K0C, cc = idx % K0C; kreg[i] = *(const u32x4*)(K0 + (size_t)(64 * (t) + rr) * ldk0 + cc * 8); } \
    if (tid < 64 * K1C) { const int rr = tid / K1C, cc = tid % K1C; k1reg = *(const u32x4*)(K1 + (size_t)(64 * (t) + rr) * ldk1 + cc * 8); } \
    _Pragma("unroll") for (int i = 0; i < VN; ++i) { const int idx = tid + 512 * i, dd = idx >> 3, cc = idx & 7; vreg[i] = *(const u32x4*)(Vt + (size_t)dd * ldv + 64 * (t) + cc * 8); } } while (0)
#define A4_LWRITE(buf) do { \
    _Pragma("unroll") for (int i = 0; i < K0N; ++i) { const int idx = tid + 512 * i, rr = idx / K0C, cc = idx % K0C; *(LAS u32x4*)(Kb + (buf) * KBUF + rr * KS + cc * 16) = kreg[i]; } \
    if (tid < 64 * K1C) { const int rr = tid / K1C, cc = tid % K1C; *(LAS u32x4*)(Kb + (buf) * KBUF + rr * KS + W0 * 2 + cc * 16) = k1reg; } \
    _Pragma("unroll") for (int i = 0; i < VN; ++i) { const int idx = tid + 512 * i, dd = idx >> 3, cc = idx & 7; LAS u32x2* vp = (LAS u32x2*)(Vb + (buf) * VBUF + dd * VS + cc * 16); \
        u32x2 lo_; lo_.x = vreg[i].x; lo_.y = vreg[i].y; u32x2 hi_; hi_.x = vreg[i].z; hi_.y = vreg[i].w; vp[0] = lo_; vp[1] = hi_; } } while (0)
    A4_GLOAD(0);
    A4_LWRITE(0);
    __syncthreads();
    const int qw0 = q0 + wid * 64;
    for (int t = 0; t < NT; ++t) {
        const int buf = t & 1;
        if (t + 1 < NT) A4_GLOAD(t + 1);
        const int kvt = 64 * t;
        if (kvt <= qw0) {
            const bool band = (kvt == qw0);
            f32x16 s[2][2];
#pragma unroll
            for (int c = 0; c < NC; ++c) {
                const bf16x8 kf0 = *(const LAS bf16x8*)(Kb + buf * KBUF + r32 * KS + (16 * c + 8 * hi) * 2);
                const bf16x8 kf1 = *(const LAS bf16x8*)(Kb + buf * KBUF + (32 + r32) * KS + (16 * c + 8 * hi) * 2);
#pragma unroll
                for (int rb = 0; rb < 2; ++rb) { const bf16x8 qv = *(const LAS bf16x8*)(Qs + rb * 32 * QROW + c * 32);
                    if (c == 0) { s[rb][0] = __builtin_amdgcn_mfma_f32_32x32x16_bf16(kf0, qv, negm[rb], 0, 0, 0); s[rb][1] = __builtin_amdgcn_mfma_f32_32x32x16_bf16(kf1, qv, negm[rb], 0, 0, 0); }
                    else { s[rb][0] = __builtin_amdgcn_mfma_f32_32x32x16_bf16(kf0, qv, s[rb][0], 0, 0, 0); s[rb][1] = __builtin_amdgcn_mfma_f32_32x32x16_bf16(kf1, qv, s[rb][1], 0, 0, 0); } }
            }
            asm volatile("s_nop 15\n\ts_nop 7" : "+v"(s[0][0]), "+v"(s[0][1]), "+v"(s[1][0]), "+v"(s[1][1]));
#pragma unroll
            for (int rb = 0; rb < 2; ++rb) {
                f32x16& s0 = s[rb][0]; f32x16& s1 = s[rb][1];
                if (band) {
                    const int qd = 32 * rb + r32;
#pragma unroll
                    for (int r = 0; r < 16; ++r) { const int kv = crow(r, hi); if (kv > qd) s0[r] = -INFINITY; if (kv + 32 > qd) s1[r] = -INFINITY; }
                }
                float mx = rowmax32(s0, s1);
                mx = half_max(mx);
                if (__any(t == 0 || mx > 8.0f)) {
                    const float dl = (t == 0) ? mx : fmaxf(mx, 0.f), alpha = fast_exp2(-dl);
                    lrow[rb] *= alpha;
#pragma unroll
                    for (int r = 0; r < 16; ++r) { s0[r] -= dl; s1[r] -= dl; negm[rb][r] -= dl; }
#pragma unroll
                    for (int db = 0; db < NDB; ++db)
#pragma unroll
                        for (int r = 0; r < 16; ++r) o[rb][db][r] *= alpha;
                }
            }
#pragma unroll
            for (int kb = 0; kb < 2; ++kb) {
                bf16x8 vf[NDB][2];
#pragma unroll
                for (int db = 0; db < NDB; ++db)
#pragma unroll
                    for (int j = 0; j < 2; ++j) { const LAS unsigned char* vp = Vb + buf * VBUF + (32 * db + r32) * VS + (32 * kb + 16 * j + 4 * hi) * 2;
                        const s16x4 lo = *(const LAS s16x4*)vp, hh = *(const LAS s16x4*)(vp + 16);
                        vf[db][j] = (bf16x8){lo[0], lo[1], lo[2], lo[3], hh[0], hh[1], hh[2], hh[3]}; }
#pragma unroll
                for (int rb = 0; rb < 2; ++rb) {
                    f32x16& sv = s[rb][kb]; float ls = 0.f;
#pragma unroll
                    for (int r = 0; r < 16; ++r) sv[r] = fast_exp2(sv[r]);
                    asm volatile("s_nop 1" : "+v"(sv));
#pragma unroll
                    for (int r = 0; r < 16; ++r) ls = fadd_s(ls, sv[r]);
                    lrow[rb] += ls;
                    bf16x8 pa[2];
#pragma unroll
                    for (int j = 0; j < 2; ++j) { u32x4 w; w.x = cvtpk(sv[8 * j + 0], sv[8 * j + 1]); w.y = cvtpk(sv[8 * j + 2], sv[8 * j + 3]); w.z = cvtpk(sv[8 * j + 4], sv[8 * j + 5]); w.w = cvtpk(sv[8 * j + 6], sv[8 * j + 7]); pa[j] = __builtin_bit_cast(bf16x8, w); }
#pragma unroll
                    for (int db = 0; db < NDB; ++db)
#pragma unroll
                        for (int j = 0; j < 2; ++j) o[rb][db] = __builtin_amdgcn_mfma_f32_32x32x16_bf16(vf[db][j], pa[j], o[rb][db], 0, 0, 0);
                }
            }
        }
        if (t + 1 < NT) A4_LWRITE(buf ^ 1);
        __syncthreads();
    }
#undef A4_GLOAD
#undef A4_LWRITE
#pragma unroll
    for (int rb = 0; rb < 2; ++rb) {
        const float inv = 1.0f / half_sum(lrow[rb]);
        bf16_t* orow = O + (size_t)(q0 + wid * 64 + rb * 32 + r32) * ldo;
#pragma unroll
        for (int db = 0; db < NDB; ++db)
#pragma unroll
            for (int g = 0; g < 4; ++g) { f32x4 v; for (int i = 0; i < 4; ++i) v[i] = o[rb][db][4 * g + i] * inv; store4bf(orow + 32 * db + 8 * g + 4 * hi, v); }
    }
}

__device__ __forceinline__ float wave_sum(float v) {
#pragma unroll
    for (int o = 1; o < 64; o <<= 1) v += __shfl_xor(v, o);
    return v;
}
__device__ __forceinline__ void transpose_block(const float* __restrict__ W, int ldw, int src_col0, const float* __restrict__ gain, bf16_t* WT, int K, int dst_row0, int k0, LAS float* scr, int lane) {
#pragma unroll 8
    for (int i = 0; i < 32; ++i) { const int kk = 2 * i + (lane >> 5); float v = W[(size_t)(k0 + kk) * ldw + src_col0 + (lane & 31)]; if (gain) v *= gain[k0 + kk]; scr[kk * 33 + (lane & 31)] = v; }
    asm volatile("s_waitcnt lgkmcnt(0)" ::: "memory");
    const int c = lane & 7;
#pragma unroll
    for (int j = 0; j < 4; ++j) { const int n = (lane >> 3) + 8 * j; const LAS float* s = scr + (8 * c) * 33 + n;
        u32x4 ov; ov.x = cvtpk(s[0 * 33], s[1 * 33]); ov.y = cvtpk(s[2 * 33], s[3 * 33]); ov.z = cvtpk(s[4 * 33], s[5 * 33]); ov.w = cvtpk(s[6 * 33], s[7 * 33]);
        *(u32x4*)(WT + (size_t)(dst_row0 + n) * K + k0 + 8 * c) = ov; }
    asm volatile("s_waitcnt lgkmcnt(0)" ::: "memory");
}

#define XB_TMO      128
#define XB_XCNT(j)  (256  + 64 * (j))
#define XB_XSUB(j)  (1280 + 64 * (j))
#define XB_XGEN(j)  (2304 + 64 * (j))
#define XB_TOP      3328
#define XB_TOPGEN   3392
#define XCD_BAR_WORDS 3456
#define XB_SPIN_CAP (1u << 18)

__device__ __forceinline__ unsigned xb_ld(unsigned* p)              { return __hip_atomic_load(p, __ATOMIC_RELAXED, __HIP_MEMORY_SCOPE_AGENT); }
__device__ __forceinline__ unsigned xb_add(unsigned* p, unsigned v) { return __hip_atomic_fetch_add(p, v, __ATOMIC_RELAXED, __HIP_MEMORY_SCOPE_AGENT); }
__device__ __forceinline__ unsigned xb_xcc_id() { return (unsigned)__builtin_amdgcn_s_getreg((3 << 11) | 20) & 0xFu; }
#define XB_SPIN(cond, bar) do { unsigned _sp = 0; while (cond) { __builtin_amdgcn_s_sleep(1); \
    if ((++_sp & 255u) == 0u) { if (xb_ld(&(bar)[XB_TMO])) break; if (_sp > XB_SPIN_CAP) { atomicAdd(&(bar)[XB_TMO], 1u); break; } } } } while (0)

struct XcdBarrier {
    unsigned* bar; unsigned x;
    volatile LAS unsigned* st;
};

__device__ __forceinline__ XcdBarrier xcd_barrier_post(unsigned* bar, volatile LAS unsigned* st) {
    XcdBarrier b; b.bar = bar; b.x = xb_xcc_id(); b.st = st;
    if (threadIdx.x == 0) (void)xb_add(&bar[XB_XCNT(b.x)], 1u);
    return b;
}
__device__ __forceinline__ void xcd_barrier_complete(unsigned* bar, unsigned x, unsigned& nloc, unsigned& nx) {
    const unsigned G = gridDim.x * gridDim.y * gridDim.z;
    unsigned sum, cnt, mine, sp = 0u;
    for (;;) {
        sum = 0u; cnt = 0u; mine = 0u;
#pragma unroll
        for (unsigned j = 0; j < 16; ++j) { const unsigned c = xb_ld(&bar[XB_XCNT(j)]); sum += c; cnt += (c > 0u) ? 1u : 0u; mine = (j == x) ? c : mine; }
        if (sum == G) break;
        __builtin_amdgcn_s_sleep(1);
        if ((++sp & 255u) == 0u) { if (xb_ld(&bar[XB_TMO])) break; if (sp > XB_SPIN_CAP) { atomicAdd(&bar[XB_TMO], 1u); break; } }
    }
    nloc = mine > 0u ? mine : 1u; nx = cnt > 0u ? cnt : 1u;
}

__device__ __forceinline__ void xcd_barrier(const XcdBarrier& b) {
    asm volatile("s_waitcnt vmcnt(0)" ::: "memory");
    __syncthreads();
    if (threadIdx.x == 0) {
        unsigned* bar = b.bar;
        __builtin_amdgcn_s_waitcnt(0);
        unsigned nloc = b.st[0], nx = b.st[1];
        if (nloc == 0u) { xcd_barrier_complete(bar, b.x, nloc, nx); b.st[0] = nloc; b.st[1] = nx; }
        const unsigned old = xb_add(&bar[XB_XSUB(b.x)], 1u);
        const unsigned gen = old / nloc;
        if (old + 1u == (gen + 1u) * nloc) {
            __builtin_amdgcn_fence(__ATOMIC_RELEASE, "agent");
            asm volatile("s_waitcnt vmcnt(0)" ::: "memory");
            const unsigned og = xb_add(&bar[XB_TOP], 1u);
            const unsigned tg = og / nx;
            if (og + 1u == (tg + 1u) * nx) xb_add(&bar[XB_TOPGEN], 1u);
            else XB_SPIN(xb_ld(&bar[XB_TOPGEN]) == tg, bar);
            __builtin_amdgcn_fence(__ATOMIC_ACQUIRE, "agent");
            xb_add(&bar[XB_XGEN(b.x)], 1u);
            asm volatile("s_waitcnt vmcnt(0)" ::: "memory");
        } else {
            XB_SPIN(xb_ld(&bar[XB_XGEN(b.x)]) == gen, bar);
            __builtin_amdgcn_fence(__ATOMIC_ACQUIRE, "agent");
            asm volatile("s_waitcnt vmcnt(0)" ::: "memory");
        }
    }
    __syncthreads();
}


struct Args { const float* in[20]; float* out; unsigned char* ws; int ph_lo, ph_hi, coop, pad; float lam_init[4]; };

__global__ void __launch_bounds__(512, 2) hybrid_fwd(Args a) {
    extern __shared__ __attribute__((aligned(16))) unsigned char lds_raw[];
    LAS unsigned char* lds = (LAS unsigned char*)lds_raw;
    const float* x_in = a.in[0]; const float* mem = a.in[1]; const int* positions = (const int*)a.in[2];
    const float* norm_pre = a.in[3]; const float* norm_post = a.in[4]; const float* w_in = a.in[5]; const float* q_norm = a.in[6]; const float* w_uq = a.in[7];
    const float* kv_norm = a.in[8]; const float* w_ukv = a.in[9]; const float* lq1 = a.in[10]; const float* lk1 = a.in[11]; const float* lq2 = a.in[12]; const float* lk2 = a.in[13];
    const float* diff_subln = a.in[14]; const float* mem_norm = a.in[15]; const float* w_mem_kv = a.in[16]; const float* b_gate = a.in[17]; const float* w_branch = a.in[18]; const float* w_out = a.in[19];
#define P_WT ((bf16_t*)(ws + OFF_W))
#define P_COS ((float*)(ws + OFF_COS))
#define P_SIN ((float*)(ws + OFF_SIN))
#define P_SSQq ((float*)(ws + OFF_SSQQ))
#define P_SSQkv ((float*)(ws + OFF_SSQKV))
#define P_MN ((bf16_t*)(ws + OFF_MN))
#define P_KM ((bf16_t*)(ws + OFF_KM))
#define P_VMT ((bf16_t*)(ws + OFF_VMT))
#define P_XN ((bf16_t*)(ws + OFF_XN))
#define P_OB ((bf16_t*)(ws + OFF_O))
#define P_CQ ((bf16_t*)(ws + OFF_CQ))
#define P_CKV ((bf16_t*)(ws + OFF_CKV))
#define P_KPE ((bf16_t*)(ws + OFF_KPE))
#define P_QD ((bf16_t*)(ws + OFF_QD))
#define P_KD ((bf16_t*)(ws + OFF_KD))
#define P_VDT ((bf16_t*)(ws + OFF_VDT))
#define P_QX ((bf16_t*)(ws + OFF_QX))
#define P_QA ((bf16_t*)(ws + OFF_QA))
#define P_KN ((bf16_t*)(ws + OFF_KN))
#define P_VAT ((bf16_t*)(ws + OFF_VAT))
#define P_SB ((bf16_t*)(ws + OFF_S))
#define P_MG ((bf16_t*)(ws + OFF_MERGED))
#define P_OUTB ((float*)(ws + OFF_OUT))

    volatile LAS unsigned* bst = (volatile LAS unsigned*)(lds + LDS_BYTES - 16);
    if (threadIdx.x < 4) bst[threadIdx.x] = 0u;
    __syncthreads();
    XcdBarrier xbar; xbar.bar = (unsigned*)(a.ws + OFF_BAR); xbar.x = 0; xbar.st = bst;
    if (a.coop) xbar = xcd_barrier_post((unsigned*)(a.ws + OFF_BAR), bst);
    for (int ph = a.ph_lo; ph < a.ph_hi; ++ph) {
        __attribute__((address_space(1))) unsigned char* ws = (__attribute__((address_space(1))) unsigned char*)a.ws; asm volatile("" : "+s"(ws));
        int tid = threadIdx.x; asm volatile("" : "+v"(tid)); const int lane = tid & 63, wave = __builtin_amdgcn_readfirstlane(tid >> 6);
        int G = gridDim.x, bx = blockIdx.x; asm volatile("" : "+s"(G), "+s"(bx));
        const int vcu = (G % 8 == 0) ? (bx % 8) * (G / 8) + bx / 8 : bx;
        const int gw = vcu * 8 + wave, NGW = G * 8;
        if (ph == 0) {
#if PHSEL & 1
            LAS float* scr = (LAS float*)(lds + wave * 16384);
            constexpr int I_IN = 16 * 221, I_UQ = 4 * 24, I_UKV = 2 * 32, I_MEM = 16 * 32, I_BR = 3 * 256, I_OUT = 16 * 32;
            constexpr int I_L = I_IN + I_UQ + I_UKV + I_MEM + I_BR + I_OUT;
            for (int it = gw; it < DEPTH * I_L; it += NGW) {
                const int l = it / I_L; int r = it - l * I_L; bf16_t* wl = P_WT + (size_t)l * WL_TOTAL;
                if (r < I_IN) { const int kb = r / 221, nb = r - kb * 221, n = nb * 32; int dr;
                    if (n < 416) dr = n; else if (n < 1440) dr = n + 96; else if (n < 1952) dr = n - 1440 + 2048; else if (n < 2464) dr = n - 1952 + 1536; else dr = n + 96;
                    transpose_block(w_in + (size_t)l * 1024 * IN_WIDTH, IN_WIDTH, n, norm_pre + l * 1024, wl + WL_IN, 1024, dr, kb * 64, scr, lane); continue; }
                r -= I_IN;
                if (r < I_UQ) { const int kb = r / 24, nb = r - kb * 24, n = nb * 32, h = n / 96, w = n - h * 96; const int dr = (w < 64) ? h * 64 + w : 512 + h * 32 + (w - 64);
                    transpose_block(w_uq + (size_t)l * 256 * 768, 768, n, q_norm + l * 256, wl + WL_UQ, 256, dr, kb * 64, scr, lane); continue; }
                r -= I_UQ;
                if (r < I_UKV) { const int kb = r / 32, nb = r - kb * 32, n = nb * 32, h = n / 128, w = n - h * 128; const int dr = (w < 64) ? h * 64 + w : 512 + h * 64 + (w - 64);
                    transpose_block(w_ukv + (size_t)l * 128 * 1024, 1024, n, kv_norm + l * 128, wl + WL_UKV, 128, dr, kb * 64, scr, lane); continue; }
                r -= I_UKV;
                if (r < I_MEM) { const int kb = r / 32, nb = r - kb * 32;
                    transpose_block(w_mem_kv + (size_t)l * 1024 * 1024, 1024, nb * 32, mem_norm + l * 1024, wl + WL_MEM, 1024, nb * 32, kb * 64, scr, lane); continue; }
                r -= I_MEM;
                if (r < I_BR) { const int i = r / 256, rr = r - i * 256, kb = rr / 32, nb = rr - kb * 32;
                    transpose_block(w_branch + (size_t)(l * 3 + i) * 512 * 1024, 1024, nb * 32, nullptr, wl + WL_BR + (size_t)i * 1024 * 512, 512, nb * 32, kb * 64, scr, lane); continue; }
                r -= I_BR;
                { const int kb = r / 32, nb = r - kb * 32;
                    transpose_block(w_out + (size_t)l * 1024 * 1024, 1024, nb * 32, nullptr, wl + WL_OUT, 1024, nb * 32, kb * 64, scr, lane); }
            }
            for (int i = bx * 512 + tid; i < DEPTH * 96 * 1024 / 8; i += G * 512) { const int l = i / (96 * 1024 / 8), rr = i - l * (96 * 1024 / 8);
                *(u32x4*)(P_WT + (size_t)l * WL_TOTAL + WL_IN + (size_t)416 * 1024 + (size_t)rr * 8) = (u32x4){0u, 0u, 0u, 0u}; }
            for (int i = bx * 512 + tid; i < SEQ * 16; i += G * 512) { const int s = i >> 4, j = i & 15;
                const float invf = powf(10000.0f, -(float)j / 16.0f); const float ang = (float)positions[s] * invf;
                double rv = (double)ang * 0.15915494309189535; rv -= floor(rv); const float f = (float)rv;
                P_COS[i] = __builtin_amdgcn_cosf(f); P_SIN[i] = __builtin_amdgcn_sinf(f); }
            for (int m0 = gw; m0 < MMEM + MTOK; m0 += 2 * NGW) {
                const int m1 = (m0 + NGW < MMEM + MTOK) ? m0 + NGW : m0;
                f32x4 v[2][4]; float ss[2] = {0.f, 0.f};
#pragma unroll
                for (int q = 0; q < 2; ++q) { const int m = q ? m1 : m0; const float* src = (m < MMEM) ? mem + (size_t)m * 1024 : x_in + (size_t)(m - MMEM) * 1024;
#pragma unroll
                    for (int j = 0; j < 4; ++j) v[q][j] = ((const f32x4*)src)[64 * j + lane]; }
#pragma unroll
                for (int q = 0; q < 2; ++q)
#pragma unroll
                    for (int j = 0; j < 4; ++j) ss[q] += (v[q][j][0] * v[q][j][0] + v[q][j][1] * v[q][j][1]) + (v[q][j][2] * v[q][j][2] + v[q][j][3] * v[q][j][3]);
#pragma unroll
                for (int q = 0; q < 2; ++q) { const int m = q ? m1 : m0; bf16_t* dst = (m < MMEM) ? P_MN + (size_t)m * 1024 : P_XN + (size_t)(m - MMEM) * 1024;
                    const float rstd = __builtin_amdgcn_rsqf(wave_sum(ss[q]) * (1.0f / 1024.0f) + NORM_EPS);
#pragma unroll
                    for (int j = 0; j < 4; ++j) store4bf(dst + 4 * (64 * j + lane), v[q][j] * rstd); }
            }
#endif
        } else {
            const int l = (ph - 1) / 7, sub = (ph - 1) % 7;
            const bf16_t* wl = P_WT + (size_t)l * WL_TOTAL;
            if (sub == 0) {
#if PHSEL & 2
#if GSEL & 1
                { pg8::Gemm g{P_XN, wl + WL_IN, MTOK, 2048, 1024, 1024, 1024, 0, 0}; pg8::StaticOrder S; S.init(MTOK, 2048, G, bx);
                  pg8::Epi1 E{P_CQ, P_CKV, P_KPE, P_QD, P_KD, P_QX, P_SSQq, P_SSQkv, P_COS, P_SIN, 0.17677669529663687f * LOG2E, 0.08838834764831845f * LOG2E};
                  pg8::gemm_phase(lds, g, S, E); }
#endif
#if GSEL & 2
                { pg8::Gemm g{wl + WL_IN + (size_t)2048 * 1024, P_XN, 512, MTOK, 1024, 1024, 1024, 0, 0}; pg8::StaticOrder S; S.init(512, MTOK, G, bx);
                  pg8::EpiT E{P_VDT, (size_t)MTOK, 0, nullptr, 0.f, nullptr};
                  pg8::gemm_phase(lds, g, S, E); }
#endif
                if (l == 0) {
#if GSEL & 4
                    { pg8::Gemm g{P_MN, P_WT + WL_MEM, MMEM, 512, 1024, 1024, 1024, 0, WL_TOTAL}; pg8::StaticOrder S; S.init(MMEM, 512, G, bx, DEPTH);
                      pg8::EpiRow E{P_KM, 512, (size_t)MMEM * 512, nullptr, 0.f};
                      pg8::gemm_phase(lds, g, S, E); }
#endif
#if GSEL & 8
                    { pg8::Gemm g{P_WT + WL_MEM + (size_t)512 * 1024, P_MN, 512, MMEM, 1024, 1024, 1024, WL_TOTAL, 0}; pg8::StaticOrder S; S.init(512, MMEM, G, bx, DEPTH);
                      pg8::EpiT E{P_VMT, (size_t)MMEM, (size_t)512 * MMEM, nullptr, 0.f, nullptr};
                      pg8::gemm_phase(lds, g, S, E); }
#endif
                }
#endif
            } else if (sub == 1) {
#if PHSEL & 4
#if GSEL & 16
                { pg8::Gemm g{P_CQ, wl + WL_UQ, MTOK, 768, 256, 256, 256, 0, 0}; pg8::StaticOrder S; S.init(MTOK, 768, G, bx);
                  pg8::Epi2 E{P_QA, P_SSQq, P_COS, P_SIN, 0.10206207261596575f * LOG2E};
                  pg8::gemm_phase(lds, g, S, E); }
#endif
#if GSEL & 32
                { pg8::Gemm g{P_CKV, wl + WL_UKV, MTOK, 512, 128, 128, 128, 0, 0}; pg8::StaticOrder S; S.init(MTOK, 512, G, bx);
                  pg8::EpiRow E{P_KN, 512, 0, P_SSQkv, 1.0f / 128.0f};
                  pg8::gemm_phase(lds, g, S, E); }
#endif
#if GSEL & 64
                { pg8::Gemm g{wl + WL_UKV + (size_t)512 * 128, P_CKV, 512, MTOK, 128, 128, 128, 0, 0}; pg8::StaticOrder S; S.init(512, MTOK, G, bx);
                  pg8::EpiT E{P_VAT, (size_t)MTOK, 0, P_SSQkv, 1.0f / 128.0f, nullptr};
                  pg8::gemm_phase(lds, g, S, E); }
#endif
#endif
            } else if (sub == 2) {
#if PHSEL & 8
                const float d1 = wave_sum(lane < 32 ? lq1[l * 32 + lane] * lk1[l * 32 + lane] : 0.f), d2 = wave_sum(lane < 32 ? lq2[l * 32 + lane] * lk2[l * 32 + lane] : 0.f);
                const float lam_init = a.lam_init[l]; const float lam = expf(d1) - expf(d2) + lam_init;
#if ATTSEL & 1
                for (int P = vcu; P < 512; P += G) { const int bh = P >> 2, s = P & 3, b = bh >> 3, h = bh & 7; const size_t rb = (size_t)b * SEQ;
                    for (int k = 0; k < 2; ++k) { const int qb = k ? s : 7 - s;
                        attn_unit4<96, 64, 64, 32>(lds, P_QA + rb * 768 + h * 96, 768, P_KN + rb * 512 + h * 64, 512, P_KPE + rb * 32, 32, P_VAT + (size_t)(h * 64) * MTOK + rb, (size_t)MTOK,
                                                   qb * 512, 8 * (qb + 1), P_OB + rb * 1536 + h * 64, 1536); } }
#endif
                asm volatile("" ::: "memory"); __builtin_amdgcn_sched_barrier(0);
#if ATTSEL & 2
                for (int P = vcu; P < 1024; P += G) { const int bh = P >> 3, s = P & 7, b = bh >> 3, h = bh & 7; const size_t rb = (size_t)b * SEQ;
                    for (int k = 0; k < 2; ++k) { const int qb = k ? s : 15 - s;
                        attn_unit2<2, 32, 64, 64, 0>(lds, P_QD + rb * 512 + h * 64, 512, P_KD + rb * 512 + h * 64, 512, nullptr, 0, P_VDT + (size_t)(h * 64) * MTOK + rb, (size_t)MTOK,
                                                           qb * 256, 4 * (qb + 1), P_OB + rb * 1536 + 512 + h * 64, 1536, lam, diff_subln + l * 64, 1.0f - lam_init); } }
#endif
                asm volatile("" ::: "memory"); __builtin_amdgcn_sched_barrier(0);
#if ATTSEL & 4
                for (int X = vcu; X < 1024; X += G) { const int bh = X >> 4, qb = X & 15, b = bh >> 2, h = bh & 3; const size_t rb = (size_t)b * SEQ;
                    attn_unit<1, 128, 128, false, 128, 0>(lds, P_QX + rb * 512 + h * 128, 512, P_KM + (size_t)l * MMEM * 512 + (size_t)b * MEMT * 512 + h * 128, 512, nullptr, 0,
                                                           P_VMT + (size_t)l * 512 * MMEM + (size_t)(h * 128) * MMEM + (size_t)b * MEMT, (size_t)MMEM,
                                                           qb * 256, 4, P_OB + rb * 1536 + 1024 + h * 128, 1536, 0.f, nullptr, 1.f); }
#endif
#endif
            } else if (sub == 3) {
#if PHSEL & 16
                { pg8::Gemm g{P_XN, wl + WL_IN + (size_t)2560 * 1024, MTOK, 1536, 1024, 1024, 1024, 0, 0}; pg8::StaticOrder S; S.init(MTOK, 1536, G, bx);
                  pg8::EpiSG E{P_OB};
                  pg8::gemm_phase(lds, g, S, E); }
                { pg8::Gemm g{P_XN, wl + WL_IN + (size_t)4096 * 1024, MTOK, 3072, 1024, 1024, 1024, 0, 0}; pg8::StaticOrder S; S.init(MTOK, 3072, G, bx);
                  pg8::EpiGL E{(unsigned char*)P_SB, b_gate + l * 3072};
                  pg8::gemm_phase(lds, g, S, E); }
#endif
            } else if (sub == 4) {
#if PHSEL & 32
                pg8::Gemm g{P_OB, wl + WL_BR, MTOK, 1024, 512, 1536, 512, 512, (size_t)1024 * 512}; pg8::StaticOrder S; S.init(MTOK, 1024, G, bx, 3);
                pg8::EpiBR E{(const unsigned char*)P_SB, P_MG};
                pg8::gemm_phase(lds, g, S, E);
#endif
            } else if (sub == 5) {
#if PHSEL & 64
                pg8::Gemm g{P_MG, wl + WL_OUT, MTOK, 1024, 1024, 1024, 1024, 0, 0}; pg8::StaticOrder S; S.init(MTOK, 1024, G, bx);
                pg8::EpiRow E{(bf16_t*)P_OUTB, 1024, 0, nullptr, 0.f};
                pg8::gemm_phase(lds, g, S, E);
#endif
            } else {
#if PHSEL & 128
                const float* xo = (l == 0) ? x_in : a.out; const float* gp = norm_post + l * 1024;
                for (int m0 = gw; m0 < MTOK; m0 += 2 * NGW) {
                    const int m1 = (m0 + NGW < MTOK) ? m0 + NGW : m0;
                    f32x4 v[2][4], xv[2][4]; float s[2] = {0.f, 0.f};
#pragma unroll
                    for (int q = 0; q < 2; ++q) { const int m = q ? m1 : m0;
#pragma unroll
                        for (int j = 0; j < 4; ++j) { v[q][j] = unpack4bf(((const u32x2*)((const bf16_t*)P_OUTB + (size_t)m * 1024))[64 * j + lane]); xv[q][j] = ((const f32x4*)(xo + (size_t)m * 1024))[64 * j + lane]; } }
#pragma unroll
                    for (int q = 0; q < 2; ++q)
#pragma unroll
                        for (int j = 0; j < 4; ++j) s[q] += (v[q][j][0] * v[q][j][0] + v[q][j][1] * v[q][j][1]) + (v[q][j][2] * v[q][j][2] + v[q][j][3] * v[q][j][3]);
#pragma unroll
                    for (int q = 0; q < 2; ++q) { const int m = q ? m1 : m0;
                        const float rstd = __builtin_amdgcn_rsqf(wave_sum(s[q]) * (1.0f / 1024.0f) + NORM_EPS); float s2 = 0.f;
#pragma unroll
                        for (int j = 0; j < 4; ++j) { const f32x4 gv = ((const f32x4*)gp)[64 * j + lane];
                            v[q][j] = xv[q][j] + v[q][j] * rstd * gv; ((f32x4*)(a.out + (size_t)m * 1024))[64 * j + lane] = v[q][j];
                            s2 += (v[q][j][0] * v[q][j][0] + v[q][j][1] * v[q][j][1]) + (v[q][j][2] * v[q][j][2] + v[q][j][3] * v[q][j][3]); }
                        if (l + 1 < DEPTH) { const float rstd2 = __builtin_amdgcn_rsqf(wave_sum(s2) * (1.0f / 1024.0f) + NORM_EPS);
#pragma unroll
                            for (int j = 0; j < 4; ++j) store4bf(P_XN + (size_t)m * 1024 + 4 * (64 * j + lane), v[q][j] * rstd2); } }
                }
#endif
            }
        }
        if (ph + 1 < a.ph_hi) { if (a.coop) { if (ph == 0) cg::this_grid().sync(); else xcd_barrier(xbar); } }
    }
#ifdef DBG_NPH
    if (a.pad) {
        if (a.coop) cg::this_grid().sync();
        const unsigned short* w16 = (const unsigned short*)(a.ws + OFF_MN);
        const size_t n16 = (WS_END - OFF_MN) / 2, nout = (size_t)MTOK * 1024;
        for (size_t i = (size_t)blockIdx.x * 512 + threadIdx.x; i < nout; i += (size_t)gridDim.x * 512) {
            unsigned x = 0; for (size_t k = i; k < n16; k += nout) x ^= w16[k];
            const unsigned short* w2 = (const unsigned short*)(a.ws + OFF_COS); if (i < (size_t)(4 * MiB) / 2) x ^= w2[i];
            a.out[i] = (float)x;
        }
    }
#endif
}

extern "C" void kernel_launch(void* const* d_in, const int* in_sizes, int n_in, void* d_out, int out_size, void* d_ws, size_t ws_size, hipStream_t stream) {
    static int grid = 0;
    if (grid == 0) {
        if (n_in != 20 || ws_size < WS_END) { fprintf(stderr, "kernel_launch: need 20 inputs and >= %zu bytes of workspace (got %d, %zu)\n", (size_t)WS_END, n_in, ws_size); grid = -1; return; }
        int dev = 0, cus = 0, per_cu = 0;
        hipGetDevice(&dev); hipDeviceGetAttribute(&cus, hipDeviceAttributeMultiprocessorCount, dev);
        if (hipFuncSetAttribute((const void*)hybrid_fwd, hipFuncAttributeMaxDynamicSharedMemorySize, LDS_BYTES) != hipSuccess) { fprintf(stderr, "kernel_launch: hipFuncSetAttribute failed\n"); grid = -1; return; }
        if (hipOccupancyMaxActiveBlocksPerMultiprocessor(&per_cu, (const void*)hybrid_fwd, 512, LDS_BYTES) != hipSuccess || per_cu < 1) per_cu = 1;
        (void)hipGetLastError();
        grid = cus * 1;
    }
    if (grid < 0) return;
    if (hipMemsetAsync((char*)d_ws + OFF_BAR, 0, 16384, stream) != hipSuccess) { fprintf(stderr, "kernel_launch: hipMemsetAsync failed\n"); return; }
    Args a{};
    for (int i = 0; i < 20; ++i) a.in[i] = (const float*)d_in[i];
    a.out = (float*)d_out; a.ws = (unsigned char*)d_ws; a.pad = 0;
    a.lam_init[0] = 0.2f; a.lam_init[1] = 0.35550906759096926f; a.lam_init[2] = 0.47071301834358424f; a.lam_init[3] = 0.55605820415654f;
#if MK_ONE_LAUNCH
#ifdef DBG_NPH
    a.ph_lo = 0; a.ph_hi = DBG_NPH; a.coop = 1; a.pad = 1;
#else
    a.ph_lo = 0; a.ph_hi = NPHASE; a.coop = 1;
#endif
    void* args[] = {&a};
    hipError_t e = hipLaunchCooperativeKernel((const void*)hybrid_fwd, dim3(grid), dim3(512), args, LDS_BYTES, stream);
    if (e != hipSuccess) fprintf(stderr, "cooperative launch failed: %s (grid %d)\n", hipGetErrorString(e), grid);
#else
    for (int ph = 0; ph < NPHASE; ++ph) { a.ph_lo = ph; a.ph_hi = ph + 1; a.coop = 0;
        hipLaunchKernelGGL(hybrid_fwd, dim3(grid), dim3(512), LDS_BYTES, stream, a); }
#endif
}
```

```cpp
#include <hip/hip_runtime.h>
#include <hip/hip_cooperative_groups.h>
#include <cstdio>
#include <cstdint>
namespace cg = cooperative_groups;

#ifndef ATTSEL
#define ATTSEL 7
#endif
#ifndef GSEL
#define GSEL 0xFFFF
#endif
#ifndef PHSEL
#define PHSEL 0xFFFF
#endif
#ifndef MK_ONE_LAUNCH
#define MK_ONE_LAUNCH 1
#endif

#define LAS __attribute__((address_space(3)))
typedef unsigned short bf16_t;
typedef short bf16x8 __attribute__((ext_vector_type(8)));
typedef short s16x4 __attribute__((ext_vector_type(4)));
typedef float f32x4 __attribute__((ext_vector_type(4)));
typedef float f32x16 __attribute__((ext_vector_type(16)));
typedef unsigned u32x4 __attribute__((ext_vector_type(4)));
typedef unsigned u32x2 __attribute__((ext_vector_type(2)));
typedef float f32x2_t __attribute__((ext_vector_type(2)));
typedef __bf16 bf16x2_t __attribute__((ext_vector_type(2)));

constexpr int D_MODEL = 1024, BATCH = 16, SEQ = 4096, DEPTH = 4, MEMT = 256;
constexpr int MTOK = BATCH * SEQ;
constexpr int MMEM = BATCH * MEMT;
constexpr int IN_WIDTH = 7072;
constexpr float NORM_EPS = 1e-6f;
constexpr float LOG2E = 1.4426950408889634f;

constexpr size_t WL_IN = 0;
constexpr size_t WL_UQ = WL_IN + (size_t)7168 * 1024;
constexpr size_t WL_UKV = WL_UQ + (size_t)768 * 256;
constexpr size_t WL_MEM = WL_UKV + (size_t)1024 * 128;
constexpr size_t WL_BR = WL_MEM + (size_t)1024 * 1024;
constexpr size_t WL_OUT = WL_BR + (size_t)3 * 1024 * 512;
constexpr size_t WL_TOTAL = WL_OUT + (size_t)1024 * 3072;

constexpr size_t MiB = 1u << 20;
constexpr size_t OFF_W = 0;
constexpr size_t OFF_COS = 104 * MiB, OFF_SIN = OFF_COS + 256 * 1024;
constexpr size_t OFF_SSQQ = 105 * MiB, OFF_SSQKV = 106 * MiB;
constexpr size_t OFF_BAR = 107 * MiB;
constexpr size_t OFF_MN = 108 * MiB;
constexpr size_t OFF_KM = 116 * MiB;
constexpr size_t OFF_VMT = 132 * MiB;
constexpr size_t OFF_XN = 148 * MiB;
constexpr size_t OFF_O = 276 * MiB;
constexpr size_t OFF_R = 468 * MiB;
constexpr size_t OFF_CQ = OFF_R;
constexpr size_t OFF_CKV = OFF_CQ + 32 * MiB;
constexpr size_t OFF_KPE = OFF_CKV + 16 * MiB;
constexpr size_t OFF_QD = OFF_KPE + 4 * MiB;
constexpr size_t OFF_KD = OFF_QD + 64 * MiB;
constexpr size_t OFF_VDT = OFF_KD + 64 * MiB;
constexpr size_t OFF_QX = OFF_VDT + 64 * MiB;
constexpr size_t OFF_QA = OFF_QX + 64 * MiB;
constexpr size_t OFF_KN = OFF_QA + 96 * MiB;
constexpr size_t OFF_VAT = OFF_KN + 64 * MiB;
constexpr size_t WS_END = OFF_VAT + 64 * MiB;
constexpr size_t OFF_S = OFF_R;
constexpr size_t OFF_MERGED = OFF_R + 384 * MiB;
constexpr size_t OFF_OUT = OFF_R;
static_assert(4 * WL_TOTAL * 2 <= OFF_COS && OFF_MERGED + 128 * MiB <= WS_END, "ws map");

constexpr int LDS_BYTES = 163840;
constexpr int NPHASE = 1 + 7 * DEPTH;

__device__ __forceinline__ unsigned cvtpk(float lo, float hi) { f32x2_t v = {lo, hi}; bf16x2_t b = __builtin_convertvector(v, bf16x2_t); return __builtin_bit_cast(unsigned, b); }
__device__ __forceinline__ void store4bf(bf16_t* p, f32x4 v) { u32x2 w; w.x = cvtpk(v[0], v[1]); w.y = cvtpk(v[2], v[3]); *(u32x2*)p = w; }
__device__ __forceinline__ f32x4 unpack4bf(u32x2 w) { f32x4 r; r[0] = __uint_as_float(w.x << 16); r[1] = __uint_as_float(w.x & 0xffff0000u); r[2] = __uint_as_float(w.y << 16); r[3] = __uint_as_float(w.y & 0xffff0000u); return r; }
__device__ __forceinline__ void store8bf(bf16_t* p, f32x4 a, f32x4 b) { u32x4 w; w.x = cvtpk(a[0], a[1]); w.y = cvtpk(a[2], a[3]); w.z = cvtpk(b[0], b[1]); w.w = cvtpk(b[2], b[3]); *(u32x4*)p = w; }
__device__ __forceinline__ float fast_rcp(float x) { return __builtin_amdgcn_rcpf(x); }
__device__ __forceinline__ float fast_exp2(float x) { return __builtin_amdgcn_exp2f(x); }
__device__ __forceinline__ float sigmoidf_(float v) { return fast_rcp(1.0f + fast_exp2(-v * LOG2E)); }

namespace pg8 {
constexpr int BM = 256, BK = 64, HALF = 128, HTB = HALF * BK * 2, STAGE_BYTES = 8 * HTB, NXCD = 8, WGM = 8;
__host__ __device__ __forceinline__ int lds_byte(int r, int c) { const int st = (r >> 4) * 2 + (c >> 5), rr = r & 15, cc = c & 31, ob = rr * 64 + cc * 2; return st * 1024 + (ob ^ (((ob >> 9) & 1) << 5)); }
__host__ __device__ __forceinline__ void stage_rc(int b, int& R, int& C) { const int st = b / 1024, sb = b % 1024, swz = sb ^ (((sb >> 9) & 1) << 5); R = (st >> 1) * 16 + swz / 64; C = (st & 1) * 32 + (swz % 64) / 2; }

__host__ __device__ __forceinline__ int perm32(int rho) { const int n = rho >> 4, i = rho & 15; return 8 * (i >> 2) + 4 * n + (i & 3); }
struct Unit { int pm, pn, z; };
struct Gemm { const bf16_t* A; const bf16_t* Bt; int M, N, K, lda, ldb; size_t zA, zB; };

struct StaticOrder {
    int nM, nN, nwg, G, c, nz;
    __device__ void init(int M, int N, int G_, int c_, int nz_ = 1) { nM = M / BM; nN = N / BM; nwg = nM * nN; G = G_; c = c_; nz = nz_; }
    __device__ bool next(int i, Unit& u) const {
        const int ib = i / nz; u.z = i - ib * nz;
        const long L = (long)ib * G + c; if (L >= nwg) return false;
        int wgid = (int)L; { const int q = nwg / NXCD, r = nwg % NXCD, xcd = wgid % NXCD, off = wgid / NXCD; wgid = (xcd < r ? xcd * (q + 1) : r * (q + 1) + (xcd - r) * q) + off; }
        const int nig = WGM * nN, gid = wgid / nig, fm = gid * WGM, gsz = (nM - fm) < WGM ? (nM - fm) : WGM;
        u.pm = fm + ((wgid % nig) % gsz); u.pn = (wgid % nig) / gsz; return true;
    }
};

template <class Epi>
__device__ __forceinline__ void gemm_phase(LAS unsigned char* lds, const Gemm g, const StaticOrder& S, const Epi& E) {
    int tid = threadIdx.x; asm volatile("" : "+v"(tid));
    const int wid = __builtin_amdgcn_readfirstlane(tid >> 6), lane = tid & 63, wr = wid >> 2, wc = wid & 3, fr = lane & 15, fq = lane >> 4;
    int K = g.K; asm volatile("" : "+s"(K)); const int nt = K / BK;
    unsigned voffA[2], voffB[2];
#pragma unroll
    for (int i = 0; i < 2; ++i) { int R, C; stage_rc(tid * 16 + i * 8192, R, C);
        const int Rb = Epi::PERM ? ((R & ~31) + perm32(R & 31)) : R;
        voffA[i] = (unsigned)(R * g.lda + C) * 2u; voffB[i] = (unsigned)(Rb * g.ldb + C) * 2u; }
    const size_t kstep = (size_t)(BK * 2);
    const size_t hstepA = (size_t)HALF * g.lda * 2, hstepB = (size_t)HALF * g.ldb * 2;
    const size_t tstepA = 2 * hstepA, tstepB = 2 * hstepB;
    const unsigned ldsw = (unsigned)wid * 1024u;
    const int aoff = lds_byte(wr * 64 + fr, fq * 8), boff = lds_byte(wc * 32 + fr, fq * 8);
#define PG8_SA(b, h) (((b) * 2 + (h)) * HTB)
#define PG8_SB(b, h) ((4 + (b) * 2 + (h)) * HTB)
#define PG8_STAGE(bufoff, gbase, voff) do { _Pragma("unroll") for (int _i = 0; _i < 2; ++_i) \
        __builtin_amdgcn_global_load_lds((const unsigned*)((const char*)(gbase) + (voff)[_i]), (LAS unsigned*)(lds + (bufoff) + ldsw + _i * 8192), 16, 0, 0); } while (0)
#define PG8_LDA(dst, b, h) do { _Pragma("unroll") for (int m = 0; m < 4; ++m) _Pragma("unroll") for (int k = 0; k < 2; ++k) dst[m][k] = *(const LAS bf16x8*)(lds + PG8_SA(b, h) + aoff + m * 2048 + k * 1024); } while (0)
#define PG8_LDB(dst, b, h) do { _Pragma("unroll") for (int n = 0; n < 2; ++n) _Pragma("unroll") for (int k = 0; k < 2; ++k) dst[n][k] = *(const LAS bf16x8*)(lds + PG8_SB(b, h) + boff + n * 2048 + k * 1024); } while (0)
#define PG8_MMA(ai, bj, At, Bt) do { __builtin_amdgcn_s_setprio(1); _Pragma("unroll") for (int m = 0; m < 4; ++m) _Pragma("unroll") for (int n = 0; n < 2; ++n) _Pragma("unroll") for (int k = 0; k < 2; ++k) \
        acc[ai][bj][m][n] = __builtin_amdgcn_mfma_f32_16x16x32_bf16(Bt[n][k], At[m][k], acc[ai][bj][m][n], 0, 0, 0); __builtin_amdgcn_s_setprio(0); } while (0)
#define PG8_WAIT_V(n) asm volatile("s_waitcnt vmcnt(" #n ")" ::: "memory")
#define PG8_WAIT_L(n) asm volatile("s_waitcnt lgkmcnt(" #n ")" ::: "memory")
#define PG8_BAR __builtin_amdgcn_s_barrier()
#define PG8_SCHED __builtin_amdgcn_sched_barrier(0)
    Unit cur, nxt; int ui = 0;
    if (!S.next(0, cur)) return;
    f32x4 acc[2][2][4][2];
#pragma unroll
    for (int a = 0; a < 2; ++a)
#pragma unroll
        for (int b = 0; b < 2; ++b)
#pragma unroll
            for (int m = 0; m < 4; ++m)
#pragma unroll
                for (int n = 0; n < 2; ++n) acc[a][b][m][n] = (f32x4){0.f, 0.f, 0.f, 0.f};
    bf16x8 At[4][2], B0[2][2], B1[2][2];
    const char* cA = (const char*)g.A + ((size_t)cur.z * g.zA) * 2 + (size_t)cur.pm * tstepA;
    const char* cB = (const char*)g.Bt + ((size_t)cur.z * g.zB) * 2 + (size_t)cur.pn * tstepB;
    PG8_STAGE(PG8_SB(0, 0), cB, voffB); PG8_STAGE(PG8_SB(0, 1), cB + hstepB, voffB); PG8_STAGE(PG8_SA(0, 0), cA, voffA); PG8_STAGE(PG8_SA(0, 1), cA + hstepA, voffA);
    if (wr == 1) PG8_BAR;
    PG8_WAIT_V(2); PG8_BAR;
    PG8_STAGE(PG8_SB(1, 0), cB + kstep, voffB); PG8_STAGE(PG8_SA(1, 0), cA + kstep, voffA); PG8_STAGE(PG8_SB(1, 1), cB + hstepB + kstep, voffB);
    PG8_WAIT_V(6); PG8_BAR;
    for (;;) {
        const bool has_next = S.next(ui + 1, nxt);
        const char* nA = has_next ? (const char*)g.A + ((size_t)nxt.z * g.zA) * 2 + (size_t)nxt.pm * tstepA : cA;
        const char* nB = has_next ? (const char*)g.Bt + ((size_t)nxt.z * g.zB) * 2 + (size_t)nxt.pn * tstepB : cB;
        for (int t = 0; t < nt; t += 2) {
            const bool last = (t == nt - 2);
            const char* a1 = cA + (size_t)(t + 1) * kstep;
            const char* a2 = last ? nA : cA + (size_t)(t + 2) * kstep; const char* b2 = last ? nB : cB + (size_t)(t + 2) * kstep;
            const char* a3 = a2 + kstep; const char* b3 = b2 + kstep;
            PG8_LDB(B0, 0, 0); PG8_LDB(B1, 0, 1); PG8_SCHED; PG8_LDA(At, 0, 0); PG8_STAGE(PG8_SA(1, 1), a1 + hstepA, voffA);
            PG8_WAIT_V(8); PG8_WAIT_L(0); PG8_BAR; PG8_MMA(0, 0, At, B0); PG8_MMA(0, 1, At, B1); PG8_BAR; PG8_SCHED;
            PG8_LDA(At, 0, 1); PG8_STAGE(PG8_SB(0, 0), b2, voffB); PG8_STAGE(PG8_SB(0, 1), b2 + hstepB, voffB); PG8_STAGE(PG8_SA(0, 0), a2, voffA);
            PG8_WAIT_V(8); PG8_WAIT_L(0); PG8_BAR; PG8_MMA(1, 0, At, B0); PG8_MMA(1, 1, At, B1); PG8_BAR; PG8_SCHED;
            PG8_LDB(B0, 1, 0); PG8_LDB(B1, 1, 1); PG8_SCHED; PG8_LDA(At, 1, 0); PG8_STAGE(PG8_SA(0, 1), a2 + hstepA, voffA);
            PG8_WAIT_V(8); PG8_WAIT_L(0); PG8_BAR; PG8_MMA(0, 0, At, B0); PG8_MMA(0, 1, At, B1); PG8_BAR; PG8_SCHED;
            PG8_LDA(At, 1, 1); PG8_STAGE(PG8_SB(1, 0), b3, voffB); PG8_STAGE(PG8_SB(1, 1), b3 + hstepB, voffB); PG8_STAGE(PG8_SA(1, 0), a3, voffA);
            PG8_WAIT_V(8); PG8_WAIT_L(0); PG8_BAR; PG8_MMA(1, 0, At, B0); PG8_MMA(1, 1, At, B1); PG8_BAR; PG8_SCHED;
        }
        if (wr == 0) PG8_BAR;
        E(acc, cur, wr, wc, fr, fq);
        if (!has_next) break;
#pragma unroll
        for (int a = 0; a < 2; ++a)
#pragma unroll
            for (int b = 0; b < 2; ++b)
#pragma unroll
                for (int m = 0; m < 4; ++m)
#pragma unroll
                    for (int n = 0; n < 2; ++n) acc[a][b][m][n] = (f32x4){0.f, 0.f, 0.f, 0.f};
        cur = nxt; cA = nA; cB = nB; ++ui;
        if (wr == 1) PG8_BAR;
    }
    PG8_WAIT_V(0);
    PG8_BAR;
    asm volatile("" ::: "memory"); PG8_SCHED;
#undef PG8_SA
#undef PG8_SB
#undef PG8_STAGE
#undef PG8_LDA
#undef PG8_LDB
#undef PG8_MMA
#undef PG8_WAIT_V
#undef PG8_WAIT_L
#undef PG8_BAR
#undef PG8_SCHED
}

#define EPI_ROWS_BEGIN _Pragma("unroll") for (int ai = 0; ai < 2; ++ai) _Pragma("unroll") for (int m = 0; m < 4; ++m) { const int row = u.pm * BM + ai * HALF + wr * 64 + m * 16 + fr;
#define EPI_ROWS_END if (m & 1) asm volatile("" ::: "memory"); }
#define EPI_COLS_BEGIN _Pragma("unroll") for (int bj = 0; bj < 2; ++bj) _Pragma("unroll") for (int n = 0; n < 2; ++n) { const int colt = bj * HALF + wc * 32 + n * 16 + 4 * fq;
#define EPI_COLS_END }
typedef f32x4 Acc[2][2][4][2];

__device__ __forceinline__ float rstd4(const float* ssq, int row, float inv_dim) { const f32x4 p = *(const f32x4*)(ssq + (size_t)row * 4); return __builtin_amdgcn_rsqf(((p[0] + p[1]) + (p[2] + p[3])) * inv_dim + NORM_EPS); }

struct Epi1 {
    static constexpr bool PERM = false;
    bf16_t *CQ, *CKV, *KPE, *QD, *KD, *QX; float *SSQq, *SSQkv; const float *COS, *SIN; float sc_d, sc_x;
    __device__ __forceinline__ void operator()(const Acc& acc, const Unit& u, int wr, int wc, int fr, int fq) const {
        const int pn = u.pn;
        EPI_ROWS_BEGIN
            const float r = 1.0f;
            if (pn == 0) {
                float ss = 0.f;
                EPI_COLS_BEGIN const f32x4 v = acc[ai][bj][m][n] * r; ss += (v[0] * v[0] + v[1] * v[1]) + (v[2] * v[2] + v[3] * v[3]); store4bf(CQ + (size_t)row * 256 + colt, v); EPI_COLS_END
                ss += __shfl_xor(ss, 16); ss += __shfl_xor(ss, 32);
                if (fq == 0) SSQq[(size_t)row * 4 + wc] = ss;
            } else if (pn == 1) {
                float ss = 0.f;
#pragma unroll
                for (int n = 0; n < 2; ++n) { const f32x4 v = acc[ai][0][m][n] * r; ss += (v[0] * v[0] + v[1] * v[1]) + (v[2] * v[2] + v[3] * v[3]); store4bf(CKV + (size_t)row * 128 + wc * 32 + n * 16 + 4 * fq, v); }
                ss += __shfl_xor(ss, 16); ss += __shfl_xor(ss, 32);
                if (fq == 0) SSQkv[(size_t)row * 4 + wc] = ss;
                if (wc == 0) {
                    const int s = row & (SEQ - 1); const f32x4 cs = *(const f32x4*)(COS + s * 16 + 4 * fq), sn = *(const f32x4*)(SIN + s * 16 + 4 * fq);
                    const f32x4 x1 = acc[ai][1][m][0] * r, x2 = acc[ai][1][m][1] * r;
                    store4bf(KPE + (size_t)row * 32 + 4 * fq, x1 * cs - x2 * sn); store4bf(KPE + (size_t)row * 32 + 16 + 4 * fq, x2 * cs + x1 * sn);
                }
            } else if (pn < 6) {
                bf16_t* dst = (pn < 4 ? QD : KD) + (size_t)row * 512 + (pn & 1) * 256 + wc * 32 + 4 * fq; const float sc = (pn < 4 ? sc_d : 1.0f) * r;
                const int s = row & (SEQ - 1); const f32x4 cs = *(const f32x4*)(COS + s * 16 + 4 * fq), sn = *(const f32x4*)(SIN + s * 16 + 4 * fq);
#pragma unroll
                for (int bj = 0; bj < 2; ++bj) { const f32x4 x1 = acc[ai][bj][m][0] * sc, x2 = acc[ai][bj][m][1] * sc;
                    store4bf(dst + bj * HALF, x1 * cs - x2 * sn); store4bf(dst + bj * HALF + 16, x2 * cs + x1 * sn); }
            } else {
                const float sc = sc_x * r;
                EPI_COLS_BEGIN store4bf(QX + (size_t)row * 512 + (pn - 6) * 256 + colt, acc[ai][bj][m][n] * sc); EPI_COLS_END
            }
        EPI_ROWS_END
    }
};
#define EPIP_BJ_BEGIN _Pragma("unroll") for (int bj = 0; bj < 2; ++bj) { const int colt = bj * HALF + wc * 32 + 8 * fq;
#define EPIP_BJ_END }
struct EpiT {
    static constexpr bool PERM = true;
    bf16_t* O; size_t ldc; size_t zO; const float* ssq; float inv_dim; const float* colscale;
    __device__ __forceinline__ void operator()(const Acc& acc, const Unit& u, int wr, int wc, int fr, int fq) const {
        f32x4 cs[2][2];
        EPIP_BJ_BEGIN
            const int col = u.pn * BM + colt;
#pragma unroll
            for (int n = 0; n < 2; ++n) {
                if (ssq) { for (int i = 0; i < 4; ++i) cs[bj][n][i] = rstd4(ssq, col + 4 * n + i, inv_dim); }
                else cs[bj][n] = (f32x4){1.f, 1.f, 1.f, 1.f}; }
        EPIP_BJ_END
        bf16_t* base = O + (size_t)u.z * zO;
        EPI_ROWS_BEGIN
            EPIP_BJ_BEGIN store8bf(base + (size_t)row * ldc + u.pn * BM + colt, acc[ai][bj][m][0] * cs[bj][0], acc[ai][bj][m][1] * cs[bj][1]); EPIP_BJ_END
        EPI_ROWS_END
    }
};
struct EpiRow {
    static constexpr bool PERM = true;
    bf16_t* O; size_t ldc; size_t zO; const float* ssq; float inv_dim;
    __device__ __forceinline__ void operator()(const Acc& acc, const Unit& u, int wr, int wc, int fr, int fq) const {
        bf16_t* base = O + (size_t)u.z * zO;
        EPI_ROWS_BEGIN
            const float sc = ssq ? rstd4(ssq, row, inv_dim) : 1.0f;
            EPIP_BJ_BEGIN store8bf(base + (size_t)row * ldc + u.pn * BM + colt, acc[ai][bj][m][0] * sc, acc[ai][bj][m][1] * sc); EPIP_BJ_END
        EPI_ROWS_END
    }
};
struct Epi2 {
    static constexpr bool PERM = false;
    bf16_t* QA; const float* SSQq; const float *COS, *SIN; float sc_a;
    __device__ __forceinline__ void operator()(const Acc& acc, const Unit& u, int wr, int wc, int fr, int fq) const {
        EPI_ROWS_BEGIN
            const float sc = rstd4(SSQq, row, 1.0f / 256.0f) * sc_a;
            if (u.pn < 2) {
                EPI_COLS_BEGIN const int nn = u.pn * BM + colt; store4bf(QA + (size_t)row * 768 + (nn >> 6) * 96 + (nn & 63), acc[ai][bj][m][n] * sc); EPI_COLS_END
            } else {
                const int s = row & (SEQ - 1); const f32x4 cs = *(const f32x4*)(COS + s * 16 + 4 * fq), sn = *(const f32x4*)(SIN + s * 16 + 4 * fq);
#pragma unroll
                for (int bj = 0; bj < 2; ++bj) { const f32x4 x1 = acc[ai][bj][m][0] * sc, x2 = acc[ai][bj][m][1] * sc; bf16_t* dst = QA + (size_t)row * 768 + (4 * bj + wc) * 96 + 64 + 4 * fq;
                    store4bf(dst, x1 * cs - x2 * sn); store4bf(dst + 16, x2 * cs + x1 * sn); }
            }
        EPI_ROWS_END
    }
};
struct EpiSG {
    static constexpr bool PERM = true;
    bf16_t* O;
    __device__ __forceinline__ void operator()(const Acc& acc, const Unit& u, int wr, int wc, int fr, int fq) const {
#pragma unroll
        for (int ai = 0; ai < 2; ++ai) {
            u32x4 ov[4][2];
#pragma unroll
            for (int m = 0; m < 4; ++m) { const int row = u.pm * BM + ai * HALF + wr * 64 + m * 16 + fr;
                EPIP_BJ_BEGIN ov[m][bj] = *(const u32x4*)(O + (size_t)row * 1536 + u.pn * BM + colt); EPIP_BJ_END }
#pragma unroll
            for (int m = 0; m < 4; ++m) { const int row = u.pm * BM + ai * HALF + wr * 64 + m * 16 + fr;
                EPIP_BJ_BEGIN u32x2 lo_, hi_; lo_.x = ov[m][bj].x; lo_.y = ov[m][bj].y; hi_.x = ov[m][bj].z; hi_.y = ov[m][bj].w;
                    const f32x4 o0 = unpack4bf(lo_), o1 = unpack4bf(hi_); const f32x4 g0 = acc[ai][bj][m][0], g1 = acc[ai][bj][m][1]; f32x4 v0, v1;
#pragma unroll
                    for (int i = 0; i < 4; ++i) { v0[i] = o0[i] * g0[i] * sigmoidf_(g0[i]); v1[i] = o1[i] * g1[i] * sigmoidf_(g1[i]); }
                    store8bf(O + (size_t)row * 1536 + u.pn * BM + colt, v0, v1); EPIP_BJ_END }
            asm volatile("" ::: "memory");
        }
    }
};
struct EpiGL {
    static constexpr bool PERM = true;
    bf16_t* S; const float* bias;
    __device__ __forceinline__ void operator()(const Acc& acc, const Unit& u, int wr, int wc, int fr, int fq) const {
        f32x4 bv[2][2];
        EPIP_BJ_BEGIN bv[bj][0] = *(const f32x4*)(bias + u.pn * BM + colt); bv[bj][1] = *(const f32x4*)(bias + u.pn * BM + colt + 4); EPIP_BJ_END
        EPI_ROWS_BEGIN
            EPIP_BJ_BEGIN const f32x4 g0 = acc[ai][bj][m][0] + bv[bj][0], g1 = acc[ai][bj][m][1] + bv[bj][1]; f32x4 v0, v1;
#pragma unroll
                for (int i = 0; i < 4; ++i) { v0[i] = sigmoidf_(g0[i]); v1[i] = sigmoidf_(g1[i]); }
                store8bf(S + (size_t)row * 3072 + u.pn * BM + colt, v0, v1); EPIP_BJ_END
        EPI_ROWS_END
    }
};
struct EpiBR {
    static constexpr bool PERM = true;
    const bf16_t* S; bf16_t* MG;
    __device__ __forceinline__ void operator()(const Acc& acc, const Unit& u, int wr, int wc, int fr, int fq) const {
#pragma unroll
        for (int ai = 0; ai < 2; ++ai) {
            u32x4 sv[4][2]; unsigned long long mv[4][2][2];
#pragma unroll
            for (int m = 0; m < 4; ++m) { const int row = u.pm * BM + ai * HALF + wr * 64 + m * 16 + fr;
                EPIP_BJ_BEGIN const int col = u.pn * BM + colt; sv[m][bj] = *(const u32x4*)(S + (size_t)row * 3072 + u.z * 1024 + col);
                    const unsigned long long* mp_ = (const unsigned long long*)(MG + (size_t)row * 1024 + col);
                    mv[m][bj][0] = (u.z > 0) ? __hip_atomic_load(mp_, __ATOMIC_RELAXED, __HIP_MEMORY_SCOPE_AGENT) : 0ull;
                    mv[m][bj][1] = (u.z > 0) ? __hip_atomic_load(mp_ + 1, __ATOMIC_RELAXED, __HIP_MEMORY_SCOPE_AGENT) : 0ull; EPIP_BJ_END }
#pragma unroll
            for (int m = 0; m < 4; ++m) { const int row = u.pm * BM + ai * HALF + wr * 64 + m * 16 + fr;
                EPIP_BJ_BEGIN const int col = u.pn * BM + colt; u32x2 lo_, hi_; lo_.x = sv[m][bj].x; lo_.y = sv[m][bj].y; hi_.x = sv[m][bj].z; hi_.y = sv[m][bj].w;
                    f32x4 v0 = unpack4bf(lo_) * acc[ai][bj][m][0], v1 = unpack4bf(hi_) * acc[ai][bj][m][1];
                    u32x2 w0, w1; w0.x = (unsigned)mv[m][bj][0]; w0.y = (unsigned)(mv[m][bj][0] >> 32); w1.x = (unsigned)mv[m][bj][1]; w1.y = (unsigned)(mv[m][bj][1] >> 32);
                    v0 += unpack4bf(w0); v1 += unpack4bf(w1);
                    store8bf(MG + (size_t)row * 1024 + col, v0, v1); EPIP_BJ_END }
            asm volatile("" ::: "memory");
        }
    }
};
struct EpiOut {
    static constexpr bool PERM = false;
    float* OUT;
    __device__ __forceinline__ void operator()(const Acc& acc, const Unit& u, int wr, int wc, int fr, int fq) const {
        EPI_ROWS_BEGIN
            EPI_COLS_BEGIN *(f32x4*)(OUT + (size_t)row * 1024 + u.pn * BM + colt) = acc[ai][bj][m][n]; EPI_COLS_END
        EPI_ROWS_END
    }
};
}

__device__ __forceinline__ float max3f(float a, float b, float c) { float r; asm("v_max3_f32 %0, %1, %2, %3" : "=v"(r) : "v"(a), "v"(b), "v"(c)); return r; }
__device__ __forceinline__ float max2f(float a, float b) { float r; asm("v_max_f32_e32 %0, %1, %2" : "=v"(r) : "v"(a), "v"(b)); return r; }
__device__ __forceinline__ float fadd_s(float a, float b) { float r; asm("v_add_f32_e32 %0, %1, %2" : "=v"(r) : "v"(a), "v"(b)); return r; }
__device__ __forceinline__ float rowmax32(const f32x16& p0, const f32x16& p1) {
    float a = max3f(p0[0], p0[1], p1[0]), b = max3f(p0[2], p0[3], p1[1]); a = max3f(a, p1[2], p1[3]);
#pragma unroll
    for (int r = 4; r < 16; r += 4) { a = max3f(a, p0[r], p0[r + 1]); b = max3f(b, p0[r + 2], p0[r + 3]); a = max3f(a, p1[r], p1[r + 1]); b = max3f(b, p1[r + 2], p1[r + 3]); }
    return max2f(a, b);
}
__device__ __forceinline__ float half_max(float v) { auto rr = __builtin_amdgcn_permlane32_swap(__float_as_uint(v), __float_as_uint(v), false, false); return fmaxf(__uint_as_float(rr[0]), __uint_as_float(rr[1])); }
__device__ __forceinline__ float half_sum(float v) { auto rr = __builtin_amdgcn_permlane32_swap(__float_as_uint(v), __float_as_uint(v), false, false); return __uint_as_float(rr[0]) + __uint_as_float(rr[1]); }
__device__ __forceinline__ int crow(int r, int hi) { return (r & 3) + 8 * (r >> 2) + 4 * hi; }

template <int NMAP, int DKM, int DV, bool CAUSAL, int W0, int W1>
__device__ __forceinline__ void attn_unit(LAS unsigned char* lds, const bf16_t* __restrict__ Q, int ldq, const bf16_t* __restrict__ K0, int ldk0, const bf16_t* __restrict__ K1, int ldk1,
                                          const bf16_t* __restrict__ Vt, size_t ldv, int q0, int NT, bf16_t* O, int ldo, float lam, const float* subln, float outscale) {
    constexpr int DKT = NMAP * DKM, KS = DKT * 2 + 16, VS = 136, KBUF = 64 * KS, VBUF = DV * VS;
    constexpr int NC = DKM / 16, NDB = DV / 32;
    constexpr int K0C = W0 / 8, K0N = (64 * K0C) / 512, K1C = W1 / 8, VN = (DV * 8) / 512;
    static_assert(W0 + W1 == DKT && K0N >= 1 && VN >= 1, "attention staging geometry");
    int tid = threadIdx.x; asm volatile("" : "+v"(tid));
    const int lane = tid & 63, wid = __builtin_amdgcn_readfirstlane(tid >> 6), r32 = lane & 31, hi = lane >> 5;
    LAS unsigned char* Kb = lds; LAS unsigned char* Vb = lds + 2 * KBUF;
    bf16x8 qf[NMAP][NC];
    { const bf16_t* qrow = Q + (size_t)(q0 + wid * 32 + r32) * ldq;
#pragma unroll
      for (int mp = 0; mp < NMAP; ++mp)
#pragma unroll
          for (int c = 0; c < NC; ++c) qf[mp][c] = *(const bf16x8*)(qrow + mp * DKM + 16 * c + 8 * hi); }
    f32x16 o[NMAP][NDB]; float mrow[NMAP], lrow[NMAP];
#pragma unroll
    for (int mp = 0; mp < NMAP; ++mp) { mrow[mp] = -INFINITY; lrow[mp] = 0.f;
#pragma unroll
        for (int db = 0; db < NDB; ++db)
#pragma unroll
            for (int r = 0; r < 16; ++r) o[mp][db][r] = 0.f; }
    u32x4 kreg[K0N], k1reg = {0u, 0u, 0u, 0u}, vreg[VN];
#define ATT_GLOAD(t) do { \
    _Pragma("unroll") for (int i = 0; i < K0N; ++i) { const int idx = tid + 512 * i, rr = idx / K0C, cc = idx % K0C; kreg[i] = *(const u32x4*)(K0 + (size_t)(64 * (t) + rr) * ldk0 + cc * 8); } \
    if (W1 > 0) { if (tid < 64 * K1C) { const int rr = tid / (K1C > 0 ? K1C : 1), cc = tid % (K1C > 0 ? K1C : 1); k1reg = *(const u32x4*)(K1 + (size_t)(64 * (t) + rr) * ldk1 + cc * 8); } } \
    _Pragma("unroll") for (int i = 0; i < VN; ++i) { const int idx = tid + 512 * i, dd = idx >> 3, cc = idx & 7; vreg[i] = *(const u32x4*)(Vt + (size_t)dd * ldv + 64 * (t) + cc * 8); } } while (0)
#define ATT_LWRITE(buf) do { \
    _Pragma("unroll") for (int i = 0; i < K0N; ++i) { const int idx = tid + 512 * i, rr = idx / K0C, cc = idx % K0C; *(LAS u32x4*)(Kb + (buf) * KBUF + rr * KS + cc * 16) = kreg[i]; } \
    if (W1 > 0) { if (tid < 64 * K1C) { const int rr = tid / (K1C > 0 ? K1C : 1), cc = tid % (K1C > 0 ? K1C : 1); *(LAS u32x4*)(Kb + (buf) * KBUF + rr * KS + W0 * 2 + cc * 16) = k1reg; } } \
    _Pragma("unroll") for (int i = 0; i < VN; ++i) { const int idx = tid + 512 * i, dd = idx >> 3, cc = idx & 7; LAS u32x2* vp = (LAS u32x2*)(Vb + (buf) * VBUF + dd * VS + cc * 16); \
        u32x2 lo_; lo_.x = vreg[i].x; lo_.y = vreg[i].y; u32x2 hi_; hi_.x = vreg[i].z; hi_.y = vreg[i].w; vp[0] = lo_; vp[1] = hi_; } } while (0)
    ATT_GLOAD(0);
    ATT_LWRITE(0);
    __syncthreads();
    const int qw0 = q0 + wid * 32;
    for (int t = 0; t < NT; ++t) {
        const int buf = t & 1;
        if (t + 1 < NT) ATT_GLOAD(t + 1);
#pragma unroll
        for (int kb = 0; kb < 2; ++kb) {
            const int kv0 = 64 * t + 32 * kb;
            if (CAUSAL && kv0 > qw0) continue;
            const bool diag = CAUSAL && (kv0 == qw0);
            bf16x8 vf[NDB][2];
#pragma unroll
            for (int db = 0; db < NDB; ++db)
#pragma unroll
                for (int j = 0; j < 2; ++j) { const LAS unsigned char* vp = Vb + buf * VBUF + (32 * db + r32) * VS + (32 * kb + 16 * j + 4 * hi) * 2;
                    const s16x4 lo = *(const LAS s16x4*)vp, hh = *(const LAS s16x4*)(vp + 16);
                    vf[db][j] = (bf16x8){lo[0], lo[1], lo[2], lo[3], hh[0], hh[1], hh[2], hh[3]}; }
#pragma unroll
            for (int mp = 0; mp < NMAP; ++mp) {
                f32x16 s;
#pragma unroll
                for (int r = 0; r < 16; ++r) s[r] = 0.f;
#pragma unroll
                for (int c = 0; c < NC; ++c) { const bf16x8 kf = *(const LAS bf16x8*)(Kb + buf * KBUF + (32 * kb + r32) * KS + (mp * DKM + 16 * c + 8 * hi) * 2);
                    s = __builtin_amdgcn_mfma_f32_32x32x16_bf16(kf, qf[mp][c], s, 0, 0, 0); }
                if (diag) {
#pragma unroll
                    for (int r = 0; r < 16; ++r) if (crow(r, hi) > r32) s[r] = -INFINITY;
                }
                float mx = s[0];
#pragma unroll
                for (int r = 1; r < 16; ++r) mx = fmaxf(mx, s[r]);
                mx = fmaxf(mx, __shfl_xor(mx, 32));
                if (__any(mx > mrow[mp])) {
                    const float mnew = fmaxf(mrow[mp], mx), alpha = fast_exp2(mrow[mp] - mnew);
                    mrow[mp] = mnew; lrow[mp] *= alpha;
#pragma unroll
                    for (int db = 0; db < NDB; ++db)
#pragma unroll
                        for (int r = 0; r < 16; ++r) o[mp][db][r] *= alpha;
                }
                const float mcur = mrow[mp]; float ls = 0.f;
#pragma unroll
                for (int r = 0; r < 16; ++r) { s[r] = fast_exp2(s[r] - mcur); ls += s[r]; }
                lrow[mp] += ls;
                bf16x8 pa[2];
#pragma unroll
                for (int j = 0; j < 2; ++j) { u32x4 w; w.x = cvtpk(s[8 * j + 0], s[8 * j + 1]); w.y = cvtpk(s[8 * j + 2], s[8 * j + 3]); w.z = cvtpk(s[8 * j + 4], s[8 * j + 5]); w.w = cvtpk(s[8 * j + 6], s[8 * j + 7]); pa[j] = __builtin_bit_cast(bf16x8, w); }
#pragma unroll
                for (int db = 0; db < NDB; ++db)
#pragma unroll
                    for (int j = 0; j < 2; ++j) o[mp][db] = __builtin_amdgcn_mfma_f32_32x32x16_bf16(vf[db][j], pa[j], o[mp][db], 0, 0, 0);
            }
        }
        if (t + 1 < NT) ATT_LWRITE(buf ^ 1);
        __syncthreads();
    }
#undef ATT_GLOAD
#undef ATT_LWRITE
    float inv[NMAP];
#pragma unroll
    for (int mp = 0; mp < NMAP; ++mp) { const float lt = lrow[mp] + __shfl_xor(lrow[mp], 32); inv[mp] = 1.0f / lt; }
    bf16_t* orow = O + (size_t)(q0 + wid * 32 + r32) * ldo;
    if constexpr (NMAP == 1) {
#pragma unroll
        for (int db = 0; db < NDB; ++db)
#pragma unroll
            for (int g = 0; g < 4; ++g) { f32x4 v; for (int i = 0; i < 4; ++i) v[i] = o[0][db][4 * g + i] * inv[0]; store4bf(orow + 32 * db + 8 * g + 4 * hi, v); }
    } else {
        float ss = 0.f;
#pragma unroll
        for (int db = 0; db < NDB; ++db)
#pragma unroll
            for (int r = 0; r < 16; ++r) { const float v = o[0][db][r] * inv[0] - lam * (o[1][db][r] * inv[1]); o[0][db][r] = v; ss += v * v; }
        ss += __shfl_xor(ss, 32);
        const float rstd = __builtin_amdgcn_rsqf(ss * (1.0f / DV) + NORM_EPS) * outscale;
#pragma unroll
        for (int db = 0; db < NDB; ++db)
#pragma unroll
            for (int g = 0; g < 4; ++g) { const f32x4 gn = *(const f32x4*)(subln + 32 * db + 8 * g + 4 * hi); f32x4 v; for (int i = 0; i < 4; ++i) v[i] = o[0][db][4 * g + i] * rstd * gn[i]; store4bf(orow + 32 * db + 8 * g + 4 * hi, v); }
    }
}

template <int NMAP, int DKM, int DV, int W0, int W1>
__device__ __forceinline__ void attn_unit2(LAS unsigned char* lds, const bf16_t* __restrict__ Q, int ldq, const bf16_t* __restrict__ K0, int ldk0, const bf16_t* __restrict__ K1, int ldk1,
                                           const bf16_t* __restrict__ Vt, size_t ldv, int q0, int NT, bf16_t* O, int ldo, float lam, const float* subln, float outscale) {
    constexpr int DKT = NMAP * DKM, KS = DKT * 2 + 16, VS = 136, KBUF = 64 * KS, VBUF = DV * VS;
    constexpr int NC = DKM / 16, NDB = DV / 32;
    constexpr int K0C = W0 / 8, K0N = (64 * K0C) / 512, K1C = W1 / 8, VN = (DV * 8) / 512;
    static_assert(W0 + W1 == DKT && K0N >= 1 && VN >= 1, "attention staging geometry");
    int tid = threadIdx.x; asm volatile("" : "+v"(tid));
    const int lane = tid & 63, wid = __builtin_amdgcn_readfirstlane(tid >> 6), r32 = lane & 31, hi = lane >> 5;
    LAS unsigned char* Kb = lds; LAS unsigned char* Vb = lds + 2 * KBUF;
    bf16x8 qf[NMAP][NC];
    { const bf16_t* qrow = Q + (size_t)(q0 + wid * 32 + r32) * ldq;
#pragma unroll
      for (int mp = 0; mp < NMAP; ++mp)
#pragma unroll
          for (int c = 0; c < NC; ++c) qf[mp][c] = *(const bf16x8*)(qrow + mp * DKM + 16 * c + 8 * hi); }
    f32x16 o[NMAP][NDB], negm[NMAP]; float lrow[NMAP];
#pragma unroll
    for (int mp = 0; mp < NMAP; ++mp) { lrow[mp] = 0.f;
#pragma unroll
        for (int r = 0; r < 16; ++r) negm[mp][r] = 0.f;
#pragma unroll
        for (int db = 0; db < NDB; ++db)
#pragma unroll
            for (int r = 0; r < 16; ++r) o[mp][db][r] = 0.f; }
    u32x4 kreg[K0N], k1reg = {0u, 0u, 0u, 0u}, vreg[VN];
#define ATT_GLOAD(t) do { \
    _Pragma("unroll") for (int i = 0; i < K0N; ++i) { const int idx = tid + 512 * i, rr = idx / K0C, cc = idx % K0C; kreg[i] = *(const u32x4*)(K0 + (size_t)(64 * (t) + rr) * ldk0 + cc * 8); } \
    if (W1 > 0) { if (tid < 64 * K1C) { const int rr = tid / (K1C > 0 ? K1C : 1), cc = tid % (K1C > 0 ? K1C : 1); k1reg = *(const u32x4*)(K1 + (size_t)(64 * (t) + rr) * ldk1 + cc * 8); } } \
    _Pragma("unroll") for (int i = 0; i < VN; ++i) { const int idx = tid + 512 * i, dd = idx >> 3, cc = idx & 7; vreg[i] = *(const u32x4*)(Vt + (size_t)dd * ldv + 64 * (t) + cc * 8); } } while (0)
#define ATT_LWRITE(buf) do { \
    _Pragma("unroll") for (int i = 0; i < K0N; ++i) { const int idx = tid + 512 * i, rr = idx / K0C, cc = idx % K0C; *(LAS u32x4*)(Kb + (buf) * KBUF + rr * KS + cc * 16) = kreg[i]; } \
    if (W1 > 0) { if (tid < 64 * K1C) { const int rr = tid / (K1C > 0 ? K1C : 1), cc = tid % (K1C > 0 ? K1C : 1); *(LAS u32x4*)(Kb + (buf) * KBUF + rr * KS + W0 * 2 + cc * 16) = k1reg; } } \
    _Pragma("unroll") for (int i = 0; i < VN; ++i) { const int idx = tid + 512 * i, dd = idx >> 3, cc = idx & 7; LAS u32x2* vp = (LAS u32x2*)(Vb + (buf) * VBUF + dd * VS + cc * 16); \
        u32x2 lo_; lo_.x = vreg[i].x; lo_.y = vreg[i].y; u32x2 hi_; hi_.x = vreg[i].z; hi_.y = vreg[i].w; vp[0] = lo_; vp[1] = hi_; } } while (0)
    ATT_GLOAD(0);
    ATT_LWRITE(0);
    __syncthreads();
    const int qw0 = q0 + wid * 32;
    for (int t = 0; t < NT; ++t) {
        const int buf = t & 1;
        if (t + 1 < NT) ATT_GLOAD(t + 1);
        const int kvt = 64 * t;
        if (kvt <= qw0) {
            const bool band = (kvt + 63 > qw0);
#pragma unroll
            for (int mp = 0; mp < NMAP; ++mp) {
                f32x16 s0, s1;
#pragma unroll
                for (int c = 0; c < NC; ++c) {
                    const bf16x8 kf0 = *(const LAS bf16x8*)(Kb + buf * KBUF + r32 * KS + (mp * DKM + 16 * c + 8 * hi) * 2);
                    const bf16x8 kf1 = *(const LAS bf16x8*)(Kb + buf * KBUF + (32 + r32) * KS + (mp * DKM + 16 * c + 8 * hi) * 2);
                    if (c == 0) { s0 = __builtin_amdgcn_mfma_f32_32x32x16_bf16(kf0, qf[mp][0], negm[mp], 0, 0, 0); s1 = __builtin_amdgcn_mfma_f32_32x32x16_bf16(kf1, qf[mp][0], negm[mp], 0, 0, 0); }
                    else { s0 = __builtin_amdgcn_mfma_f32_32x32x16_bf16(kf0, qf[mp][c], s0, 0, 0, 0); s1 = __builtin_amdgcn_mfma_f32_32x32x16_bf16(kf1, qf[mp][c], s1, 0, 0, 0); }
                }
                asm volatile("s_nop 15\n\ts_nop 7" : "+v"(s0), "+v"(s1));
                if (band) {
                    const int qd = qw0 + r32 - kvt;
#pragma unroll
                    for (int r = 0; r < 16; ++r) { const int kv = crow(r, hi); if (kv > qd) s0[r] = -INFINITY; if (kv + 32 > qd) s1[r] = -INFINITY; }
                }
                float mx = rowmax32(s0, s1);
                mx = fmaxf(mx, __shfl_xor(mx, 32));
                if (__any(t == 0 || mx > 8.0f)) {
                    const float dl = (t == 0) ? mx : fmaxf(mx, 0.f), alpha = fast_exp2(-dl);
                    lrow[mp] *= alpha;
#pragma unroll
                    for (int r = 0; r < 16; ++r) { s0[r] -= dl; s1[r] -= dl; negm[mp][r] -= dl; }
#pragma unroll
                    for (int db = 0; db < NDB; ++db)
#pragma unroll
                        for (int r = 0; r < 16; ++r) o[mp][db][r] *= alpha;
                }
                float ls = 0.f;
#pragma unroll
                for (int kb = 0; kb < 2; ++kb) {
                    f32x16& s = kb ? s1 : s0;
                    bf16x8 vf[NDB][2];
#pragma unroll
                    for (int db = 0; db < NDB; ++db)
#pragma unroll
                        for (int j = 0; j < 2; ++j) { const LAS unsigned char* vp = Vb + buf * VBUF + (32 * db + r32) * VS + (32 * kb + 16 * j + 4 * hi) * 2;
                            const s16x4 lo = *(const LAS s16x4*)vp, hh = *(const LAS s16x4*)(vp + 16);
                            vf[db][j] = (bf16x8){lo[0], lo[1], lo[2], lo[3], hh[0], hh[1], hh[2], hh[3]}; }
#pragma unroll
                    for (int r = 0; r < 16; ++r) s[r] = fast_exp2(s[r]);
                    asm volatile("s_nop 1" : "+v"(s));
#pragma unroll
                    for (int r = 0; r < 16; ++r) ls = fadd_s(ls, s[r]);
                    bf16x8 pa[2];
#pragma unroll
                    for (int j = 0; j < 2; ++j) { u32x4 w; w.x = cvtpk(s[8 * j + 0], s[8 * j + 1]); w.y = cvtpk(s[8 * j + 2], s[8 * j + 3]); w.z = cvtpk(s[8 * j + 4], s[8 * j + 5]); w.w = cvtpk(s[8 * j + 6], s[8 * j + 7]); pa[j] = __builtin_bit_cast(bf16x8, w); }
#pragma unroll
                    for (int db = 0; db < NDB; ++db)
#pragma unroll
                        for (int j = 0; j < 2; ++j) o[mp][db] = __builtin_amdgcn_mfma_f32_32x32x16_bf16(vf[db][j], pa[j], o[mp][db], 0, 0, 0);
                }
                lrow[mp] += ls;
                if (NMAP > 1) __builtin_amdgcn_sched_barrier(0);
            }
        }
        if (t + 1 < NT) ATT_LWRITE(buf ^ 1);
        __syncthreads();
    }
#undef ATT_GLOAD
#undef ATT_LWRITE
    float inv[NMAP];
#pragma unroll
    for (int mp = 0; mp < NMAP; ++mp) { const float lt = lrow[mp] + __shfl_xor(lrow[mp], 32); inv[mp] = 1.0f / lt; }
    bf16_t* orow = O + (size_t)(q0 + wid * 32 + r32) * ldo;
    if constexpr (NMAP == 1) {
#pragma unroll
        for (int db = 0; db < NDB; ++db)
#pragma unroll
            for (int g = 0; g < 4; ++g) { f32x4 v; for (int i = 0; i < 4; ++i) v[i] = o[0][db][4 * g + i] * inv[0]; store4bf(orow + 32 * db + 8 * g + 4 * hi, v); }
    } else {
        float ss = 0.f;
#pragma unroll
        for (int db = 0; db < NDB; ++db)
#pragma unroll
            for (int r = 0; r < 16; ++r) { const float v = o[0][db][r] * inv[0] - lam * (o[1][db][r] * inv[1]); o[0][db][r] = v; ss += v * v; }
        ss += __shfl_xor(ss, 32);
        const float rstd = __builtin_amdgcn_rsqf(ss * (1.0f / DV) + NORM_EPS) * outscale;
#pragma unroll
        for (int db = 0; db < NDB; ++db)
#pragma unroll
            for (int g = 0; g < 4; ++g) { const f32x4 gn = *(const f32x4*)(subln + 32 * db + 8 * g + 4 * hi); f32x4 v; for (int i = 0; i < 4; ++i) v[i] = o[0][db][4 * g + i] * rstd * gn[i]; store4bf(orow + 32 * db + 8 * g + 4 * hi, v); }
    }
}

template <int DKM, int DV, int W0, int W1>
__device__ __forceinline__ void attn_unit4(LAS unsigned char* lds, const bf16_t* __restrict__ Q, int ldq, const bf16_t* __restrict__ K0, int ldk0, const bf16_t* __restrict__ K1, int ldk1,
                                           const bf16_t* __restrict__ Vt, size_t ldv, int q0, int NT, bf16_t* O, int ldo) {
    constexpr int KS = DKM * 2 + 16, VS = 136, KBUF = 64 * KS, VBUF = DV * VS, QROW = DKM * 2 + 16;
    constexpr int NC = DKM / 16, NDB = DV / 32;
    constexpr int K0C = W0 / 8, K0N = (64 * K0C) / 512, K1C = W1 / 8, VN = (DV * 8) / 512;
    static_assert(W0 + W1 == DKM && K0N >= 1 && VN >= 1 && K1C >= 1, "attention staging geometry");
    static_assert(2 * KBUF + 2 * VBUF + 8 * 64 * QROW <= LDS_BYTES - 16, "attention LDS budget");
    int tid = threadIdx.x; asm volatile("" : "+v"(tid));
    const int lane = tid & 63, wid = __builtin_amdgcn_readfirstlane(tid >> 6), r32 = lane & 31, hi = lane >> 5;
    LAS unsigned char* Kb = lds; LAS unsigned char* Vb = lds + 2 * KBUF;
    LAS unsigned char* Qs = lds + 2 * KBUF + 2 * VBUF + wid * (64 * QROW) + r32 * QROW + 16 * hi;
#pragma unroll
    for (int rb = 0; rb < 2; ++rb) { const bf16_t* qrow = Q + (size_t)(q0 + wid * 64 + rb * 32 + r32) * ldq;
#pragma unroll
        for (int c = 0; c < NC; ++c) *(LAS bf16x8*)(Qs + rb * 32 * QROW + c * 32) = *(const bf16x8*)(qrow + 16 * c + 8 * hi); }
    f32x16 o[2][NDB], negm[2]; float lrow[2] = {0.f, 0.f};
#pragma unroll
    for (int rb = 0; rb < 2; ++rb) {
#pragma unroll
        for (int r = 0; r < 16; ++r) negm[rb][r] = 0.f;
#pragma unroll
        for (int db = 0; db < NDB; ++db)
#pragma unroll
            for (int r = 0; r < 16; ++r) o[rb][db][r] = 0.f; }
    u32x4 kreg[K0N], k1reg = {0u, 0u, 0u, 0u}, vreg[VN];
#define A4_GLOAD(t) do { \
    _Pragma("unroll") for (int i = 0; i < K0N; ++i) { const int idx = tid + 512 * i, rr = idx / K0C, cc = idx % K0C; kreg[i] = *(const u32x4*)(K0 + (size_t)(64 * (t) + rr) * ldk0 + cc * 8); } \
    if (tid < 64 * K1C) { const int rr = tid / K1C, cc = tid % K1C; k1reg = *(const u32x4*)(K1 + (size_t)(64 * (t) + rr) * ldk1 + cc * 8); } \
    _Pragma("unroll") for (int i = 0; i < VN; ++i) { const int idx = tid + 512 * i, dd = idx >> 3, cc = idx & 7; vreg[i] = *(const u32x4*)(Vt + (size_t)dd * ldv + 64 * (t) + cc * 8); } } while (0)
#define A4_LWRITE(buf) do { \
    _Pragma("unroll") for (int i = 0; i < K0N; ++i) { const int idx = tid + 512 * i, rr = idx / K0C, cc = idx % K0C; *(LAS u32x4*)(Kb + (buf) * KBUF + rr * KS + cc * 16) = kreg[i]; } \
    if (tid < 64 * K1C) { const int rr = tid / K1C, cc = tid % K1C; *(LAS u32x4*)(Kb + (buf) * KBUF + rr * KS + W0 * 2 + cc * 16) = k1reg; } \
    _Pragma("unroll") for (int i = 0; i < VN; ++i) { const int idx = tid + 512 * i, dd = idx >> 3, cc = idx & 7; LAS u32x2* vp = (LAS u32x2*)(Vb + (buf) * VBUF + dd * VS + cc * 16); \
        u32x2 lo_; lo_.x = vreg[i].x; lo_.y = vreg[i].y; u32x2 hi_; hi_.x = vreg[i].z; hi_.y = vreg[i].w; vp[0] = lo_; vp[1] = hi_; } } while (0)
    A4_GLOAD(0);
    A4_LWRITE(0);
    __syncthreads();
    const int qw0 = q0 + wid * 64;
    for (int t = 0; t < NT; ++t) {
        const int buf = t & 1;
        if (t + 1 < NT) A4_GLOAD(t + 1);
        const int kvt = 64 * t;
        if (kvt <= qw0) {
            const bool band = (kvt == qw0);
            f32x16 s[2][2];
#pragma unroll
            for (int c = 0; c < NC; ++c) {
                const bf16x8 kf0 = *(const LAS bf16x8*)(Kb + buf * KBUF + r32 * KS + (16 * c + 8 * hi) * 2);
                const bf16x8 kf1 = *(const LAS bf16x8*)(Kb + buf * KBUF + (32 + r32) * KS + (16 * c + 8 * hi) * 2);
#pragma unroll
                for (int rb = 0; rb < 2; ++rb) { const bf16x8 qv = *(const LAS bf16x8*)(Qs + rb * 32 * QROW + c * 32);
                    if (c == 0) { s[rb][0] = __builtin_amdgcn_mfma_f32_32x32x16_bf16(kf0, qv, negm[rb], 0, 0, 0); s[rb][1] = __builtin_amdgcn_mfma_f32_32x32x16_bf16(kf1, qv, negm[rb], 0, 0, 0); }
                    else { s[rb][0] = __builtin_amdgcn_mfma_f32_32x32x16_bf16(kf0, qv, s[rb][0], 0, 0, 0); s[rb][1] = __builtin_amdgcn_mfma_f32_32x32x16_bf16(kf1, qv, s[rb][1], 0, 0, 0); } }
            }
            asm volatile("s_nop 15\n\ts_nop 7" : "+v"(s[0][0]), "+v"(s[0][1]), "+v"(s[1][0]), "+v"(s[1][1]));
#pragma unroll
            for (int rb = 0; rb < 2; ++rb) {
                f32x16& s0 = s[rb][0]; f32x16& s1 = s[rb][1];
                if (band) {
                    const int qd = 32 * rb + r32;
#pragma unroll
                    for (int r = 0; r < 16; ++r) { const int kv = crow(r, hi); if (kv > qd) s0[r] = -INFINITY; if (kv + 32 > qd) s1[r] = -INFINITY; }
                }
                float mx = rowmax32(s0, s1);
                mx = half_max(mx);
                if (__any(t == 0 || mx > 8.0f)) {
                    const float dl = (t == 0) ? mx : fmaxf(mx, 0.f), alpha = fast_exp2(-dl);
                    lrow[rb] *= alpha;
#pragma unroll
                    for (int r = 0; r < 16; ++r) { s0[r] -= dl; s1[r] -= dl; negm[rb][r] -= dl; }
#pragma unroll
                    for (int db = 0; db < NDB; ++db)
#pragma unroll
                        for (int r = 0; r < 16; ++r) o[rb][db][r] *= alpha;
                }
            }
#pragma unroll
            for (int kb = 0; kb < 2; ++kb) {
                bf16x8 vf[NDB][2];
#pragma unroll
                for (int db = 0; db < NDB; ++db)
#pragma unroll
                    for (int j = 0; j < 2; ++j) { const LAS unsigned char* vp = Vb + buf * VBUF + (32 * db + r32) * VS + (32 * kb + 16 * j + 4 * hi) * 2;
                        const s16x4 lo = *(const LAS s16x4*)vp, hh = *(const LAS s16x4*)(vp + 16);
                        vf[db][j] = (bf16x8){lo[0], lo[1], lo[2], lo[3], hh[0], hh[1], hh[2], hh[3]}; }
#pragma unroll
                for (int rb = 0; rb < 2; ++rb) {
                    f32x16& sv = s[rb][kb]; float ls = 0.f;
#pragma unroll
                    for (int r = 0; r < 16; ++r) sv[r] = fast_exp2(sv[r]);
                    asm volatile("s_nop 1" : "+v"(sv));
#pragma unroll
                    for (int r = 0; r < 16; ++r) ls = fadd_s(ls, sv[r]);
                    lrow[rb] += ls;
                    bf16x8 pa[2];
#pragma unroll
                    for (int j = 0; j < 2; ++j) { u32x4 w; w.x = cvtpk(sv[8 * j + 0], sv[8 * j + 1]); w.y = cvtpk(sv[8 * j + 2], sv[8 * j + 3]); w.z = cvtpk(sv[8 * j + 4], sv[8 * j + 5]); w.w = cvtpk(sv[8 * j + 6], sv[8 * j + 7]); pa[j] = __builtin_bit_cast(bf16x8, w); }
#pragma unroll
                    for (int db = 0; db < NDB; ++db)
#pragma unroll
                        for (int j = 0; j < 2; ++j) o[rb][db] = __builtin_amdgcn_mfma_f32_32x32x16_bf16(vf[db][j], pa[j], o[rb][db], 0, 0, 0);
                }
            }
        }
        if (t + 1 < NT) A4_LWRITE(buf ^ 1);
        __syncthreads();
    }
#undef A4_GLOAD
#undef A4_LWRITE
#pragma unroll
    for (int rb = 0; rb < 2; ++rb) {
        const float inv = 1.0f / half_sum(lrow[rb]);
        bf16_t* orow = O + (size_t)(q0 + wid * 64 + rb * 32 + r32) * ldo;
#pragma unroll
        for (int db = 0; db < NDB; ++db)
#pragma unroll
            for (int g = 0; g < 4; ++g) { f32x4 v; for (int i = 0; i < 4; ++i) v[i] = o[rb][db][4 * g + i] * inv; store4bf(orow + 32 * db + 8 * g + 4 * hi, v); }
    }
}

__device__ __forceinline__ float wave_sum(float v) {
#pragma unroll
    for (int o = 1; o < 64; o <<= 1) v += __shfl_xor(v, o);
    return v;
}
__device__ __forceinline__ void transpose_block(const float* __restrict__ W, int ldw, int src_col0, const float* __restrict__ gain, bf16_t* WT, int K, int dst_row0, int k0, LAS float* scr, int lane) {
    float wv[32];
#pragma unroll
    for (int i = 0; i < 32; ++i) wv[i] = W[(size_t)(k0 + 2 * i + (lane >> 5)) * ldw + src_col0 + (lane & 31)];
#pragma unroll
    for (int i = 0; i < 32; ++i) { const int kk = 2 * i + (lane >> 5); float v = wv[i]; if (gain) v *= gain[k0 + kk]; scr[kk * 33 + (lane & 31)] = v; }
    asm volatile("s_waitcnt lgkmcnt(0)" ::: "memory");
    const int c = lane & 7;
#pragma unroll
    for (int j = 0; j < 4; ++j) { const int n = (lane >> 3) + 8 * j; const LAS float* s = scr + (8 * c) * 33 + n;
        u32x4 ov; ov.x = cvtpk(s[0 * 33], s[1 * 33]); ov.y = cvtpk(s[2 * 33], s[3 * 33]); ov.z = cvtpk(s[4 * 33], s[5 * 33]); ov.w = cvtpk(s[6 * 33], s[7 * 33]);
        *(u32x4*)(WT + (size_t)(dst_row0 + n) * K + k0 + 8 * c) = ov; }
    asm volatile("s_waitcnt lgkmcnt(0)" ::: "memory");
}

#define XB_TMO      128
#define XB_XCNT(j)  (256  + 64 * (j))
#define XB_XSUB(j)  (1280 + 64 * (j))
#define XB_XGEN(j)  (2304 + 64 * (j))
#define XB_TOP      3328
#define XB_TOPGEN   3392
#define XCD_BAR_WORDS 3456
#define XB_SPIN_CAP (1u << 18)

__device__ __forceinline__ unsigned xb_ld(unsigned* p)              { return __hip_atomic_load(p, __ATOMIC_RELAXED, __HIP_MEMORY_SCOPE_AGENT); }
__device__ __forceinline__ unsigned xb_add(unsigned* p, unsigned v) { return __hip_atomic_fetch_add(p, v, __ATOMIC_RELAXED, __HIP_MEMORY_SCOPE_AGENT); }
__device__ __forceinline__ unsigned xb_xcc_id() { return (unsigned)__builtin_amdgcn_s_getreg((3 << 11) | 20) & 0xFu; }
#define XB_SPIN(cond, bar) do { unsigned _sp = 0; while (cond) { __builtin_amdgcn_s_sleep(1); \
    if ((++_sp & 255u) == 0u) { if (xb_ld(&(bar)[XB_TMO])) break; if (_sp > XB_SPIN_CAP) { atomicAdd(&(bar)[XB_TMO], 1u); break; } } } } while (0)

struct XcdBarrier {
    unsigned* bar; unsigned x;
    volatile LAS unsigned* st;
};

__device__ __forceinline__ XcdBarrier xcd_barrier_post(unsigned* bar, volatile LAS unsigned* st) {
    XcdBarrier b; b.bar = bar; b.x = xb_xcc_id(); b.st = st;
    if (threadIdx.x == 0) (void)xb_add(&bar[XB_XCNT(b.x)], 1u);
    return b;
}
__device__ __forceinline__ void xcd_barrier_complete(unsigned* bar, unsigned x, unsigned& nloc, unsigned& nx) {
    const unsigned G = gridDim.x * gridDim.y * gridDim.z;
    unsigned sum, cnt, mine, sp = 0u;
    for (;;) {
        sum = 0u; cnt = 0u; mine = 0u;
#pragma unroll
        for (unsigned j = 0; j < 16; ++j) { const unsigned c = xb_ld(&bar[XB_XCNT(j)]); sum += c; cnt += (c > 0u) ? 1u : 0u; mine = (j == x) ? c : mine; }
        if (sum == G) break;
        __builtin_amdgcn_s_sleep(1);
        if ((++sp & 255u) == 0u) { if (xb_ld(&bar[XB_TMO])) break; if (sp > XB_SPIN_CAP) { atomicAdd(&bar[XB_TMO], 1u); break; } }
    }
    nloc = mine > 0u ? mine : 1u; nx = cnt > 0u ? cnt : 1u;
}

__device__ __forceinline__ void xcd_barrier(const XcdBarrier& b) {
    asm volatile("s_waitcnt vmcnt(0)" ::: "memory");
    __syncthreads();
    if (threadIdx.x == 0) {
        unsigned* bar = b.bar;
        __builtin_amdgcn_s_waitcnt(0);
        unsigned nloc = b.st[0], nx = b.st[1];
        if (nloc == 0u) { xcd_barrier_complete(bar, b.x, nloc, nx); b.st[0] = nloc; b.st[1] = nx; }
        const unsigned old = xb_add(&bar[XB_XSUB(b.x)], 1u);
        const unsigned gen = old / nloc;
        if (old + 1u == (gen + 1u) * nloc) {
            __builtin_amdgcn_fence(__ATOMIC_RELEASE, "agent");
            asm volatile("s_waitcnt vmcnt(0)" ::: "memory");
            const unsigned og = xb_add(&bar[XB_TOP], 1u);
            const unsigned tg = og / nx;
            if (og + 1u == (tg + 1u) * nx) xb_add(&bar[XB_TOPGEN], 1u);
            else XB_SPIN(xb_ld(&bar[XB_TOPGEN]) == tg, bar);
            __builtin_amdgcn_fence(__ATOMIC_ACQUIRE, "agent");
            xb_add(&bar[XB_XGEN(b.x)], 1u);
            asm volatile("s_waitcnt vmcnt(0)" ::: "memory");
        } else {
            XB_SPIN(xb_ld(&bar[XB_XGEN(b.x)]) == gen, bar);
            __builtin_amdgcn_fence(__ATOMIC_ACQUIRE, "agent");
            asm volatile("s_waitcnt vmcnt(0)" ::: "memory");
        }
    }
    __syncthreads();
}


struct Args { const float* in[20]; float* out; unsigned char* ws; int ph_lo, ph_hi, coop, pad; float lam_init[4]; };

__global__ void __launch_bounds__(512, 2) hybrid_fwd(Args a) {
    extern __shared__ __attribute__((aligned(16))) unsigned char lds_raw[];
    LAS unsigned char* lds = (LAS unsigned char*)lds_raw;
    const float* x_in = a.in[0]; const float* mem = a.in[1]; const int* positions = (const int*)a.in[2];
    const float* norm_pre = a.in[3]; const float* norm_post = a.in[4]; const float* w_in = a.in[5]; const float* q_norm = a.in[6]; const float* w_uq = a.in[7];
    const float* kv_norm = a.in[8]; const float* w_ukv = a.in[9]; const float* lq1 = a.in[10]; const float* lk1 = a.in[11]; const float* lq2 = a.in[12]; const float* lk2 = a.in[13];
    const float* diff_subln = a.in[14]; const float* mem_norm = a.in[15]; const float* w_mem_kv = a.in[16]; const float* b_gate = a.in[17]; const float* w_branch = a.in[18]; const float* w_out = a.in[19];
#define P_WT ((bf16_t*)(ws + OFF_W))
#define P_COS ((float*)(ws + OFF_COS))
#define P_SIN ((float*)(ws + OFF_SIN))
#define P_SSQq ((float*)(ws + OFF_SSQQ))
#define P_SSQkv ((float*)(ws + OFF_SSQKV))
#define P_MN ((bf16_t*)(ws + OFF_MN))
#define P_KM ((bf16_t*)(ws + OFF_KM))
#define P_VMT ((bf16_t*)(ws + OFF_VMT))
#define P_XN ((bf16_t*)(ws + OFF_XN))
#define P_OB ((bf16_t*)(ws + OFF_O))
#define P_CQ ((bf16_t*)(ws + OFF_CQ))
#define P_CKV ((bf16_t*)(ws + OFF_CKV))
#define P_KPE ((bf16_t*)(ws + OFF_KPE))
#define P_QD ((bf16_t*)(ws + OFF_QD))
#define P_KD ((bf16_t*)(ws + OFF_KD))
#define P_VDT ((bf16_t*)(ws + OFF_VDT))
#define P_QX ((bf16_t*)(ws + OFF_QX))
#define P_QA ((bf16_t*)(ws + OFF_QA))
#define P_KN ((bf16_t*)(ws + OFF_KN))
#define P_VAT ((bf16_t*)(ws + OFF_VAT))
#define P_SB ((bf16_t*)(ws + OFF_S))
#define P_MG ((bf16_t*)(ws + OFF_MERGED))
#define P_OUTB ((float*)(ws + OFF_OUT))

    volatile LAS unsigned* bst = (volatile LAS unsigned*)(lds + LDS_BYTES - 16);
    if (threadIdx.x < 4) bst[threadIdx.x] = 0u;
    __syncthreads();
    XcdBarrier xbar; xbar.bar = (unsigned*)(a.ws + OFF_BAR); xbar.x = 0; xbar.st = bst;
    if (a.coop) xbar = xcd_barrier_post((unsigned*)(a.ws + OFF_BAR), bst);
    for (int ph = a.ph_lo; ph < a.ph_hi; ++ph) {
        __attribute__((address_space(1))) unsigned char* ws = (__attribute__((address_space(1))) unsigned char*)a.ws; asm volatile("" : "+s"(ws));
        int tid = threadIdx.x; asm volatile("" : "+v"(tid)); const int lane = tid & 63, wave = __builtin_amdgcn_readfirstlane(tid >> 6);
        int G = gridDim.x, bx = blockIdx.x; asm volatile("" : "+s"(G), "+s"(bx));
        const int vcu = (G % 8 == 0) ? (bx % 8) * (G / 8) + bx / 8 : bx;
        const int gw = vcu * 8 + wave, NGW = G * 8;
        if (ph == 0) {
#if PHSEL & 1
            LAS float* scr = (LAS float*)(lds + wave * 16384);
            constexpr int I_IN = 16 * 221, I_UQ = 4 * 24, I_UKV = 2 * 32, I_MEM = 16 * 32, I_BR = 3 * 256, I_OUT = 16 * 32;
            constexpr int I_L = I_IN + I_UQ + I_UKV + I_MEM + I_BR + I_OUT;
            for (int it = gw; it < DEPTH * I_L; it += NGW) {
                const int l = it / I_L; int r = it - l * I_L; bf16_t* wl = P_WT + (size_t)l * WL_TOTAL;
                if (r < I_IN) { const int kb = r / 221, nb = r - kb * 221, n = nb * 32; int dr;
                    if (n < 416) dr = n; else if (n < 1440) dr = n + 96; else if (n < 1952) dr = n - 1440 + 2048; else if (n < 2464) dr = n - 1952 + 1536; else dr = n + 96;
                    transpose_block(w_in + (size_t)l * 1024 * IN_WIDTH, IN_WIDTH, n, norm_pre + l * 1024, wl + WL_IN, 1024, dr, kb * 64, scr, lane); continue; }
                r -= I_IN;
                if (r < I_UQ) { const int kb = r / 24, nb = r - kb * 24, n = nb * 32, h = n / 96, w = n - h * 96; const int dr = (w < 64) ? h * 64 + w : 512 + h * 32 + (w - 64);
                    transpose_block(w_uq + (size_t)l * 256 * 768, 768, n, q_norm + l * 256, wl + WL_UQ, 256, dr, kb * 64, scr, lane); continue; }
                r -= I_UQ;
                if (r < I_UKV) { const int kb = r / 32, nb = r - kb * 32, n = nb * 32, h = n / 128, w = n - h * 128; const int dr = (w < 64) ? h * 64 + w : 512 + h * 64 + (w - 64);
                    transpose_block(w_ukv + (size_t)l * 128 * 1024, 1024, n, kv_norm + l * 128, wl + WL_UKV, 128, dr, kb * 64, scr, lane); continue; }
                r -= I_UKV;
                if (r < I_MEM) { const int kb = r / 32, nb = r - kb * 32;
                    transpose_block(w_mem_kv + (size_t)l * 1024 * 1024, 1024, nb * 32, mem_norm + l * 1024, wl + WL_MEM, 1024, nb * 32, kb * 64, scr, lane); continue; }
                r -= I_MEM;
                if (r < I_BR) { const int i = r / 256, rr = r - i * 256, kb = rr / 32, nb = rr - kb * 32;
                    transpose_block(w_branch + (size_t)(l * 3 + i) * 512 * 1024, 1024, nb * 32, nullptr, wl + WL_BR + (size_t)i * 1024 * 512, 512, nb * 32, kb * 64, scr, lane); continue; }
                r -= I_BR;
                { const int kb = r / 32, nb = r - kb * 32;
                    transpose_block(w_out + (size_t)l * 1024 * 1024, 1024, nb * 32, nullptr, wl + WL_OUT, 1024, nb * 32, kb * 64, scr, lane); }
            }
            for (int i = bx * 512 + tid; i < DEPTH * 96 * 1024 / 8; i += G * 512) { const int l = i / (96 * 1024 / 8), rr = i - l * (96 * 1024 / 8);
                *(u32x4*)(P_WT + (size_t)l * WL_TOTAL + WL_IN + (size_t)416 * 1024 + (size_t)rr * 8) = (u32x4){0u, 0u, 0u, 0u}; }
            for (int i = bx * 512 + tid; i < SEQ * 16; i += G * 512) { const int s = i >> 4, j = i & 15;
                const float invf = powf(10000.0f, -(float)j / 16.0f); const float ang = (float)positions[s] * invf;
                double rv = (double)ang * 0.15915494309189535; rv -= floor(rv); const float f = (float)rv;
                P_COS[i] = __builtin_amdgcn_cosf(f); P_SIN[i] = __builtin_amdgcn_sinf(f); }
            for (int m0 = gw; m0 < MMEM + MTOK; m0 += 2 * NGW) {
                const int m1 = (m0 + NGW < MMEM + MTOK) ? m0 + NGW : m0;
                f32x4 v[2][4]; float ss[2] = {0.f, 0.f};
#pragma unroll
                for (int q = 0; q < 2; ++q) { const int m = q ? m1 : m0; const float* src = (m < MMEM) ? mem + (size_t)m * 1024 : x_in + (size_t)(m - MMEM) * 1024;
#pragma unroll
                    for (int j = 0; j < 4; ++j) v[q][j] = ((const f32x4*)src)[64 * j + lane]; }
#pragma unroll
                for (int q = 0; q < 2; ++q)
#pragma unroll
                    for (int j = 0; j < 4; ++j) ss[q] += (v[q][j][0] * v[q][j][0] + v[q][j][1] * v[q][j][1]) + (v[q][j][2] * v[q][j][2] + v[q][j][3] * v[q][j][3]);
#pragma unroll
                for (int q = 0; q < 2; ++q) { const int m = q ? m1 : m0; bf16_t* dst = (m < MMEM) ? P_MN + (size_t)m * 1024 : P_XN + (size_t)(m - MMEM) * 1024;
                    const float rstd = __builtin_amdgcn_rsqf(wave_sum(ss[q]) * (1.0f / 1024.0f) + NORM_EPS);
#pragma unroll
                    for (int j = 0; j < 4; ++j) store4bf(dst + 4 * (64 * j + lane), v[q][j] * rstd); }
            }
#endif
        } else {
            const int l = (ph - 1) / 7, sub = (ph - 1) % 7;
            const bf16_t* wl = P_WT + (size_t)l * WL_TOTAL;
            if (sub == 0) {
#if PHSEL & 2
#if GSEL & 1
                { pg8::Gemm g{P_XN, wl + WL_IN, MTOK, 2048, 1024, 1024, 1024, 0, 0}; pg8::StaticOrder S; S.init(MTOK, 2048, G, bx);
                  pg8::Epi1 E{P_CQ, P_CKV, P_KPE, P_QD, P_KD, P_QX, P_SSQq, P_SSQkv, P_COS, P_SIN, 0.17677669529663687f * LOG2E, 0.08838834764831845f * LOG2E};
                  pg8::gemm_phase(lds, g, S, E); }
#endif
#if GSEL & 2
                { pg8::Gemm g{wl + WL_IN + (size_t)2048 * 1024, P_XN, 512, MTOK, 1024, 1024, 1024, 0, 0}; pg8::StaticOrder S; S.init(512, MTOK, G, bx);
                  pg8::EpiT E{P_VDT, (size_t)MTOK, 0, nullptr, 0.f, nullptr};
                  pg8::gemm_phase(lds, g, S, E); }
#endif
                if (l == 0) {
#if GSEL & 4
                    { pg8::Gemm g{P_MN, P_WT + WL_MEM, MMEM, 512, 1024, 1024, 1024, 0, WL_TOTAL}; pg8::StaticOrder S; S.init(MMEM, 512, G, bx, DEPTH);
                      pg8::EpiRow E{P_KM, 512, (size_t)MMEM * 512, nullptr, 0.f};
                      pg8::gemm_phase(lds, g, S, E); }
#endif
#if GSEL & 8
                    { pg8::Gemm g{P_WT + WL_MEM + (size_t)512 * 1024, P_MN, 512, MMEM, 1024, 1024, 1024, WL_TOTAL, 0}; pg8::StaticOrder S; S.init(512, MMEM, G, bx, DEPTH);
                      pg8::EpiT E{P_VMT, (size_t)MMEM, (size_t)512 * MMEM, nullptr, 0.f, nullptr};
                      pg8::gemm_phase(lds, g, S, E); }
#endif
                }
#endif
            } else if (sub == 1) {
#if PHSEL & 4
#if GSEL & 16
                { pg8::Gemm g{P_CQ, wl + WL_UQ, MTOK, 768, 256, 256, 256, 0, 0}; pg8::StaticOrder S; S.init(MTOK, 768, G, bx);
                  pg8::Epi2 E{P_QA, P_SSQq, P_COS, P_SIN, 0.10206207261596575f * LOG2E};
                  pg8::gemm_phase(lds, g, S, E); }
#endif
#if GSEL & 32
                { pg8::Gemm g{P_CKV, wl + WL_UKV, MTOK, 512, 128, 128, 128, 0, 0}; pg8::StaticOrder S; S.init(MTOK, 512, G, bx);
                  pg8::EpiRow E{P_KN, 512, 0, P_SSQkv, 1.0f / 128.0f};
                  pg8::gemm_phase(lds, g, S, E); }
#endif
#if GSEL & 64
                { pg8::Gemm g{wl + WL_UKV + (size_t)512 * 128, P_CKV, 512, MTOK, 128, 128, 128, 0, 0}; pg8::StaticOrder S; S.init(512, MTOK, G, bx);
                  pg8::EpiT E{P_VAT, (size_t)MTOK, 0, P_SSQkv, 1.0f / 128.0f, nullptr};
                  pg8::gemm_phase(lds, g, S, E); }
#endif
#endif
            } else if (sub == 2) {
#if PHSEL & 8
                const float d1 = wave_sum(lane < 32 ? lq1[l * 32 + lane] * lk1[l * 32 + lane] : 0.f), d2 = wave_sum(lane < 32 ? lq2[l * 32 + lane] * lk2[l * 32 + lane] : 0.f);
                const float lam_init = a.lam_init[l]; const float lam = expf(d1) - expf(d2) + lam_init;
#if ATTSEL & 1
                for (int P = vcu; P < 512; P += G) { const int bh = P >> 2, s = P & 3, b = bh >> 3, h = bh & 7; const size_t rb = (size_t)b * SEQ;
                    for (int k = 0; k < 2; ++k) { const int qb = k ? s : 7 - s;
                        attn_unit4<96, 64, 64, 32>(lds, P_QA + rb * 768 + h * 96, 768, P_KN + rb * 512 + h * 64, 512, P_KPE + rb * 32, 32, P_VAT + (size_t)(h * 64) * MTOK + rb, (size_t)MTOK,
                                                   qb * 512, 8 * (qb + 1), P_OB + rb * 1536 + h * 64, 1536); } }
#endif
                asm volatile("" ::: "memory"); __builtin_amdgcn_sched_barrier(0);
#if ATTSEL & 2
                for (int P = vcu; P < 1024; P += G) { const int bh = P >> 3, s = P & 7, b = bh >> 3, h = bh & 7; const size_t rb = (size_t)b * SEQ;
                    for (int k = 0; k < 2; ++k) { const int qb = k ? s : 15 - s;
                        attn_unit2<2, 32, 64, 64, 0>(lds, P_QD + rb * 512 + h * 64, 512, P_KD + rb * 512 + h * 64, 512, nullptr, 0, P_VDT + (size_t)(h * 64) * MTOK + rb, (size_t)MTOK,
                                                           qb * 256, 4 * (qb + 1), P_OB + rb * 1536 + 512 + h * 64, 1536, lam, diff_subln + l * 64, 1.0f - lam_init); } }
#endif
                asm volatile("" ::: "memory"); __builtin_amdgcn_sched_barrier(0);
#if ATTSEL & 4
                for (int X = vcu; X < 1024; X += G) { const int bh = X >> 4, qb = X & 15, b = bh >> 2, h = bh & 3; const size_t rb = (size_t)b * SEQ;
                    attn_unit<1, 128, 128, false, 128, 0>(lds, P_QX + rb * 512 + h * 128, 512, P_KM + (size_t)l * MMEM * 512 + (size_t)b * MEMT * 512 + h * 128, 512, nullptr, 0,
                                                           P_VMT + (size_t)l * 512 * MMEM + (size_t)(h * 128) * MMEM + (size_t)b * MEMT, (size_t)MMEM,
                                                           qb * 256, 4, P_OB + rb * 1536 + 1024 + h * 128, 1536, 0.f, nullptr, 1.f); }
#endif
#endif
            } else if (sub == 3) {
#if PHSEL & 16
                { pg8::Gemm g{P_XN, wl + WL_IN + (size_t)2560 * 1024, MTOK, 1536, 1024, 1024, 1024, 0, 0}; pg8::StaticOrder S; S.init(MTOK, 1536, G, bx);
                  pg8::EpiSG E{P_OB};
                  pg8::gemm_phase(lds, g, S, E); }
                { pg8::Gemm g{P_XN, wl + WL_IN + (size_t)4096 * 1024, MTOK, 3072, 1024, 1024, 1024, 0, 0}; pg8::StaticOrder S; S.init(MTOK, 3072, G, bx);
                  pg8::EpiGL E{P_SB, b_gate + l * 3072};
                  pg8::gemm_phase(lds, g, S, E); }
#endif
            } else if (sub == 4) {
#if PHSEL & 32
                pg8::Gemm g{P_OB, wl + WL_BR, MTOK, 1024, 512, 1536, 512, 512, (size_t)1024 * 512}; pg8::StaticOrder S; S.init(MTOK, 1024, G, bx, 3);
                pg8::EpiBR E{P_SB, P_MG};
                pg8::gemm_phase(lds, g, S, E);
#endif
            } else if (sub == 5) {
#if PHSEL & 64
                pg8::Gemm g{P_MG, wl + WL_OUT, MTOK, 1024, 1024, 1024, 1024, 0, 0}; pg8::StaticOrder S; S.init(MTOK, 1024, G, bx);
                pg8::EpiRow E{(bf16_t*)P_OUTB, 1024, 0, nullptr, 0.f};
                pg8::gemm_phase(lds, g, S, E);
#endif
            } else {
#if PHSEL & 128
                const float* xo = (l == 0) ? x_in : a.out; const float* gp = norm_post + l * 1024;
                for (int m0 = gw; m0 < MTOK; m0 += 2 * NGW) {
                    const int m1 = (m0 + NGW < MTOK) ? m0 + NGW : m0;
                    f32x4 v[2][4], xv[2][4]; float s[2] = {0.f, 0.f};
#pragma unroll
                    for (int q = 0; q < 2; ++q) { const int m = q ? m1 : m0;
#pragma unroll
                        for (int j = 0; j < 4; ++j) { v[q][j] = unpack4bf(((const u32x2*)((const bf16_t*)P_OUTB + (size_t)m * 1024))[64 * j + lane]); xv[q][j] = ((const f32x4*)(xo + (size_t)m * 1024))[64 * j + lane]; } }
#pragma unroll
                    for (int q = 0; q < 2; ++q)
#pragma unroll
                        for (int j = 0; j < 4; ++j) s[q] += (v[q][j][0] * v[q][j][0] + v[q][j][1] * v[q][j][1]) + (v[q][j][2] * v[q][j][2] + v[q][j][3] * v[q][j][3]);
#pragma unroll
                    for (int q = 0; q < 2; ++q) { const int m = q ? m1 : m0;
                        const float rstd = __builtin_amdgcn_rsqf(wave_sum(s[q]) * (1.0f / 1024.0f) + NORM_EPS); float s2 = 0.f;
#pragma unroll
                        for (int j = 0; j < 4; ++j) { const f32x4 gv = ((const f32x4*)gp)[64 * j + lane];
                            v[q][j] = xv[q][j] + v[q][j] * rstd * gv; ((f32x4*)(a.out + (size_t)m * 1024))[64 * j + lane] = v[q][j];
                            s2 += (v[q][j][0] * v[q][j][0] + v[q][j][1] * v[q][j][1]) + (v[q][j][2] * v[q][j][2] + v[q][j][3] * v[q][j][3]); }
                        if (l + 1 < DEPTH) { const float rstd2 = __builtin_amdgcn_rsqf(wave_sum(s2) * (1.0f / 1024.0f) + NORM_EPS);
#pragma unroll
                            for (int j = 0; j < 4; ++j) store4bf(P_XN + (size_t)m * 1024 + 4 * (64 * j + lane), v[q][j] * rstd2); } }
                }
#endif
            }
        }
        if (ph + 1 < a.ph_hi) { if (a.coop) { if (ph == 0) cg::this_grid().sync(); else xcd_barrier(xbar); } }
    }
#ifdef DBG_NPH
    if (a.pad) {
        if (a.coop) cg::this_grid().sync();
        const unsigned short* w16 = (const unsigned short*)(a.ws + OFF_MN);
        const size_t n16 = (WS_END - OFF_MN) / 2, nout = (size_t)MTOK * 1024;
        for (size_t i = (size_t)blockIdx.x * 512 + threadIdx.x; i < nout; i += (size_t)gridDim.x * 512) {
            unsigned x = 0; for (size_t k = i; k < n16; k += nout) x ^= w16[k];
            const unsigned short* w2 = (const unsigned short*)(a.ws + OFF_COS); if (i < (size_t)(4 * MiB) / 2) x ^= w2[i];
            a.out[i] = (float)x;
        }
    }
#endif
}

extern "C" void kernel_launch(void* const* d_in, const int* in_sizes, int n_in, void* d_out, int out_size, void* d_ws, size_t ws_size, hipStream_t stream) {
    static int grid = 0;
    if (grid == 0) {
        if (n_in != 20 || ws_size < WS_END) { fprintf(stderr, "kernel_launch: need 20 inputs and >= %zu bytes of workspace (got %d, %zu)\n", (size_t)WS_END, n_in, ws_size); grid = -1; return; }
        int dev = 0, cus = 0, per_cu = 0;
        hipGetDevice(&dev); hipDeviceGetAttribute(&cus, hipDeviceAttributeMultiprocessorCount, dev);
        if (hipFuncSetAttribute((const void*)hybrid_fwd, hipFuncAttributeMaxDynamicSharedMemorySize, LDS_BYTES) != hipSuccess) { fprintf(stderr, "kernel_launch: hipFuncSetAttribute failed\n"); grid = -1; return; }
        if (hipOccupancyMaxActiveBlocksPerMultiprocessor(&per_cu, (const void*)hybrid_fwd, 512, LDS_BYTES) != hipSuccess || per_cu < 1) per_cu = 1;
        (void)hipGetLastError();
        grid = cus * 1;
    }
    if (grid < 0) return;
    if (hipMemsetAsync((char*)d_ws + OFF_BAR, 0, 16384, stream) != hipSuccess) { fprintf(stderr, "kernel_launch: hipMemsetAsync failed\n"); return; }
    Args a{};
    for (int i = 0; i < 20; ++i) a.in[i] = (const float*)d_in[i];
    a.out = (float*)d_out; a.ws = (unsigned char*)d_ws; a.pad = 0;
    a.lam_init[0] = 0.2f; a.lam_init[1] = 0.35550906759096926f; a.lam_init[2] = 0.47071301834358424f; a.lam_init[3] = 0.55605820415654f;
#if MK_ONE_LAUNCH
#ifdef DBG_NPH
    a.ph_lo = 0; a.ph_hi = DBG_NPH; a.coop = 1; a.pad = 1;
#else
    a.ph_lo = 0; a.ph_hi = NPHASE; a.coop = 1;
#endif
    void* args[] = {&a};
    hipError_t e = hipLaunchCooperativeKernel((const void*)hybrid_fwd, dim3(grid), dim3(512), args, LDS_BYTES, stream);
    if (e != hipSuccess) fprintf(stderr, "cooperative launch failed: %s (grid %d)\n", hipGetErrorString(e), grid);
#else
    for (int ph = 0; ph < NPHASE; ++ph) { a.ph_lo = ph; a.ph_hi = ph + 1; a.coop = 0;
        hipLaunchKernelGGL(hybrid_fwd, dim3(grid), dim3(512), LDS_BYTES, stream, a); }
#endif
}
```
